# Optimizing an MI355X kernel written in HIP

```python
import jax, jax.numpy as jnp
from jax import lax
import numpy as np

D_MODEL = 2048
BATCH = 4
SEQ = 2048
DEPTH = 2

CHUNK = 64
N_HEADS = 16
HEAD_DIM = 128
N_KV_HEADS = 4
HEADS_PER_KV = N_HEADS // N_KV_HEADS
IDX_HEADS = 16
IDX_DIM = 64
TOPK_MAX = 256
ROPE_THETA = 10000.0
POOL_WINDOWS = (2, 4, 8, 16)
POOL_W = D_MODEL
POOL_GROUP = POOL_W // len(POOL_WINDOWS)
LRU_W = D_MODEL
LRU_BLOCKS = 16
LRU_BLOCK = LRU_W // LRU_BLOCKS
CONV_WIDTH = 4
LRU_C = 8.0
ATTN_W = N_HEADS * HEAD_DIM
KV_W = N_KV_HEADS * HEAD_DIM
MIX_W = ATTN_W + POOL_W + LRU_W
IN_SPLITS = (ATTN_W, KV_W, KV_W, IDX_HEADS * IDX_DIM, IDX_DIM, IDX_HEADS,
             POOL_W, LRU_W, LRU_W, MIX_W)
IN_COLS = sum(IN_SPLITS)
IN_OFFSETS = tuple(int(v) for v in np.cumsum(IN_SPLITS)[:-1])
D_FF = 5504
N_EXPERTS = 8
TOP_K = 2
D_EXPERT = 7168
MOE_BLOCK = 128
N_DENSE = (DEPTH + 1) // 2
N_MOE = DEPTH // 2
ALPHA = (2 * DEPTH) ** 0.25
BETA = (8 * DEPTH) ** -0.25
LN_EPS = 1e-5

kernel_name = "chunk_causal_hybrid_dsa_pool_rglru_moe"


def layer_norm(x, g, b):
    xf = x.astype(jnp.float32)
    mu = jnp.mean(xf, axis=-1, keepdims=True)
    var = jnp.mean(jnp.square(xf - mu), axis=-1, keepdims=True)
    y = (xf - mu) * lax.rsqrt(var + LN_EPS) * g.astype(jnp.float32) + b.astype(jnp.float32)
    return y.astype(x.dtype)


def rope_tables(positions, dim):
    inv = ROPE_THETA ** (-jnp.arange(0, dim, 2, dtype=jnp.float32) / dim)
    ang = positions.astype(jnp.float32)[..., None] * inv
    return jnp.cos(ang)[:, :, None, :], jnp.sin(ang)[:, :, None, :]


def apply_rope(x, cos, sin):
    half = x.shape[-1] // 2
    x1 = x[..., :half].astype(jnp.float32)
    x2 = x[..., half:].astype(jnp.float32)
    return jnp.concatenate([x1 * cos - x2 * sin, x2 * cos + x1 * sin], axis=-1).astype(x.dtype)


def dsa_attention(q, k, v, qi, ki, wi):
    B, S = q.shape[0], q.shape[1]
    n_blk = S // CHUNK
    topk = min(TOPK_MAX, S // 4)
    key_pos = jnp.arange(S)
    wi = wi * (IDX_HEADS ** -0.5)

    def to_blocks(t):
        return jnp.swapaxes(t.reshape((B, n_blk, CHUNK) + t.shape[2:]), 0, 1)

    def one_chunk(args):
        q_b, qi_b, wi_b, blk = args
        limit = (blk + 1) * CHUNK
        s_idx = jnp.einsum('bqhd,bsd->bqhs', qi_b, ki) * (IDX_DIM ** -0.5)
        score = jnp.einsum('bqh,bqhs->bqs', wi_b.astype(jnp.float32),
                           jax.nn.relu(s_idx).astype(jnp.float32))
        score = jnp.where(key_pos < limit, score, -jnp.inf)
        _, sel = lax.top_k(score, topk)
        valid = sel < limit
        k_sel = jax.vmap(lambda kb, ib: kb[ib])(k, sel)
        v_sel = jax.vmap(lambda vb, ib: vb[ib])(v, sel)
        qg = q_b.reshape(B, CHUNK, N_KV_HEADS, HEADS_PER_KV, HEAD_DIM)
        logits = jnp.einsum('bqgrd,bqkgd->bqgrk', qg, k_sel).astype(jnp.float32) * (HEAD_DIM ** -0.5)
        logits = jnp.where(valid[:, :, None, None, :], logits, -jnp.inf)
        p = jax.nn.softmax(logits, axis=-1).astype(v.dtype)
        o = jnp.einsum('bqgrk,bqkgd->bqgrd', p, v_sel)
        return o.reshape(B, CHUNK, ATTN_W)

    out = lax.map(one_chunk, (to_blocks(q), to_blocks(qi), to_blocks(wi), jnp.arange(n_blk)))
    return jnp.swapaxes(out, 0, 1).reshape(B, S, ATTN_W)


def pool_mixer(p, pool_w, pool_scale):
    B, S, _ = p.shape
    pg = p.reshape(B, S, len(POOL_WINDOWS), POOL_GROUP)
    pf = pg.astype(jnp.float32)
    csum = jnp.cumsum(pf, axis=1)
    t = jnp.arange(S)
    means = []
    for g, win in enumerate(POOL_WINDOWS):
        c = csum[:, :, g]
        prev = jnp.pad(c, ((0, 0), (win, 0), (0, 0)))[:, :S]
        cnt = jnp.minimum(t + 1, win).astype(jnp.float32)[None, :, None]
        means.append((c - prev) / cnt)
    diff = (jnp.stack(means, axis=2) - pf).astype(p.dtype)
    y = jnp.einsum('bsgc,gcd->bsgd', diff, pool_w).reshape(B, S, POOL_W)
    return y * pool_scale


def rglru_mixer(xr, gr, conv_w, conv_b, wa, ba, wx, bx, lam):
    B, S, _ = xr.shape
    xp = jnp.pad(xr, ((0, 0), (CONV_WIDTH - 1, 0), (0, 0)))
    xc = conv_b
    for tap in range(CONV_WIDTH):
        xc = xc + xp[:, tap:tap + S] * conv_w[tap]
    xb = xc.reshape(B, S, LRU_BLOCKS, LRU_BLOCK)
    r = jax.nn.sigmoid(jnp.einsum('bsni,nij->bsnj', xb, wa).reshape(B, S, LRU_W) + ba)
    i = jax.nn.sigmoid(jnp.einsum('bsni,nij->bsnj', xb, wx).reshape(B, S, LRU_W) + bx)
    log_a = -LRU_C * r.astype(jnp.float32) * jax.nn.softplus(-lam.astype(jnp.float32))
    a = jnp.exp(log_a)
    b_in = jnp.sqrt(-jnp.expm1(2.0 * log_a)) * (i * xc).astype(jnp.float32)

    def combine(left, right):
        a1, b1 = left
        a2, b2 = right
        return a1 * a2, a2 * b1 + b2

    _, h = lax.associative_scan(combine, (a, b_in), axis=1)
    return h.astype(xr.dtype) * jax.nn.gelu(gr)


def hybrid_mixer(x, cos_a, sin_a, cos_i, sin_i, w_in, w_out, pool_w, pool_scale,
                 conv_w, conv_b, wa, ba, wx, bx, lam):
    B, S, _ = x.shape
    proj = jnp.einsum('bsd,dc->bsc', x, w_in)
    q, k, v, qi, ki, wi, p, xr, gr, gates = jnp.split(proj, IN_OFFSETS, axis=-1)
    q = apply_rope(q.reshape(B, S, N_HEADS, HEAD_DIM), cos_a, sin_a)
    k = apply_rope(k.reshape(B, S, N_KV_HEADS, HEAD_DIM), cos_a, sin_a)
    v = v.reshape(B, S, N_KV_HEADS, HEAD_DIM)
    qi = apply_rope(qi.reshape(B, S, IDX_HEADS, IDX_DIM), cos_i, sin_i)
    ki = apply_rope(ki[:, :, None, :], cos_i, sin_i)[:, :, 0]
    y_a = dsa_attention(q, k, v, qi, ki, wi)
    y_b = pool_mixer(p, pool_w, pool_scale)
    y_c = rglru_mixer(xr, gr, conv_w, conv_b, wa, ba, wx, bx, lam)
    merged = jax.nn.sigmoid(gates) * jnp.concatenate([y_a, y_b, y_c], axis=-1)
    return jnp.einsum('bsc,cd->bsd', merged, w_out)


def swiglu(x, w_gate, w_up, w_down):
    h = jax.nn.silu(jnp.einsum('bsd,df->bsf', x, w_gate)) * jnp.einsum('bsd,df->bsf', x, w_up)
    return jnp.einsum('bsf,fd->bsd', h, w_down)


def moe_swiglu(x, w_router, w_gate, w_up, w_down):
    B, S, D = x.shape
    xt = x.reshape(-1, D)
    n = xt.shape[0]
    logits = jnp.einsum('nd,de->ne', xt.astype(jnp.float32), w_router.astype(jnp.float32))
    top_logit, top_e = lax.top_k(logits, TOP_K)
    top_w = jax.nn.softmax(top_logit, axis=-1)
    n_assign = n * TOP_K
    flat_e = top_e.reshape(-1)
    flat_w = top_w.reshape(-1)
    flat_tok = jnp.repeat(jnp.arange(n, dtype=jnp.int32), TOP_K)
    order = jnp.argsort(flat_e)
    se, st, sw = flat_e[order], flat_tok[order], flat_w[order]
    counts = jnp.bincount(flat_e, length=N_EXPERTS)
    padded = (counts + MOE_BLOCK - 1) // MOE_BLOCK * MOE_BLOCK
    start_sorted = jnp.cumsum(counts) - counts
    end_padded = jnp.cumsum(padded)
    start_padded = end_padded - padded
    dest = start_padded[se] + jnp.arange(n_assign) - start_sorted[se]
    n_rows = n_assign + N_EXPERTS * MOE_BLOCK
    n_blocks = n_rows // MOE_BLOCK
    row_tok = jnp.zeros((n_rows,), jnp.int32).at[dest].set(st)
    row_w = jnp.zeros((n_rows,), jnp.float32).at[dest].set(sw)
    blk_e = jnp.minimum(jnp.searchsorted(end_padded, jnp.arange(n_blocks) * MOE_BLOCK, side='right'),
                        N_EXPERTS - 1)
    xb = xt[row_tok].reshape(n_blocks, MOE_BLOCK, D)

    def expert_rows(args):
        xblk, e = args
        h = jax.nn.silu(xblk @ w_gate[e]) * (xblk @ w_up[e])
        return h @ w_down[e]

    yb = lax.map(expert_rows, (xb, blk_e)).reshape(n_rows, D)
    y = jnp.zeros((n, D), jnp.float32).at[row_tok].add(yb.astype(jnp.float32) * row_w[:, None])
    return y.astype(x.dtype).reshape(B, S, D)


def setup_inputs(seed: int = 0) -> dict:
    key = jax.random.key(seed)
    ks = jax.random.split(key, 26)
    f32 = jnp.float32

    def nrm(k, shape, scale):
        return jax.random.normal(k, shape, f32) * scale

    x = jax.random.normal(ks[0], (BATCH, SEQ, D_MODEL), f32)
    offsets = jax.random.randint(ks[1], (BATCH, 1), 0, 64) * CHUNK
    positions = (offsets + jnp.arange(SEQ, dtype=jnp.int32)[None, :]).astype(jnp.int32)
    u = jax.random.uniform(ks[12], (DEPTH, LRU_W), f32, minval=0.9, maxval=0.999)
    s_base = u ** (1.0 / LRU_C)
    lru_lam = jnp.log(s_base) - jnp.log1p(-s_base)
    return {
        "x": x,
        "positions": positions,
        "mix_w_in": nrm(ks[2], (DEPTH, D_MODEL, IN_COLS), D_MODEL ** -0.5),
        "mix_w_out": nrm(ks[3], (DEPTH, MIX_W, D_MODEL), BETA * MIX_W ** -0.5),
        "pool_w": nrm(ks[4], (DEPTH, len(POOL_WINDOWS), POOL_GROUP, POOL_GROUP), POOL_GROUP ** -0.5),
        "pool_scale": 1.0 + nrm(ks[5], (DEPTH, POOL_W), 0.02),
        "conv_w": nrm(ks[6], (DEPTH, CONV_WIDTH, LRU_W), CONV_WIDTH ** -0.5),
        "conv_b": nrm(ks[7], (DEPTH, LRU_W), 0.02),
        "lru_wa": nrm(ks[8], (DEPTH, LRU_BLOCKS, LRU_BLOCK, LRU_BLOCK), LRU_BLOCK ** -0.5),
        "lru_ba": nrm(ks[9], (DEPTH, LRU_W), 0.02),
        "lru_wx": nrm(ks[10], (DEPTH, LRU_BLOCKS, LRU_BLOCK, LRU_BLOCK), LRU_BLOCK ** -0.5),
        "lru_bx": nrm(ks[11], (DEPTH, LRU_W), 0.02),
        "lru_lam": lru_lam,
        "ln_mix_g": 1.0 + nrm(ks[13], (DEPTH, D_MODEL), 0.02),
        "ln_mix_b": nrm(ks[14], (DEPTH, D_MODEL), 0.02),
        "ln_ffn_g": 1.0 + nrm(ks[15], (DEPTH, D_MODEL), 0.02),
        "ln_ffn_b": nrm(ks[16], (DEPTH, D_MODEL), 0.02),
        "dense_w_gate": nrm(ks[17], (N_DENSE, D_MODEL, D_FF), D_MODEL ** -0.5),
        "dense_w_up": nrm(ks[18], (N_DENSE, D_MODEL, D_FF), D_MODEL ** -0.5),
        "dense_w_down": nrm(ks[19], (N_DENSE, D_FF, D_MODEL), BETA * D_FF ** -0.5),
        "moe_router": nrm(ks[20], (N_MOE, D_MODEL, N_EXPERTS), D_MODEL ** -0.5),
        "moe_w_gate": nrm(ks[21], (N_MOE, N_EXPERTS, D_MODEL, D_EXPERT), D_MODEL ** -0.5),
        "moe_w_up": nrm(ks[22], (N_MOE, N_EXPERTS, D_MODEL, D_EXPERT), D_MODEL ** -0.5),
        "moe_w_down": nrm(ks[23], (N_MOE, N_EXPERTS, D_EXPERT, D_MODEL), BETA * D_EXPERT ** -0.5),
    }


def reference(x, positions, mix_w_in, mix_w_out, pool_w, pool_scale, conv_w, conv_b,
              lru_wa, lru_ba, lru_wx, lru_bx, lru_lam, ln_mix_g, ln_mix_b, ln_ffn_g, ln_ffn_b,
              dense_w_gate, dense_w_up, dense_w_down, moe_router, moe_w_gate, moe_w_up, moe_w_down):
    cos_a, sin_a = rope_tables(positions, HEAD_DIM)
    cos_i, sin_i = rope_tables(positions, IDX_DIM)
    for layer in range(DEPTH):
        m = hybrid_mixer(x, cos_a, sin_a, cos_i, sin_i, mix_w_in[layer], mix_w_out[layer],
                         pool_w[layer], pool_scale[layer], conv_w[layer], conv_b[layer],
                         lru_wa[layer], lru_ba[layer], lru_wx[layer], lru_bx[layer], lru_lam[layer])
        x = layer_norm(ALPHA * x + m, ln_mix_g[layer], ln_mix_b[layer])
        if layer % 2 == 0:
            j = layer // 2
            f = swiglu(x, dense_w_gate[j], dense_w_up[j], dense_w_down[j])
        else:
            j = layer // 2
            f = moe_swiglu(x, moe_router[j], moe_w_gate[j], moe_w_up[j], moe_w_down[j])
        x = layer_norm(ALPHA * x + f, ln_ffn_g[layer], ln_ffn_b[layer])
    return x
```

```cpp
#include <hip/hip_runtime.h>
#include <cstdio>
#include <cstdint>

#ifndef MK_N_LAUNCHES
#define MK_N_LAUNCHES 0
#endif

#define DI __device__ __forceinline__
#define LAS __attribute__((address_space(3)))
#define GAS __attribute__((address_space(1)))
typedef unsigned short bf16;
typedef short bf16x8 __attribute__((ext_vector_type(8)));
typedef float f32x2 __attribute__((ext_vector_type(2)));
typedef float f32x4 __attribute__((ext_vector_type(4)));
typedef float f32x16 __attribute__((ext_vector_type(16)));
typedef unsigned u32x2 __attribute__((ext_vector_type(2)));
typedef unsigned u32x4 __attribute__((ext_vector_type(4)));
typedef __bf16 bf16x2_t __attribute__((ext_vector_type(2)));

#define LDS_WAIT() asm volatile("s_waitcnt lgkmcnt(0)" ::: "memory")
#define VM_WAIT() asm volatile("s_waitcnt vmcnt(0)" ::: "memory")

DI unsigned pk2(float lo, float hi) { f32x2 v = {lo, hi}; return __builtin_bit_cast(unsigned, __builtin_convertvector(v, bf16x2_t)); }
DI float bflo(unsigned w) { return __uint_as_float(w << 16); }
DI float bfhi(unsigned w) { return __uint_as_float(w & 0xffff0000u); }
DI float bf2f(bf16 b) { return __uint_as_float(((unsigned)b) << 16); }
DI float rcp_(float x) { return __builtin_amdgcn_rcpf(x); }
DI float sigmoidf_(float x) { return rcp_(1.0f + __expf(-x)); }
DI float siluf_(float x) { return x * rcp_(1.0f + __expf(-x)); }
DI float gelu_tanh_(float x) { const float u = 0.7978845608028654f * (x + 0.044715f * x * x * x); const float t = 1.0f - 2.0f * rcp_(1.0f + __expf(2.0f * u)); return 0.5f * x * (1.0f + t); }
DI float one_minus_exp_(float x) {
    const float p = -x * (1.0f + x * 0.5f * (1.0f + x * (1.0f / 3.0f) * (1.0f + x * 0.25f * (1.0f + x * 0.2f * (1.0f + x * (1.0f / 6.0f) * (1.0f + x * (1.0f / 7.0f)))))));
    return x > -0.5f ? p : 1.0f - __expf(x);
}
DI int lane_id_() { int l; asm volatile("v_mbcnt_lo_u32_b32 %0, -1, 0\n\tv_mbcnt_hi_u32_b32 %0, -1, %0" : "=v"(l)); return l; }

constexpr int DM = 2048, BATCH = 4, SEQ = 2048, MTOK = BATCH * SEQ;
constexpr int NIN = 16464, NINP = 16640;
constexpr int C_Q = 0, C_K = 2048, C_V = 2560, C_QI = 3072, C_KI = 4096, C_WI = 4160, C_PADLO = 4176, C_P = 4352, C_XR = 6400, C_GR = 8448, C_G = 10496;
constexpr int MIXW = 6144, DFF = 5504, NEXP = 8, DEXP = 7168;
constexpr int MOE_ROWS_MAX = (MTOK * 2 / 256 + NEXP) * 256;
constexpr float ALPHA = 1.4142135623730951f, LN_EPS = 1e-5f;

constexpr size_t MiB = 1u << 20;
constexpr size_t WS_CTL = 0, CTL_ZERO_BYTES = 1 * MiB;
constexpr size_t WS_COSA = 1 * MiB, WS_SINA = 3 * MiB, WS_COSI = 5 * MiB, WS_SINI = 6 * MiB;
constexpr size_t WS_CARRY = 7 * MiB;
constexpr size_t WS_ROUTE = 9 * MiB;
constexpr size_t WS_MASK = 10 * MiB;
constexpr size_t WS_LRUC = 9 * MiB + 512 * 1024;
constexpr size_t WS_WIN = 12 * MiB;
constexpr size_t WS_WOUT = 142 * MiB;
constexpr size_t WS_WPOOL = 190 * MiB;
constexpr size_t WS_WLRU = 194 * MiB;
constexpr size_t WS_WGU = 198 * MiB;
constexpr size_t WS_WDN = 241 * MiB;
constexpr size_t WS_XB = 263 * MiB;
constexpr size_t WS_X1 = 295 * MiB;
constexpr size_t WS_X1B = 359 * MiB;
constexpr size_t WS_X2 = 391 * MiB;
constexpr size_t WS_PRE = 455 * MiB;
constexpr size_t WS_OV = 519 * MiB;
constexpr size_t WS_PROJ = WS_OV;
constexpr size_t WS_DIFF = WS_OV + 260 * MiB;
constexpr size_t WS_XC = WS_OV + 292 * MiB;
constexpr size_t WS_A = WS_OV + 324 * MiB;
constexpr size_t WS_B = WS_OV + 388 * MiB;
constexpr size_t WS_SC = WS_OV + 452 * MiB;
constexpr size_t WS_MRG = WS_OV + 516 * MiB;
constexpr size_t WS_H = WS_OV;
constexpr size_t WS_MWGU = WS_OV;
constexpr size_t WS_MWDN = WS_OV + 448 * MiB;
constexpr size_t WS_AMOE = WS_OV + 672 * MiB;
constexpr size_t WS_HMOE = WS_OV + 744 * MiB;
constexpr size_t WS_YB = WS_OV + 996 * MiB;
constexpr size_t WS_END = WS_OV + 1140 * MiB;
constexpr int CW_BAR = 4096, CW_CNT = 16384;
constexpr int RT_E = 0, RT_SLOT = 2 * MTOK, RT_W = 4 * MTOK, RT_ROW = 6 * MTOK;

constexpr int RING_BYTES = 131072, LDSCTL_OFF = RING_BYTES, LDS_BYTES = 147456;

#define XB_TMO      128
#define XB_XCNT(j)  (256  + 64 * (j))
#define XB_XSUB(j)  (1280 + 64 * (j))
#define XB_XGEN(j)  (2304 + 64 * (j))
#define XB_TOP      3328
#define XB_TOPGEN   3392
#define XCD_BAR_WORDS 3456
#define XB_SPIN_CAP (1u << 18)
DI unsigned xb_ld(unsigned* p)              { return __hip_atomic_load(p, __ATOMIC_RELAXED, __HIP_MEMORY_SCOPE_AGENT); }
DI unsigned xb_add(unsigned* p, unsigned v) { return __hip_atomic_fetch_add(p, v, __ATOMIC_RELAXED, __HIP_MEMORY_SCOPE_AGENT); }
DI unsigned xb_xcc_id() { return (unsigned)__builtin_amdgcn_s_getreg((3 << 11) | 20) & 0xFu; }
#define XB_SPIN(cond, bar) do { unsigned _sp = 0; while (cond) { __builtin_amdgcn_s_sleep(1); \
    if ((++_sp & 255u) == 0u) { if (xb_ld(&(bar)[XB_TMO])) break; if (_sp > XB_SPIN_CAP) { atomicAdd(&(bar)[XB_TMO], 1u); break; } } } } while (0)
struct XcdBarrier { unsigned* bar; unsigned x; volatile LAS unsigned* st; int wave; };
DI bool xb_t0(int wave) { return wave == 0 && lane_id_() == 0; }
DI XcdBarrier xcd_barrier_post(unsigned* bar, volatile LAS unsigned* st, int wave) {
    XcdBarrier b; b.bar = bar; b.x = xb_xcc_id(); b.st = st; b.wave = wave;
    if (xb_t0(wave)) (void)xb_add(&bar[XB_XCNT(b.x)], 1u);
    return b;
}
DI void xcd_barrier_complete(unsigned* bar, unsigned x, unsigned& nloc, unsigned& nx) {
    const unsigned G = gridDim.x * gridDim.y * gridDim.z;
    unsigned sum, cnt, mine, sp = 0u;
    for (;;) {
        sum = 0u; cnt = 0u; mine = 0u;
#pragma unroll
        for (unsigned j = 0; j < 16; ++j) { const unsigned c = xb_ld(&bar[XB_XCNT(j)]); sum += c; cnt += (c > 0u) ? 1u : 0u; mine = (j == x) ? c : mine; }
        if (sum == G) break;
        __builtin_amdgcn_s_sleep(1);
        if ((++sp & 255u) == 0u) { if (xb_ld(&bar[XB_TMO])) break; if (sp > XB_SPIN_CAP) { atomicAdd(&bar[XB_TMO], 1u); break; } }
    }
    nloc = mine > 0u ? mine : 1u; nx = cnt > 0u ? cnt : 1u;
}
DI void xcd_barrier(const XcdBarrier& b) {
    asm volatile("s_waitcnt vmcnt(0)" ::: "memory");
    __syncthreads();
    if (xb_t0(b.wave)) {
        unsigned* bar = b.bar;
        __builtin_amdgcn_s_waitcnt(0);
        unsigned nloc = b.st[0], nx = b.st[1];
        if (nloc == 0u) { xcd_barrier_complete(bar, b.x, nloc, nx); b.st[0] = nloc; b.st[1] = nx; }
        const unsigned old = xb_add(&bar[XB_XSUB(b.x)], 1u);
        const unsigned gen = old / nloc;
        if (old + 1u == (gen + 1u) * nloc) {
            __builtin_amdgcn_fence(__ATOMIC_RELEASE, "agent");
            asm volatile("s_waitcnt vmcnt(0)" ::: "memory");
            const unsigned og = xb_add(&bar[XB_TOP], 1u);
            const unsigned tg = og / nx;
            if (og + 1u == (tg + 1u) * nx) xb_add(&bar[XB_TOPGEN], 1u);
            else XB_SPIN(xb_ld(&bar[XB_TOPGEN]) == tg, bar);
            __builtin_amdgcn_fence(__ATOMIC_ACQUIRE, "agent");
            xb_add(&bar[XB_XGEN(b.x)], 1u);
            asm volatile("s_waitcnt vmcnt(0)" ::: "memory");
        } else {
            XB_SPIN(xb_ld(&bar[XB_XGEN(b.x)]) == gen, bar);
            __builtin_amdgcn_fence(__ATOMIC_ACQUIRE, "agent");
            asm volatile("s_waitcnt vmcnt(0)" ::: "memory");
        }
    }
    __syncthreads();
}

namespace pg8 {
constexpr int BM = 256, BK = 64, HALF = 128, HTB = HALF * BK * 2, STAGE_BYTES = 8 * HTB, NXCD = 8, WGM = 8;
DI int lds_byte(int r, int c) { const int st = (r >> 4) * 2 + (c >> 5), rr = r & 15, cc = c & 31, ob = rr * 64 + cc * 2; return st * 1024 + (ob ^ (((ob >> 9) & 1) << 5)); }
DI void stage_rc(int b, int& R, int& C) { const int st = b / 1024, sb = b % 1024, swz = sb ^ (((sb >> 9) & 1) << 5); R = (st >> 1) * 16 + swz / 64; C = (st & 1) * 32 + (swz % 64) / 2; }
DI int perm32(int rho) { const int n = rho >> 4, i = rho & 15; return 8 * (i >> 2) + 4 * n + (i & 3); }

struct Unit { int pm, pn, e; };
struct Gemm { const bf16* A; const bf16* Bt; int lda, ldb, K; };

struct TileOrder {
    int nM, nN, nwg, G, c, a_div; size_t a_pm, a_pn, b_pn;
    DI void init(int nM_, int nN_, int G_, int c_, size_t a_pm_, size_t b_pn_, int a_div_ = 1, size_t a_pn_ = 0) { nM = nM_; nN = nN_; nwg = nM * nN; G = G_; c = c_; a_pm = a_pm_; b_pn = b_pn_; a_div = a_div_; a_pn = a_pn_; }
    DI bool next(int i, Unit& u) const {
        const long L = (long)i * G + c; if (L >= nwg) return false;
        int wgid = (int)L; { const int q = nwg / NXCD, r = nwg % NXCD, xcd = wgid % NXCD, off = wgid / NXCD; wgid = (xcd < r ? xcd * (q + 1) : r * (q + 1) + (xcd - r) * q) + off; }
        const int nig = WGM * nN, gid = wgid / nig, fm = gid * WGM, gsz = (nM - fm) < WGM ? (nM - fm) : WGM;
        u.pm = fm + ((wgid % nig) % gsz); u.pn = (wgid % nig) / gsz; u.e = 0; return true;
    }
    DI size_t aoff(const Unit& u) const { return (size_t)u.pm * a_pm + (size_t)(u.pn / a_div) * a_pn; }
    DI size_t boff(const Unit& u) const { return (size_t)u.pn * b_pn; }
};
struct MoeOrder {
    int nN, nwg, G, c; int t1, t2, t3, t4, t5, t6, t7, t8; size_t a_pm, b_e, b_pn;
    DI void init(const unsigned* cnt, int nN_, int G_, int c_, size_t a_pm_, size_t b_e_, size_t b_pn_) {
        nN = nN_; G = G_; c = c_; a_pm = a_pm_; b_e = b_e_; b_pn = b_pn_;
        int s = 0; s += ((int)cnt[0] + 255) >> 8; t1 = s; s += ((int)cnt[1] + 255) >> 8; t2 = s; s += ((int)cnt[2] + 255) >> 8; t3 = s; s += ((int)cnt[3] + 255) >> 8; t4 = s;
        s += ((int)cnt[4] + 255) >> 8; t5 = s; s += ((int)cnt[5] + 255) >> 8; t6 = s; s += ((int)cnt[6] + 255) >> 8; t7 = s; s += ((int)cnt[7] + 255) >> 8; t8 = s;
        nwg = t8 * nN;
    }
    DI bool next(int i, Unit& u) const {
        const long L = (long)i * G + c; if (L >= nwg) return false;
        int wgid = (int)L; { const int q = nwg / NXCD, r = nwg % NXCD, xcd = wgid % NXCD, off = wgid / NXCD; wgid = (xcd < r ? xcd * (q + 1) : r * (q + 1) + (xcd - r) * q) + off; }
        int e = 0, ts = 0, nt = t1;
        if (wgid >= t1 * nN) { e = 1; ts = t1; nt = t2 - t1; }
        if (wgid >= t2 * nN) { e = 2; ts = t2; nt = t3 - t2; }
        if (wgid >= t3 * nN) { e = 3; ts = t3; nt = t4 - t3; }
        if (wgid >= t4 * nN) { e = 4; ts = t4; nt = t5 - t4; }
        if (wgid >= t5 * nN) { e = 5; ts = t5; nt = t6 - t5; }
        if (wgid >= t6 * nN) { e = 6; ts = t6; nt = t7 - t6; }
        if (wgid >= t7 * nN) { e = 7; ts = t7; nt = t8 - t7; }
        const int loc = wgid - ts * nN; nt = nt > 0 ? nt : 1;
        u.pm = ts + loc % nt; u.pn = loc / nt; u.e = e; return true;
    }
    DI size_t aoff(const Unit& u) const { return (size_t)u.pm * a_pm; }
    DI size_t boff(const Unit& u) const { return (size_t)u.e * b_e + (size_t)u.pn * b_pn; }
};

struct EpiBf16 {
    static constexpr bool PERM = true;
    bf16* O; int ldc;
    DI void operator()(const f32x4 (&acc)[2][2][4][2], const Unit& u, int wr, int wc, int fr, int fq) const {
        const int row0 = u.pm * BM + wr * 64 + fr, col0 = u.pn * BM + wc * 32 + 8 * fq;
#pragma unroll
        for (int ai = 0; ai < 2; ++ai)
#pragma unroll
            for (int m = 0; m < 4; ++m) { bf16* rowp = O + (size_t)(row0 + ai * HALF + m * 16) * ldc + col0;
#pragma unroll
                for (int bj = 0; bj < 2; ++bj) { const f32x4 v0 = acc[ai][bj][m][0], v1 = acc[ai][bj][m][1];
                    u32x4 w; w.x = pk2(v0[0], v0[1]); w.y = pk2(v0[2], v0[3]); w.z = pk2(v1[0], v1[1]); w.w = pk2(v1[2], v1[3]);
                    *(u32x4*)(rowp + bj * HALF) = w; } }
    }
};
struct EpiF32 {
    static constexpr bool PERM = false;
    float* C; int ldc;
    DI void operator()(const f32x4 (&acc)[2][2][4][2], const Unit& u, int wr, int wc, int fr, int fq) const {
        const int row0 = u.pm * BM + wr * 64 + fr, col0 = u.pn * BM + wc * 32 + 4 * fq;
#pragma unroll
        for (int ai = 0; ai < 2; ++ai)
#pragma unroll
            for (int m = 0; m < 4; ++m) { float* rowp = C + (size_t)(row0 + ai * HALF + m * 16) * ldc + col0;
#pragma unroll
                for (int bj = 0; bj < 2; ++bj)
#pragma unroll
                    for (int n = 0; n < 2; ++n) *(f32x4*)(rowp + bj * HALF + n * 16) = acc[ai][bj][m][n]; }
    }
};
struct EpiRes {
    static constexpr bool PERM = false;
    float* C; const float* res; int ldc;
    DI void operator()(const f32x4 (&acc)[2][2][4][2], const Unit& u, int wr, int wc, int fr, int fq) const {
        const int row0 = u.pm * BM + wr * 64 + fr, col0 = u.pn * BM + wc * 32 + 4 * fq;
#pragma unroll
        for (int ai = 0; ai < 2; ++ai)
#pragma unroll
            for (int m = 0; m < 4; ++m) { const size_t off = (size_t)(row0 + ai * HALF + m * 16) * ldc + col0;
#pragma unroll
                for (int bj = 0; bj < 2; ++bj)
#pragma unroll
                    for (int n = 0; n < 2; ++n) { const f32x4 rv = *(const f32x4*)(res + off + bj * HALF + n * 16); *(f32x4*)(C + off + bj * HALF + n * 16) = acc[ai][bj][m][n] + rv * ALPHA; }
                asm volatile("" ::: "memory"); }
    }
};
struct EpiSwiglu {
    static constexpr bool PERM = true;
    bf16* H; int ldc;
    DI void operator()(const f32x4 (&acc)[2][2][4][2], const Unit& u, int wr, int wc, int fr, int fq) const {
        const int row0 = u.pm * BM + wr * 64 + fr, col0 = u.pn * HALF + wc * 32 + 8 * fq;
#pragma unroll
        for (int ai = 0; ai < 2; ++ai)
#pragma unroll
            for (int m = 0; m < 4; ++m) { bf16* rowp = H + (size_t)(row0 + ai * HALF + m * 16) * ldc + col0;
                const f32x4 g0 = acc[ai][0][m][0], g1 = acc[ai][0][m][1], u0 = acc[ai][1][m][0], u1 = acc[ai][1][m][1];
                u32x4 w; w.x = pk2(siluf_(g0[0]) * u0[0], siluf_(g0[1]) * u0[1]); w.y = pk2(siluf_(g0[2]) * u0[2], siluf_(g0[3]) * u0[3]);
                w.z = pk2(siluf_(g1[0]) * u1[0], siluf_(g1[1]) * u1[1]); w.w = pk2(siluf_(g1[2]) * u1[2], siluf_(g1[3]) * u1[3]);
                *(u32x4*)rowp = w; asm volatile("" ::: "memory"); }
    }
};
struct EpiPool {
    static constexpr bool PERM = true;
    bf16* mrg; const bf16* proj; const float* scale;
    DI void operator()(const f32x4 (&acc)[2][2][4][2], const Unit& u, int wr, int wc, int fr, int fq) const {
        const int row0 = u.pm * BM + wr * 64 + fr, col0 = u.pn * BM + wc * 32 + 8 * fq;
#pragma unroll
        for (int bj = 0; bj < 2; ++bj) { const int c = col0 + bj * HALF; const f32x4 s0 = *(const f32x4*)(scale + c), s1 = *(const f32x4*)(scale + c + 4);
#pragma unroll
            for (int ai = 0; ai < 2; ++ai)
#pragma unroll
                for (int m = 0; m < 4; ++m) { const size_t row = (size_t)(row0 + ai * HALF + m * 16);
                    const u32x4 gv = *(const u32x4*)(proj + row * NINP + C_G + 2048 + c);
                    const f32x4 v0 = acc[ai][bj][m][0] * s0, v1 = acc[ai][bj][m][1] * s1;
                    u32x4 w; w.x = pk2(v0[0] * sigmoidf_(bflo(gv.x)), v0[1] * sigmoidf_(bfhi(gv.x))); w.y = pk2(v0[2] * sigmoidf_(bflo(gv.y)), v0[3] * sigmoidf_(bfhi(gv.y)));
                    w.z = pk2(v1[0] * sigmoidf_(bflo(gv.z)), v1[1] * sigmoidf_(bfhi(gv.z))); w.w = pk2(v1[2] * sigmoidf_(bflo(gv.w)), v1[3] * sigmoidf_(bfhi(gv.w)));
                    *(u32x4*)(mrg + row * MIXW + 2048 + c) = w; asm volatile("" ::: "memory"); } }
    }
};
struct EpiLru {
    static constexpr bool PERM = false;
    float* Aout; float* Bout; const bf16* xc; const float* ba; const float* bx; const float* c8sp;
    DI void operator()(const f32x4 (&acc)[2][2][4][2], const Unit& u, int wr, int wc, int fr, int fq) const {
        const int row0 = u.pm * BM + wr * 64 + fr, ch0 = u.pn * HALF + wc * 32 + 4 * fq;
#pragma unroll
        for (int n = 0; n < 2; ++n) { const int ch = ch0 + n * 16; const f32x4 vba = *(const f32x4*)(ba + ch), vbx = *(const f32x4*)(bx + ch), vsp = *(const f32x4*)(c8sp + ch);
#pragma unroll
            for (int ai = 0; ai < 2; ++ai)
#pragma unroll
                for (int m = 0; m < 4; ++m) { const size_t off = (size_t)(row0 + ai * HALF + m * 16) * DM + ch;
                    const u32x2 xv = *(const u32x2*)(xc + off); const float xf[4] = {bflo(xv.x), bfhi(xv.x), bflo(xv.y), bfhi(xv.y)};
                    f32x4 av, bv;
#pragma unroll
                    for (int j = 0; j < 4; ++j) { const float r = sigmoidf_(acc[ai][0][m][n][j] + vba[j]), ig = sigmoidf_(acc[ai][1][m][n][j] + vbx[j]);
                        const float la = -vsp[j] * r; av[j] = __expf(la); bv[j] = __builtin_amdgcn_sqrtf(fmaxf(one_minus_exp_(2.0f * la), 0.f)) * ig * xf[j]; }
                    *(f32x4*)(Aout + off) = av; *(f32x4*)(Bout + off) = bv; asm volatile("" ::: "memory"); } }
    }
};

template <class Epi, class Sched, bool ALIGN_EPI = true, bool SP2 = true>
DI void gemm_phase(LAS unsigned char* lds, const Gemm g, const Sched& S, const Epi& E, const int wave_id) {
    int lane_ = lane_id_(); asm volatile("" : "+v"(lane_));
    const int wid = wave_id, lane = lane_, tid = wid * 64 + lane, wr = wid >> 2, wc = wid & 3, fr = lane & 15, fq = lane >> 4;
    const int nt = g.K / BK;
    unsigned voffA[2], voffB[2];
#pragma unroll
    for (int i = 0; i < 2; ++i) { int R, C; stage_rc(tid * 16 + i * 8192, R, C); const int Rb = Epi::PERM ? ((R & ~31) + perm32(R & 31)) : R;
        voffA[i] = (unsigned)(R * g.lda + C) * 2u; voffB[i] = (unsigned)(Rb * g.ldb + C) * 2u; }
    const size_t kstep = (size_t)(BK * 2);
    const size_t hstepA = (size_t)HALF * g.lda * 2, hstepB = (size_t)HALF * g.ldb * 2;
    const unsigned ldsw = (unsigned)wid * 1024u;
    const int aoff = lds_byte(wr * 64 + fr, fq * 8), boff = lds_byte(wc * 32 + fr, fq * 8);
#define PG8_SA(b, h) (((b) * 2 + (h)) * HTB)
#define PG8_SB(b, h) ((4 + (b) * 2 + (h)) * HTB)
#define PG8_STAGE(bufoff, gbase, voff) do { _Pragma("unroll") for (int _i = 0; _i < 2; ++_i) \
        __builtin_amdgcn_global_load_lds((const unsigned*)((const char*)(gbase) + (voff)[_i]), (LAS unsigned*)(lds + (bufoff) + ldsw + _i * 8192), 16, 0, 0); } while (0)
#define PG8_LDA(dst, b, h) do { _Pragma("unroll") for (int m = 0; m < 4; ++m) _Pragma("unroll") for (int k = 0; k < 2; ++k) dst[m][k] = *(const LAS bf16x8*)(lds + PG8_SA(b, h) + aoff + m * 2048 + k * 1024); } while (0)
#define PG8_LDB(dst, b, h) do { _Pragma("unroll") for (int n = 0; n < 2; ++n) _Pragma("unroll") for (int k = 0; k < 2; ++k) dst[n][k] = *(const LAS bf16x8*)(lds + PG8_SB(b, h) + boff + n * 2048 + k * 1024); } while (0)
#define PG8_MMA(ai, bj, At, Bt) do { __builtin_amdgcn_s_setprio(1); _Pragma("unroll") for (int m = 0; m < 4; ++m) _Pragma("unroll") for (int n = 0; n < 2; ++n) _Pragma("unroll") for (int k = 0; k < 2; ++k) \
        acc[ai][bj][m][n] = __builtin_amdgcn_mfma_f32_16x16x32_bf16(Bt[n][k], At[m][k], acc[ai][bj][m][n], 0, 0, 0); __builtin_amdgcn_s_setprio(0); } while (0)
#define PG8_WAIT_V(n) asm volatile("s_waitcnt vmcnt(" #n ")" ::: "memory")
#define PG8_WAIT_L(n) asm volatile("s_waitcnt lgkmcnt(" #n ")" ::: "memory")
#define PG8_BAR __builtin_amdgcn_s_barrier()
#define PG8_SCHED __builtin_amdgcn_sched_barrier(0)
    Unit cur, nxt; int ui = 0;
    if (!S.next(0, cur)) return;
    f32x4 acc[2][2][4][2];
#pragma unroll
    for (int a = 0; a < 2; ++a)
#pragma unroll
        for (int b = 0; b < 2; ++b)
#pragma unroll
            for (int m = 0; m < 4; ++m)
#pragma unroll
                for (int n = 0; n < 2; ++n) acc[a][b][m][n] = (f32x4){0.f, 0.f, 0.f, 0.f};
    bf16x8 At[4][2], B0[2][2], B1[2][2];
    const char* cA = (const char*)g.A + S.aoff(cur); const char* cB = (const char*)g.Bt + S.boff(cur);
    if constexpr (SP2) {
        PG8_STAGE(PG8_SB(0, 0), cB, voffB); PG8_STAGE(PG8_SB(0, 1), cB + hstepB, voffB); PG8_STAGE(PG8_SA(0, 0), cA, voffA); PG8_STAGE(PG8_SA(0, 1), cA + hstepA, voffA);
        if (wr == 1) PG8_BAR;
        PG8_WAIT_V(2); PG8_BAR;
        PG8_STAGE(PG8_SB(1, 0), cB + kstep, voffB); PG8_STAGE(PG8_SA(1, 0), cA + kstep, voffA); PG8_STAGE(PG8_SB(1, 1), cB + hstepB + kstep, voffB);
        PG8_WAIT_V(6); PG8_BAR;
    } else {
        PG8_STAGE(PG8_SB(0, 0), cB, voffB); PG8_STAGE(PG8_SA(0, 0), cA, voffA); PG8_STAGE(PG8_SB(0, 1), cB + hstepB, voffB); PG8_STAGE(PG8_SA(0, 1), cA + hstepA, voffA);
        if (wr == 1) PG8_BAR;
        PG8_WAIT_V(4); PG8_BAR;
        PG8_STAGE(PG8_SB(1, 0), cB + kstep, voffB); PG8_STAGE(PG8_SA(1, 0), cA + kstep, voffA); PG8_STAGE(PG8_SB(1, 1), cB + hstepB + kstep, voffB);
        PG8_WAIT_V(6); PG8_BAR;
    }
    for (;;) {
        const bool has_next = S.next(ui + 1, nxt);
        const char* nA = has_next ? (const char*)g.A + S.aoff(nxt) : cA; const char* nB = has_next ? (const char*)g.Bt + S.boff(nxt) : cB;
#pragma nounroll
        for (int t = 0; t < nt; t += 2) {
            const bool last = (t == nt - 2);
            const char* a1 = cA + (size_t)(t + 1) * kstep;
            const char* a2 = last ? nA : cA + (size_t)(t + 2) * kstep; const char* b2 = last ? nB : cB + (size_t)(t + 2) * kstep;
            const char* a3 = a2 + kstep; const char* b3 = b2 + kstep;
            if constexpr (SP2) {
            PG8_LDB(B0, 0, 0); PG8_LDB(B1, 0, 1); PG8_SCHED; PG8_LDA(At, 0, 0); PG8_STAGE(PG8_SA(1, 1), a1 + hstepA, voffA);
            PG8_WAIT_V(8); PG8_WAIT_L(0); PG8_BAR; PG8_MMA(0, 0, At, B0); PG8_MMA(0, 1, At, B1); PG8_BAR; PG8_SCHED;
            PG8_LDA(At, 0, 1); PG8_STAGE(PG8_SB(0, 0), b2, voffB); PG8_STAGE(PG8_SB(0, 1), b2 + hstepB, voffB); PG8_STAGE(PG8_SA(0, 0), a2, voffA);
            PG8_WAIT_V(8); PG8_WAIT_L(0); PG8_BAR; PG8_MMA(1, 0, At, B0); PG8_MMA(1, 1, At, B1); PG8_BAR; PG8_SCHED;
            PG8_LDB(B0, 1, 0); PG8_LDB(B1, 1, 1); PG8_SCHED; PG8_LDA(At, 1, 0); PG8_STAGE(PG8_SA(0, 1), a2 + hstepA, voffA);
            PG8_WAIT_V(8); PG8_WAIT_L(0); PG8_BAR; PG8_MMA(0, 0, At, B0); PG8_MMA(0, 1, At, B1); PG8_BAR; PG8_SCHED;
            PG8_LDA(At, 1, 1); PG8_STAGE(PG8_SB(1, 0), b3, voffB); PG8_STAGE(PG8_SB(1, 1), b3 + hstepB, voffB); PG8_STAGE(PG8_SA(1, 0), a3, voffA);
            PG8_WAIT_V(8); PG8_WAIT_L(0); PG8_BAR; PG8_MMA(1, 0, At, B0); PG8_MMA(1, 1, At, B1); PG8_BAR; PG8_SCHED;
            } else {
            PG8_LDB(B0, 0, 0); PG8_SCHED; PG8_LDA(At, 0, 0); PG8_STAGE(PG8_SA(1, 1), a1 + hstepA, voffA);
            PG8_WAIT_L(8); PG8_BAR; PG8_WAIT_L(0); PG8_MMA(0, 0, At, B0); PG8_BAR; PG8_SCHED;
            PG8_LDB(B1, 0, 1); PG8_STAGE(PG8_SB(0, 0), b2, voffB);
            PG8_BAR; PG8_WAIT_L(0); PG8_MMA(0, 1, At, B1); PG8_BAR;
            PG8_LDA(At, 0, 1); PG8_STAGE(PG8_SA(0, 0), a2, voffA);
            PG8_BAR; PG8_WAIT_L(0); PG8_MMA(1, 0, At, B0); PG8_BAR; PG8_SCHED;
            PG8_STAGE(PG8_SB(0, 1), b2 + hstepB, voffB);
            PG8_WAIT_V(6); PG8_BAR; PG8_MMA(1, 1, At, B1); PG8_BAR;
            PG8_LDB(B0, 1, 0); PG8_SCHED; PG8_LDA(At, 1, 0); PG8_STAGE(PG8_SA(0, 1), a2 + hstepA, voffA);
            PG8_WAIT_L(8); PG8_BAR; PG8_WAIT_L(0); PG8_MMA(0, 0, At, B0); PG8_BAR; PG8_SCHED;
            PG8_LDB(B1, 1, 1); PG8_STAGE(PG8_SB(1, 0), b3, voffB);
            PG8_BAR; PG8_WAIT_L(0); PG8_MMA(0, 1, At, B1); PG8_BAR;
            PG8_LDA(At, 1, 1); PG8_STAGE(PG8_SA(1, 0), a3, voffA);
            PG8_BAR; PG8_WAIT_L(0); PG8_MMA(1, 0, At, B0); PG8_BAR; PG8_SCHED;
            PG8_STAGE(PG8_SB(1, 1), b3 + hstepB, voffB);
            PG8_WAIT_V(6); PG8_BAR; PG8_MMA(1, 1, At, B1); PG8_BAR;
            }
        }
        if constexpr (ALIGN_EPI) { if (wr == 0) PG8_BAR; }
        E(acc, cur, wr, wc, fr, fq);
        if (!has_next) break;
#pragma unroll
        for (int a = 0; a < 2; ++a)
#pragma unroll
            for (int b = 0; b < 2; ++b)
#pragma unroll
                for (int m = 0; m < 4; ++m)
#pragma unroll
                    for (int n = 0; n < 2; ++n) acc[a][b][m][n] = (f32x4){0.f, 0.f, 0.f, 0.f};
        cur = nxt; cA = nA; cB = nB; ++ui;
        if constexpr (ALIGN_EPI) { if (wr == 1) PG8_BAR; }
    }
    PG8_WAIT_V(0);
    if constexpr (!ALIGN_EPI) { if (wr == 0) PG8_BAR; }
    PG8_BAR;
#undef PG8_SA
#undef PG8_SB
#undef PG8_STAGE
#undef PG8_LDA
#undef PG8_LDB
#undef PG8_MMA
#undef PG8_WAIT_V
#undef PG8_WAIT_L
#undef PG8_BAR
#undef PG8_SCHED
}
}

struct Args { const void* in[24]; float* out; unsigned char* ws; int ph_lo, ph_hi; };
struct Frame {
    LAS unsigned char* lds; unsigned* ctl; unsigned char* ws;
    int tid, lane, wave, G, bid;
};
#define INF(k) ((const float*)args.in[k])
DI float wave_sum(float v) {
#pragma unroll
    for (int o = 1; o < 64; o <<= 1) v += __shfl_xor(v, o);
    return v;
}

template <class RM>
DI void tr_item(const float* W, int ldS, int Nvalid, bf16* WT, int ldD, int koff, RM rowmap, LAS float* scr, int k0, int n0, int lane) {
    const int nl = n0 + (lane & 31);
#pragma unroll 8
    for (int i = 0; i < 32; ++i) { const int kk = 2 * i + (lane >> 5); scr[kk * 33 + (lane & 31)] = (nl < Nvalid) ? W[(size_t)(k0 + kk) * ldS + nl] : 0.f; }
    LDS_WAIT(); asm volatile("" ::: "memory");
    const int c = lane & 7;
#pragma unroll
    for (int j = 0; j < 4; ++j) { const int nn = (lane >> 3) + 8 * j, n = n0 + nn; const LAS float* s = scr + (8 * c) * 33 + nn;
        u32x4 o; o.x = pk2(s[0 * 33], s[1 * 33]); o.y = pk2(s[2 * 33], s[3 * 33]); o.z = pk2(s[4 * 33], s[5 * 33]); o.w = pk2(s[6 * 33], s[7 * 33]);
        if (n < Nvalid) *(u32x4*)(WT + (size_t)rowmap(n) * ldD + koff + k0 + 8 * c) = o; }
    LDS_WAIT(); asm volatile("" ::: "memory");
}
struct RmIn { DI int operator()(int n) const { return n < C_PADLO ? n : n + (C_P - C_PADLO); } };
struct RmId { int off; DI int operator()(int n) const { return off + n; } };
struct RmGU { int off; DI int operator()(int n) const { return ((n >> 7) << 8) + off + (n & 127); } };

DI void p0_prologue(Frame& F, const Args& args) {
    LAS float* scr = (LAS float*)(F.lds + F.wave * 16384);
    const int gw = F.bid * 8 + F.wave, NGW = F.G * 8;
    bf16* Win = (bf16*)(F.ws + WS_WIN); bf16* Wout = (bf16*)(F.ws + WS_WOUT); bf16* Wpool = (bf16*)(F.ws + WS_WPOOL); bf16* Wlru = (bf16*)(F.ws + WS_WLRU);
    bf16* Wgu = (bf16*)(F.ws + WS_WGU); bf16* Wdn = (bf16*)(F.ws + WS_WDN);
    constexpr int NB_IN = (NIN + 31) / 32;
    constexpr int I_IN = 32 * NB_IN, I_OUT = 96 * 64, I_POOL = 8 * 16, I_LRU = 2 * 4, I_G = 32 * 172, I_D = 86 * 64;
    constexpr int T_IN = 2 * I_IN, T_OUT = 2 * I_OUT, T_POOL = 8 * I_POOL, T_LRU = 64 * I_LRU, T_G = 2 * I_G, T_D = I_D;
    constexpr int NITEMS = T_IN + T_OUT + T_POOL + T_LRU + T_G + T_D;
    for (int it = gw; it < NITEMS; it += NGW) {
        int r = it;
        if (r < T_IN) { const int l = r / I_IN, q = r % I_IN, kb = q / NB_IN, nb = q % NB_IN;
            tr_item(INF(2) + (size_t)l * DM * NIN, NIN, NIN, Win + (size_t)l * NINP * DM, DM, 0, RmIn{}, scr, 64 * kb, 32 * nb, F.lane); continue; } r -= T_IN;
        if (r < T_OUT) { const int l = r / I_OUT, q = r % I_OUT, kb = q / 64, nb = q % 64;
            tr_item(INF(3) + (size_t)l * MIXW * DM, DM, DM, Wout + (size_t)l * DM * MIXW, MIXW, 0, RmId{0}, scr, 64 * kb, 32 * nb, F.lane); continue; } r -= T_OUT;
        if (r < T_POOL) { const int lg = r / I_POOL, q = r % I_POOL, kb = q / 16, nb = q % 16, l = lg >> 2, g = lg & 3;
            tr_item(INF(4) + (size_t)lg * 512 * 512, 512, 512, Wpool + (size_t)l * 2048 * 512, 512, 0, RmId{g * 512}, scr, 64 * kb, 32 * nb, F.lane); continue; } r -= T_POOL;
        if (r < T_LRU) { const int cmb = r / I_LRU, q = r % I_LRU, kb = q / 4, nb = q % 4, l = cmb >> 5, which = (cmb >> 4) & 1, n = cmb & 15;
            const float* src = (which ? INF(10) : INF(8)) + ((size_t)l * 16 + n) * 128 * 128;
            tr_item(src, 128, 128, Wlru + (size_t)l * 4096 * 256, 256, (n & 1) * 128, RmId{n * 256 + which * 128}, scr, 64 * kb, 32 * nb, F.lane); continue; } r -= T_LRU;
        if (r < T_G) { const int which = r / I_G, q = r % I_G, kb = q / 172, nb = q % 172;
            tr_item(which ? INF(18) : INF(17), DFF, DFF, Wgu, DM, 0, RmGU{which * 128}, scr, 64 * kb, 32 * nb, F.lane); continue; } r -= T_G;
        { const int kb = r / 64, nb = r % 64; tr_item(INF(19), DM, DM, Wdn, DFF, 0, RmId{0}, scr, 64 * kb, 32 * nb, F.lane); }
    }
    const int gt = F.bid * 512 + F.tid, NT = F.G * 512;
    for (int i = gt; i < 2 * 4096 * 16; i += NT) { const int row = i >> 4, ch = i & 15, n = (row & 4095) >> 8;
        *(u32x4*)(Wlru + (size_t)row * 256 + ((n + 1) & 1) * 128 + ch * 8) = (u32x4){0u, 0u, 0u, 0u}; }
    float* cosA = (float*)(F.ws + WS_COSA); float* sinA = (float*)(F.ws + WS_SINA); float* cosI = (float*)(F.ws + WS_COSI); float* sinI = (float*)(F.ws + WS_SINI);
    for (int i = gt; i < MTOK * 96; i += NT) {
        const int tok = i / 96, j = i % 96; const bool isA = j < 64; const int fi = isA ? j : j - 64; const double dim = isA ? 128.0 : 64.0;
        const float inv = (float)pow(10000.0, -(double)(2 * fi) / dim);
        const float ang = (float)((const int*)args.in[1])[tok] * inv; const double a = (double)ang; const double nrev = rint(a * 0.15915494309189535); const double rr = a - nrev * 6.283185307179586;
        const float cv = (float)cos(rr), sv = (float)sin(rr);
        if (isA) { cosA[tok * 64 + fi] = cv; sinA[tok * 64 + fi] = sv; } else { cosI[tok * 32 + fi] = cv; sinI[tok * 32 + fi] = sv; }
    }
    float* c8 = (float*)(F.ws + WS_LRUC);
    for (int i = gt; i < 2 * DM; i += NT) { const float lam = INF(12)[i]; c8[i] = 8.0f * log1pf(expf(-lam)); }
    bf16* xb = (bf16*)(F.ws + WS_XB);
    for (int i = gt; i < MTOK * DM / 8; i += NT) { const f32x4 a = *(const f32x4*)(INF(0) + (size_t)i * 8), b = *(const f32x4*)(INF(0) + (size_t)i * 8 + 4);
        u32x4 o; o.x = pk2(a[0], a[1]); o.y = pk2(a[2], a[3]); o.z = pk2(b[0], b[1]); o.w = pk2(b[2], b[3]); *(u32x4*)(xb + (size_t)i * 8) = o; }
}
DI void p_convert_moe(Frame& F, const Args& args) {
    LAS float* scr = (LAS float*)(F.lds + F.wave * 16384);
    const int gw = F.bid * 8 + F.wave, NGW = F.G * 8;
    bf16* Wgu = (bf16*)(F.ws + WS_MWGU); bf16* Wdn = (bf16*)(F.ws + WS_MWDN);
    constexpr int I_G = 32 * 224, I_D = 112 * 64;
    constexpr int T_G = 16 * I_G, T_D = 8 * I_D;
    for (int it = gw; it < T_G + T_D; it += NGW) {
        int r = it;
        if (r < T_G) { const int ew = r / I_G, q = r % I_G, kb = q / 224, nb = q % 224, e = ew >> 1, which = ew & 1;
            tr_item((which ? INF(22) : INF(21)) + (size_t)e * DM * DEXP, DEXP, DEXP, Wgu + (size_t)e * 2 * DEXP * DM, DM, 0, RmGU{which * 128}, scr, 64 * kb, 32 * nb, F.lane); continue; } r -= T_G;
        { const int e = r / I_D, q = r % I_D, kb = q / 64, nb = q % 64;
          tr_item(INF(23) + (size_t)e * DEXP * DM, DM, DM, Wdn + (size_t)e * DM * DEXP, DEXP, 0, RmId{0}, scr, 64 * kb, 32 * nb, F.lane); }
    }
}

DI void ld8(const bf16* p, float (&v)[8]) { const u32x4 w = *(const u32x4*)p; v[0] = bflo(w.x); v[1] = bfhi(w.x); v[2] = bflo(w.y); v[3] = bfhi(w.y); v[4] = bflo(w.z); v[5] = bfhi(w.z); v[6] = bflo(w.w); v[7] = bfhi(w.w); }
DI void st8(bf16* p, const float (&v)[8]) { u32x4 o; o.x = pk2(v[0], v[1]); o.y = pk2(v[2], v[3]); o.z = pk2(v[4], v[5]); o.w = pk2(v[6], v[7]); *(u32x4*)p = o; }

DI void p2_prep(Frame& F, const Args& args, int layer) {
    bf16* proj = (bf16*)(F.ws + WS_PROJ); bf16* diff = (bf16*)(F.ws + WS_DIFF); bf16* xc = (bf16*)(F.ws + WS_XC);
    const float* cosA = (const float*)(F.ws + WS_COSA); const float* sinA = (const float*)(F.ws + WS_SINA); const float* cosI = (const float*)(F.ws + WS_COSI); const float* sinI = (const float*)(F.ws + WS_SINI);
    const int gt = F.bid * 512 + F.tid, NT = F.G * 512;
    for (int it = gt; it < MTOK * 228; it += NT) {
        const int tok = it / 228, j = it % 228; int col, half, d; const float *ct, *st;
        if (j < 128) { d = (j & 7) * 8; col = C_Q + (j >> 3) * 128 + d; half = 64; ct = cosA + tok * 64 + d; st = sinA + tok * 64 + d; }
        else if (j < 160) { const int jj = j - 128; d = (jj & 7) * 8; col = C_K + (jj >> 3) * 128 + d; half = 64; ct = cosA + tok * 64 + d; st = sinA + tok * 64 + d; }
        else if (j < 224) { const int jj = j - 160; d = (jj & 3) * 8; col = C_QI + (jj >> 2) * 64 + d; half = 32; ct = cosI + tok * 32 + d; st = sinI + tok * 32 + d; }
        else { d = (j - 224) * 8; col = C_KI + d; half = 32; ct = cosI + tok * 32 + d; st = sinI + tok * 32 + d; }
        bf16* p1 = proj + (size_t)tok * NINP + col; bf16* p2 = p1 + half;
        float x1[8], x2[8], y1[8], y2[8]; ld8(p1, x1); ld8(p2, x2);
        const f32x4 c0 = *(const f32x4*)ct, c1 = *(const f32x4*)(ct + 4), s0 = *(const f32x4*)st, s1 = *(const f32x4*)(st + 4);
#pragma unroll
        for (int i = 0; i < 8; ++i) { const float c = i < 4 ? c0[i & 3] : c1[i & 3], s = i < 4 ? s0[i & 3] : s1[i & 3]; y1[i] = x1[i] * c - x2[i] * s; y2[i] = x2[i] * c + x1[i] * s; }
        st8(p1, y1); st8(p2, y2);
    }
    const float* cw = INF(6) + (size_t)layer * 4 * DM; const float* cb = INF(7) + (size_t)layer * DM;
    for (int it = gt; it < MTOK * 256; it += NT) {
        const int tok = it >> 8, c = (it & 255) * 8, tpos = tok & (SEQ - 1);
        { const int g = c >> 9, W = 2 << g, cnt = (tpos + 1) < W ? (tpos + 1) : W;
          float sum[8], cur[8], v[8]; const bf16* pp = proj + (size_t)tok * NINP + C_P + c; ld8(pp, cur);
#pragma unroll
          for (int i = 0; i < 8; ++i) sum[i] = cur[i];
          for (int jj = 1; jj < cnt; ++jj) { ld8(pp - (size_t)jj * NINP, v);
#pragma unroll
              for (int i = 0; i < 8; ++i) sum[i] += v[i]; }
          const float rc = 1.0f / (float)cnt;
#pragma unroll
          for (int i = 0; i < 8; ++i) v[i] = sum[i] * rc - cur[i];
          st8(diff + (size_t)tok * DM + c, v); }
        { float acc[8], v[8]; const f32x4 b0 = *(const f32x4*)(cb + c), b1 = *(const f32x4*)(cb + c + 4);
#pragma unroll
          for (int i = 0; i < 8; ++i) acc[i] = i < 4 ? b0[i & 3] : b1[i & 3];
          const bf16* px = proj + (size_t)tok * NINP + C_XR + c;
#pragma unroll
          for (int jj = 0; jj < 4; ++jj) { const int back = 3 - jj; if (tpos - back >= 0) { ld8(px - (size_t)back * NINP, v);
              const f32x4 w0 = *(const f32x4*)(cw + jj * DM + c), w1 = *(const f32x4*)(cw + jj * DM + c + 4);
#pragma unroll
              for (int i = 0; i < 8; ++i) acc[i] += v[i] * (i < 4 ? w0[i & 3] : w1[i & 3]); } }
          st8(xc + (size_t)tok * DM + c, acc); }
    }
}

DI void p3_indexer(Frame& F) {
    const bf16* proj = (const bf16*)(F.ws + WS_PROJ); float* sc = (float*)(F.ws + WS_SC);
    const int gw = F.bid * 8 + F.wave, NGW = F.G * 8, l15 = F.lane & 15, l4 = F.lane >> 4;
    for (int u = gw; u < BATCH * 576; u += NGW) {
        const int b = u / 576, r = u % 576; int g8 = 0;
#pragma unroll
        for (int k = 1; k < 8; ++k) g8 = (r >= 8 * k * (k + 1)) ? k : g8;
        const int rr = r - 8 * g8 * (g8 + 1), sp = rr % (g8 + 1), qq = rr / (g8 + 1), qb16 = g8 * 16 + qq, c = qb16 >> 2;
        const int limit = (c + 1) * 64, kbeg = sp * 256, kend = (kbeg + 256) < limit ? (kbeg + 256) : limit;
        const int qtok = b * SEQ + qb16 * 16 + l15;
        const bf16* qrow = proj + (size_t)qtok * NINP;
        bf16x8 qf[16][2]; float w[16];
        { const u32x4 w0 = *(const u32x4*)(qrow + C_WI), w1 = *(const u32x4*)(qrow + C_WI + 8); const float s = 0.125f * 0.25f;
          w[0] = bflo(w0.x) * s; w[1] = bfhi(w0.x) * s; w[2] = bflo(w0.y) * s; w[3] = bfhi(w0.y) * s; w[4] = bflo(w0.z) * s; w[5] = bfhi(w0.z) * s; w[6] = bflo(w0.w) * s; w[7] = bfhi(w0.w) * s;
          w[8] = bflo(w1.x) * s; w[9] = bfhi(w1.x) * s; w[10] = bflo(w1.y) * s; w[11] = bfhi(w1.y) * s; w[12] = bflo(w1.z) * s; w[13] = bfhi(w1.z) * s; w[14] = bflo(w1.w) * s; w[15] = bfhi(w1.w) * s; }
#pragma unroll
        for (int h = 0; h < 16; ++h)
#pragma unroll
            for (int ks = 0; ks < 2; ++ks) qf[h][ks] = *(const bf16x8*)(qrow + C_QI + h * 64 + ks * 32 + l4 * 8);
        for (int k0 = kbeg; k0 < kend; k0 += 16) {
            const bf16* krow = proj + (size_t)(b * SEQ + k0 + l15) * NINP + C_KI + l4 * 8;
            const bf16x8 ka0 = *(const bf16x8*)krow, ka1 = *(const bf16x8*)(krow + 32);
            f32x4 tot = {0.f, 0.f, 0.f, 0.f};
#pragma unroll
            for (int h = 0; h < 16; ++h) { f32x4 s = {0.f, 0.f, 0.f, 0.f};
                s = __builtin_amdgcn_mfma_f32_16x16x32_bf16(ka0, qf[h][0], s, 0, 0, 0); s = __builtin_amdgcn_mfma_f32_16x16x32_bf16(ka1, qf[h][1], s, 0, 0, 0);
#pragma unroll
                for (int j = 0; j < 4; ++j) tot[j] += w[h] * fmaxf(s[j], 0.f); }
            *(f32x4*)(sc + (size_t)qtok * SEQ + k0 + 4 * l4) = tot;
        }
    }
}

DI void p4_select(Frame& F) {
    const float* sc = (const float*)(F.ws + WS_SC); unsigned* mask = (unsigned*)(F.ws + WS_MASK);
    const int gw = F.bid * 8 + F.wave, NGW = F.G * 8, lane = F.lane;
    for (int tok = gw; tok < MTOK; tok += NGW) {
        const int tpos = tok & (SEQ - 1), limit = ((tpos >> 6) + 1) * 64, nw = limit >> 5;
        unsigned mw = 0u;
        if (limit <= 256) { mw = lane < nw ? 0xffffffffu : 0u; }
        else {
            unsigned key[32];
            if (lane < nw) { const float* p = sc + (size_t)tok * SEQ + lane * 32;
#pragma unroll
                for (int q = 0; q < 8; ++q) { const f32x4 v = *(const f32x4*)(p + 4 * q);
#pragma unroll
                    for (int j = 0; j < 4; ++j) { const unsigned uu = __float_as_uint(v[j]); key[4 * q + j] = (uu & 0x80000000u) ? ~uu : (uu | 0x80000000u); } } }
            else {
#pragma unroll
                for (int j = 0; j < 32; ++j) key[j] = 0u; }
            unsigned T = 0u; bool exact = false;
            for (int bit = 31; bit >= 0; --bit) {
                const unsigned cand = T | (1u << bit); int cnt = 0;
#pragma unroll
                for (int j = 0; j < 32; ++j) cnt += __popcll(__ballot(key[j] >= cand));
                if (cnt >= 256) { T = cand; if (cnt == 256) { exact = true; break; } }
            }
            unsigned gtw = 0u, eqw = 0u;
#pragma unroll
            for (int j = 0; j < 32; ++j) { gtw |= (key[j] > T) ? (1u << j) : 0u; eqw |= (key[j] == T) ? (1u << j) : 0u; }
            if (exact) { mw = gtw | eqw; }
            else {
                int ngt = 0;
#pragma unroll
                for (int j = 0; j < 32; ++j) ngt += __popcll(__ballot(key[j] > T));
                const int need = 256 - ngt; const int el = __popc(eqw);
                int pre = el;
#pragma unroll
                for (int o = 1; o < 64; o <<= 1) { const int t = __shfl_up(pre, o); pre += (lane >= o) ? t : 0; }
                int take = need - (pre - el); take = take < 0 ? 0 : (take > el ? el : take);
                unsigned sel = 0u, rem = eqw;
                for (int t = 0; t < 32; ++t) { if (t < take) { const unsigned low = rem & (0u - rem); sel |= low; rem ^= low; } }
                mw = gtw | sel;
            }
        }
        mask[(size_t)tok * 64 + lane] = mw;
    }
}

DI void p4_lru_pass1(Frame& F) {
    const float* A = (const float*)(F.ws + WS_A); const float* B = (const float*)(F.ws + WS_B); float* CP = (float*)(F.ws + WS_CARRY); float* CH = CP + BATCH * 32 * DM;
    for (int u = F.bid; u < BATCH * 32 * 2; u += F.G) {
        const int hh = u & 1, j = (u >> 1) & 31, b = u >> 6, c = hh * 1024 + 2 * F.tid;
        const size_t base = ((size_t)b * SEQ + j * 64) * DM + c;
        f32x2 P = {1.f, 1.f}, H = {0.f, 0.f};
#pragma unroll 8
        for (int t = 0; t < 64; ++t) { const f32x2 a = *(const f32x2*)(A + base + (size_t)t * DM), bb = *(const f32x2*)(B + base + (size_t)t * DM); H = a * H + bb; P = P * a; }
        *(f32x2*)(CP + ((size_t)b * 32 + j) * DM + c) = P; *(f32x2*)(CH + ((size_t)b * 32 + j) * DM + c) = H;
    }
}
DI void p5_lru_pass2(Frame& F) {
    const float* A = (const float*)(F.ws + WS_A); const float* B = (const float*)(F.ws + WS_B); const float* CP = (const float*)(F.ws + WS_CARRY); const float* CH = CP + BATCH * 32 * DM;
    const bf16* proj = (const bf16*)(F.ws + WS_PROJ); bf16* mrg = (bf16*)(F.ws + WS_MRG);
    for (int u = F.bid; u < BATCH * 32 * 2; u += F.G) {
        const int hh = u & 1, j = (u >> 1) & 31, b = u >> 6, c = hh * 1024 + 2 * F.tid;
        f32x2 h = {0.f, 0.f};
        for (int jj = 0; jj < j; ++jj) { const f32x2 p = *(const f32x2*)(CP + ((size_t)b * 32 + jj) * DM + c), q = *(const f32x2*)(CH + ((size_t)b * 32 + jj) * DM + c); h = p * h + q; }
        const size_t tok0 = (size_t)b * SEQ + j * 64;
#pragma unroll 4
        for (int t = 0; t < 64; ++t) { const size_t tok = tok0 + t; const f32x2 a = *(const f32x2*)(A + tok * DM + c), bb = *(const f32x2*)(B + tok * DM + c); h = a * h + bb;
            const unsigned gr = *(const unsigned*)(proj + tok * NINP + C_GR + c), gg = *(const unsigned*)(proj + tok * NINP + C_G + 4096 + c);
            const float y0 = h[0] * gelu_tanh_(bflo(gr)) * sigmoidf_(bflo(gg)), y1 = h[1] * gelu_tanh_(bfhi(gr)) * sigmoidf_(bfhi(gg));
            *(unsigned*)(mrg + tok * MIXW + 4096 + c) = pk2(y0, y1); }
    }
}

constexpr int KS_STRIDE = 272, VT_STRIDE = 136;
constexpr int ATT_KS = 0, ATT_VT = 64 * KS_STRIDE;
DI void p5_attention(Frame& F) {
    const bf16* proj = (const bf16*)(F.ws + WS_PROJ); const unsigned* mask = (const unsigned*)(F.ws + WS_MASK); bf16* mrg = (bf16*)(F.ws + WS_MRG);
    LAS unsigned char* Ks = F.lds + ATT_KS; LAS unsigned char* Vt = F.lds + ATT_VT;
    const int lane = F.lane, l31 = lane & 31, hf = lane >> 5, wave = F.wave, hh = wave >> 1, qh = wave & 1, tid = F.tid;
    const float sc2 = 0.08838834764831845f * 1.4426950408889634f;
    for (int u = F.bid; u < BATCH * 16 * 4; u += F.G) {
        const int g = u & 3, cp = (u >> 2) & 15, b = u >> 6;
        for (int half = 0; half < 2; ++half) {
            const int c = half ? (31 - cp) : cp, nkt = c + 1, head = g * 4 + hh;
            const int qtok = b * SEQ + c * 64 + qh * 32 + l31;
            const bf16* qrow = proj + (size_t)qtok * NINP + C_Q + head * 128 + hf * 8;
            bf16x8 qf[8];
#pragma unroll
            for (int ks = 0; ks < 8; ++ks) qf[ks] = *(const bf16x8*)(qrow + ks * 16);
            f32x16 o[4];
#pragma unroll
            for (int db = 0; db < 4; ++db)
#pragma unroll
                for (int i = 0; i < 16; ++i) o[db][i] = 0.f;
            float mrun = -1e30f, lrun = 0.f;
            const int sr0 = tid >> 4, sch = tid & 15;
            const bf16* kg = proj + (size_t)(b * SEQ + sr0) * NINP + C_K + g * 128 + sch * 8;
            const bf16* vg = proj + (size_t)(b * SEQ + sr0) * NINP + C_V + g * 128 + sch * 8;
            u32x4 kr0 = *(const u32x4*)kg, kr1 = *(const u32x4*)(kg + (size_t)32 * NINP), vr0 = *(const u32x4*)vg, vr1 = *(const u32x4*)(vg + (size_t)32 * NINP);
            const unsigned* mrow = mask + (size_t)qtok * 64;
            unsigned mw0 = mrow[0], mw1 = mrow[1];
            for (int kt = 0; kt < nkt; ++kt) {
                __syncthreads();
                *(LAS u32x4*)(Ks + sr0 * KS_STRIDE + sch * 16) = kr0; *(LAS u32x4*)(Ks + (sr0 + 32) * KS_STRIDE + sch * 16) = kr1;
                { const unsigned vv0[4] = {vr0.x, vr0.y, vr0.z, vr0.w}, vv1[4] = {vr1.x, vr1.y, vr1.z, vr1.w};
#pragma unroll
                  for (int i = 0; i < 4; ++i) { LAS unsigned char* d0 = Vt + (sch * 8 + 2 * i) * VT_STRIDE;
                      *(LAS bf16*)(d0 + sr0 * 2) = (bf16)(vv0[i] & 0xffffu); *(LAS bf16*)(d0 + VT_STRIDE + sr0 * 2) = (bf16)(vv0[i] >> 16);
                      *(LAS bf16*)(d0 + (sr0 + 32) * 2) = (bf16)(vv1[i] & 0xffffu); *(LAS bf16*)(d0 + VT_STRIDE + (sr0 + 32) * 2) = (bf16)(vv1[i] >> 16); } }
                __syncthreads();
                const unsigned cm0 = mw0, cm1 = mw1;
                if (kt + 1 < nkt) { const size_t adv = (size_t)(kt + 1) * 64 * NINP;
                    kr0 = *(const u32x4*)(kg + adv); kr1 = *(const u32x4*)(kg + adv + (size_t)32 * NINP); vr0 = *(const u32x4*)(vg + adv); vr1 = *(const u32x4*)(vg + adv + (size_t)32 * NINP);
                    mw0 = mrow[2 * kt + 2]; mw1 = mrow[2 * kt + 3]; }
                f32x16 s0, s1;
#pragma unroll
                for (int i = 0; i < 16; ++i) { s0[i] = 0.f; s1[i] = 0.f; }
#pragma unroll
                for (int ks = 0; ks < 8; ++ks) {
                    const bf16x8 ka = *(const LAS bf16x8*)(Ks + l31 * KS_STRIDE + ks * 32 + hf * 16);
                    const bf16x8 kb = *(const LAS bf16x8*)(Ks + (32 + l31) * KS_STRIDE + ks * 32 + hf * 16);
                    s0 = __builtin_amdgcn_mfma_f32_32x32x16_bf16(ka, qf[ks], s0, 0, 0, 0);
                    s1 = __builtin_amdgcn_mfma_f32_32x32x16_bf16(kb, qf[ks], s1, 0, 0, 0);
                }
                const unsigned sm0 = cm0 >> (4 * hf), sm1 = cm1 >> (4 * hf);
                float tmax = -INFINITY;
#pragma unroll
                for (int i = 0; i < 16; ++i) { const unsigned bit = 1u << ((i & 3) + 8 * (i >> 2));
                    s0[i] = (sm0 & bit) ? s0[i] * sc2 : -INFINITY; s1[i] = (sm1 & bit) ? s1[i] * sc2 : -INFINITY; tmax = fmaxf(tmax, fmaxf(s0[i], s1[i])); }
                tmax = fmaxf(tmax, __shfl_xor(tmax, 32));
                const float mnew = fmaxf(mrun, tmax), alpha = exp2f(mrun - mnew); mrun = mnew;
                float psum = 0.f;
#pragma unroll
                for (int i = 0; i < 16; ++i) { s0[i] = exp2f(s0[i] - mnew); s1[i] = exp2f(s1[i] - mnew); psum += s0[i] + s1[i]; }
                lrun = lrun * alpha + psum;
#pragma unroll
                for (int db = 0; db < 4; ++db)
#pragma unroll
                    for (int i = 0; i < 16; ++i) o[db][i] *= alpha;
#pragma unroll
                for (int kb = 0; kb < 2; ++kb)
#pragma unroll
                    for (int s = 0; s < 2; ++s) {
                        u32x4 pw;
                        if (kb == 0) { pw.x = pk2(s0[8 * s], s0[8 * s + 1]); pw.y = pk2(s0[8 * s + 2], s0[8 * s + 3]); pw.z = pk2(s0[8 * s + 4], s0[8 * s + 5]); pw.w = pk2(s0[8 * s + 6], s0[8 * s + 7]); }
                        else { pw.x = pk2(s1[8 * s], s1[8 * s + 1]); pw.y = pk2(s1[8 * s + 2], s1[8 * s + 3]); pw.z = pk2(s1[8 * s + 4], s1[8 * s + 5]); pw.w = pk2(s1[8 * s + 6], s1[8 * s + 7]); }
                        const bf16x8 pf = __builtin_bit_cast(bf16x8, pw);
#pragma unroll
                        for (int db = 0; db < 4; ++db) {
                            const LAS unsigned char* vp = Vt + (db * 32 + l31) * VT_STRIDE + (kb * 32 + 16 * s + 4 * hf) * 2;
                            const u32x2 lo = *(const LAS u32x2*)vp, hi = *(const LAS u32x2*)(vp + 16);
                            const u32x4 vw = {lo.x, lo.y, hi.x, hi.y};
                            o[db] = __builtin_amdgcn_mfma_f32_32x32x16_bf16(__builtin_bit_cast(bf16x8, vw), pf, o[db], 0, 0, 0);
                        }
                    }
            }
            const float ltot = lrun + __shfl_xor(lrun, 32), rl = 1.0f / ltot;
            const bf16* grow = proj + (size_t)qtok * NINP + C_G + head * 128; bf16* orow = mrg + (size_t)qtok * MIXW + head * 128;
#pragma unroll
            for (int db = 0; db < 4; ++db)
#pragma unroll
                for (int q4 = 0; q4 < 4; ++q4) { const int d0 = db * 32 + q4 * 8 + hf * 4; const u32x2 gv = *(const u32x2*)(grow + d0);
                    u32x2 w; w.x = pk2(o[db][4 * q4] * rl * sigmoidf_(bflo(gv.x)), o[db][4 * q4 + 1] * rl * sigmoidf_(bfhi(gv.x)));
                    w.y = pk2(o[db][4 * q4 + 2] * rl * sigmoidf_(bflo(gv.y)), o[db][4 * q4 + 3] * rl * sigmoidf_(bfhi(gv.y)));
                    *(u32x2*)(orow + d0) = w; }
        }
    }
    __syncthreads();
}

template <int MODE, bool ROUTE, bool WRITE_BF>
DI void p_layernorm(Frame& F, const Args& args, const float* src, const float* gam, const float* bet, float* outf, bf16* outb) {
    const int gw = F.bid * 8 + F.wave, NGW = F.G * 8, lane = F.lane;
    const unsigned* rt = (const unsigned*)(F.ws + WS_ROUTE); unsigned* rtw = (unsigned*)(F.ws + WS_ROUTE);
    LAS float* wr_l = (LAS float*)F.lds;
    if (ROUTE) { for (int i = F.tid; i < DM * NEXP / 4; i += 512) *(LAS f32x4*)(wr_l + 4 * i) = *(const f32x4*)(INF(20) + 4 * i); __syncthreads(); }
    for (int row = gw; row < MTOK; row += NGW) {
        f32x4 v[8]; float s = 0.f;
        if (MODE == 0) {
#pragma unroll
            for (int j = 0; j < 8; ++j) v[j] = *(const f32x4*)(src + (size_t)row * DM + 4 * lane + 256 * j);
        } else {
            const unsigned r0 = rt[RT_ROW + 2 * row], r1 = rt[RT_ROW + 2 * row + 1]; const float w0 = __uint_as_float(rt[RT_W + 2 * row]), w1 = __uint_as_float(rt[RT_W + 2 * row + 1]);
            const float* yb = (const float*)(F.ws + WS_YB);
#pragma unroll
            for (int j = 0; j < 8; ++j) { const int cc = 4 * lane + 256 * j; v[j] = *(const f32x4*)(src + (size_t)row * DM + cc) * ALPHA + *(const f32x4*)(yb + (size_t)r0 * DM + cc) * w0 + *(const f32x4*)(yb + (size_t)r1 * DM + cc) * w1; }
        }
#pragma unroll
        for (int j = 0; j < 8; ++j) s += (v[j][0] + v[j][1]) + (v[j][2] + v[j][3]);
        const float mean = wave_sum(s) * (1.f / DM); float s2 = 0.f;
#pragma unroll
        for (int j = 0; j < 8; ++j) { v[j] = v[j] - mean; s2 += (v[j][0] * v[j][0] + v[j][1] * v[j][1]) + (v[j][2] * v[j][2] + v[j][3] * v[j][3]); }
        const float rstd = 1.0f / sqrtf(wave_sum(s2) * (1.f / DM) + LN_EPS);
        float lg[8];
#pragma unroll
        for (int e = 0; e < 8; ++e) lg[e] = 0.f;
#pragma unroll
        for (int j = 0; j < 8; ++j) { const f32x4 gv = *(const f32x4*)(gam + 4 * lane + 256 * j), bv = *(const f32x4*)(bet + 4 * lane + 256 * j);
            const f32x4 y = v[j] * rstd * gv + bv; *(f32x4*)(outf + (size_t)row * DM + 4 * lane + 256 * j) = y;
            if (WRITE_BF) { u32x2 w; w.x = pk2(y[0], y[1]); w.y = pk2(y[2], y[3]); *(u32x2*)(outb + (size_t)row * DM + 4 * lane + 256 * j) = w; }
            if (ROUTE) {
#pragma unroll
                for (int i = 0; i < 4; ++i) { const LAS float* wp = wr_l + (size_t)(4 * lane + 256 * j + i) * 8; const f32x4 wa = *(const LAS f32x4*)wp, wb = *(const LAS f32x4*)(wp + 4); const float xv = y[i];
                    lg[0] += xv * wa[0]; lg[1] += xv * wa[1]; lg[2] += xv * wa[2]; lg[3] += xv * wa[3]; lg[4] += xv * wb[0]; lg[5] += xv * wb[1]; lg[6] += xv * wb[2]; lg[7] += xv * wb[3]; }
            }
            asm volatile("" ::: "memory"); }
        if (ROUTE) {
#pragma unroll
            for (int e = 0; e < 8; ++e) lg[e] = wave_sum(lg[e]);
            int e0 = 0; float l0 = lg[0];
#pragma unroll
            for (int e = 1; e < 8; ++e) if (lg[e] > l0) { l0 = lg[e]; e0 = e; }
            int e1 = 0; float l1 = -INFINITY;
#pragma unroll
            for (int e = 0; e < 8; ++e) if (e != e0 && lg[e] > l1) { l1 = lg[e]; e1 = e; }
            const float p1 = 1.0f / (1.0f + expf(l0 - l1)), p0 = 1.0f - p1;
            if (lane == 0) { const unsigned sl0 = atomicAdd(F.ctl + CW_CNT + e0, 1u), sl1 = atomicAdd(F.ctl + CW_CNT + e1, 1u);
                rtw[RT_E + 2 * row] = (unsigned)e0; rtw[RT_E + 2 * row + 1] = (unsigned)e1; rtw[RT_SLOT + 2 * row] = sl0; rtw[RT_SLOT + 2 * row + 1] = sl1;
                rtw[RT_W + 2 * row] = __float_as_uint(p0); rtw[RT_W + 2 * row + 1] = __float_as_uint(p1); }
        }
    }
    if (ROUTE) __syncthreads();
}

DI void p_moe_gather(Frame& F) {
    const unsigned* cnt = F.ctl + CW_CNT; unsigned* rt = (unsigned*)(F.ws + WS_ROUTE);
    const bf16* x1b = (const bf16*)(F.ws + WS_X1B); bf16* am = (bf16*)(F.ws + WS_AMOE);
    int ts[9]; ts[0] = 0;
#pragma unroll
    for (int e = 0; e < 8; ++e) ts[e + 1] = ts[e] + (((int)cnt[e] + 255) >> 8);
    const int gw = F.bid * 8 + F.wave, NGW = F.G * 8, lane = F.lane;
    for (int a = gw; a < MTOK * 2; a += NGW) {
        const int tok = a >> 1; const int e = (int)rt[RT_E + a], slot = (int)rt[RT_SLOT + a]; int tse = 0;
#pragma unroll
        for (int k = 0; k < 8; ++k) tse = (e == k) ? ts[k] : tse;
        const int row = tse * 256 + slot;
        const u32x4* s = (const u32x4*)(x1b + (size_t)tok * DM); u32x4* d = (u32x4*)(am + (size_t)row * DM);
#pragma unroll
        for (int i = 0; i < 4; ++i) d[lane + 64 * i] = s[lane + 64 * i];
        if (lane == 0) rt[RT_ROW + a] = (unsigned)row;
    }
    for (int pr = gw; pr < 8 * 256; pr += NGW) { const int e = pr >> 8, i = pr & 255; int tse = 0, tn = 0, ce = 0;
#pragma unroll
        for (int k = 0; k < 8; ++k) { tse = (e == k) ? ts[k] : tse; tn = (e == k) ? ts[k + 1] : tn; ce = (e == k) ? (int)cnt[k] : ce; }
        const int row = tse * 256 + ce + i;
        if (row < tn * 256) { u32x4* d = (u32x4*)(am + (size_t)row * DM);
#pragma unroll
            for (int q = 0; q < 4; ++q) d[lane + 64 * q] = (u32x4){0u, 0u, 0u, 0u}; } }
}

constexpr int NPH_LAYER = 12;
constexpr int NPHASES = 1 + 2 * NPH_LAYER;
#define IN(k) (lo <= (k) && (k) < hi)
#define RELAUNDER() do { int l_ = lane_id_(); asm volatile("" : "+v"(l_)); F.lane = l_; F.tid = F.wave * 64 + l_; } while (0)
#define SEAM(k) do { if (IN(k) && IN((k) + 1)) xcd_barrier(bar); } while (0)
template <int LAYER>
DI void run_layer(Frame& F, const Args& args, const XcdBarrier& bar, const int lo, const int hi) {
    constexpr int P = 1 + NPH_LAYER * LAYER;
    bf16* proj = (bf16*)(F.ws + WS_PROJ); bf16* xb = (bf16*)(F.ws + WS_XB); bf16* mrg = (bf16*)(F.ws + WS_MRG);
    float* x1 = (float*)(F.ws + WS_X1); bf16* x1b = (bf16*)(F.ws + WS_X1B); float* x2 = (float*)(F.ws + WS_X2); float* pre = (float*)(F.ws + WS_PRE);
    if (IN(P + 0)) {
        pg8::Gemm g{xb, (const bf16*)(F.ws + WS_WIN) + (size_t)LAYER * NINP * DM, DM, DM, DM};
        pg8::TileOrder S; S.init(MTOK / 256, NINP / 256, F.G, F.bid, (size_t)256 * DM * 2, (size_t)256 * DM * 2);
        pg8::EpiBf16 E{proj, NINP};
        pg8::gemm_phase(F.lds, g, S, E, F.wave);
    }
    SEAM(P + 0);
    if (IN(P + 1)) { RELAUNDER(); p2_prep(F, args, LAYER); }
    SEAM(P + 1);
    if (IN(P + 2)) {
        { pg8::Gemm g{(const bf16*)(F.ws + WS_DIFF), (const bf16*)(F.ws + WS_WPOOL) + (size_t)LAYER * 2048 * 512, DM, 512, 512};
          pg8::TileOrder S; S.init(MTOK / 256, 8, F.G, F.bid, (size_t)256 * DM * 2, (size_t)256 * 512 * 2, 2, (size_t)512 * 2);
          pg8::EpiPool E{mrg, proj, INF(5) + (size_t)LAYER * DM};
          pg8::gemm_phase(F.lds, g, S, E, F.wave); }
        { pg8::Gemm g{(const bf16*)(F.ws + WS_XC), (const bf16*)(F.ws + WS_WLRU) + (size_t)LAYER * 4096 * 256, DM, 256, 256};
          pg8::TileOrder S; S.init(MTOK / 256, 16, F.G, F.bid, (size_t)256 * DM * 2, (size_t)256 * 256 * 2, 2, (size_t)256 * 2);
          pg8::EpiLru E{(float*)(F.ws + WS_A), (float*)(F.ws + WS_B), (const bf16*)(F.ws + WS_XC), INF(9) + (size_t)LAYER * DM, INF(11) + (size_t)LAYER * DM, (const float*)(F.ws + WS_LRUC) + (size_t)LAYER * DM};
          pg8::gemm_phase(F.lds, g, S, E, F.wave); }
        RELAUNDER(); p3_indexer(F);
    }
    SEAM(P + 2);
    if (IN(P + 3)) { RELAUNDER(); p4_select(F); RELAUNDER(); p4_lru_pass1(F); }
    SEAM(P + 3);
    if (IN(P + 4)) { RELAUNDER(); p5_attention(F); RELAUNDER(); p5_lru_pass2(F); }
    SEAM(P + 4);
    if (IN(P + 5)) {
        pg8::Gemm g{mrg, (const bf16*)(F.ws + WS_WOUT) + (size_t)LAYER * DM * MIXW, MIXW, MIXW, MIXW};
        pg8::TileOrder S; S.init(MTOK / 256, DM / 256, F.G, F.bid, (size_t)256 * MIXW * 2, (size_t)256 * MIXW * 2);
        pg8::EpiRes E{pre, LAYER == 0 ? INF(0) : (const float*)x2, DM};
        pg8::gemm_phase(F.lds, g, S, E, F.wave);
    }
    SEAM(P + 5);
    if (IN(P + 6)) { RELAUNDER(); } if (IN(P + 6)) p_layernorm<0, LAYER == 1, true>(F, args, pre, INF(13) + LAYER * DM, INF(14) + LAYER * DM, x1, x1b);
    SEAM(P + 6);
    if constexpr (LAYER == 0) {
        if (IN(P + 7)) {
            pg8::Gemm g{x1b, (const bf16*)(F.ws + WS_WGU), DM, DM, DM};
            pg8::TileOrder S; S.init(MTOK / 256, 2 * DFF / 256, F.G, F.bid, (size_t)256 * DM * 2, (size_t)256 * DM * 2);
            pg8::EpiSwiglu E{(bf16*)(F.ws + WS_H), DFF};
            pg8::gemm_phase(F.lds, g, S, E, F.wave);
        }
        SEAM(P + 7);
        if (IN(P + 8)) {
            pg8::Gemm g{(const bf16*)(F.ws + WS_H), (const bf16*)(F.ws + WS_WDN), DFF, DFF, DFF};
            pg8::TileOrder S; S.init(MTOK / 256, DM / 256, F.G, F.bid, (size_t)256 * DFF * 2, (size_t)256 * DFF * 2);
            pg8::EpiRes E{pre, x1, DM};
            pg8::gemm_phase(F.lds, g, S, E, F.wave);
        }
        SEAM(P + 8);
        if (IN(P + 9)) { RELAUNDER(); } if (IN(P + 9)) p_layernorm<0, false, true>(F, args, pre, INF(15), INF(16), x2, xb);
        SEAM(P + 9); SEAM(P + 10); SEAM(P + 11);
    } else {
        if (IN(P + 7)) { RELAUNDER(); p_convert_moe(F, args); RELAUNDER(); p_moe_gather(F); }
        SEAM(P + 7);
        if (IN(P + 8)) {
            pg8::Gemm g{(const bf16*)(F.ws + WS_AMOE), (const bf16*)(F.ws + WS_MWGU), DM, DM, DM};
            pg8::MoeOrder S; S.init(F.ctl + CW_CNT, 2 * DEXP / 256, F.G, F.bid, (size_t)256 * DM * 2, (size_t)2 * DEXP * DM * 2, (size_t)256 * DM * 2);
            pg8::EpiSwiglu E{(bf16*)(F.ws + WS_HMOE), DEXP};
            pg8::gemm_phase(F.lds, g, S, E, F.wave);
        }
        SEAM(P + 8);
        if (IN(P + 9)) {
            pg8::Gemm g{(const bf16*)(F.ws + WS_HMOE), (const bf16*)(F.ws + WS_MWDN), DEXP, DEXP, DEXP};
            pg8::MoeOrder S; S.init(F.ctl + CW_CNT, DM / 256, F.G, F.bid, (size_t)256 * DEXP * 2, (size_t)DM * DEXP * 2, (size_t)256 * DEXP * 2);
            pg8::EpiF32 E{(float*)(F.ws + WS_YB), DM};
            pg8::gemm_phase(F.lds, g, S, E, F.wave);
        }
        SEAM(P + 9);
        if (IN(P + 10)) { RELAUNDER(); } if (IN(P + 10)) p_layernorm<1, false, false>(F, args, x1, INF(15) + DM, INF(16) + DM, args.out, nullptr);
    }
}
__global__ void __launch_bounds__(512, 2) fwd_kernel(Args args) {
    extern __shared__ __attribute__((aligned(16))) unsigned char lds_raw[];
    Frame F;
    F.lds = (LAS unsigned char*)lds_raw; F.ws = args.ws; F.ctl = (unsigned*)(args.ws + WS_CTL);
    F.wave = __builtin_amdgcn_readfirstlane((int)threadIdx.x >> 6); F.lane = lane_id_(); F.tid = F.wave * 64 + F.lane; F.G = gridDim.x; F.bid = blockIdx.x;
    volatile LAS unsigned* MISC = (volatile LAS unsigned*)(F.lds + LDSCTL_OFF);
    for (int u = F.tid; u < (LDS_BYTES - LDSCTL_OFF) / 4; u += 512) ((LAS unsigned*)(F.lds + LDSCTL_OFF))[u] = 0u;
    __syncthreads();
    const int lo = args.ph_lo, hi = args.ph_hi;
    XcdBarrier bar; bar.bar = F.ctl + CW_BAR; bar.x = 0; bar.st = nullptr; bar.wave = F.wave;
    if ((hi - lo) > 1) bar = xcd_barrier_post(F.ctl + CW_BAR, MISC + 8, F.wave);
    if (IN(0)) { RELAUNDER(); p0_prologue(F, args); __syncthreads(); }
    SEAM(0);
    run_layer<0>(F, args, bar, lo, hi);
    run_layer<1>(F, args, bar, lo, hi);
}
#undef IN
#undef SEAM

extern "C" void kernel_launch(void* const* d_in, const int* in_sizes, int n_in, void* d_out, int out_size, void* d_ws, size_t ws_size, hipStream_t stream) {
    static int grid = 0;
    if (grid == 0) {
        if (n_in != 24 || out_size != MTOK * DM || ws_size < WS_END) { fprintf(stderr, "kernel_launch: unexpected problem (n_in %d, out %d, ws %zu, need %zu)\n", n_in, out_size, ws_size, (size_t)WS_END); grid = -1; return; }
        int dev = 0, cus = 0, per_cu = 0;
        if (hipGetDevice(&dev) != hipSuccess || hipDeviceGetAttribute(&cus, hipDeviceAttributeMultiprocessorCount, dev) != hipSuccess) { grid = -1; return; }
        if (hipFuncSetAttribute((const void*)fwd_kernel, hipFuncAttributeMaxDynamicSharedMemorySize, LDS_BYTES) != hipSuccess) { fprintf(stderr, "kernel_launch: hipFuncSetAttribute failed\n"); grid = -1; return; }
        if (hipOccupancyMaxActiveBlocksPerMultiprocessor(&per_cu, (const void*)fwd_kernel, 512, LDS_BYTES) != hipSuccess || per_cu < 1) fprintf(stderr, "kernel_launch: occupancy query reports %d\n", per_cu);
        (void)hipGetLastError();
        grid = cus;
    }
    if (grid < 0) return;
    (void)hipMemsetAsync((char*)d_ws + WS_CTL, 0, CTL_ZERO_BYTES, stream);
    Args a{};
    for (int i = 0; i < 24; ++i) a.in[i] = d_in[i];
    a.out = (float*)d_out; a.ws = (unsigned char*)d_ws;
#if MK_N_LAUNCHES == 1
    a.ph_lo = 0; a.ph_hi = NPHASES;
    hipLaunchKernelGGL(fwd_kernel, dim3(grid), dim3(512), LDS_BYTES, stream, a);
#else
    const int plist[] = {0, 1, 2, 3, 4, 5, 6, 7, 8, 9, 10, 13, 14, 15, 16, 17, 18, 19, 20, 21, 22, 23};
    for (int i = 0; i < (int)(sizeof(plist) / sizeof(int)); ++i) { a.ph_lo = plist[i]; a.ph_hi = plist[i] + 1; hipLaunchKernelGGL(fwd_kernel, dim3(grid), dim3(512), LDS_BYTES, stream, a); }
#endif
}
```

```cpp
#include <hip/hip_runtime.h>
#include <cstdio>
#include <cstdint>

#ifndef MK_N_LAUNCHES
#define MK_N_LAUNCHES 1
#endif

#define DI __device__ __forceinline__
#define LAS __attribute__((address_space(3)))
#define GAS __attribute__((address_space(1)))
typedef unsigned short bf16;
typedef short bf16x8 __attribute__((ext_vector_type(8)));
typedef float f32x2 __attribute__((ext_vector_type(2)));
typedef float f32x4 __attribute__((ext_vector_type(4)));
typedef float f32x16 __attribute__((ext_vector_type(16)));
typedef unsigned u32x2 __attribute__((ext_vector_type(2)));
typedef unsigned u32x4 __attribute__((ext_vector_type(4)));
typedef __bf16 bf16x2_t __attribute__((ext_vector_type(2)));

#define LDS_WAIT() asm volatile("s_waitcnt lgkmcnt(0)" ::: "memory")
#define VM_WAIT() asm volatile("s_waitcnt vmcnt(0)" ::: "memory")

DI unsigned pk2(float lo, float hi) { f32x2 v = {lo, hi}; return __builtin_bit_cast(unsigned, __builtin_convertvector(v, bf16x2_t)); }
DI float bflo(unsigned w) { return __uint_as_float(w << 16); }
DI float bfhi(unsigned w) { return __uint_as_float(w & 0xffff0000u); }
DI float bf2f(bf16 b) { return __uint_as_float(((unsigned)b) << 16); }
DI float rcp_(float x) { return __builtin_amdgcn_rcpf(x); }
DI float sigmoidf_(float x) { return rcp_(1.0f + __expf(-x)); }
DI float siluf_(float x) { return x * rcp_(1.0f + __expf(-x)); }
DI float gelu_tanh_(float x) { const float u = 0.7978845608028654f * (x + 0.044715f * x * x * x); const float t = 1.0f - 2.0f * rcp_(1.0f + __expf(2.0f * u)); return 0.5f * x * (1.0f + t); }
DI float one_minus_exp_(float x) {
    const float p = -x * (1.0f + x * 0.5f * (1.0f + x * (1.0f / 3.0f) * (1.0f + x * 0.25f * (1.0f + x * 0.2f * (1.0f + x * (1.0f / 6.0f) * (1.0f + x * (1.0f / 7.0f)))))));
    return x > -0.5f ? p : 1.0f - __expf(x);
}
DI int lane_id_() { int l; asm volatile("v_mbcnt_lo_u32_b32 %0, -1, 0\n\tv_mbcnt_hi_u32_b32 %0, -1, %0" : "=v"(l)); return l; }

constexpr int DM = 2048, BATCH = 4, SEQ = 2048, MTOK = BATCH * SEQ;
constexpr int NIN = 16464, NINP = 16640;
constexpr int C_Q = 0, C_K = 2048, C_V = 2560, C_QI = 3072, C_KI = 4096, C_WI = 4160, C_PADLO = 4176, C_P = 4352, C_XR = 6400, C_GR = 8448, C_G = 10496;
constexpr int MIXW = 6144, DFF = 5504, NEXP = 8, DEXP = 7168;
constexpr int MOE_ROWS_MAX = (MTOK * 2 / 256 + NEXP) * 256;
constexpr float ALPHA = 1.4142135623730951f, LN_EPS = 1e-5f;

constexpr size_t MiB = 1u << 20;
constexpr size_t WS_CTL = 0, CTL_ZERO_BYTES = 1 * MiB;
constexpr size_t WS_COSA = 1 * MiB, WS_SINA = 3 * MiB, WS_COSI = 5 * MiB, WS_SINI = 6 * MiB;
constexpr size_t WS_CARRY = 7 * MiB;
constexpr size_t WS_ROUTE = 9 * MiB;
constexpr size_t WS_MASK = 10 * MiB;
constexpr size_t WS_LRUC = 9 * MiB + 512 * 1024;
constexpr size_t WS_WIN = 12 * MiB;
constexpr size_t WS_WOUT = 142 * MiB;
constexpr size_t WS_WPOOL = 190 * MiB;
constexpr size_t WS_WLRU = 194 * MiB;
constexpr size_t WS_WGU = 198 * MiB;
constexpr size_t WS_WDN = 241 * MiB;
constexpr size_t WS_XB = 263 * MiB;
constexpr size_t WS_X1 = 295 * MiB;
constexpr size_t WS_X1B = 359 * MiB;
constexpr size_t WS_X2 = 391 * MiB;
constexpr size_t WS_PRE = 455 * MiB;
constexpr size_t WS_OV = 519 * MiB;
constexpr size_t WS_PROJ = WS_OV;
constexpr size_t WS_DIFF = WS_OV + 260 * MiB;
constexpr size_t WS_XC = WS_OV + 292 * MiB;
constexpr size_t WS_A = WS_OV + 324 * MiB;
constexpr size_t WS_B = WS_OV + 388 * MiB;
constexpr size_t WS_SC = WS_OV + 452 * MiB;
constexpr size_t WS_MRG = WS_OV + 516 * MiB;
constexpr size_t WS_H = WS_OV;
constexpr size_t WS_MWGU = WS_OV;
constexpr size_t WS_MWDN = WS_OV + 448 * MiB;
constexpr size_t WS_AMOE = WS_OV + 672 * MiB;
constexpr size_t WS_HMOE = WS_OV + 744 * MiB;
constexpr size_t WS_YB = WS_OV + 996 * MiB;
constexpr size_t WS_END = WS_OV + 1140 * MiB;
constexpr int CW_BAR = 4096, CW_CNT = 16384;
constexpr int RT_E = 0, RT_SLOT = 2 * MTOK, RT_W = 4 * MTOK, RT_ROW = 6 * MTOK;

constexpr int RING_BYTES = 131072, LDSCTL_OFF = RING_BYTES, LDS_BYTES = 147456;

#define XB_TMO      128
#define XB_XCNT(j)  (256  + 64 * (j))
#define XB_XSUB(j)  (1280 + 64 * (j))
#define XB_XGEN(j)  (2304 + 64 * (j))
#define XB_TOP      3328
#define XB_TOPGEN   3392
#define XCD_BAR_WORDS 3456
#define XB_SPIN_CAP (1u << 18)
DI unsigned xb_ld(unsigned* p)              { return __hip_atomic_load(p, __ATOMIC_RELAXED, __HIP_MEMORY_SCOPE_AGENT); }
DI unsigned xb_add(unsigned* p, unsigned v) { return __hip_atomic_fetch_add(p, v, __ATOMIC_RELAXED, __HIP_MEMORY_SCOPE_AGENT); }
DI unsigned xb_xcc_id() { return (unsigned)__builtin_amdgcn_s_getreg((3 << 11) | 20) & 0xFu; }
#define XB_SPIN(cond, bar) do { unsigned _sp = 0; while (cond) { __builtin_amdgcn_s_sleep(1); \
    if ((++_sp & 255u) == 0u) { if (xb_ld(&(bar)[XB_TMO])) break; if (_sp > XB_SPIN_CAP) { atomicAdd(&(bar)[XB_TMO], 1u); break; } } } } while (0)
struct XcdBarrier { unsigned* bar; unsigned x; volatile LAS unsigned* st; int wave; };
DI bool xb_t0(int wave) { return wave == 0 && lane_id_() == 0; }
DI XcdBarrier xcd_barrier_post(unsigned* bar, volatile LAS unsigned* st, int wave) {
    XcdBarrier b; b.bar = bar; b.x = xb_xcc_id(); b.st = st; b.wave = wave;
    if (xb_t0(wave)) (void)xb_add(&bar[XB_XCNT(b.x)], 1u);
    return b;
}
DI void xcd_barrier_complete(unsigned* bar, unsigned x, unsigned& nloc, unsigned& nx) {
    const unsigned G = gridDim.x * gridDim.y * gridDim.z;
    unsigned sum, cnt, mine, sp = 0u;
    for (;;) {
        sum = 0u; cnt = 0u; mine = 0u;
#pragma unroll
        for (unsigned j = 0; j < 16; ++j) { const unsigned c = xb_ld(&bar[XB_XCNT(j)]); sum += c; cnt += (c > 0u) ? 1u : 0u; mine = (j == x) ? c : mine; }
        if (sum == G) break;
        __builtin_amdgcn_s_sleep(1);
        if ((++sp & 255u) == 0u) { if (xb_ld(&bar[XB_TMO])) break; if (sp > XB_SPIN_CAP) { atomicAdd(&bar[XB_TMO], 1u); break; } }
    }
    nloc = mine > 0u ? mine : 1u; nx = cnt > 0u ? cnt : 1u;
}
DI void xcd_barrier(const XcdBarrier& b) {
    asm volatile("s_waitcnt vmcnt(0)" ::: "memory");
    __syncthreads();
    if (xb_t0(b.wave)) {
        unsigned* bar = b.bar;
        __builtin_amdgcn_s_waitcnt(0);
        unsigned nloc = b.st[0], nx = b.st[1];
        if (nloc == 0u) { xcd_barrier_complete(bar, b.x, nloc, nx); b.st[0] = nloc; b.st[1] = nx; }
        const unsigned old = xb_add(&bar[XB_XSUB(b.x)], 1u);
        const unsigned gen = old / nloc;
        if (old + 1u == (gen + 1u) * nloc) {
            __builtin_amdgcn_fence(__ATOMIC_RELEASE, "agent");
            asm volatile("s_waitcnt vmcnt(0)" ::: "memory");
            const unsigned og = xb_add(&bar[XB_TOP], 1u);
            const unsigned tg = og / nx;
            if (og + 1u == (tg + 1u) * nx) xb_add(&bar[XB_TOPGEN], 1u);
            else XB_SPIN(xb_ld(&bar[XB_TOPGEN]) == tg, bar);
            __builtin_amdgcn_fence(__ATOMIC_ACQUIRE, "agent");
            xb_add(&bar[XB_XGEN(b.x)], 1u);
            asm volatile("s_waitcnt vmcnt(0)" ::: "memory");
        } else {
            XB_SPIN(xb_ld(&bar[XB_XGEN(b.x)]) == gen, bar);
            __builtin_amdgcn_fence(__ATOMIC_ACQUIRE, "agent");
            asm volatile("s_waitcnt vmcnt(0)" ::: "memory");
        }
    }
    __syncthreads();
}

namespace pg8 {
constexpr int BM = 256, BK = 64, HALF = 128, HTB = HALF * BK * 2, STAGE_BYTES = 8 * HTB, NXCD = 8, WGM = 8;
DI int lds_byte(int r, int c) { const int st = (r >> 4) * 2 + (c >> 5), rr = r & 15, cc = c & 31, ob = rr * 64 + cc * 2; return st * 1024 + (ob ^ (((ob >> 9) & 1) << 5)); }
DI void stage_rc(int b, int& R, int& C) { const int st = b / 1024, sb = b % 1024, swz = sb ^ (((sb >> 9) & 1) << 5); R = (st >> 1) * 16 + swz / 64; C = (st & 1) * 32 + (swz % 64) / 2; }
DI int perm32(int rho) { const int n = rho >> 4, i = rho & 15; return 8 * (i >> 2) + 4 * n + (i & 3); }

struct Unit { int pm, pn, e; };
struct Gemm { const bf16* A; const bf16* Bt; int lda, ldb, K; };

struct TileOrder {
    int nM, nN, nwg, G, c, a_div; size_t a_pm, a_pn, b_pn;
    DI void init(int nM_, int nN_, int G_, int c_, size_t a_pm_, size_t b_pn_, int a_div_ = 1, size_t a_pn_ = 0) { nM = nM_; nN = nN_; nwg = nM * nN; G = G_; c = c_; a_pm = a_pm_; b_pn = b_pn_; a_div = a_div_; a_pn = a_pn_; }
    DI bool next(int i, Unit& u) const {
        const long L = (long)i * G + c; if (L >= nwg) return false;
        int wgid = (int)L; { const int q = nwg / NXCD, r = nwg % NXCD, xcd = wgid % NXCD, off = wgid / NXCD; wgid = (xcd < r ? xcd * (q + 1) : r * (q + 1) + (xcd - r) * q) + off; }
        const int nig = WGM * nN, gid = wgid / nig, fm = gid * WGM, gsz = (nM - fm) < WGM ? (nM - fm) : WGM;
        u.pm = fm + ((wgid % nig) % gsz); u.pn = (wgid % nig) / gsz; u.e = 0; return true;
    }
    DI size_t aoff(const Unit& u) const { return (size_t)u.pm * a_pm + (size_t)(u.pn / a_div) * a_pn; }
    DI size_t boff(const Unit& u) const { return (size_t)u.pn * b_pn; }
};
struct MoeOrder {
    int nN, nwg, G, c; int t1, t2, t3, t4, t5, t6, t7, t8; size_t a_pm, b_e, b_pn;
    DI void init(const unsigned* cnt, int nN_, int G_, int c_, size_t a_pm_, size_t b_e_, size_t b_pn_) {
        nN = nN_; G = G_; c = c_; a_pm = a_pm_; b_e = b_e_; b_pn = b_pn_;
        int s = 0; s += ((int)cnt[0] + 255) >> 8; t1 = s; s += ((int)cnt[1] + 255) >> 8; t2 = s; s += ((int)cnt[2] + 255) >> 8; t3 = s; s += ((int)cnt[3] + 255) >> 8; t4 = s;
        s += ((int)cnt[4] + 255) >> 8; t5 = s; s += ((int)cnt[5] + 255) >> 8; t6 = s; s += ((int)cnt[6] + 255) >> 8; t7 = s; s += ((int)cnt[7] + 255) >> 8; t8 = s;
        nwg = t8 * nN;
    }
    DI bool next(int i, Unit& u) const {
        const long L = (long)i * G + c; if (L >= nwg) return false;
        int wgid = (int)L; { const int q = nwg / NXCD, r = nwg % NXCD, xcd = wgid % NXCD, off = wgid / NXCD; wgid = (xcd < r ? xcd * (q + 1) : r * (q + 1) + (xcd - r) * q) + off; }
        int e = 0, ts = 0, nt = t1;
        if (wgid >= t1 * nN) { e = 1; ts = t1; nt = t2 - t1; }
        if (wgid >= t2 * nN) { e = 2; ts = t2; nt = t3 - t2; }
        if (wgid >= t3 * nN) { e = 3; ts = t3; nt = t4 - t3; }
        if (wgid >= t4 * nN) { e = 4; ts = t4; nt = t5 - t4; }
        if (wgid >= t5 * nN) { e = 5; ts = t5; nt = t6 - t5; }
        if (wgid >= t6 * nN) { e = 6; ts = t6; nt = t7 - t6; }
        if (wgid >= t7 * nN) { e = 7; ts = t7; nt = t8 - t7; }
        const int loc = wgid - ts * nN; nt = nt > 0 ? nt : 1;
        u.pm = ts + loc % nt; u.pn = loc / nt; u.e = e; return true;
    }
    DI size_t aoff(const Unit& u) const { return (size_t)u.pm * a_pm; }
    DI size_t boff(const Unit& u) const { return (size_t)u.e * b_e + (size_t)u.pn * b_pn; }
};

struct EpiBf16 {
    static constexpr bool PERM = true;
    bf16* O; int ldc;
    DI void operator()(const f32x4 (&acc)[2][2][4][2], const Unit& u, int wr, int wc, int fr, int fq) const {
        const int row0 = u.pm * BM + wr * 64 + fr, col0 = u.pn * BM + wc * 32 + 8 * fq;
#pragma unroll
        for (int ai = 0; ai < 2; ++ai)
#pragma unroll
            for (int m = 0; m < 4; ++m) { bf16* rowp = O + (size_t)(row0 + ai * HALF + m * 16) * ldc + col0;
#pragma unroll
                for (int bj = 0; bj < 2; ++bj) { const f32x4 v0 = acc[ai][bj][m][0], v1 = acc[ai][bj][m][1];
                    u32x4 w; w.x = pk2(v0[0], v0[1]); w.y = pk2(v0[2], v0[3]); w.z = pk2(v1[0], v1[1]); w.w = pk2(v1[2], v1[3]);
                    *(u32x4*)(rowp + bj * HALF) = w; } }
    }
};
struct EpiF32 {
    static constexpr bool PERM = false;
    float* C; int ldc;
    DI void operator()(const f32x4 (&acc)[2][2][4][2], const Unit& u, int wr, int wc, int fr, int fq) const {
        const int row0 = u.pm * BM + wr * 64 + fr, col0 = u.pn * BM + wc * 32 + 4 * fq;
#pragma unroll
        for (int ai = 0; ai < 2; ++ai)
#pragma unroll
            for (int m = 0; m < 4; ++m) { float* rowp = C + (size_t)(row0 + ai * HALF + m * 16) * ldc + col0;
#pragma unroll
                for (int bj = 0; bj < 2; ++bj)
#pragma unroll
                    for (int n = 0; n < 2; ++n) *(f32x4*)(rowp + bj * HALF + n * 16) = acc[ai][bj][m][n]; }
    }
};
struct EpiRes {
    static constexpr bool PERM = false;
    float* C; const float* res; int ldc;
    DI void operator()(const f32x4 (&acc)[2][2][4][2], const Unit& u, int wr, int wc, int fr, int fq) const {
        const int row0 = u.pm * BM + wr * 64 + fr, col0 = u.pn * BM + wc * 32 + 4 * fq;
#pragma unroll
        for (int ai = 0; ai < 2; ++ai)
#pragma unroll
            for (int m = 0; m < 4; ++m) { const size_t off = (size_t)(row0 + ai * HALF + m * 16) * ldc + col0;
#pragma unroll
                for (int bj = 0; bj < 2; ++bj)
#pragma unroll
                    for (int n = 0; n < 2; ++n) { const f32x4 rv = *(const f32x4*)(res + off + bj * HALF + n * 16); *(f32x4*)(C + off + bj * HALF + n * 16) = acc[ai][bj][m][n] + rv * ALPHA; }
                asm volatile("" ::: "memory"); }
    }
};
struct EpiSwiglu {
    static constexpr bool PERM = true;
    bf16* H; int ldc;
    DI void operator()(const f32x4 (&acc)[2][2][4][2], const Unit& u, int wr, int wc, int fr, int fq) const {
        const int row0 = u.pm * BM + wr * 64 + fr, col0 = u.pn * HALF + wc * 32 + 8 * fq;
#pragma unroll
        for (int ai = 0; ai < 2; ++ai)
#pragma unroll
            for (int m = 0; m < 4; ++m) { bf16* rowp = H + (size_t)(row0 + ai * HALF + m * 16) * ldc + col0;
                const f32x4 g0 = acc[ai][0][m][0], g1 = acc[ai][0][m][1], u0 = acc[ai][1][m][0], u1 = acc[ai][1][m][1];
                u32x4 w; w.x = pk2(siluf_(g0[0]) * u0[0], siluf_(g0[1]) * u0[1]); w.y = pk2(siluf_(g0[2]) * u0[2], siluf_(g0[3]) * u0[3]);
                w.z = pk2(siluf_(g1[0]) * u1[0], siluf_(g1[1]) * u1[1]); w.w = pk2(siluf_(g1[2]) * u1[2], siluf_(g1[3]) * u1[3]);
                *(u32x4*)rowp = w; asm volatile("" ::: "memory"); }
    }
};
struct EpiPool {
    static constexpr bool PERM = true;
    bf16* mrg; const bf16* proj; const float* scale;
    DI void operator()(const f32x4 (&acc)[2][2][4][2], const Unit& u, int wr, int wc, int fr, int fq) const {
        const int row0 = u.pm * BM + wr * 64 + fr, col0 = u.pn * BM + wc * 32 + 8 * fq;
#pragma unroll
        for (int bj = 0; bj < 2; ++bj) { const int c = col0 + bj * HALF; const f32x4 s0 = *(const f32x4*)(scale + c), s1 = *(const f32x4*)(scale + c + 4);
#pragma unroll
            for (int ai = 0; ai < 2; ++ai)
#pragma unroll
                for (int m = 0; m < 4; ++m) { const size_t row = (size_t)(row0 + ai * HALF + m * 16);
                    const u32x4 gv = *(const u32x4*)(proj + row * NINP + C_G + 2048 + c);
                    const f32x4 v0 = acc[ai][bj][m][0] * s0, v1 = acc[ai][bj][m][1] * s1;
                    u32x4 w; w.x = pk2(v0[0] * sigmoidf_(bflo(gv.x)), v0[1] * sigmoidf_(bfhi(gv.x))); w.y = pk2(v0[2] * sigmoidf_(bflo(gv.y)), v0[3] * sigmoidf_(bfhi(gv.y)));
                    w.z = pk2(v1[0] * sigmoidf_(bflo(gv.z)), v1[1] * sigmoidf_(bfhi(gv.z))); w.w = pk2(v1[2] * sigmoidf_(bflo(gv.w)), v1[3] * sigmoidf_(bfhi(gv.w)));
                    *(u32x4*)(mrg + row * MIXW + 2048 + c) = w; asm volatile("" ::: "memory"); } }
    }
};
struct EpiLru {
    static constexpr bool PERM = false;
    float* Aout; float* Bout; const bf16* xc; const float* ba; const float* bx; const float* c8sp;
    DI void operator()(const f32x4 (&acc)[2][2][4][2], const Unit& u, int wr, int wc, int fr, int fq) const {
        const int row0 = u.pm * BM + wr * 64 + fr, ch0 = u.pn * HALF + wc * 32 + 4 * fq;
#pragma unroll
        for (int n = 0; n < 2; ++n) { const int ch = ch0 + n * 16; const f32x4 vba = *(const f32x4*)(ba + ch), vbx = *(const f32x4*)(bx + ch), vsp = *(const f32x4*)(c8sp + ch);
#pragma unroll
            for (int ai = 0; ai < 2; ++ai)
#pragma unroll
                for (int m = 0; m < 4; ++m) { const size_t off = (size_t)(row0 + ai * HALF + m * 16) * DM + ch;
                    const u32x2 xv = *(const u32x2*)(xc + off); const float xf[4] = {bflo(xv.x), bfhi(xv.x), bflo(xv.y), bfhi(xv.y)};
                    f32x4 av, bv;
#pragma unroll
                    for (int j = 0; j < 4; ++j) { const float r = sigmoidf_(acc[ai][0][m][n][j] + vba[j]), ig = sigmoidf_(acc[ai][1][m][n][j] + vbx[j]);
                        const float la = -vsp[j] * r; av[j] = __expf(la); bv[j] = __builtin_amdgcn_sqrtf(fmaxf(one_minus_exp_(2.0f * la), 0.f)) * ig * xf[j]; }
                    *(f32x4*)(Aout + off) = av; *(f32x4*)(Bout + off) = bv; asm volatile("" ::: "memory"); } }
    }
};

template <class Epi, class Sched, bool ALIGN_EPI = true, bool SP2 = true>
DI void gemm_phase(LAS unsigned char* lds, const Gemm g, const Sched& S, const Epi& E, const int wave_id) {
    int lane_ = lane_id_(); asm volatile("" : "+v"(lane_));
    const int wid = wave_id, lane = lane_, tid = wid * 64 + lane, wr = wid >> 2, wc = wid & 3, fr = lane & 15, fq = lane >> 4;
    const int nt = g.K / BK;
    unsigned voffA[2], voffB[2];
#pragma unroll
    for (int i = 0; i < 2; ++i) { int R, C; stage_rc(tid * 16 + i * 8192, R, C); const int Rb = Epi::PERM ? ((R & ~31) + perm32(R & 31)) : R;
        voffA[i] = (unsigned)(R * g.lda + C) * 2u; voffB[i] = (unsigned)(Rb * g.ldb + C) * 2u; }
    const size_t kstep = (size_t)(BK * 2);
    const size_t hstepA = (size_t)HALF * g.lda * 2, hstepB = (size_t)HALF * g.ldb * 2;
    const unsigned ldsw = (unsigned)wid * 1024u;
    const int aoff = lds_byte(wr * 64 + fr, fq * 8), boff = lds_byte(wc * 32 + fr, fq * 8);
#define PG8_SA(b, h) (((b) * 2 + (h)) * HTB)
#define PG8_SB(b, h) ((4 + (b) * 2 + (h)) * HTB)
#define PG8_STAGE(bufoff, gbase, voff) do { _Pragma("unroll") for (int _i = 0; _i < 2; ++_i) \
        __builtin_amdgcn_global_load_lds((const unsigned*)((const char*)(gbase) + (voff)[_i]), (LAS unsigned*)(lds + (bufoff) + ldsw + _i * 8192), 16, 0, 0); } while (0)
#define PG8_LDA(dst, b, h) do { _Pragma("unroll") for (int m = 0; m < 4; ++m) _Pragma("unroll") for (int k = 0; k < 2; ++k) dst[m][k] = *(const LAS bf16x8*)(lds + PG8_SA(b, h) + aoff + m * 2048 + k * 1024); } while (0)
#define PG8_LDB(dst, b, h) do { _Pragma("unroll") for (int n = 0; n < 2; ++n) _Pragma("unroll") for (int k = 0; k < 2; ++k) dst[n][k] = *(const LAS bf16x8*)(lds + PG8_SB(b, h) + boff + n * 2048 + k * 1024); } while (0)
#define PG8_MMA(ai, bj, At, Bt) do { __builtin_amdgcn_s_setprio(1); _Pragma("unroll") for (int m = 0; m < 4; ++m) _Pragma("unroll") for (int n = 0; n < 2; ++n) _Pragma("unroll") for (int k = 0; k < 2; ++k) \
        acc[ai][bj][m][n] = __builtin_amdgcn_mfma_f32_16x16x32_bf16(Bt[n][k], At[m][k], acc[ai][bj][m][n], 0, 0, 0); __builtin_amdgcn_s_setprio(0); } while (0)
#define PG8_WAIT_V(n) asm volatile("s_waitcnt vmcnt(" #n ")" ::: "memory")
#define PG8_WAIT_L(n) asm volatile("s_waitcnt lgkmcnt(" #n ")" ::: "memory")
#define PG8_BAR __builtin_amdgcn_s_barrier()
#define PG8_SCHED __builtin_amdgcn_sched_barrier(0)
    Unit cur, nxt; int ui = 0;
    if (!S.next(0, cur)) return;
    f32x4 acc[2][2][4][2];
#pragma unroll
    for (int a = 0; a < 2; ++a)
#pragma unroll
        for (int b = 0; b < 2; ++b)
#pragma unroll
            for (int m = 0; m < 4; ++m)
#pragma unroll
                for (int n = 0; n < 2; ++n) acc[a][b][m][n] = (f32x4){0.f, 0.f, 0.f, 0.f};
    bf16x8 At[4][2], B0[2][2], B1[2][2];
    const char* cA = (const char*)g.A + S.aoff(cur); const char* cB = (const char*)g.Bt + S.boff(cur);
    if constexpr (SP2) {
        PG8_STAGE(PG8_SB(0, 0), cB, voffB); PG8_STAGE(PG8_SB(0, 1), cB + hstepB, voffB); PG8_STAGE(PG8_SA(0, 0), cA, voffA); PG8_STAGE(PG8_SA(0, 1), cA + hstepA, voffA);
        if (wr == 1) PG8_BAR;
        PG8_WAIT_V(2); PG8_BAR;
        PG8_STAGE(PG8_SB(1, 0), cB + kstep, voffB); PG8_STAGE(PG8_SA(1, 0), cA + kstep, voffA); PG8_STAGE(PG8_SB(1, 1), cB + hstepB + kstep, voffB);
        PG8_WAIT_V(6); PG8_BAR;
    } else {
        PG8_STAGE(PG8_SB(0, 0), cB, voffB); PG8_STAGE(PG8_SA(0, 0), cA, voffA); PG8_STAGE(PG8_SB(0, 1), cB + hstepB, voffB); PG8_STAGE(PG8_SA(0, 1), cA + hstepA, voffA);
        if (wr == 1) PG8_BAR;
        PG8_WAIT_V(4); PG8_BAR;
        PG8_STAGE(PG8_SB(1, 0), cB + kstep, voffB); PG8_STAGE(PG8_SA(1, 0), cA + kstep, voffA); PG8_STAGE(PG8_SB(1, 1), cB + hstepB + kstep, voffB);
        PG8_WAIT_V(6); PG8_BAR;
    }
    for (;;) {
        const bool has_next = S.next(ui + 1, nxt);
        const char* nA = has_next ? (const char*)g.A + S.aoff(nxt) : cA; const char* nB = has_next ? (const char*)g.Bt + S.boff(nxt) : cB;
#pragma nounroll
        for (int t = 0; t < nt; t += 2) {
            const bool last = (t == nt - 2);
            const char* a1 = cA + (size_t)(t + 1) * kstep;
            const char* a2 = last ? nA : cA + (size_t)(t + 2) * kstep; const char* b2 = last ? nB : cB + (size_t)(t + 2) * kstep;
            const char* a3 = a2 + kstep; const char* b3 = b2 + kstep;
            if constexpr (SP2) {
            PG8_LDB(B0, 0, 0); PG8_LDB(B1, 0, 1); PG8_SCHED; PG8_LDA(At, 0, 0); PG8_STAGE(PG8_SA(1, 1), a1 + hstepA, voffA);
            PG8_WAIT_V(8); PG8_WAIT_L(0); PG8_BAR; PG8_MMA(0, 0, At, B0); PG8_MMA(0, 1, At, B1); PG8_BAR; PG8_SCHED;
            PG8_LDA(At, 0, 1); PG8_STAGE(PG8_SB(0, 0), b2, voffB); PG8_STAGE(PG8_SB(0, 1), b2 + hstepB, voffB); PG8_STAGE(PG8_SA(0, 0), a2, voffA);
            PG8_WAIT_V(8); PG8_WAIT_L(0); PG8_BAR; PG8_MMA(1, 0, At, B0); PG8_MMA(1, 1, At, B1); PG8_BAR; PG8_SCHED;
            PG8_LDB(B0, 1, 0); PG8_LDB(B1, 1, 1); PG8_SCHED; PG8_LDA(At, 1, 0); PG8_STAGE(PG8_SA(0, 1), a2 + hstepA, voffA);
            PG8_WAIT_V(8); PG8_WAIT_L(0); PG8_BAR; PG8_MMA(0, 0, At, B0); PG8_MMA(0, 1, At, B1); PG8_BAR; PG8_SCHED;
            PG8_LDA(At, 1, 1); PG8_STAGE(PG8_SB(1, 0), b3, voffB); PG8_STAGE(PG8_SB(1, 1), b3 + hstepB, voffB); PG8_STAGE(PG8_SA(1, 0), a3, voffA);
            PG8_WAIT_V(8); PG8_WAIT_L(0); PG8_BAR; PG8_MMA(1, 0, At, B0); PG8_MMA(1, 1, At, B1); PG8_BAR; PG8_SCHED;
            } else {
            PG8_LDB(B0, 0, 0); PG8_SCHED; PG8_LDA(At, 0, 0); PG8_STAGE(PG8_SA(1, 1), a1 + hstepA, voffA);
            PG8_WAIT_L(8); PG8_BAR; PG8_WAIT_L(0); PG8_MMA(0, 0, At, B0); PG8_BAR; PG8_SCHED;
            PG8_LDB(B1, 0, 1); PG8_STAGE(PG8_SB(0, 0), b2, voffB);
            PG8_BAR; PG8_WAIT_L(0); PG8_MMA(0, 1, At, B1); PG8_BAR;
            PG8_LDA(At, 0, 1); PG8_STAGE(PG8_SA(0, 0), a2, voffA);
            PG8_BAR; PG8_WAIT_L(0); PG8_MMA(1, 0, At, B0); PG8_BAR; PG8_SCHED;
            PG8_STAGE(PG8_SB(0, 1), b2 + hstepB, voffB);
            PG8_WAIT_V(6); PG8_BAR; PG8_MMA(1, 1, At, B1); PG8_BAR;
            PG8_LDB(B0, 1, 0); PG8_SCHED; PG8_LDA(At, 1, 0); PG8_STAGE(PG8_SA(0, 1), a2 + hstepA, voffA);
            PG8_WAIT_L(8); PG8_BAR; PG8_WAIT_L(0); PG8_MMA(0, 0, At, B0); PG8_BAR; PG8_SCHED;
            PG8_LDB(B1, 1, 1); PG8_STAGE(PG8_SB(1, 0), b3, voffB);
            PG8_BAR; PG8_WAIT_L(0); PG8_MMA(0, 1, At, B1); PG8_BAR;
            PG8_LDA(At, 1, 1); PG8_STAGE(PG8_SA(1, 0), a3, voffA);
            PG8_BAR; PG8_WAIT_L(0); PG8_MMA(1, 0, At, B0); PG8_BAR; PG8_SCHED;
            PG8_STAGE(PG8_SB(1, 1), b3 + hstepB, voffB);
            PG8_WAIT_V(6); PG8_BAR; PG8_MMA(1, 1, At, B1); PG8_BAR;
            }
        }
        if constexpr (ALIGN_EPI) { if (wr == 0) PG8_BAR; }
        E(acc, cur, wr, wc, fr, fq);
        if (!has_next) break;
#pragma unroll
        for (int a = 0; a < 2; ++a)
#pragma unroll
            for (int b = 0; b < 2; ++b)
#pragma unroll
                for (int m = 0; m < 4; ++m)
#pragma unroll
                    for (int n = 0; n < 2; ++n) acc[a][b][m][n] = (f32x4){0.f, 0.f, 0.f, 0.f};
        cur = nxt; cA = nA; cB = nB; ++ui;
        if constexpr (ALIGN_EPI) { if (wr == 1) PG8_BAR; }
    }
    PG8_WAIT_V(0);
    if constexpr (!ALIGN_EPI) { if (wr == 0) PG8_BAR; }
    PG8_BAR;
#undef PG8_SA
#undef PG8_SB
#undef PG8_STAGE
#undef PG8_LDA
#undef PG8_LDB
#undef PG8_MMA
#undef PG8_WAIT_V
#undef PG8_WAIT_L
#undef PG8_BAR
#undef PG8_SCHED
}
}

struct Args { const void* in[24]; float* out; unsigned char* ws; int ph_lo, ph_hi; };
struct Frame {
    LAS unsigned char* lds; unsigned* ctl; unsigned char* ws;
    int tid, lane, wave, G, bid;
};
#define INF(k) ((const float*)args.in[k])
DI float wave_sum(float v) {
#pragma unroll
    for (int o = 1; o < 64; o <<= 1) v += __shfl_xor(v, o);
    return v;
}

template <class RM>
DI void tr_item(const float* W, int ldS, int Nvalid, bf16* WT, int ldD, int koff, RM rowmap, LAS float* scr, int k0, int n0, int lane) {
    const int nl = n0 + (lane & 31);
#pragma unroll 8
    for (int i = 0; i < 32; ++i) { const int kk = 2 * i + (lane >> 5); scr[kk * 33 + (lane & 31)] = (nl < Nvalid) ? W[(size_t)(k0 + kk) * ldS + nl] : 0.f; }
    LDS_WAIT(); asm volatile("" ::: "memory");
    const int c = lane & 7;
#pragma unroll
    for (int j = 0; j < 4; ++j) { const int nn = (lane >> 3) + 8 * j, n = n0 + nn; const LAS float* s = scr + (8 * c) * 33 + nn;
        u32x4 o; o.x = pk2(s[0 * 33], s[1 * 33]); o.y = pk2(s[2 * 33], s[3 * 33]); o.z = pk2(s[4 * 33], s[5 * 33]); o.w = pk2(s[6 * 33], s[7 * 33]);
        if (n < Nvalid) *(u32x4*)(WT + (size_t)rowmap(n) * ldD + koff + k0 + 8 * c) = o; }
    LDS_WAIT(); asm volatile("" ::: "memory");
}
struct RmIn { DI int operator()(int n) const { return n < C_PADLO ? n : n + (C_P - C_PADLO); } };
struct RmId { int off; DI int operator()(int n) const { return off + n; } };
struct RmGU { int off; DI int operator()(int n) const { return ((n >> 7) << 8) + off + (n & 127); } };

DI void p0_prologue(Frame& F, const Args& args) {
    LAS float* scr = (LAS float*)(F.lds + F.wave * 16384);
    const int gw = F.bid * 8 + F.wave, NGW = F.G * 8;
    bf16* Win = (bf16*)(F.ws + WS_WIN); bf16* Wout = (bf16*)(F.ws + WS_WOUT); bf16* Wpool = (bf16*)(F.ws + WS_WPOOL); bf16* Wlru = (bf16*)(F.ws + WS_WLRU);
    bf16* Wgu = (bf16*)(F.ws + WS_WGU); bf16* Wdn = (bf16*)(F.ws + WS_WDN);
    constexpr int NB_IN = (NIN + 31) / 32;
    constexpr int I_IN = 32 * NB_IN, I_OUT = 96 * 64, I_POOL = 8 * 16, I_LRU = 2 * 4, I_G = 32 * 172, I_D = 86 * 64;
    constexpr int T_IN = 2 * I_IN, T_OUT = 2 * I_OUT, T_POOL = 8 * I_POOL, T_LRU = 64 * I_LRU, T_G = 2 * I_G, T_D = I_D;
    constexpr int NITEMS = T_IN + T_OUT + T_POOL + T_LRU + T_G + T_D;
    for (int it = gw; it < NITEMS; it += NGW) {
        int r = it;
        if (r < T_IN) { const int l = r / I_IN, q = r % I_IN, kb = q / NB_IN, nb = q % NB_IN;
            tr_item(INF(2) + (size_t)l * DM * NIN, NIN, NIN, Win + (size_t)l * NINP * DM, DM, 0, RmIn{}, scr, 64 * kb, 32 * nb, F.lane); continue; } r -= T_IN;
        if (r < T_OUT) { const int l = r / I_OUT, q = r % I_OUT, kb = q / 64, nb = q % 64;
            tr_item(INF(3) + (size_t)l * MIXW * DM, DM, DM, Wout + (size_t)l * DM * MIXW, MIXW, 0, RmId{0}, scr, 64 * kb, 32 * nb, F.lane); continue; } r -= T_OUT;
        if (r < T_POOL) { const int lg = r / I_POOL, q = r % I_POOL, kb = q / 16, nb = q % 16, l = lg >> 2, g = lg & 3;
            tr_item(INF(4) + (size_t)lg * 512 * 512, 512, 512, Wpool + (size_t)l * 2048 * 512, 512, 0, RmId{g * 512}, scr, 64 * kb, 32 * nb, F.lane); continue; } r -= T_POOL;
        if (r < T_LRU) { const int cmb = r / I_LRU, q = r % I_LRU, kb = q / 4, nb = q % 4, l = cmb >> 5, which = (cmb >> 4) & 1, n = cmb & 15;
            const float* src = (which ? INF(10) : INF(8)) + ((size_t)l * 16 + n) * 128 * 128;
            tr_item(src, 128, 128, Wlru + (size_t)l * 4096 * 256, 256, (n & 1) * 128, RmId{n * 256 + which * 128}, scr, 64 * kb, 32 * nb, F.lane); continue; } r -= T_LRU;
        if (r < T_G) { const int which = r / I_G, q = r % I_G, kb = q / 172, nb = q % 172;
            tr_item(which ? INF(18) : INF(17), DFF, DFF, Wgu, DM, 0, RmGU{which * 128}, scr, 64 * kb, 32 * nb, F.lane); continue; } r -= T_G;
        { const int kb = r / 64, nb = r % 64; tr_item(INF(19), DM, DM, Wdn, DFF, 0, RmId{0}, scr, 64 * kb, 32 * nb, F.lane); }
    }
    const int gt = F.bid * 512 + F.tid, NT = F.G * 512;
    for (int i = gt; i < 2 * 4096 * 16; i += NT) { const int row = i >> 4, ch = i & 15, n = (row & 4095) >> 8;
        *(u32x4*)(Wlru + (size_t)row * 256 + ((n + 1) & 1) * 128 + ch * 8) = (u32x4){0u, 0u, 0u, 0u}; }
    float* cosA = (float*)(F.ws + WS_COSA); float* sinA = (float*)(F.ws + WS_SINA); float* cosI = (float*)(F.ws + WS_COSI); float* sinI = (float*)(F.ws + WS_SINI);
    for (int i = gt; i < MTOK * 96; i += NT) {
        const int tok = i / 96, j = i % 96; const bool isA = j < 64; const int fi = isA ? j : j - 64; const double dim = isA ? 128.0 : 64.0;
        const float inv = (float)pow(10000.0, -(double)(2 * fi) / dim);
        const float ang = (float)((const int*)args.in[1])[tok] * inv; const double a = (double)ang; const double nrev = rint(a * 0.15915494309189535); const double rr = a - nrev * 6.283185307179586;
        const float cv = (float)cos(rr), sv = (float)sin(rr);
        if (isA) { cosA[tok * 64 + fi] = cv; sinA[tok * 64 + fi] = sv; } else { cosI[tok * 32 + fi] = cv; sinI[tok * 32 + fi] = sv; }
    }
    float* c8 = (float*)(F.ws + WS_LRUC);
    for (int i = gt; i < 2 * DM; i += NT) { const float lam = INF(12)[i]; c8[i] = 8.0f * log1pf(expf(-lam)); }
    bf16* xb = (bf16*)(F.ws + WS_XB);
    for (int i = gt; i < MTOK * DM / 8; i += NT) { const f32x4 a = *(const f32x4*)(INF(0) + (size_t)i * 8), b = *(const f32x4*)(INF(0) + (size_t)i * 8 + 4);
        u32x4 o; o.x = pk2(a[0], a[1]); o.y = pk2(a[2], a[3]); o.z = pk2(b[0], b[1]); o.w = pk2(b[2], b[3]); *(u32x4*)(xb + (size_t)i * 8) = o; }
}
DI void p_convert_moe(Frame& F, const Args& args) {
    LAS float* scr = (LAS float*)(F.lds + F.wave * 16384);
    const int gw = F.bid * 8 + F.wave, NGW = F.G * 8;
    bf16* Wgu = (bf16*)(F.ws + WS_MWGU); bf16* Wdn = (bf16*)(F.ws + WS_MWDN);
    constexpr int I_G = 32 * 224, I_D = 112 * 64;
    constexpr int T_G = 16 * I_G, T_D = 8 * I_D;
    for (int it = gw; it < T_G + T_D; it += NGW) {
        int r = it;
        if (r < T_G) { const int ew = r / I_G, q = r % I_G, kb = q / 224, nb = q % 224, e = ew >> 1, which = ew & 1;
            tr_item((which ? INF(22) : INF(21)) + (size_t)e * DM * DEXP, DEXP, DEXP, Wgu + (size_t)e * 2 * DEXP * DM, DM, 0, RmGU{which * 128}, scr, 64 * kb, 32 * nb, F.lane); continue; } r -= T_G;
        { const int e = r / I_D, q = r % I_D, kb = q / 64, nb = q % 64;
          tr_item(INF(23) + (size_t)e * DEXP * DM, DM, DM, Wdn + (size_t)e * DM * DEXP, DEXP, 0, RmId{0}, scr, 64 * kb, 32 * nb, F.lane); }
    }
}

DI void ld8(const bf16* p, float (&v)[8]) { const u32x4 w = *(const u32x4*)p; v[0] = bflo(w.x); v[1] = bfhi(w.x); v[2] = bflo(w.y); v[3] = bfhi(w.y); v[4] = bflo(w.z); v[5] = bfhi(w.z); v[6] = bflo(w.w); v[7] = bfhi(w.w); }
DI void st8(bf16* p, const float (&v)[8]) { u32x4 o; o.x = pk2(v[0], v[1]); o.y = pk2(v[2], v[3]); o.z = pk2(v[4], v[5]); o.w = pk2(v[6], v[7]); *(u32x4*)p = o; }

DI void p2_prep(Frame& F, const Args& args, int layer) {
    bf16* proj = (bf16*)(F.ws + WS_PROJ); bf16* diff = (bf16*)(F.ws + WS_DIFF); bf16* xc = (bf16*)(F.ws + WS_XC);
    const float* cosA = (const float*)(F.ws + WS_COSA); const float* sinA = (const float*)(F.ws + WS_SINA); const float* cosI = (const float*)(F.ws + WS_COSI); const float* sinI = (const float*)(F.ws + WS_SINI);
    const int gt = F.bid * 512 + F.tid, NT = F.G * 512;
    for (int it = gt; it < MTOK * 228; it += NT) {
        const int tok = it / 228, j = it % 228; int col, half, d; const float *ct, *st;
        if (j < 128) { d = (j & 7) * 8; col = C_Q + (j >> 3) * 128 + d; half = 64; ct = cosA + tok * 64 + d; st = sinA + tok * 64 + d; }
        else if (j < 160) { const int jj = j - 128; d = (jj & 7) * 8; col = C_K + (jj >> 3) * 128 + d; half = 64; ct = cosA + tok * 64 + d; st = sinA + tok * 64 + d; }
        else if (j < 224) { const int jj = j - 160; d = (jj & 3) * 8; col = C_QI + (jj >> 2) * 64 + d; half = 32; ct = cosI + tok * 32 + d; st = sinI + tok * 32 + d; }
        else { d = (j - 224) * 8; col = C_KI + d; half = 32; ct = cosI + tok * 32 + d; st = sinI + tok * 32 + d; }
        bf16* p1 = proj + (size_t)tok * NINP + col; bf16* p2 = p1 + half;
        float x1[8], x2[8], y1[8], y2[8]; ld8(p1, x1); ld8(p2, x2);
        const f32x4 c0 = *(const f32x4*)ct, c1 = *(const f32x4*)(ct + 4), s0 = *(const f32x4*)st, s1 = *(const f32x4*)(st + 4);
#pragma unroll
        for (int i = 0; i < 8; ++i) { const float c = i < 4 ? c0[i & 3] : c1[i & 3], s = i < 4 ? s0[i & 3] : s1[i & 3]; y1[i] = x1[i] * c - x2[i] * s; y2[i] = x2[i] * c + x1[i] * s; }
        st8(p1, y1); st8(p2, y2);
    }
    const float* cw = INF(6) + (size_t)layer * 4 * DM; const float* cb = INF(7) + (size_t)layer * DM;
    for (int it = gt; it < MTOK * 256; it += NT) {
        const int tok = it >> 8, c = (it & 255) * 8, tpos = tok & (SEQ - 1);
        { const int g = c >> 9, W = 2 << g, cnt = (tpos + 1) < W ? (tpos + 1) : W;
          float sum[8], cur[8], v[8]; const bf16* pp = proj + (size_t)tok * NINP + C_P + c; ld8(pp, cur);
#pragma unroll
          for (int i = 0; i < 8; ++i) sum[i] = cur[i];
          for (int jj = 1; jj < cnt; ++jj) { ld8(pp - (size_t)jj * NINP, v);
#pragma unroll
              for (int i = 0; i < 8; ++i) sum[i] += v[i]; }
          const float rc = 1.0f / (float)cnt;
#pragma unroll
          for (int i = 0; i < 8; ++i) v[i] = sum[i] * rc - cur[i];
          st8(diff + (size_t)tok * DM + c, v); }
        { float acc[8], v[8]; const f32x4 b0 = *(const f32x4*)(cb + c), b1 = *(const f32x4*)(cb + c + 4);
#pragma unroll
          for (int i = 0; i < 8; ++i) acc[i] = i < 4 ? b0[i & 3] : b1[i & 3];
          const bf16* px = proj + (size_t)tok * NINP + C_XR + c;
#pragma unroll
          for (int jj = 0; jj < 4; ++jj) { const int back = 3 - jj; if (tpos - back >= 0) { ld8(px - (size_t)back * NINP, v);
              const f32x4 w0 = *(const f32x4*)(cw + jj * DM + c), w1 = *(const f32x4*)(cw + jj * DM + c + 4);
#pragma unroll
              for (int i = 0; i < 8; ++i) acc[i] += v[i] * (i < 4 ? w0[i & 3] : w1[i & 3]); } }
          st8(xc + (size_t)tok * DM + c, acc); }
    }
}

DI void p3_indexer(Frame& F) {
    const bf16* proj = (const bf16*)(F.ws + WS_PROJ); float* sc = (float*)(F.ws + WS_SC);
    const int gw = F.bid * 8 + F.wave, NGW = F.G * 8, l15 = F.lane & 15, l4 = F.lane >> 4;
    for (int u = gw; u < BATCH * 576; u += NGW) {
        const int b = u / 576, r = u % 576; int g8 = 0;
#pragma unroll
        for (int k = 1; k < 8; ++k) g8 = (r >= 8 * k * (k + 1)) ? k : g8;
        const int rr = r - 8 * g8 * (g8 + 1), sp = rr % (g8 + 1), qq = rr / (g8 + 1), qb16 = g8 * 16 + qq, c = qb16 >> 2;
        const int limit = (c + 1) * 64, kbeg = sp * 256, kend = (kbeg + 256) < limit ? (kbeg + 256) : limit;
        const int qtok = b * SEQ + qb16 * 16 + l15;
        const bf16* qrow = proj + (size_t)qtok * NINP;
        bf16x8 qf[16][2]; float w[16];
        { const u32x4 w0 = *(const u32x4*)(qrow + C_WI), w1 = *(const u32x4*)(qrow + C_WI + 8); const float s = 0.125f * 0.25f;
          w[0] = bflo(w0.x) * s; w[1] = bfhi(w0.x) * s; w[2] = bflo(w0.y) * s; w[3] = bfhi(w0.y) * s; w[4] = bflo(w0.z) * s; w[5] = bfhi(w0.z) * s; w[6] = bflo(w0.w) * s; w[7] = bfhi(w0.w) * s;
          w[8] = bflo(w1.x) * s; w[9] = bfhi(w1.x) * s; w[10] = bflo(w1.y) * s; w[11] = bfhi(w1.y) * s; w[12] = bflo(w1.z) * s; w[13] = bfhi(w1.z) * s; w[14] = bflo(w1.w) * s; w[15] = bfhi(w1.w) * s; }
#pragma unroll
        for (int h = 0; h < 16; ++h)
#pragma unroll
            for (int ks = 0; ks < 2; ++ks) qf[h][ks] = *(const bf16x8*)(qrow + C_QI + h * 64 + ks * 32 + l4 * 8);
        for (int k0 = kbeg; k0 < kend; k0 += 16) {
            const bf16* krow = proj + (size_t)(b * SEQ + k0 + l15) * NINP + C_KI + l4 * 8;
            const bf16x8 ka0 = *(const bf16x8*)krow, ka1 = *(const bf16x8*)(krow + 32);
            f32x4 tot = {0.f, 0.f, 0.f, 0.f};
#pragma unroll
            for (int h = 0; h < 16; ++h) { f32x4 s = {0.f, 0.f, 0.f, 0.f};
                s = __builtin_amdgcn_mfma_f32_16x16x32_bf16(ka0, qf[h][0], s, 0, 0, 0); s = __builtin_amdgcn_mfma_f32_16x16x32_bf16(ka1, qf[h][1], s, 0, 0, 0);
#pragma unroll
                for (int j = 0; j < 4; ++j) tot[j] += w[h] * fmaxf(s[j], 0.f); }
            *(f32x4*)(sc + (size_t)qtok * SEQ + k0 + 4 * l4) = tot;
        }
    }
}

DI void p4_select(Frame& F) {
    const float* sc = (const float*)(F.ws + WS_SC); unsigned* mask = (unsigned*)(F.ws + WS_MASK);
    const int gw = F.bid * 8 + F.wave, NGW = F.G * 8, lane = F.lane;
    for (int tok = gw; tok < MTOK; tok += NGW) {
        const int tpos = tok & (SEQ - 1), limit = ((tpos >> 6) + 1) * 64, nw = limit >> 5;
        unsigned mw = 0u;
        if (limit <= 256) { mw = lane < nw ? 0xffffffffu : 0u; }
        else {
            unsigned key[32];
            if (lane < nw) { const float* p = sc + (size_t)tok * SEQ + lane * 32;
#pragma unroll
                for (int q = 0; q < 8; ++q) { const f32x4 v = *(const f32x4*)(p + 4 * q);
#pragma unroll
                    for (int j = 0; j < 4; ++j) { const unsigned uu = __float_as_uint(v[j]); key[4 * q + j] = (uu & 0x80000000u) ? ~uu : (uu | 0x80000000u); } } }
            else {
#pragma unroll
                for (int j = 0; j < 32; ++j) key[j] = 0u; }
            unsigned T = 0u; bool exact = false;
            for (int bit = 31; bit >= 0; --bit) {
                const unsigned cand = T | (1u << bit); int cnt = 0;
#pragma unroll
                for (int j = 0; j < 32; ++j) cnt += __popcll(__ballot(key[j] >= cand));
                if (cnt >= 256) { T = cand; if (cnt == 256) { exact = true; break; } }
            }
            unsigned gtw = 0u, eqw = 0u;
#pragma unroll
            for (int j = 0; j < 32; ++j) { gtw |= (key[j] > T) ? (1u << j) : 0u; eqw |= (key[j] == T) ? (1u << j) : 0u; }
            if (exact) { mw = gtw | eqw; }
            else {
                int ngt = 0;
#pragma unroll
                for (int j = 0; j < 32; ++j) ngt += __popcll(__ballot(key[j] > T));
                const int need = 256 - ngt; const int el = __popc(eqw);
                int pre = el;
#pragma unroll
                for (int o = 1; o < 64; o <<= 1) { const int t = __shfl_up(pre, o); pre += (lane >= o) ? t : 0; }
                int take = need - (pre - el); take = take < 0 ? 0 : (take > el ? el : take);
                unsigned sel = 0u, rem = eqw;
                for (int t = 0; t < 32; ++t) { if (t < take) { const unsigned low = rem & (0u - rem); sel |= low; rem ^= low; } }
                mw = gtw | sel;
            }
        }
        mask[(size_t)tok * 64 + lane] = mw;
    }
}

DI void p4_lru_pass1(Frame& F) {
    const float* A = (const float*)(F.ws + WS_A); const float* B = (const float*)(F.ws + WS_B); float* CP = (float*)(F.ws + WS_CARRY); float* CH = CP + BATCH * 32 * DM;
    for (int u = F.bid; u < BATCH * 32 * 2; u += F.G) {
        const int hh = u & 1, j = (u >> 1) & 31, b = u >> 6, c = hh * 1024 + 2 * F.tid;
        const size_t base = ((size_t)b * SEQ + j * 64) * DM + c;
        f32x2 P = {1.f, 1.f}, H = {0.f, 0.f};
#pragma unroll 8
        for (int t = 0; t < 64; ++t) { const f32x2 a = *(const f32x2*)(A + base + (size_t)t * DM), bb = *(const f32x2*)(B + base + (size_t)t * DM); H = a * H + bb; P = P * a; }
        *(f32x2*)(CP + ((size_t)b * 32 + j) * DM + c) = P; *(f32x2*)(CH + ((size_t)b * 32 + j) * DM + c) = H;
    }
}
DI void p5_lru_pass2(Frame& F) {
    const float* A = (const float*)(F.ws + WS_A); const float* B = (const float*)(F.ws + WS_B); const float* CP = (const float*)(F.ws + WS_CARRY); const float* CH = CP + BATCH * 32 * DM;
    const bf16* proj = (const bf16*)(F.ws + WS_PROJ); bf16* mrg = (bf16*)(F.ws + WS_MRG);
    for (int u = F.bid; u < BATCH * 32 * 2; u += F.G) {
        const int hh = u & 1, j = (u >> 1) & 31, b = u >> 6, c = hh * 1024 + 2 * F.tid;
        f32x2 h = {0.f, 0.f};
        for (int jj = 0; jj < j; ++jj) { const f32x2 p = *(const f32x2*)(CP + ((size_t)b * 32 + jj) * DM + c), q = *(const f32x2*)(CH + ((size_t)b * 32 + jj) * DM + c); h = p * h + q; }
        const size_t tok0 = (size_t)b * SEQ + j * 64;
#pragma unroll 4
        for (int t = 0; t < 64; ++t) { const size_t tok = tok0 + t; const f32x2 a = *(const f32x2*)(A + tok * DM + c), bb = *(const f32x2*)(B + tok * DM + c); h = a * h + bb;
            const unsigned gr = *(const unsigned*)(proj + tok * NINP + C_GR + c), gg = *(const unsigned*)(proj + tok * NINP + C_G + 4096 + c);
            const float y0 = h[0] * gelu_tanh_(bflo(gr)) * sigmoidf_(bflo(gg)), y1 = h[1] * gelu_tanh_(bfhi(gr)) * sigmoidf_(bfhi(gg));
            *(unsigned*)(mrg + tok * MIXW + 4096 + c) = pk2(y0, y1); }
    }
}

constexpr int KS_STRIDE = 272, VT_STRIDE = 136;
constexpr int ATT_KS = 0, ATT_VT = 64 * KS_STRIDE;
DI void p5_attention(Frame& F) {
    const bf16* proj = (const bf16*)(F.ws + WS_PROJ); const unsigned* mask = (const unsigned*)(F.ws + WS_MASK); bf16* mrg = (bf16*)(F.ws + WS_MRG);
    LAS unsigned char* Ks = F.lds + ATT_KS; LAS unsigned char* Vt = F.lds + ATT_VT;
    const int lane = F.lane, l31 = lane & 31, hf = lane >> 5, wave = F.wave, hh = wave >> 1, qh = wave & 1, tid = F.tid;
    const float sc2 = 0.08838834764831845f * 1.4426950408889634f;
    for (int u = F.bid; u < BATCH * 16 * 4; u += F.G) {
        const int g = u & 3, cp = (u >> 2) & 15, b = u >> 6;
        for (int half = 0; half < 2; ++half) {
            const int c = half ? (31 - cp) : cp, nkt = c + 1, head = g * 4 + hh;
            const int qtok = b * SEQ + c * 64 + qh * 32 + l31;
            const bf16* qrow = proj + (size_t)qtok * NINP + C_Q + head * 128 + hf * 8;
            bf16x8 qf[8];
#pragma unroll
            for (int ks = 0; ks < 8; ++ks) qf[ks] = *(const bf16x8*)(qrow + ks * 16);
            f32x16 o[4];
#pragma unroll
            for (int db = 0; db < 4; ++db)
#pragma unroll
                for (int i = 0; i < 16; ++i) o[db][i] = 0.f;
            float mrun = -1e30f, lrun = 0.f;
            const int sr0 = tid >> 4, sch = tid & 15;
            const bf16* kg = proj + (size_t)(b * SEQ + sr0) * NINP + C_K + g * 128 + sch * 8;
            const bf16* vg = proj + (size_t)(b * SEQ + sr0) * NINP + C_V + g * 128 + sch * 8;
            u32x4 kr0 = *(const u32x4*)kg, kr1 = *(const u32x4*)(kg + (size_t)32 * NINP), vr0 = *(const u32x4*)vg, vr1 = *(const u32x4*)(vg + (size_t)32 * NINP);
            const unsigned* mrow = mask + (size_t)qtok * 64;
            unsigned mw0 = mrow[0], mw1 = mrow[1];
            for (int kt = 0; kt < nkt; ++kt) {
                __syncthreads();
                *(LAS u32x4*)(Ks + sr0 * KS_STRIDE + sch * 16) = kr0; *(LAS u32x4*)(Ks + (sr0 + 32) * KS_STRIDE + sch * 16) = kr1;
                { const unsigned vv0[4] = {vr0.x, vr0.y, vr0.z, vr0.w}, vv1[4] = {vr1.x, vr1.y, vr1.z, vr1.w};
#pragma unroll
                  for (int i = 0; i < 4; ++i) { LAS unsigned char* d0 = Vt + (sch * 8 + 2 * i) * VT_STRIDE;
                      *(LAS bf16*)(d0 + sr0 * 2) = (bf16)(vv0[i] & 0xffffu); *(LAS bf16*)(d0 + VT_STRIDE + sr0 * 2) = (bf16)(vv0[i] >> 16);
                      *(LAS bf16*)(d0 + (sr0 + 32) * 2) = (bf16)(vv1[i] & 0xffffu); *(LAS bf16*)(d0 + VT_STRIDE + (sr0 + 32) * 2) = (bf16)(vv1[i] >> 16); } }
                __syncthreads();
                const unsigned cm0 = mw0, cm1 = mw1;
                if (kt + 1 < nkt) { const size_t adv = (size_t)(kt + 1) * 64 * NINP;
                    kr0 = *(const u32x4*)(kg + adv); kr1 = *(const u32x4*)(kg + adv + (size_t)32 * NINP); vr0 = *(const u32x4*)(vg + adv); vr1 = *(const u32x4*)(vg + adv + (size_t)32 * NINP);
                    mw0 = mrow[2 * kt + 2]; mw1 = mrow[2 * kt + 3]; }
                f32x16 s0, s1;
#pragma unroll
                for (int i = 0; i < 16; ++i) { s0[i] = 0.f; s1[i] = 0.f; }
#pragma unroll
                for (int ks = 0; ks < 8; ++ks) {
                    const bf16x8 ka = *(const LAS bf16x8*)(Ks + l31 * KS_STRIDE + ks * 32 + hf * 16);
                    const bf16x8 kb = *(const LAS bf16x8*)(Ks + (32 + l31) * KS_STRIDE + ks * 32 + hf * 16);
                    s0 = __builtin_amdgcn_mfma_f32_32x32x16_bf16(ka, qf[ks], s0, 0, 0, 0);
                    s1 = __builtin_amdgcn_mfma_f32_32x32x16_bf16(kb, qf[ks], s1, 0, 0, 0);
                }
                const unsigned sm0 = cm0 >> (4 * hf), sm1 = cm1 >> (4 * hf);
                float tmax = -INFINITY;
#pragma unroll
                for (int i = 0; i < 16; ++i) { const unsigned bit = 1u << ((i & 3) + 8 * (i >> 2));
                    s0[i] = (sm0 & bit) ? s0[i] * sc2 : -INFINITY; s1[i] = (sm1 & bit) ? s1[i] * sc2 : -INFINITY; tmax = fmaxf(tmax, fmaxf(s0[i], s1[i])); }
                tmax = fmaxf(tmax, __shfl_xor(tmax, 32));
                const float mnew = fmaxf(mrun, tmax), alpha = exp2f(mrun - mnew); mrun = mnew;
                float psum = 0.f;
#pragma unroll
                for (int i = 0; i < 16; ++i) { s0[i] = exp2f(s0[i] - mnew); s1[i] = exp2f(s1[i] - mnew); psum += s0[i] + s1[i]; }
                lrun = lrun * alpha + psum;
#pragma unroll
                for (int db = 0; db < 4; ++db)
#pragma unroll
                    for (int i = 0; i < 16; ++i) o[db][i] *= alpha;
#pragma unroll
                for (int kb = 0; kb < 2; ++kb)
#pragma unroll
                    for (int s = 0; s < 2; ++s) {
                        u32x4 pw;
                        if (kb == 0) { pw.x = pk2(s0[8 * s], s0[8 * s + 1]); pw.y = pk2(s0[8 * s + 2], s0[8 * s + 3]); pw.z = pk2(s0[8 * s + 4], s0[8 * s + 5]); pw.w = pk2(s0[8 * s + 6], s0[8 * s + 7]); }
                        else { pw.x = pk2(s1[8 * s], s1[8 * s + 1]); pw.y = pk2(s1[8 * s + 2], s1[8 * s + 3]); pw.z = pk2(s1[8 * s + 4], s1[8 * s + 5]); pw.w = pk2(s1[8 * s + 6], s1[8 * s + 7]); }
                        const bf16x8 pf = __builtin_bit_cast(bf16x8, pw);
#pragma unroll
                        for (int db = 0; db < 4; ++db) {
                            const LAS unsigned char* vp = Vt + (db * 32 + l31) * VT_STRIDE + (kb * 32 + 16 * s + 4 * hf) * 2;
                            const u32x2 lo = *(const LAS u32x2*)vp, hi = *(const LAS u32x2*)(vp + 16);
                            const u32x4 vw = {lo.x, lo.y, hi.x, hi.y};
                            o[db] = __builtin_amdgcn_mfma_f32_32x32x16_bf16(__builtin_bit_cast(bf16x8, vw), pf, o[db], 0, 0, 0);
                        }
                    }
            }
            const float ltot = lrun + __shfl_xor(lrun, 32), rl = 1.0f / ltot;
            const bf16* grow = proj + (size_t)qtok * NINP + C_G + head * 128; bf16* orow = mrg + (size_t)qtok * MIXW + head * 128;
#pragma unroll
            for (int db = 0; db < 4; ++db)
#pragma unroll
                for (int q4 = 0; q4 < 4; ++q4) { const int d0 = db * 32 + q4 * 8 + hf * 4; const u32x2 gv = *(const u32x2*)(grow + d0);
                    u32x2 w; w.x = pk2(o[db][4 * q4] * rl * sigmoidf_(bflo(gv.x)), o[db][4 * q4 + 1] * rl * sigmoidf_(bfhi(gv.x)));
                    w.y = pk2(o[db][4 * q4 + 2] * rl * sigmoidf_(bflo(gv.y)), o[db][4 * q4 + 3] * rl * sigmoidf_(bfhi(gv.y)));
                    *(u32x2*)(orow + d0) = w; }
        }
    }
    __syncthreads();
}

template <int MODE, bool ROUTE, bool WRITE_BF>
DI void p_layernorm(Frame& F, const Args& args, const float* src, const float* gam, const float* bet, float* outf, bf16* outb) {
    const int gw = F.bid * 8 + F.wave, NGW = F.G * 8, lane = F.lane;
    const unsigned* rt = (const unsigned*)(F.ws + WS_ROUTE); unsigned* rtw = (unsigned*)(F.ws + WS_ROUTE);
    LAS float* wr_l = (LAS float*)F.lds;
    if (ROUTE) { for (int i = F.tid; i < DM * NEXP / 4; i += 512) *(LAS f32x4*)(wr_l + 4 * i) = *(const f32x4*)(INF(20) + 4 * i); __syncthreads(); }
    for (int row = gw; row < MTOK; row += NGW) {
        f32x4 v[8]; float s = 0.f;
        if (MODE == 0) {
#pragma unroll
            for (int j = 0; j < 8; ++j) v[j] = *(const f32x4*)(src + (size_t)row * DM + 4 * lane + 256 * j);
        } else {
            const unsigned r0 = rt[RT_ROW + 2 * row], r1 = rt[RT_ROW + 2 * row + 1]; const float w0 = __uint_as_float(rt[RT_W + 2 * row]), w1 = __uint_as_float(rt[RT_W + 2 * row + 1]);
            const float* yb = (const float*)(F.ws + WS_YB);
#pragma unroll
            for (int j = 0; j < 8; ++j) { const int cc = 4 * lane + 256 * j; v[j] = *(const f32x4*)(src + (size_t)row * DM + cc) * ALPHA + *(const f32x4*)(yb + (size_t)r0 * DM + cc) * w0 + *(const f32x4*)(yb + (size_t)r1 * DM + cc) * w1; }
        }
#pragma unroll
        for (int j = 0; j < 8; ++j) s += (v[j][0] + v[j][1]) + (v[j][2] + v[j][3]);
        const float mean = wave_sum(s) * (1.f / DM); float s2 = 0.f;
#pragma unroll
        for (int j = 0; j < 8; ++j) { v[j] = v[j] - mean; s2 += (v[j][0] * v[j][0] + v[j][1] * v[j][1]) + (v[j][2] * v[j][2] + v[j][3] * v[j][3]); }
        const float rstd = 1.0f / sqrtf(wave_sum(s2) * (1.f / DM) + LN_EPS);
        float lg[8];
#pragma unroll
        for (int e = 0; e < 8; ++e) lg[e] = 0.f;
#pragma unroll
        for (int j = 0; j < 8; ++j) { const f32x4 gv = *(const f32x4*)(gam + 4 * lane + 256 * j), bv = *(const f32x4*)(bet + 4 * lane + 256 * j);
            const f32x4 y = v[j] * rstd * gv + bv; *(f32x4*)(outf + (size_t)row * DM + 4 * lane + 256 * j) = y;
            if (WRITE_BF) { u32x2 w; w.x = pk2(y[0], y[1]); w.y = pk2(y[2], y[3]); *(u32x2*)(outb + (size_t)row * DM + 4 * lane + 256 * j) = w; }
            if (ROUTE) {
#pragma unroll
                for (int i = 0; i < 4; ++i) { const LAS float* wp = wr_l + (size_t)(4 * lane + 256 * j + i) * 8; const f32x4 wa = *(const LAS f32x4*)wp, wb = *(const LAS f32x4*)(wp + 4); const float xv = y[i];
                    lg[0] += xv * wa[0]; lg[1] += xv * wa[1]; lg[2] += xv * wa[2]; lg[3] += xv * wa[3]; lg[4] += xv * wb[0]; lg[5] += xv * wb[1]; lg[6] += xv * wb[2]; lg[7] += xv * wb[3]; }
            }
            asm volatile("" ::: "memory"); }
        if (ROUTE) {
#pragma unroll
            for (int e = 0; e < 8; ++e) lg[e] = wave_sum(lg[e]);
            int e0 = 0; float l0 = lg[0];
#pragma unroll
            for (int e = 1; e < 8; ++e) if (lg[e] > l0) { l0 = lg[e]; e0 = e; }
            int e1 = 0; float l1 = -INFINITY;
#pragma unroll
            for (int e = 0; e < 8; ++e) if (e != e0 && lg[e] > l1) { l1 = lg[e]; e1 = e; }
            const float p1 = 1.0f / (1.0f + expf(l0 - l1)), p0 = 1.0f - p1;
            if (lane == 0) { const unsigned sl0 = atomicAdd(F.ctl + CW_CNT + e0, 1u), sl1 = atomicAdd(F.ctl + CW_CNT + e1, 1u);
                rtw[RT_E + 2 * row] = (unsigned)e0; rtw[RT_E + 2 * row + 1] = (unsigned)e1; rtw[RT_SLOT + 2 * row] = sl0; rtw[RT_SLOT + 2 * row + 1] = sl1;
                rtw[RT_W + 2 * row] = __float_as_uint(p0); rtw[RT_W + 2 * row + 1] = __float_as_uint(p1); }
        }
    }
    if (ROUTE) __syncthreads();
}

DI void p_moe_gather(Frame& F) {
    const unsigned* cnt = F.ctl + CW_CNT; unsigned* rt = (unsigned*)(F.ws + WS_ROUTE);
    const bf16* x1b = (const bf16*)(F.ws + WS_X1B); bf16* am = (bf16*)(F.ws + WS_AMOE);
    int ts[9]; ts[0] = 0;
#pragma unroll
    for (int e = 0; e < 8; ++e) ts[e + 1] = ts[e] + (((int)cnt[e] + 255) >> 8);
    const int gw = F.bid * 8 + F.wave, NGW = F.G * 8, lane = F.lane;
    for (int a = gw; a < MTOK * 2; a += NGW) {
        const int tok = a >> 1; const int e = (int)rt[RT_E + a], slot = (int)rt[RT_SLOT + a]; int tse = 0;
#pragma unroll
        for (int k = 0; k < 8; ++k) tse = (e == k) ? ts[k] : tse;
        const int row = tse * 256 + slot;
        const u32x4* s = (const u32x4*)(x1b + (size_t)tok * DM); u32x4* d = (u32x4*)(am + (size_t)row * DM);
#pragma unroll
        for (int i = 0; i < 4; ++i) d[lane + 64 * i] = s[lane + 64 * i];
        if (lane == 0) rt[RT_ROW + a] = (unsigned)row;
    }
    for (int pr = gw; pr < 8 * 256; pr += NGW) { const int e = pr >> 8, i = pr & 255; int tse = 0, tn = 0, ce = 0;
#pragma unroll
        for (int k = 0; k < 8; ++k) { tse = (e == k) ? ts[k] : tse; tn = (e == k) ? ts[k + 1] : tn; ce = (e == k) ? (int)cnt[k] : ce; }
        const int row = tse * 256 + ce + i;
        if (row < tn * 256) { u32x4* d = (u32x4*)(am + (size_t)row * DM);
#pragma unroll
            for (int q = 0; q < 4; ++q) d[lane + 64 * q] = (u32x4){0u, 0u, 0u, 0u}; } }
}

constexpr int NPH_LAYER = 12;
constexpr int NPHASES = 1 + 2 * NPH_LAYER;
#define IN(k) (lo <= (k) && (k) < hi)
#define RELAUNDER() do { int l_ = lane_id_(); asm volatile("" : "+v"(l_)); F.lane = l_; F.tid = F.wave * 64 + l_; } while (0)
#define SEAM(k) do { if (IN(k) && IN((k) + 1)) xcd_barrier(bar); } while (0)
template <int LAYER>
DI void run_layer(Frame& F, const Args& args, const XcdBarrier& bar, const int lo, const int hi) {
    constexpr int P = 1 + NPH_LAYER * LAYER;
    bf16* proj = (bf16*)(F.ws + WS_PROJ); bf16* xb = (bf16*)(F.ws + WS_XB); bf16* mrg = (bf16*)(F.ws + WS_MRG);
    float* x1 = (float*)(F.ws + WS_X1); bf16* x1b = (bf16*)(F.ws + WS_X1B); float* x2 = (float*)(F.ws + WS_X2); float* pre = (float*)(F.ws + WS_PRE);
    if (IN(P + 0)) {
        pg8::Gemm g{xb, (const bf16*)(F.ws + WS_WIN) + (size_t)LAYER * NINP * DM, DM, DM, DM};
        pg8::TileOrder S; S.init(MTOK / 256, NINP / 256, F.G, F.bid, (size_t)256 * DM * 2, (size_t)256 * DM * 2);
        pg8::EpiBf16 E{proj, NINP};
        pg8::gemm_phase(F.lds, g, S, E, F.wave);
    }
    SEAM(P + 0);
    if (IN(P + 1)) { RELAUNDER(); p2_prep(F, args, LAYER); }
    SEAM(P + 1);
    if (IN(P + 2)) {
        { pg8::Gemm g{(const bf16*)(F.ws + WS_DIFF), (const bf16*)(F.ws + WS_WPOOL) + (size_t)LAYER * 2048 * 512, DM, 512, 512};
          pg8::TileOrder S; S.init(MTOK / 256, 8, F.G, F.bid, (size_t)256 * DM * 2, (size_t)256 * 512 * 2, 2, (size_t)512 * 2);
          pg8::EpiPool E{mrg, proj, INF(5) + (size_t)LAYER * DM};
          pg8::gemm_phase(F.lds, g, S, E, F.wave); }
        { pg8::Gemm g{(const bf16*)(F.ws + WS_XC), (const bf16*)(F.ws + WS_WLRU) + (size_t)LAYER * 4096 * 256, DM, 256, 256};
          pg8::TileOrder S; S.init(MTOK / 256, 16, F.G, F.bid, (size_t)256 * DM * 2, (size_t)256 * 256 * 2, 2, (size_t)256 * 2);
          pg8::EpiLru E{(float*)(F.ws + WS_A), (float*)(F.ws + WS_B), (const bf16*)(F.ws + WS_XC), INF(9) + (size_t)LAYER * DM, INF(11) + (size_t)LAYER * DM, (const float*)(F.ws + WS_LRUC) + (size_t)LAYER * DM};
          pg8::gemm_phase(F.lds, g, S, E, F.wave); }
        RELAUNDER(); p3_indexer(F);
    }
    SEAM(P + 2);
    if (IN(P + 3)) { RELAUNDER(); p4_select(F); RELAUNDER(); p4_lru_pass1(F); }
    SEAM(P + 3);
    if (IN(P + 4)) { RELAUNDER(); p5_attention(F); RELAUNDER(); p5_lru_pass2(F); }
    SEAM(P + 4);
    if (IN(P + 5)) {
        pg8::Gemm g{mrg, (const bf16*)(F.ws + WS_WOUT) + (size_t)LAYER * DM * MIXW, MIXW, MIXW, MIXW};
        pg8::TileOrder S; S.init(MTOK / 256, DM / 256, F.G, F.bid, (size_t)256 * MIXW * 2, (size_t)256 * MIXW * 2);
        pg8::EpiRes E{pre, LAYER == 0 ? INF(0) : (const float*)x2, DM};
        pg8::gemm_phase(F.lds, g, S, E, F.wave);
    }
    SEAM(P + 5);
    if (IN(P + 6)) { RELAUNDER(); } if (IN(P + 6)) p_layernorm<0, LAYER == 1, true>(F, args, pre, INF(13) + LAYER * DM, INF(14) + LAYER * DM, x1, x1b);
    SEAM(P + 6);
    if constexpr (LAYER == 0) {
        if (IN(P + 7)) {
            pg8::Gemm g{x1b, (const bf16*)(F.ws + WS_WGU), DM, DM, DM};
            pg8::TileOrder S; S.init(MTOK / 256, 2 * DFF / 256, F.G, F.bid, (size_t)256 * DM * 2, (size_t)256 * DM * 2);
            pg8::EpiSwiglu E{(bf16*)(F.ws + WS_H), DFF};
            pg8::gemm_phase(F.lds, g, S, E, F.wave);
        }
        SEAM(P + 7);
        if (IN(P + 8)) {
            pg8::Gemm g{(const bf16*)(F.ws + WS_H), (const bf16*)(F.ws + WS_WDN), DFF, DFF, DFF};
            pg8::TileOrder S; S.init(MTOK / 256, DM / 256, F.G, F.bid, (size_t)256 * DFF * 2, (size_t)256 * DFF * 2);
            pg8::EpiRes E{pre, x1, DM};
            pg8::gemm_phase(F.lds, g, S, E, F.wave);
        }
        SEAM(P + 8);
        if (IN(P + 9)) { RELAUNDER(); } if (IN(P + 9)) p_layernorm<0, false, true>(F, args, pre, INF(15), INF(16), x2, xb);
        if (IN(P + 9) && IN(P + 12)) xcd_barrier(bar);
    } else {
        if (IN(P + 7)) { RELAUNDER(); p_convert_moe(F, args); RELAUNDER(); p_moe_gather(F); }
        SEAM(P + 7);
        if (IN(P + 8)) {
            pg8::Gemm g{(const bf16*)(F.ws + WS_AMOE), (const bf16*)(F.ws + WS_MWGU), DM, DM, DM};
            pg8::MoeOrder S; S.init(F.ctl + CW_CNT, 2 * DEXP / 256, F.G, F.bid, (size_t)256 * DM * 2, (size_t)2 * DEXP * DM * 2, (size_t)256 * DM * 2);
            pg8::EpiSwiglu E{(bf16*)(F.ws + WS_HMOE), DEXP};
            pg8::gemm_phase(F.lds, g, S, E, F.wave);
        }
        SEAM(P + 8);
        if (IN(P + 9)) {
            pg8::Gemm g{(const bf16*)(F.ws + WS_HMOE), (const bf16*)(F.ws + WS_MWDN), DEXP, DEXP, DEXP};
            pg8::MoeOrder S; S.init(F.ctl + CW_CNT, DM / 256, F.G, F.bid, (size_t)256 * DEXP * 2, (size_t)DM * DEXP * 2, (size_t)256 * DEXP * 2);
            pg8::EpiF32 E{(float*)(F.ws + WS_YB), DM};
            pg8::gemm_phase(F.lds, g, S, E, F.wave);
        }
        SEAM(P + 9);
        if (IN(P + 10)) { RELAUNDER(); } if (IN(P + 10)) p_layernorm<1, false, false>(F, args, x1, INF(15) + DM, INF(16) + DM, args.out, nullptr);
    }
}
__global__ void __launch_bounds__(512, 2) fwd_kernel(Args args) {
    extern __shared__ __attribute__((aligned(16))) unsigned char lds_raw[];
    Frame F;
    F.lds = (LAS unsigned char*)lds_raw; F.ws = args.ws; F.ctl = (unsigned*)(args.ws + WS_CTL);
    F.wave = __builtin_amdgcn_readfirstlane((int)threadIdx.x >> 6); F.lane = lane_id_(); F.tid = F.wave * 64 + F.lane; F.G = gridDim.x; F.bid = blockIdx.x;
    volatile LAS unsigned* MISC = (volatile LAS unsigned*)(F.lds + LDSCTL_OFF);
    for (int u = F.tid; u < (LDS_BYTES - LDSCTL_OFF) / 4; u += 512) ((LAS unsigned*)(F.lds + LDSCTL_OFF))[u] = 0u;
    __syncthreads();
    const int lo = args.ph_lo, hi = args.ph_hi;
    XcdBarrier bar; bar.bar = F.ctl + CW_BAR; bar.x = 0; bar.st = nullptr; bar.wave = F.wave;
    if ((hi - lo) > 1) bar = xcd_barrier_post(F.ctl + CW_BAR, MISC + 8, F.wave);
    if (IN(0)) { RELAUNDER(); p0_prologue(F, args); __syncthreads(); }
    SEAM(0);
    run_layer<0>(F, args, bar, lo, hi);
    run_layer<1>(F, args, bar, lo, hi);
}
#undef IN
#undef SEAM

extern "C" void kernel_launch(void* const* d_in, const int* in_sizes, int n_in, void* d_out, int out_size, void* d_ws, size_t ws_size, hipStream_t stream) {
    static int grid = 0;
    if (grid == 0) {
        if (n_in != 24 || out_size != MTOK * DM || ws_size < WS_END) { fprintf(stderr, "kernel_launch: unexpected problem (n_in %d, out %d, ws %zu, need %zu)\n", n_in, out_size, ws_size, (size_t)WS_END); grid = -1; return; }
        int dev = 0, cus = 0, per_cu = 0;
        if (hipGetDevice(&dev) != hipSuccess || hipDeviceGetAttribute(&cus, hipDeviceAttributeMultiprocessorCount, dev) != hipSuccess) { grid = -1; return; }
        if (hipFuncSetAttribute((const void*)fwd_kernel, hipFuncAttributeMaxDynamicSharedMemorySize, LDS_BYTES) != hipSuccess) { fprintf(stderr, "kernel_launch: hipFuncSetAttribute failed\n"); grid = -1; return; }
        if (hipOccupancyMaxActiveBlocksPerMultiprocessor(&per_cu, (const void*)fwd_kernel, 512, LDS_BYTES) != hipSuccess || per_cu < 1) fprintf(stderr, "kernel_launch: occupancy query reports %d\n", per_cu);
        (void)hipGetLastError();
        grid = cus;
    }
    if (grid < 0) return;
    (void)hipMemsetAsync((char*)d_ws + WS_CTL, 0, CTL_ZERO_BYTES, stream);
    Args a{};
    for (int i = 0; i < 24; ++i) a.in[i] = d_in[i];
    a.out = (float*)d_out; a.ws = (unsigned char*)d_ws;
#if MK_N_LAUNCHES == 1
    a.ph_lo = 0; a.ph_hi = NPHASES;
    hipLaunchKernelGGL(fwd_kernel, dim3(grid), dim3(512), LDS_BYTES, stream, a);
#else
    const int plist[] = {0, 1, 2, 3, 4, 5, 6, 7, 8, 9, 10, 13, 14, 15, 16, 17, 18, 19, 20, 21, 22, 23};
    for (int i = 0; i < (int)(sizeof(plist) / sizeof(int)); ++i) { a.ph_lo = plist[i]; a.ph_hi = plist[i] + 1; hipLaunchKernelGGL(fwd_kernel, dim3(grid), dim3(512), LDS_BYTES, stream, a); }
#endif
}
```

```cpp
#include <hip/hip_runtime.h>
#include <cstdio>
#include <cstdint>

#ifndef MK_N_LAUNCHES
#define MK_N_LAUNCHES 1
#endif

#define DI __device__ __forceinline__
#define LAS __attribute__((address_space(3)))
#define GAS __attribute__((address_space(1)))
typedef unsigned short bf16;
typedef short bf16x8 __attribute__((ext_vector_type(8)));
typedef float f32x2 __attribute__((ext_vector_type(2)));
typedef float f32x4 __attribute__((ext_vector_type(4)));
typedef float f32x16 __attribute__((ext_vector_type(16)));
typedef unsigned u32x2 __attribute__((ext_vector_type(2)));
typedef unsigned u32x4 __attribute__((ext_vector_type(4)));
typedef __bf16 bf16x2_t __attribute__((ext_vector_type(2)));

#define LDS_WAIT() asm volatile("s_waitcnt lgkmcnt(0)" ::: "memory")
#define VM_WAIT() asm volatile("s_waitcnt vmcnt(0)" ::: "memory")

DI unsigned pk2(float lo, float hi) { f32x2 v = {lo, hi}; return __builtin_bit_cast(unsigned, __builtin_convertvector(v, bf16x2_t)); }
DI float bflo(unsigned w) { return __uint_as_float(w << 16); }
DI float bfhi(unsigned w) { return __uint_as_float(w & 0xffff0000u); }
DI float bf2f(bf16 b) { return __uint_as_float(((unsigned)b) << 16); }
DI float rcp_(float x) { return __builtin_amdgcn_rcpf(x); }
DI float sigmoidf_(float x) { return rcp_(1.0f + __expf(-x)); }
DI float siluf_(float x) { return x * rcp_(1.0f + __expf(-x)); }
DI float gelu_tanh_(float x) { const float u = 0.7978845608028654f * (x + 0.044715f * x * x * x); const float t = 1.0f - 2.0f * rcp_(1.0f + __expf(2.0f * u)); return 0.5f * x * (1.0f + t); }
DI float one_minus_exp_(float x) {
    const float p = -x * (1.0f + x * 0.5f * (1.0f + x * (1.0f / 3.0f) * (1.0f + x * 0.25f * (1.0f + x * 0.2f * (1.0f + x * (1.0f / 6.0f) * (1.0f + x * (1.0f / 7.0f)))))));
    return x > -0.5f ? p : 1.0f - __expf(x);
}
DI int lane_id_() { int l; asm volatile("v_mbcnt_lo_u32_b32 %0, -1, 0\n\tv_mbcnt_hi_u32_b32 %0, -1, %0" : "=v"(l)); return l; }

constexpr int DM = 2048, BATCH = 4, SEQ = 2048, MTOK = BATCH * SEQ;
constexpr int NIN = 16464, NINP = 16640;
constexpr int C_Q = 0, C_K = 2048, C_V = 2560, C_QI = 3072, C_KI = 4096, C_WI = 4160, C_PADLO = 4176, C_P = 4352, C_XR = 6400, C_GR = 8448, C_G = 10496;
constexpr int MIXW = 6144, DFF = 5504, NEXP = 8, DEXP = 7168;
constexpr int MOE_ROWS_MAX = (MTOK * 2 / 256 + NEXP) * 256;
constexpr float ALPHA = 1.4142135623730951f, LN_EPS = 1e-5f;

constexpr size_t MiB = 1u << 20;
constexpr size_t WS_CTL = 0, CTL_ZERO_BYTES = 1 * MiB;
constexpr size_t WS_COSA = 1 * MiB, WS_SINA = 3 * MiB, WS_COSI = 5 * MiB, WS_SINI = 6 * MiB;
constexpr size_t WS_CARRY = 7 * MiB;
constexpr size_t WS_ROUTE = 9 * MiB;
constexpr size_t WS_MASK = 10 * MiB;
constexpr size_t WS_LRUC = 9 * MiB + 512 * 1024;
constexpr size_t WS_WIN = 12 * MiB;
constexpr size_t WS_WOUT = 142 * MiB;
constexpr size_t WS_WPOOL = 190 * MiB;
constexpr size_t WS_WLRU = 194 * MiB;
constexpr size_t WS_WGU = 198 * MiB;
constexpr size_t WS_WDN = 241 * MiB;
constexpr size_t WS_XB = 263 * MiB;
constexpr size_t WS_X1 = 295 * MiB;
constexpr size_t WS_X1B = 359 * MiB;
constexpr size_t WS_X2 = 391 * MiB;
constexpr size_t WS_PRE = 455 * MiB;
constexpr size_t WS_OV = 519 * MiB;
constexpr size_t WS_PROJ = WS_OV;
constexpr size_t WS_DIFF = WS_OV + 260 * MiB;
constexpr size_t WS_XC = WS_OV + 292 * MiB;
constexpr size_t WS_A = WS_OV + 324 * MiB;
constexpr size_t WS_B = WS_OV + 388 * MiB;
constexpr size_t WS_SC = WS_OV + 452 * MiB;
constexpr size_t WS_MRG = WS_OV + 516 * MiB;
constexpr size_t WS_H = WS_OV;
constexpr size_t WS_MWGU = WS_OV;
constexpr size_t WS_MWDN = WS_OV + 448 * MiB;
constexpr size_t WS_AMOE = WS_OV + 672 * MiB;
constexpr size_t WS_HMOE = WS_OV + 744 * MiB;
constexpr size_t WS_YB = WS_OV + 996 * MiB;
constexpr size_t WS_END = WS_OV + 1140 * MiB;
constexpr int CW_BAR = 4096, CW_CNT = 16384;
constexpr int RT_E = 0, RT_SLOT = 2 * MTOK, RT_W = 4 * MTOK, RT_ROW = 6 * MTOK;

constexpr int RING_BYTES = 131072, LDSCTL_OFF = RING_BYTES, LDS_BYTES = 147456;

#define XB_TMO      128
#define XB_XCNT(j)  (256  + 64 * (j))
#define XB_XSUB(j)  (1280 + 64 * (j))
#define XB_XGEN(j)  (2304 + 64 * (j))
#define XB_TOP      3328
#define XB_TOPGEN   3392
#define XCD_BAR_WORDS 3456
#define XB_SPIN_CAP (1u << 18)
DI unsigned xb_ld(unsigned* p)              { return __hip_atomic_load(p, __ATOMIC_RELAXED, __HIP_MEMORY_SCOPE_AGENT); }
DI unsigned xb_add(unsigned* p, unsigned v) { return __hip_atomic_fetch_add(p, v, __ATOMIC_RELAXED, __HIP_MEMORY_SCOPE_AGENT); }
DI unsigned xb_xcc_id() { return (unsigned)__builtin_amdgcn_s_getreg((3 << 11) | 20) & 0xFu; }
#define XB_SPIN(cond, bar) do { unsigned _sp = 0; while (cond) { __builtin_amdgcn_s_sleep(1); \
    if ((++_sp & 255u) == 0u) { if (xb_ld(&(bar)[XB_TMO])) break; if (_sp > XB_SPIN_CAP) { atomicAdd(&(bar)[XB_TMO], 1u); break; } } } } while (0)
struct XcdBarrier { unsigned* bar; unsigned x; volatile LAS unsigned* st; int wave; };
DI bool xb_t0(int wave) { return wave == 0 && lane_id_() == 0; }
DI XcdBarrier xcd_barrier_post(unsigned* bar, volatile LAS unsigned* st, int wave) {
    XcdBarrier b; b.bar = bar; b.x = xb_xcc_id(); b.st = st; b.wave = wave;
    if (xb_t0(wave)) (void)xb_add(&bar[XB_XCNT(b.x)], 1u);
    return b;
}
DI void xcd_barrier_complete(unsigned* bar, unsigned x, unsigned& nloc, unsigned& nx) {
    const unsigned G = gridDim.x * gridDim.y * gridDim.z;
    unsigned sum, cnt, mine, sp = 0u;
    for (;;) {
        sum = 0u; cnt = 0u; mine = 0u;
#pragma unroll
        for (unsigned j = 0; j < 16; ++j) { const unsigned c = xb_ld(&bar[XB_XCNT(j)]); sum += c; cnt += (c > 0u) ? 1u : 0u; mine = (j == x) ? c : mine; }
        if (sum == G) break;
        __builtin_amdgcn_s_sleep(1);
        if ((++sp & 255u) == 0u) { if (xb_ld(&bar[XB_TMO])) break; if (sp > XB_SPIN_CAP) { atomicAdd(&bar[XB_TMO], 1u); break; } }
    }
    nloc = mine > 0u ? mine : 1u; nx = cnt > 0u ? cnt : 1u;
}
DI void xcd_barrier(const XcdBarrier& b) {
    asm volatile("s_waitcnt vmcnt(0)" ::: "memory");
    __syncthreads();
    if (xb_t0(b.wave)) {
        unsigned* bar = b.bar;
        __builtin_amdgcn_s_waitcnt(0);
        unsigned nloc = b.st[0], nx = b.st[1];
        if (nloc == 0u) { xcd_barrier_complete(bar, b.x, nloc, nx); b.st[0] = nloc; b.st[1] = nx; }
        const unsigned old = xb_add(&bar[XB_XSUB(b.x)], 1u);
        const unsigned gen = old / nloc;
        if (old + 1u == (gen + 1u) * nloc) {
            __builtin_amdgcn_fence(__ATOMIC_RELEASE, "agent");
            asm volatile("s_waitcnt vmcnt(0)" ::: "memory");
            const unsigned og = xb_add(&bar[XB_TOP], 1u);
            const unsigned tg = og / nx;
            if (og + 1u == (tg + 1u) * nx) xb_add(&bar[XB_TOPGEN], 1u);
            else XB_SPIN(xb_ld(&bar[XB_TOPGEN]) == tg, bar);
            __builtin_amdgcn_fence(__ATOMIC_ACQUIRE, "agent");
            xb_add(&bar[XB_XGEN(b.x)], 1u);
            asm volatile("s_waitcnt vmcnt(0)" ::: "memory");
        } else {
            XB_SPIN(xb_ld(&bar[XB_XGEN(b.x)]) == gen, bar);
            __builtin_amdgcn_fence(__ATOMIC_ACQUIRE, "agent");
            asm volatile("s_waitcnt vmcnt(0)" ::: "memory");
        }
    }
    __syncthreads();
}

namespace pg8 {
constexpr int BM = 256, BK = 64, HALF = 128, HTB = HALF * BK * 2, STAGE_BYTES = 8 * HTB, NXCD = 8, WGM = 8;
DI int lds_byte(int r, int c) { const int st = (r >> 4) * 2 + (c >> 5), rr = r & 15, cc = c & 31, ob = rr * 64 + cc * 2; return st * 1024 + (ob ^ (((ob >> 9) & 1) << 5)); }
DI void stage_rc(int b, int& R, int& C) { const int st = b / 1024, sb = b % 1024, swz = sb ^ (((sb >> 9) & 1) << 5); R = (st >> 1) * 16 + swz / 64; C = (st & 1) * 32 + (swz % 64) / 2; }
DI int perm32(int rho) { const int n = rho >> 4, i = rho & 15; return 8 * (i >> 2) + 4 * n + (i & 3); }

struct Unit { int pm, pn, e; };
struct Gemm { const bf16* A; const bf16* Bt; int lda, ldb, K; };

struct TileOrder {
    int nM, nN, nwg, G, c, a_div; size_t a_pm, a_pn, b_pn;
    DI void init(int nM_, int nN_, int G_, int c_, size_t a_pm_, size_t b_pn_, int a_div_ = 1, size_t a_pn_ = 0) { nM = nM_; nN = nN_; nwg = nM * nN; G = G_; c = c_; a_pm = a_pm_; b_pn = b_pn_; a_div = a_div_; a_pn = a_pn_; }
    DI bool next(int i, Unit& u) const {
        const long L = (long)i * G + c; if (L >= nwg) return false;
        int wgid = (int)L; { const int q = nwg / NXCD, r = nwg % NXCD, xcd = wgid % NXCD, off = wgid / NXCD; wgid = (xcd < r ? xcd * (q + 1) : r * (q + 1) + (xcd - r) * q) + off; }
        const int nig = WGM * nN, gid = wgid / nig, fm = gid * WGM, gsz = (nM - fm) < WGM ? (nM - fm) : WGM;
        u.pm = fm + ((wgid % nig) % gsz); u.pn = (wgid % nig) / gsz; u.e = 0; return true;
    }
    DI size_t aoff(const Unit& u) const { return (size_t)u.pm * a_pm + (size_t)(u.pn / a_div) * a_pn; }
    DI size_t boff(const Unit& u) const { return (size_t)u.pn * b_pn; }
};
struct MoeOrder {
    int nN, nwg, G, c; int t1, t2, t3, t4, t5, t6, t7, t8; size_t a_pm, b_e, b_pn;
    DI void init(const unsigned* cnt, int nN_, int G_, int c_, size_t a_pm_, size_t b_e_, size_t b_pn_) {
        nN = nN_; G = G_; c = c_; a_pm = a_pm_; b_e = b_e_; b_pn = b_pn_;
        int s = 0; s += ((int)cnt[0] + 255) >> 8; t1 = s; s += ((int)cnt[1] + 255) >> 8; t2 = s; s += ((int)cnt[2] + 255) >> 8; t3 = s; s += ((int)cnt[3] + 255) >> 8; t4 = s;
        s += ((int)cnt[4] + 255) >> 8; t5 = s; s += ((int)cnt[5] + 255) >> 8; t6 = s; s += ((int)cnt[6] + 255) >> 8; t7 = s; s += ((int)cnt[7] + 255) >> 8; t8 = s;
        nwg = t8 * nN;
    }
    DI bool next(int i, Unit& u) const {
        const long L = (long)i * G + c; if (L >= nwg) return false;
        int wgid = (int)L; { const int q = nwg / NXCD, r = nwg % NXCD, xcd = wgid % NXCD, off = wgid / NXCD; wgid = (xcd < r ? xcd * (q + 1) : r * (q + 1) + (xcd - r) * q) + off; }
        int e = 0, ts = 0, nt = t1;
        if (wgid >= t1 * nN) { e = 1; ts = t1; nt = t2 - t1; }
        if (wgid >= t2 * nN) { e = 2; ts = t2; nt = t3 - t2; }
        if (wgid >= t3 * nN) { e = 3; ts = t3; nt = t4 - t3; }
        if (wgid >= t4 * nN) { e = 4; ts = t4; nt = t5 - t4; }
        if (wgid >= t5 * nN) { e = 5; ts = t5; nt = t6 - t5; }
        if (wgid >= t6 * nN) { e = 6; ts = t6; nt = t7 - t6; }
        if (wgid >= t7 * nN) { e = 7; ts = t7; nt = t8 - t7; }
        const int loc = wgid - ts * nN; nt = nt > 0 ? nt : 1;
        u.pm = ts + loc % nt; u.pn = loc / nt; u.e = e; return true;
    }
    DI size_t aoff(const Unit& u) const { return (size_t)u.pm * a_pm; }
    DI size_t boff(const Unit& u) const { return (size_t)u.e * b_e + (size_t)u.pn * b_pn; }
};

struct EpiBf16 {
    static constexpr bool PERM = true;
    bf16* O; int ldc;
    DI void operator()(const f32x4 (&acc)[2][2][4][2], const Unit& u, int wr, int wc, int fr, int fq) const {
        const int row0 = u.pm * BM + wr * 64 + fr, col0 = u.pn * BM + wc * 32 + 8 * fq;
#pragma unroll
        for (int ai = 0; ai < 2; ++ai)
#pragma unroll
            for (int m = 0; m < 4; ++m) { bf16* rowp = O + (size_t)(row0 + ai * HALF + m * 16) * ldc + col0;
#pragma unroll
                for (int bj = 0; bj < 2; ++bj) { const f32x4 v0 = acc[ai][bj][m][0], v1 = acc[ai][bj][m][1];
                    u32x4 w; w.x = pk2(v0[0], v0[1]); w.y = pk2(v0[2], v0[3]); w.z = pk2(v1[0], v1[1]); w.w = pk2(v1[2], v1[3]);
                    *(u32x4*)(rowp + bj * HALF) = w; } }
    }
};
struct EpiF32 {
    static constexpr bool PERM = false;
    float* C; int ldc;
    DI void operator()(const f32x4 (&acc)[2][2][4][2], const Unit& u, int wr, int wc, int fr, int fq) const {
        const int row0 = u.pm * BM + wr * 64 + fr, col0 = u.pn * BM + wc * 32 + 4 * fq;
#pragma unroll
        for (int ai = 0; ai < 2; ++ai)
#pragma unroll
            for (int m = 0; m < 4; ++m) { float* rowp = C + (size_t)(row0 + ai * HALF + m * 16) * ldc + col0;
#pragma unroll
                for (int bj = 0; bj < 2; ++bj)
#pragma unroll
                    for (int n = 0; n < 2; ++n) *(f32x4*)(rowp + bj * HALF + n * 16) = acc[ai][bj][m][n]; }
    }
};
struct EpiRes {
    static constexpr bool PERM = false;
    float* C; const float* res; int ldc;
    DI void operator()(const f32x4 (&acc)[2][2][4][2], const Unit& u, int wr, int wc, int fr, int fq) const {
        const int row0 = u.pm * BM + wr * 64 + fr, col0 = u.pn * BM + wc * 32 + 4 * fq;
#pragma unroll
        for (int ai = 0; ai < 2; ++ai)
#pragma unroll
            for (int m = 0; m < 4; ++m) { const size_t off = (size_t)(row0 + ai * HALF + m * 16) * ldc + col0;
#pragma unroll
                for (int bj = 0; bj < 2; ++bj)
#pragma unroll
                    for (int n = 0; n < 2; ++n) { const f32x4 rv = *(const f32x4*)(res + off + bj * HALF + n * 16); *(f32x4*)(C + off + bj * HALF + n * 16) = acc[ai][bj][m][n] + rv * ALPHA; }
                asm volatile("" ::: "memory"); }
    }
};
struct EpiSwiglu {
    static constexpr bool PERM = true;
    bf16* H; int ldc;
    DI void operator()(const f32x4 (&acc)[2][2][4][2], const Unit& u, int wr, int wc, int fr, int fq) const {
        const int row0 = u.pm * BM + wr * 64 + fr, col0 = u.pn * HALF + wc * 32 + 8 * fq;
#pragma unroll
        for (int ai = 0; ai < 2; ++ai)
#pragma unroll
            for (int m = 0; m < 4; ++m) { bf16* rowp = H + (size_t)(row0 + ai * HALF + m * 16) * ldc + col0;
                const f32x4 g0 = acc[ai][0][m][0], g1 = acc[ai][0][m][1], u0 = acc[ai][1][m][0], u1 = acc[ai][1][m][1];
                u32x4 w; w.x = pk2(siluf_(g0[0]) * u0[0], siluf_(g0[1]) * u0[1]); w.y = pk2(siluf_(g0[2]) * u0[2], siluf_(g0[3]) * u0[3]);
                w.z = pk2(siluf_(g1[0]) * u1[0], siluf_(g1[1]) * u1[1]); w.w = pk2(siluf_(g1[2]) * u1[2], siluf_(g1[3]) * u1[3]);
                *(u32x4*)rowp = w; asm volatile("" ::: "memory"); }
    }
};
struct EpiPool {
    static constexpr bool PERM = true;
    bf16* mrg; const bf16* proj; const float* scale;
    DI void operator()(const f32x4 (&acc)[2][2][4][2], const Unit& u, int wr, int wc, int fr, int fq) const {
        const int row0 = u.pm * BM + wr * 64 + fr, col0 = u.pn * BM + wc * 32 + 8 * fq;
#pragma unroll
        for (int bj = 0; bj < 2; ++bj) { const int c = col0 + bj * HALF; const f32x4 s0 = *(const f32x4*)(scale + c), s1 = *(const f32x4*)(scale + c + 4);
#pragma unroll
            for (int ai = 0; ai < 2; ++ai)
#pragma unroll
                for (int m = 0; m < 4; ++m) { const size_t row = (size_t)(row0 + ai * HALF + m * 16);
                    const u32x4 gv = *(const u32x4*)(proj + row * NINP + C_G + 2048 + c);
                    const f32x4 v0 = acc[ai][bj][m][0] * s0, v1 = acc[ai][bj][m][1] * s1;
                    u32x4 w; w.x = pk2(v0[0] * sigmoidf_(bflo(gv.x)), v0[1] * sigmoidf_(bfhi(gv.x))); w.y = pk2(v0[2] * sigmoidf_(bflo(gv.y)), v0[3] * sigmoidf_(bfhi(gv.y)));
                    w.z = pk2(v1[0] * sigmoidf_(bflo(gv.z)), v1[1] * sigmoidf_(bfhi(gv.z))); w.w = pk2(v1[2] * sigmoidf_(bflo(gv.w)), v1[3] * sigmoidf_(bfhi(gv.w)));
                    *(u32x4*)(mrg + row * MIXW + 2048 + c) = w; asm volatile("" ::: "memory"); } }
    }
};
struct EpiLru {
    static constexpr bool PERM = false;
    float* Aout; float* Bout; const bf16* xc; const float* ba; const float* bx; const float* c8sp;
    DI void operator()(const f32x4 (&acc)[2][2][4][2], const Unit& u, int wr, int wc, int fr, int fq) const {
        const int row0 = u.pm * BM + wr * 64 + fr, ch0 = u.pn * HALF + wc * 32 + 4 * fq;
#pragma unroll
        for (int n = 0; n < 2; ++n) { const int ch = ch0 + n * 16; const f32x4 vba = *(const f32x4*)(ba + ch), vbx = *(const f32x4*)(bx + ch), vsp = *(const f32x4*)(c8sp + ch);
#pragma unroll
            for (int ai = 0; ai < 2; ++ai)
#pragma unroll
                for (int m = 0; m < 4; ++m) { const size_t off = (size_t)(row0 + ai * HALF + m * 16) * DM + ch;
                    const u32x2 xv = *(const u32x2*)(xc + off); const float xf[4] = {bflo(xv.x), bfhi(xv.x), bflo(xv.y), bfhi(xv.y)};
                    f32x4 av, bv;
#pragma unroll
                    for (int j = 0; j < 4; ++j) { const float r = sigmoidf_(acc[ai][0][m][n][j] + vba[j]), ig = sigmoidf_(acc[ai][1][m][n][j] + vbx[j]);
                        const float la = -vsp[j] * r; av[j] = __expf(la); bv[j] = __builtin_amdgcn_sqrtf(fmaxf(one_minus_exp_(2.0f * la), 0.f)) * ig * xf[j]; }
                    *(f32x4*)(Aout + off) = av; *(f32x4*)(Bout + off) = bv; asm volatile("" ::: "memory"); } }
    }
};

template <class Epi, class Sched, bool ALIGN_EPI = true, bool SP2 = true>
DI void gemm_phase(LAS unsigned char* lds, const Gemm g, const Sched& S, const Epi& E, const int wave_id) {
    int lane_ = lane_id_(); asm volatile("" : "+v"(lane_));
    const int wid = wave_id, lane = lane_, tid = wid * 64 + lane, wr = wid >> 2, wc = wid & 3, fr = lane & 15, fq = lane >> 4;
    const int nt = g.K / BK;
    unsigned voffA[2], voffB[2];
#pragma unroll
    for (int i = 0; i < 2; ++i) { int R, C; stage_rc(tid * 16 + i * 8192, R, C); const int Rb = Epi::PERM ? ((R & ~31) + perm32(R & 31)) : R;
        voffA[i] = (unsigned)(R * g.lda + C) * 2u; voffB[i] = (unsigned)(Rb * g.ldb + C) * 2u; }
    const size_t kstep = (size_t)(BK * 2);
    const size_t hstepA = (size_t)HALF * g.lda * 2, hstepB = (size_t)HALF * g.ldb * 2;
    const unsigned ldsw = (unsigned)wid * 1024u;
    const int aoff = lds_byte(wr * 64 + fr, fq * 8), boff = lds_byte(wc * 32 + fr, fq * 8);
#define PG8_SA(b, h) (((b) * 2 + (h)) * HTB)
#define PG8_SB(b, h) ((4 + (b) * 2 + (h)) * HTB)
#define PG8_STAGE(bufoff, gbase, voff) do { _Pragma("unroll") for (int _i = 0; _i < 2; ++_i) \
        __builtin_amdgcn_global_load_lds((const unsigned*)((const char*)(gbase) + (voff)[_i]), (LAS unsigned*)(lds + (bufoff) + ldsw + _i * 8192), 16, 0, 0); } while (0)
#define PG8_LDA(dst, b, h) do { _Pragma("unroll") for (int m = 0; m < 4; ++m) _Pragma("unroll") for (int k = 0; k < 2; ++k) dst[m][k] = *(const LAS bf16x8*)(lds + PG8_SA(b, h) + aoff + m * 2048 + k * 1024); } while (0)
#define PG8_LDB(dst, b, h) do { _Pragma("unroll") for (int n = 0; n < 2; ++n) _Pragma("unroll") for (int k = 0; k < 2; ++k) dst[n][k] = *(const LAS bf16x8*)(lds + PG8_SB(b, h) + boff + n * 2048 + k * 1024); } while (0)
#define PG8_MMA(ai, bj, At, Bt) do { __builtin_amdgcn_s_setprio(1); _Pragma("unroll") for (int m = 0; m < 4; ++m) _Pragma("unroll") for (int n = 0; n < 2; ++n) _Pragma("unroll") for (int k = 0; k < 2; ++k) \
        acc[ai][bj][m][n] = __builtin_amdgcn_mfma_f32_16x16x32_bf16(Bt[n][k], At[m][k], acc[ai][bj][m][n], 0, 0, 0); __builtin_amdgcn_s_setprio(0); } while (0)
#define PG8_WAIT_V(n) asm volatile("s_waitcnt vmcnt(" #n ")" ::: "memory")
#define PG8_WAIT_L(n) asm volatile("s_waitcnt lgkmcnt(" #n ")" ::: "memory")
#define PG8_BAR __builtin_amdgcn_s_barrier()
#define PG8_SCHED __builtin_amdgcn_sched_barrier(0)
    Unit cur, nxt; int ui = 0;
    if (!S.next(0, cur)) return;
    f32x4 acc[2][2][4][2];
#pragma unroll
    for (int a = 0; a < 2; ++a)
#pragma unroll
        for (int b = 0; b < 2; ++b)
#pragma unroll
            for (int m = 0; m < 4; ++m)
#pragma unroll
                for (int n = 0; n < 2; ++n) acc[a][b][m][n] = (f32x4){0.f, 0.f, 0.f, 0.f};
    bf16x8 At[4][2], B0[2][2], B1[2][2];
    const char* cA = (const char*)g.A + S.aoff(cur); const char* cB = (const char*)g.Bt + S.boff(cur);
    if constexpr (SP2) {
        PG8_STAGE(PG8_SB(0, 0), cB, voffB); PG8_STAGE(PG8_SB(0, 1), cB + hstepB, voffB); PG8_STAGE(PG8_SA(0, 0), cA, voffA); PG8_STAGE(PG8_SA(0, 1), cA + hstepA, voffA);
        if (wr == 1) PG8_BAR;
        PG8_WAIT_V(2); PG8_BAR;
        PG8_STAGE(PG8_SB(1, 0), cB + kstep, voffB); PG8_STAGE(PG8_SA(1, 0), cA + kstep, voffA); PG8_STAGE(PG8_SB(1, 1), cB + hstepB + kstep, voffB);
        PG8_WAIT_V(6); PG8_BAR;
    } else {
        PG8_STAGE(PG8_SB(0, 0), cB, voffB); PG8_STAGE(PG8_SA(0, 0), cA, voffA); PG8_STAGE(PG8_SB(0, 1), cB + hstepB, voffB); PG8_STAGE(PG8_SA(0, 1), cA + hstepA, voffA);
        if (wr == 1) PG8_BAR;
        PG8_WAIT_V(4); PG8_BAR;
        PG8_STAGE(PG8_SB(1, 0), cB + kstep, voffB); PG8_STAGE(PG8_SA(1, 0), cA + kstep, voffA); PG8_STAGE(PG8_SB(1, 1), cB + hstepB + kstep, voffB);
        PG8_WAIT_V(6); PG8_BAR;
    }
    for (;;) {
        const bool has_next = S.next(ui + 1, nxt);
        const char* nA = has_next ? (const char*)g.A + S.aoff(nxt) : cA; const char* nB = has_next ? (const char*)g.Bt + S.boff(nxt) : cB;
#pragma nounroll
        for (int t = 0; t < nt; t += 2) {
            const bool last = (t == nt - 2);
            const char* a1 = cA + (size_t)(t + 1) * kstep;
            const char* a2 = last ? nA : cA + (size_t)(t + 2) * kstep; const char* b2 = last ? nB : cB + (size_t)(t + 2) * kstep;
            const char* a3 = a2 + kstep; const char* b3 = b2 + kstep;
            if constexpr (SP2) {
            PG8_LDB(B0, 0, 0); PG8_LDB(B1, 0, 1); PG8_SCHED; PG8_LDA(At, 0, 0); PG8_STAGE(PG8_SA(1, 1), a1 + hstepA, voffA);
            PG8_WAIT_V(8); PG8_WAIT_L(0); PG8_BAR; PG8_MMA(0, 0, At, B0); PG8_MMA(0, 1, At, B1); PG8_BAR; PG8_SCHED;
            PG8_LDA(At, 0, 1); PG8_STAGE(PG8_SB(0, 0), b2, voffB); PG8_STAGE(PG8_SB(0, 1), b2 + hstepB, voffB); PG8_STAGE(PG8_SA(0, 0), a2, voffA);
            PG8_WAIT_V(8); PG8_WAIT_L(0); PG8_BAR; PG8_MMA(1, 0, At, B0); PG8_MMA(1, 1, At, B1); PG8_BAR; PG8_SCHED;
            PG8_LDB(B0, 1, 0); PG8_LDB(B1, 1, 1); PG8_SCHED; PG8_LDA(At, 1, 0); PG8_STAGE(PG8_SA(0, 1), a2 + hstepA, voffA);
            PG8_WAIT_V(8); PG8_WAIT_L(0); PG8_BAR; PG8_MMA(0, 0, At, B0); PG8_MMA(0, 1, At, B1); PG8_BAR; PG8_SCHED;
            PG8_LDA(At, 1, 1); PG8_STAGE(PG8_SB(1, 0), b3, voffB); PG8_STAGE(PG8_SB(1, 1), b3 + hstepB, voffB); PG8_STAGE(PG8_SA(1, 0), a3, voffA);
            PG8_WAIT_V(8); PG8_WAIT_L(0); PG8_BAR; PG8_MMA(1, 0, At, B0); PG8_MMA(1, 1, At, B1); PG8_BAR; PG8_SCHED;
            } else {
            PG8_LDB(B0, 0, 0); PG8_SCHED; PG8_LDA(At, 0, 0); PG8_STAGE(PG8_SA(1, 1), a1 + hstepA, voffA);
            PG8_WAIT_L(8); PG8_BAR; PG8_WAIT_L(0); PG8_MMA(0, 0, At, B0); PG8_BAR; PG8_SCHED;
            PG8_LDB(B1, 0, 1); PG8_STAGE(PG8_SB(0, 0), b2, voffB);
            PG8_BAR; PG8_WAIT_L(0); PG8_MMA(0, 1, At, B1); PG8_BAR;
            PG8_LDA(At, 0, 1); PG8_STAGE(PG8_SA(0, 0), a2, voffA);
            PG8_BAR; PG8_WAIT_L(0); PG8_MMA(1, 0, At, B0); PG8_BAR; PG8_SCHED;
            PG8_STAGE(PG8_SB(0, 1), b2 + hstepB, voffB);
            PG8_WAIT_V(6); PG8_BAR; PG8_MMA(1, 1, At, B1); PG8_BAR;
            PG8_LDB(B0, 1, 0); PG8_SCHED; PG8_LDA(At, 1, 0); PG8_STAGE(PG8_SA(0, 1), a2 + hstepA, voffA);
            PG8_WAIT_L(8); PG8_BAR; PG8_WAIT_L(0); PG8_MMA(0, 0, At, B0); PG8_BAR; PG8_SCHED;
            PG8_LDB(B1, 1, 1); PG8_STAGE(PG8_SB(1, 0), b3, voffB);
            PG8_BAR; PG8_WAIT_L(0); PG8_MMA(0, 1, At, B1); PG8_BAR;
            PG8_LDA(At, 1, 1); PG8_STAGE(PG8_SA(1, 0), a3, voffA);
            PG8_BAR; PG8_WAIT_L(0); PG8_MMA(1, 0, At, B0); PG8_BAR; PG8_SCHED;
            PG8_STAGE(PG8_SB(1, 1), b3 + hstepB, voffB);
            PG8_WAIT_V(6); PG8_BAR; PG8_MMA(1, 1, At, B1); PG8_BAR;
            }
        }
        if constexpr (ALIGN_EPI) { if (wr == 0) PG8_BAR; }
        E(acc, cur, wr, wc, fr, fq);
        if (!has_next) break;
#pragma unroll
        for (int a = 0; a < 2; ++a)
#pragma unroll
            for (int b = 0; b < 2; ++b)
#pragma unroll
                for (int m = 0; m < 4; ++m)
#pragma unroll
                    for (int n = 0; n < 2; ++n) acc[a][b][m][n] = (f32x4){0.f, 0.f, 0.f, 0.f};
        cur = nxt; cA = nA; cB = nB; ++ui;
        if constexpr (ALIGN_EPI) { if (wr == 1) PG8_BAR; }
    }
    PG8_WAIT_V(0);
    if constexpr (!ALIGN_EPI) { if (wr == 0) PG8_BAR; }
    PG8_BAR;
#undef PG8_SA
#undef PG8_SB
#undef PG8_STAGE
#undef PG8_LDA
#undef PG8_LDB
#undef PG8_MMA
#undef PG8_WAIT_V
#undef PG8_WAIT_L
#undef PG8_BAR
#undef PG8_SCHED
}
}

struct Args { const void* in[24]; float* out; unsigned char* ws; int ph_lo, ph_hi; };
struct Frame {
    LAS unsigned char* lds; unsigned* ctl; unsigned char* ws;
    int tid, lane, wave, G, bid;
};
#define INF(k) ((const float*)args.in[k])
DI float wave_sum(float v) {
#pragma unroll
    for (int o = 1; o < 64; o <<= 1) v += __shfl_xor(v, o);
    return v;
}

template <class RM>
DI void tr_item(const float* W, int ldS, int Nvalid, bf16* WT, int ldD, int koff, RM rowmap, LAS float* scr, int k0, int n0, int lane) {
    const int nl = n0 + (lane & 31);
    float tv[32]; const float* wp = W + (size_t)(k0 + (lane >> 5)) * ldS + nl; const bool ok = nl < Nvalid;
#pragma unroll
    for (int i = 0; i < 32; ++i) tv[i] = ok ? __builtin_nontemporal_load(wp + (size_t)(2 * i) * ldS) : 0.f;
#pragma unroll
    for (int i = 0; i < 32; ++i) scr[(2 * i + (lane >> 5)) * 33 + (lane & 31)] = tv[i];
    LDS_WAIT(); asm volatile("" ::: "memory");
    const int c = lane & 7;
#pragma unroll
    for (int j = 0; j < 4; ++j) { const int nn = (lane >> 3) + 8 * j, n = n0 + nn; const LAS float* s = scr + (8 * c) * 33 + nn;
        u32x4 o; o.x = pk2(s[0 * 33], s[1 * 33]); o.y = pk2(s[2 * 33], s[3 * 33]); o.z = pk2(s[4 * 33], s[5 * 33]); o.w = pk2(s[6 * 33], s[7 * 33]);
        if (n < Nvalid) *(u32x4*)(WT + (size_t)rowmap(n) * ldD + koff + k0 + 8 * c) = o; }
    LDS_WAIT(); asm volatile("" ::: "memory");
}
struct RmIn { DI int operator()(int n) const { return n < C_PADLO ? n : n + (C_P - C_PADLO); } };
struct RmId { int off; DI int operator()(int n) const { return off + n; } };
struct RmGU { int off; DI int operator()(int n) const { return ((n >> 7) << 8) + off + (n & 127); } };

DI void p0_prologue(Frame& F, const Args& args) {
    LAS float* scr = (LAS float*)(F.lds + F.wave * 16384);
    const int gw = F.bid * 8 + F.wave, NGW = F.G * 8;
    bf16* Win = (bf16*)(F.ws + WS_WIN); bf16* Wout = (bf16*)(F.ws + WS_WOUT); bf16* Wpool = (bf16*)(F.ws + WS_WPOOL); bf16* Wlru = (bf16*)(F.ws + WS_WLRU);
    bf16* Wgu = (bf16*)(F.ws + WS_WGU); bf16* Wdn = (bf16*)(F.ws + WS_WDN);
    constexpr int NB_IN = (NIN + 31) / 32;
    constexpr int I_IN = 32 * NB_IN, I_OUT = 96 * 64, I_POOL = 8 * 16, I_LRU = 2 * 4, I_G = 32 * 172, I_D = 86 * 64;
    constexpr int T_IN = 2 * I_IN, T_OUT = 2 * I_OUT, T_POOL = 8 * I_POOL, T_LRU = 64 * I_LRU, T_G = 2 * I_G, T_D = I_D;
    constexpr int NITEMS = T_IN + T_OUT + T_POOL + T_LRU + T_G + T_D;
    for (int it = gw; it < NITEMS; it += NGW) {
        int r = it;
        if (r < T_IN) { const int l = r / I_IN, q = r % I_IN, kb = q / NB_IN, nb = q % NB_IN;
            tr_item(INF(2) + (size_t)l * DM * NIN, NIN, NIN, Win + (size_t)l * NINP * DM, DM, 0, RmIn{}, scr, 64 * kb, 32 * nb, F.lane); continue; } r -= T_IN;
        if (r < T_OUT) { const int l = r / I_OUT, q = r % I_OUT, kb = q / 64, nb = q % 64;
            tr_item(INF(3) + (size_t)l * MIXW * DM, DM, DM, Wout + (size_t)l * DM * MIXW, MIXW, 0, RmId{0}, scr, 64 * kb, 32 * nb, F.lane); continue; } r -= T_OUT;
        if (r < T_POOL) { const int lg = r / I_POOL, q = r % I_POOL, kb = q / 16, nb = q % 16, l = lg >> 2, g = lg & 3;
            tr_item(INF(4) + (size_t)lg * 512 * 512, 512, 512, Wpool + (size_t)l * 2048 * 512, 512, 0, RmId{g * 512}, scr, 64 * kb, 32 * nb, F.lane); continue; } r -= T_POOL;
        if (r < T_LRU) { const int cmb = r / I_LRU, q = r % I_LRU, kb = q / 4, nb = q % 4, l = cmb >> 5, which = (cmb >> 4) & 1, n = cmb & 15;
            const float* src = (which ? INF(10) : INF(8)) + ((size_t)l * 16 + n) * 128 * 128;
            tr_item(src, 128, 128, Wlru + (size_t)l * 4096 * 256, 256, (n & 1) * 128, RmId{n * 256 + which * 128}, scr, 64 * kb, 32 * nb, F.lane); continue; } r -= T_LRU;
        if (r < T_G) { const int which = r / I_G, q = r % I_G, kb = q / 172, nb = q % 172;
            tr_item(which ? INF(18) : INF(17), DFF, DFF, Wgu, DM, 0, RmGU{which * 128}, scr, 64 * kb, 32 * nb, F.lane); continue; } r -= T_G;
        { const int kb = r / 64, nb = r % 64; tr_item(INF(19), DM, DM, Wdn, DFF, 0, RmId{0}, scr, 64 * kb, 32 * nb, F.lane); }
    }
    const int gt = F.bid * 512 + F.tid, NT = F.G * 512;
    for (int i = gt; i < 2 * 4096 * 16; i += NT) { const int row = i >> 4, ch = i & 15, n = (row & 4095) >> 8;
        *(u32x4*)(Wlru + (size_t)row * 256 + ((n + 1) & 1) * 128 + ch * 8) = (u32x4){0u, 0u, 0u, 0u}; }
    float* cosA = (float*)(F.ws + WS_COSA); float* sinA = (float*)(F.ws + WS_SINA); float* cosI = (float*)(F.ws + WS_COSI); float* sinI = (float*)(F.ws + WS_SINI);
    for (int i = gt; i < MTOK * 96; i += NT) {
        const int tok = i / 96, j = i % 96; const bool isA = j < 64; const int fi = isA ? j : j - 64; const double dim = isA ? 128.0 : 64.0;
        const float inv = (float)pow(10000.0, -(double)(2 * fi) / dim);
        const float ang = (float)((const int*)args.in[1])[tok] * inv; const double a = (double)ang; const double nrev = rint(a * 0.15915494309189535); const double rr = a - nrev * 6.283185307179586;
        const float cv = (float)cos(rr), sv = (float)sin(rr);
        if (isA) { cosA[tok * 64 + fi] = cv; sinA[tok * 64 + fi] = sv; } else { cosI[tok * 32 + fi] = cv; sinI[tok * 32 + fi] = sv; }
    }
    float* c8 = (float*)(F.ws + WS_LRUC);
    for (int i = gt; i < 2 * DM; i += NT) { const float lam = INF(12)[i]; c8[i] = 8.0f * log1pf(expf(-lam)); }
    bf16* xb = (bf16*)(F.ws + WS_XB);
    for (int i = gt; i < MTOK * DM / 8; i += NT) { const f32x4 a = *(const f32x4*)(INF(0) + (size_t)i * 8), b = *(const f32x4*)(INF(0) + (size_t)i * 8 + 4);
        u32x4 o; o.x = pk2(a[0], a[1]); o.y = pk2(a[2], a[3]); o.z = pk2(b[0], b[1]); o.w = pk2(b[2], b[3]); *(u32x4*)(xb + (size_t)i * 8) = o; }
}
DI void p_convert_moe(Frame& F, const Args& args) {
    LAS float* scr = (LAS float*)(F.lds + F.wave * 16384);
    const int gw = F.bid * 8 + F.wave, NGW = F.G * 8;
    bf16* Wgu = (bf16*)(F.ws + WS_MWGU); bf16* Wdn = (bf16*)(F.ws + WS_MWDN);
    constexpr int I_G = 32 * 224, I_D = 112 * 64;
    constexpr int T_G = 16 * I_G, T_D = 8 * I_D;
    for (int it = gw; it < T_G + T_D; it += NGW) {
        int r = it;
        if (r < T_G) { const int ew = r / I_G, q = r % I_G, kb = q / 224, nb = q % 224, e = ew >> 1, which = ew & 1;
            tr_item((which ? INF(22) : INF(21)) + (size_t)e * DM * DEXP, DEXP, DEXP, Wgu + (size_t)e * 2 * DEXP * DM, DM, 0, RmGU{which * 128}, scr, 64 * kb, 32 * nb, F.lane); continue; } r -= T_G;
        { const int e = r / I_D, q = r % I_D, kb = q / 64, nb = q % 64;
          tr_item(INF(23) + (size_t)e * DEXP * DM, DM, DM, Wdn + (size_t)e * DM * DEXP, DEXP, 0, RmId{0}, scr, 64 * kb, 32 * nb, F.lane); }
    }
}

DI void ld8(const bf16* p, float (&v)[8]) { const u32x4 w = *(const u32x4*)p; v[0] = bflo(w.x); v[1] = bfhi(w.x); v[2] = bflo(w.y); v[3] = bfhi(w.y); v[4] = bflo(w.z); v[5] = bfhi(w.z); v[6] = bflo(w.w); v[7] = bfhi(w.w); }
DI void st8(bf16* p, const float (&v)[8]) { u32x4 o; o.x = pk2(v[0], v[1]); o.y = pk2(v[2], v[3]); o.z = pk2(v[4], v[5]); o.w = pk2(v[6], v[7]); *(u32x4*)p = o; }

DI void p2_prep(Frame& F, const Args& args, int layer) {
    bf16* proj = (bf16*)(F.ws + WS_PROJ); bf16* diff = (bf16*)(F.ws + WS_DIFF); bf16* xc = (bf16*)(F.ws + WS_XC);
    const float* cosA = (const float*)(F.ws + WS_COSA); const float* sinA = (const float*)(F.ws + WS_SINA); const float* cosI = (const float*)(F.ws + WS_COSI); const float* sinI = (const float*)(F.ws + WS_SINI);
    const int gt = F.bid * 512 + F.tid, NT = F.G * 512;
    for (int it = gt; it < MTOK * 228; it += NT) {
        const int tok = it / 228, j = it % 228; int col, half, d; const float *ct, *st;
        if (j < 128) { d = (j & 7) * 8; col = C_Q + (j >> 3) * 128 + d; half = 64; ct = cosA + tok * 64 + d; st = sinA + tok * 64 + d; }
        else if (j < 160) { const int jj = j - 128; d = (jj & 7) * 8; col = C_K + (jj >> 3) * 128 + d; half = 64; ct = cosA + tok * 64 + d; st = sinA + tok * 64 + d; }
        else if (j < 224) { const int jj = j - 160; d = (jj & 3) * 8; col = C_QI + (jj >> 2) * 64 + d; half = 32; ct = cosI + tok * 32 + d; st = sinI + tok * 32 + d; }
        else { d = (j - 224) * 8; col = C_KI + d; half = 32; ct = cosI + tok * 32 + d; st = sinI + tok * 32 + d; }
        bf16* p1 = proj + (size_t)tok * NINP + col; bf16* p2 = p1 + half;
        float x1[8], x2[8], y1[8], y2[8]; ld8(p1, x1); ld8(p2, x2);
        const f32x4 c0 = *(const f32x4*)ct, c1 = *(const f32x4*)(ct + 4), s0 = *(const f32x4*)st, s1 = *(const f32x4*)(st + 4);
#pragma unroll
        for (int i = 0; i < 8; ++i) { const float c = i < 4 ? c0[i & 3] : c1[i & 3], s = i < 4 ? s0[i & 3] : s1[i & 3]; y1[i] = x1[i] * c - x2[i] * s; y2[i] = x2[i] * c + x1[i] * s; }
        st8(p1, y1); st8(p2, y2);
    }
    const float* cw = INF(6) + (size_t)layer * 4 * DM; const float* cb = INF(7) + (size_t)layer * DM;
    for (int it = gt; it < MTOK * 256; it += NT) {
        const int tok = it >> 8, c = (it & 255) * 8, tpos = tok & (SEQ - 1);
        { const int g = c >> 9, W = 2 << g, cnt = (tpos + 1) < W ? (tpos + 1) : W;
          float sum[8], cur[8], v[8]; const bf16* pp = proj + (size_t)tok * NINP + C_P + c; ld8(pp, cur);
#pragma unroll
          for (int i = 0; i < 8; ++i) sum[i] = cur[i];
          for (int jj = 1; jj < cnt; ++jj) { ld8(pp - (size_t)jj * NINP, v);
#pragma unroll
              for (int i = 0; i < 8; ++i) sum[i] += v[i]; }
          const float rc = 1.0f / (float)cnt;
#pragma unroll
          for (int i = 0; i < 8; ++i) v[i] = sum[i] * rc - cur[i];
          st8(diff + (size_t)tok * DM + c, v); }
        { float acc[8], v[8]; const f32x4 b0 = *(const f32x4*)(cb + c), b1 = *(const f32x4*)(cb + c + 4);
#pragma unroll
          for (int i = 0; i < 8; ++i) acc[i] = i < 4 ? b0[i & 3] : b1[i & 3];
          const bf16* px = proj + (size_t)tok * NINP + C_XR + c;
#pragma unroll
          for (int jj = 0; jj < 4; ++jj) { const int back = 3 - jj; if (tpos - back >= 0) { ld8(px - (size_t)back * NINP, v);
              const f32x4 w0 = *(const f32x4*)(cw + jj * DM + c), w1 = *(const f32x4*)(cw + jj * DM + c + 4);
#pragma unroll
              for (int i = 0; i < 8; ++i) acc[i] += v[i] * (i < 4 ? w0[i & 3] : w1[i & 3]); } }
          st8(xc + (size_t)tok * DM + c, acc); }
    }
}

DI void p3_indexer(Frame& F) {
    const bf16* proj = (const bf16*)(F.ws + WS_PROJ); float* sc = (float*)(F.ws + WS_SC);
    const int gw = F.bid * 8 + F.wave, NGW = F.G * 8, l15 = F.lane & 15, l4 = F.lane >> 4;
    for (int u = gw; u < BATCH * 576; u += NGW) {
        const int b = u / 576, r = u % 576; int g8 = 0;
#pragma unroll
        for (int k = 1; k < 8; ++k) g8 = (r >= 8 * k * (k + 1)) ? k : g8;
        const int rr = r - 8 * g8 * (g8 + 1), sp = rr % (g8 + 1), qq = rr / (g8 + 1), qb16 = g8 * 16 + qq, c = qb16 >> 2;
        const int limit = (c + 1) * 64, kbeg = sp * 256, kend = (kbeg + 256) < limit ? (kbeg + 256) : limit;
        const int qtok = b * SEQ + qb16 * 16 + l15;
        const bf16* qrow = proj + (size_t)qtok * NINP;
        bf16x8 qf[16][2]; float w[16];
        { const u32x4 w0 = *(const u32x4*)(qrow + C_WI), w1 = *(const u32x4*)(qrow + C_WI + 8); const float s = 0.125f * 0.25f;
          w[0] = bflo(w0.x) * s; w[1] = bfhi(w0.x) * s; w[2] = bflo(w0.y) * s; w[3] = bfhi(w0.y) * s; w[4] = bflo(w0.z) * s; w[5] = bfhi(w0.z) * s; w[6] = bflo(w0.w) * s; w[7] = bfhi(w0.w) * s;
          w[8] = bflo(w1.x) * s; w[9] = bfhi(w1.x) * s; w[10] = bflo(w1.y) * s; w[11] = bfhi(w1.y) * s; w[12] = bflo(w1.z) * s; w[13] = bfhi(w1.z) * s; w[14] = bflo(w1.w) * s; w[15] = bfhi(w1.w) * s; }
#pragma unroll
        for (int h = 0; h < 16; ++h)
#pragma unroll
            for (int ks = 0; ks < 2; ++ks) qf[h][ks] = *(const bf16x8*)(qrow + C_QI + h * 64 + ks * 32 + l4 * 8);
        for (int k0 = kbeg; k0 < kend; k0 += 16) {
            const bf16* krow = proj + (size_t)(b * SEQ + k0 + l15) * NINP + C_KI + l4 * 8;
            const bf16x8 ka0 = *(const bf16x8*)krow, ka1 = *(const bf16x8*)(krow + 32);
            f32x4 tot = {0.f, 0.f, 0.f, 0.f};
#pragma unroll
            for (int h = 0; h < 16; ++h) { f32x4 s = {0.f, 0.f, 0.f, 0.f};
                s = __builtin_amdgcn_mfma_f32_16x16x32_bf16(ka0, qf[h][0], s, 0, 0, 0); s = __builtin_amdgcn_mfma_f32_16x16x32_bf16(ka1, qf[h][1], s, 0, 0, 0);
#pragma unroll
                for (int j = 0; j < 4; ++j) tot[j] += w[h] * fmaxf(s[j], 0.f); }
            *(f32x4*)(sc + (size_t)qtok * SEQ + k0 + 4 * l4) = tot;
        }
    }
}

DI void p4_select(Frame& F) {
    const float* sc = (const float*)(F.ws + WS_SC); unsigned* mask = (unsigned*)(F.ws + WS_MASK);
    const int gw = F.bid * 8 + F.wave, NGW = F.G * 8, lane = F.lane;
    for (int tok = gw; tok < MTOK; tok += NGW) {
        const int tpos = tok & (SEQ - 1), limit = ((tpos >> 6) + 1) * 64, nw = limit >> 5;
        unsigned mw = 0u;
        if (limit <= 256) { mw = lane < nw ? 0xffffffffu : 0u; }
        else {
            unsigned key[32];
            if (lane < nw) { const float* p = sc + (size_t)tok * SEQ + lane * 32;
#pragma unroll
                for (int q = 0; q < 8; ++q) { const f32x4 v = *(const f32x4*)(p + 4 * q);
#pragma unroll
                    for (int j = 0; j < 4; ++j) { const unsigned uu = __float_as_uint(v[j]); key[4 * q + j] = (uu & 0x80000000u) ? ~uu : (uu | 0x80000000u); } } }
            else {
#pragma unroll
                for (int j = 0; j < 32; ++j) key[j] = 0u; }
            unsigned T = 0u; bool exact = false;
            for (int bit = 31; bit >= 0; --bit) {
                const unsigned cand = T | (1u << bit); int cnt = 0;
#pragma unroll
                for (int j = 0; j < 32; ++j) cnt += __popcll(__ballot(key[j] >= cand));
                if (cnt >= 256) { T = cand; if (cnt == 256) { exact = true; break; } }
            }
            unsigned gtw = 0u, eqw = 0u;
#pragma unroll
            for (int j = 0; j < 32; ++j) { gtw |= (key[j] > T) ? (1u << j) : 0u; eqw |= (key[j] == T) ? (1u << j) : 0u; }
            if (exact) { mw = gtw | eqw; }
            else {
                int ngt = 0;
#pragma unroll
                for (int j = 0; j < 32; ++j) ngt += __popcll(__ballot(key[j] > T));
                const int need = 256 - ngt; const int el = __popc(eqw);
                int pre = el;
#pragma unroll
                for (int o = 1; o < 64; o <<= 1) { const int t = __shfl_up(pre, o); pre += (lane >= o) ? t : 0; }
                int take = need - (pre - el); take = take < 0 ? 0 : (take > el ? el : take);
                unsigned sel = 0u, rem = eqw;
                for (int t = 0; t < 32; ++t) { if (t < take) { const unsigned low = rem & (0u - rem); sel |= low; rem ^= low; } }
                mw = gtw | sel;
            }
        }
        mask[(size_t)tok * 64 + lane] = mw;
    }
}

DI void p4_lru_pass1(Frame& F) {
    const float* A = (const float*)(F.ws + WS_A); const float* B = (const float*)(F.ws + WS_B); float* CP = (float*)(F.ws + WS_CARRY); float* CH = CP + BATCH * 32 * DM;
    for (int u = F.bid; u < BATCH * 32 * 2; u += F.G) {
        const int hh = u & 1, j = (u >> 1) & 31, b = u >> 6, c = hh * 1024 + 2 * F.tid;
        const size_t base = ((size_t)b * SEQ + j * 64) * DM + c;
        f32x2 P = {1.f, 1.f}, H = {0.f, 0.f};
#pragma unroll 8
        for (int t = 0; t < 64; ++t) { const f32x2 a = *(const f32x2*)(A + base + (size_t)t * DM), bb = *(const f32x2*)(B + base + (size_t)t * DM); H = a * H + bb; P = P * a; }
        *(f32x2*)(CP + ((size_t)b * 32 + j) * DM + c) = P; *(f32x2*)(CH + ((size_t)b * 32 + j) * DM + c) = H;
    }
}
DI void p5_lru_pass2(Frame& F) {
    const float* A = (const float*)(F.ws + WS_A); const float* B = (const float*)(F.ws + WS_B); const float* CP = (const float*)(F.ws + WS_CARRY); const float* CH = CP + BATCH * 32 * DM;
    const bf16* proj = (const bf16*)(F.ws + WS_PROJ); bf16* mrg = (bf16*)(F.ws + WS_MRG);
    for (int u = F.bid; u < BATCH * 32 * 2; u += F.G) {
        const int hh = u & 1, j = (u >> 1) & 31, b = u >> 6, c = hh * 1024 + 2 * F.tid;
        f32x2 h = {0.f, 0.f};
        for (int jj = 0; jj < j; ++jj) { const f32x2 p = *(const f32x2*)(CP + ((size_t)b * 32 + jj) * DM + c), q = *(const f32x2*)(CH + ((size_t)b * 32 + jj) * DM + c); h = p * h + q; }
        const size_t tok0 = (size_t)b * SEQ + j * 64;
#pragma unroll 4
        for (int t = 0; t < 64; ++t) { const size_t tok = tok0 + t; const f32x2 a = *(const f32x2*)(A + tok * DM + c), bb = *(const f32x2*)(B + tok * DM + c); h = a * h + bb;
            const unsigned gr = *(const unsigned*)(proj + tok * NINP + C_GR + c), gg = *(const unsigned*)(proj + tok * NINP + C_G + 4096 + c);
            const float y0 = h[0] * gelu_tanh_(bflo(gr)) * sigmoidf_(bflo(gg)), y1 = h[1] * gelu_tanh_(bfhi(gr)) * sigmoidf_(bfhi(gg));
            *(unsigned*)(mrg + tok * MIXW + 4096 + c) = pk2(y0, y1); }
    }
}

constexpr int KS_STRIDE = 272, VT_STRIDE = 136;
constexpr int ATT_KS = 0, ATT_VT = 64 * KS_STRIDE;
DI void p5_attention(Frame& F) {
    const bf16* proj = (const bf16*)(F.ws + WS_PROJ); const unsigned* mask = (const unsigned*)(F.ws + WS_MASK); bf16* mrg = (bf16*)(F.ws + WS_MRG);
    LAS unsigned char* Ks = F.lds + ATT_KS; LAS unsigned char* Vt = F.lds + ATT_VT;
    const int lane = F.lane, l31 = lane & 31, hf = lane >> 5, wave = F.wave, hh = wave >> 1, qh = wave & 1, tid = F.tid;
    const float sc2 = 0.08838834764831845f * 1.4426950408889634f;
    for (int u = F.bid; u < BATCH * 16 * 4; u += F.G) {
        const int g = u & 3, cp = (u >> 2) & 15, b = u >> 6;
        for (int half = 0; half < 2; ++half) {
            const int c = half ? (31 - cp) : cp, nkt = c + 1, head = g * 4 + hh;
            const int qtok = b * SEQ + c * 64 + qh * 32 + l31;
            const bf16* qrow = proj + (size_t)qtok * NINP + C_Q + head * 128 + hf * 8;
            bf16x8 qf[8];
#pragma unroll
            for (int ks = 0; ks < 8; ++ks) qf[ks] = *(const bf16x8*)(qrow + ks * 16);
            f32x16 o[4];
#pragma unroll
            for (int db = 0; db < 4; ++db)
#pragma unroll
                for (int i = 0; i < 16; ++i) o[db][i] = 0.f;
            float mrun = -1e30f, lrun = 0.f;
            const int sr0 = tid >> 4, sch = tid & 15;
            const bf16* kg = proj + (size_t)(b * SEQ + sr0) * NINP + C_K + g * 128 + sch * 8;
            const bf16* vg = proj + (size_t)(b * SEQ + sr0) * NINP + C_V + g * 128 + sch * 8;
            u32x4 kr0 = *(const u32x4*)kg, kr1 = *(const u32x4*)(kg + (size_t)32 * NINP), vr0 = *(const u32x4*)vg, vr1 = *(const u32x4*)(vg + (size_t)32 * NINP);
            const unsigned* mrow = mask + (size_t)qtok * 64;
            unsigned mw0 = mrow[0], mw1 = mrow[1];
            for (int kt = 0; kt < nkt; ++kt) {
                __syncthreads();
                *(LAS u32x4*)(Ks + sr0 * KS_STRIDE + sch * 16) = kr0; *(LAS u32x4*)(Ks + (sr0 + 32) * KS_STRIDE + sch * 16) = kr1;
                { const unsigned vv0[4] = {vr0.x, vr0.y, vr0.z, vr0.w}, vv1[4] = {vr1.x, vr1.y, vr1.z, vr1.w};
#pragma unroll
                  for (int i = 0; i < 4; ++i) { LAS unsigned char* d0 = Vt + (sch * 8 + 2 * i) * VT_STRIDE;
                      *(LAS bf16*)(d0 + sr0 * 2) = (bf16)(vv0[i] & 0xffffu); *(LAS bf16*)(d0 + VT_STRIDE + sr0 * 2) = (bf16)(vv0[i] >> 16);
                      *(LAS bf16*)(d0 + (sr0 + 32) * 2) = (bf16)(vv1[i] & 0xffffu); *(LAS bf16*)(d0 + VT_STRIDE + (sr0 + 32) * 2) = (bf16)(vv1[i] >> 16); } }
                __syncthreads();
                const unsigned cm0 = mw0, cm1 = mw1;
                if (kt + 1 < nkt) { const size_t adv = (size_t)(kt + 1) * 64 * NINP;
                    kr0 = *(const u32x4*)(kg + adv); kr1 = *(const u32x4*)(kg + adv + (size_t)32 * NINP); vr0 = *(const u32x4*)(vg + adv); vr1 = *(const u32x4*)(vg + adv + (size_t)32 * NINP);
                    mw0 = mrow[2 * kt + 2]; mw1 = mrow[2 * kt + 3]; }
                f32x16 s0, s1;
#pragma unroll
                for (int i = 0; i < 16; ++i) { s0[i] = 0.f; s1[i] = 0.f; }
#pragma unroll
                for (int ks = 0; ks < 8; ++ks) {
                    const bf16x8 ka = *(const LAS bf16x8*)(Ks + l31 * KS_STRIDE + ks * 32 + hf * 16);
                    const bf16x8 kb = *(const LAS bf16x8*)(Ks + (32 + l31) * KS_STRIDE + ks * 32 + hf * 16);
                    s0 = __builtin_amdgcn_mfma_f32_32x32x16_bf16(ka, qf[ks], s0, 0, 0, 0);
                    s1 = __builtin_amdgcn_mfma_f32_32x32x16_bf16(kb, qf[ks], s1, 0, 0, 0);
                }
                const unsigned sm0 = cm0 >> (4 * hf), sm1 = cm1 >> (4 * hf);
                float tmax = -INFINITY;
#pragma unroll
                for (int i = 0; i < 16; ++i) { const unsigned bit = 1u << ((i & 3) + 8 * (i >> 2));
                    s0[i] = (sm0 & bit) ? s0[i] * sc2 : -INFINITY; s1[i] = (sm1 & bit) ? s1[i] * sc2 : -INFINITY; tmax = fmaxf(tmax, fmaxf(s0[i], s1[i])); }
                tmax = fmaxf(tmax, __shfl_xor(tmax, 32));
                const float mnew = fmaxf(mrun, tmax), alpha = exp2f(mrun - mnew); mrun = mnew;
                float psum = 0.f;
#pragma unroll
                for (int i = 0; i < 16; ++i) { s0[i] = exp2f(s0[i] - mnew); s1[i] = exp2f(s1[i] - mnew); psum += s0[i] + s1[i]; }
                lrun = lrun * alpha + psum;
#pragma unroll
                for (int db = 0; db < 4; ++db)
#pragma unroll
                    for (int i = 0; i < 16; ++i) o[db][i] *= alpha;
#pragma unroll
                for (int kb = 0; kb < 2; ++kb)
#pragma unroll
                    for (int s = 0; s < 2; ++s) {
                        u32x4 pw;
                        if (kb == 0) { pw.x = pk2(s0[8 * s], s0[8 * s + 1]); pw.y = pk2(s0[8 * s + 2], s0[8 * s + 3]); pw.z = pk2(s0[8 * s + 4], s0[8 * s + 5]); pw.w = pk2(s0[8 * s + 6], s0[8 * s + 7]); }
                        else { pw.x = pk2(s1[8 * s], s1[8 * s + 1]); pw.y = pk2(s1[8 * s + 2], s1[8 * s + 3]); pw.z = pk2(s1[8 * s + 4], s1[8 * s + 5]); pw.w = pk2(s1[8 * s + 6], s1[8 * s + 7]); }
                        const bf16x8 pf = __builtin_bit_cast(bf16x8, pw);
#pragma unroll
                        for (int db = 0; db < 4; ++db) {
                            const LAS unsigned char* vp = Vt + (db * 32 + l31) * VT_STRIDE + (kb * 32 + 16 * s + 4 * hf) * 2;
                            const u32x2 lo = *(const LAS u32x2*)vp, hi = *(const LAS u32x2*)(vp + 16);
                            const u32x4 vw = {lo.x, lo.y, hi.x, hi.y};
                            o[db] = __builtin_amdgcn_mfma_f32_32x32x16_bf16(__builtin_bit_cast(bf16x8, vw), pf, o[db], 0, 0, 0);
                        }
                    }
            }
            const float ltot = lrun + __shfl_xor(lrun, 32), rl = 1.0f / ltot;
            const bf16* grow = proj + (size_t)qtok * NINP + C_G + head * 128; bf16* orow = mrg + (size_t)qtok * MIXW + head * 128;
#pragma unroll
            for (int db = 0; db < 4; ++db)
#pragma unroll
                for (int q4 = 0; q4 < 4; ++q4) { const int d0 = db * 32 + q4 * 8 + hf * 4; const u32x2 gv = *(const u32x2*)(grow + d0);
                    u32x2 w; w.x = pk2(o[db][4 * q4] * rl * sigmoidf_(bflo(gv.x)), o[db][4 * q4 + 1] * rl * sigmoidf_(bfhi(gv.x)));
                    w.y = pk2(o[db][4 * q4 + 2] * rl * sigmoidf_(bflo(gv.y)), o[db][4 * q4 + 3] * rl * sigmoidf_(bfhi(gv.y)));
                    *(u32x2*)(orow + d0) = w; }
        }
    }
    __syncthreads();
}

template <int MODE, bool ROUTE, bool WRITE_BF>
DI void p_layernorm(Frame& F, const Args& args, const float* src, const float* gam, const float* bet, float* outf, bf16* outb) {
    const int gw = F.bid * 8 + F.wave, NGW = F.G * 8, lane = F.lane;
    const unsigned* rt = (const unsigned*)(F.ws + WS_ROUTE); unsigned* rtw = (unsigned*)(F.ws + WS_ROUTE);
    LAS float* wr_l = (LAS float*)F.lds;
    if (ROUTE) { for (int i = F.tid; i < DM * NEXP / 4; i += 512) *(LAS f32x4*)(wr_l + 4 * i) = *(const f32x4*)(INF(20) + 4 * i); __syncthreads(); }
    for (int row = gw; row < MTOK; row += NGW) {
        f32x4 v[8]; float s = 0.f;
        if (MODE == 0) {
#pragma unroll
            for (int j = 0; j < 8; ++j) v[j] = *(const f32x4*)(src + (size_t)row * DM + 4 * lane + 256 * j);
        } else {
            const unsigned r0 = rt[RT_ROW + 2 * row], r1 = rt[RT_ROW + 2 * row + 1]; const float w0 = __uint_as_float(rt[RT_W + 2 * row]), w1 = __uint_as_float(rt[RT_W + 2 * row + 1]);
            const float* yb = (const float*)(F.ws + WS_YB);
#pragma unroll
            for (int j = 0; j < 8; ++j) { const int cc = 4 * lane + 256 * j; v[j] = *(const f32x4*)(src + (size_t)row * DM + cc) * ALPHA + *(const f32x4*)(yb + (size_t)r0 * DM + cc) * w0 + *(const f32x4*)(yb + (size_t)r1 * DM + cc) * w1; }
        }
#pragma unroll
        for (int j = 0; j < 8; ++j) s += (v[j][0] + v[j][1]) + (v[j][2] + v[j][3]);
        const float mean = wave_sum(s) * (1.f / DM); float s2 = 0.f;
#pragma unroll
        for (int j = 0; j < 8; ++j) { v[j] = v[j] - mean; s2 += (v[j][0] * v[j][0] + v[j][1] * v[j][1]) + (v[j][2] * v[j][2] + v[j][3] * v[j][3]); }
        const float rstd = 1.0f / sqrtf(wave_sum(s2) * (1.f / DM) + LN_EPS);
        float lg[8];
#pragma unroll
        for (int e = 0; e < 8; ++e) lg[e] = 0.f;
#pragma unroll
        for (int j = 0; j < 8; ++j) { const f32x4 gv = *(const f32x4*)(gam + 4 * lane + 256 * j), bv = *(const f32x4*)(bet + 4 * lane + 256 * j);
            const f32x4 y = v[j] * rstd * gv + bv; *(f32x4*)(outf + (size_t)row * DM + 4 * lane + 256 * j) = y;
            if (WRITE_BF) { u32x2 w; w.x = pk2(y[0], y[1]); w.y = pk2(y[2], y[3]); *(u32x2*)(outb + (size_t)row * DM + 4 * lane + 256 * j) = w; }
            if (ROUTE) {
#pragma unroll
                for (int i = 0; i < 4; ++i) { const LAS float* wp = wr_l + (size_t)(4 * lane + 256 * j + i) * 8; const f32x4 wa = *(const LAS f32x4*)wp, wb = *(const LAS f32x4*)(wp + 4); const float xv = y[i];
                    lg[0] += xv * wa[0]; lg[1] += xv * wa[1]; lg[2] += xv * wa[2]; lg[3] += xv * wa[3]; lg[4] += xv * wb[0]; lg[5] += xv * wb[1]; lg[6] += xv * wb[2]; lg[7] += xv * wb[3]; }
            }
            asm volatile("" ::: "memory"); }
        if (ROUTE) {
#pragma unroll
            for (int e = 0; e < 8; ++e) lg[e] = wave_sum(lg[e]);
            int e0 = 0; float l0 = lg[0];
#pragma unroll
            for (int e = 1; e < 8; ++e) if (lg[e] > l0) { l0 = lg[e]; e0 = e; }
            int e1 = 0; float l1 = -INFINITY;
#pragma unroll
            for (int e = 0; e < 8; ++e) if (e != e0 && lg[e] > l1) { l1 = lg[e]; e1 = e; }
            const float p1 = 1.0f / (1.0f + expf(l0 - l1)), p0 = 1.0f - p1;
            if (lane == 0) { const unsigned sl0 = atomicAdd(F.ctl + CW_CNT + e0, 1u), sl1 = atomicAdd(F.ctl + CW_CNT + e1, 1u);
                rtw[RT_E + 2 * row] = (unsigned)e0; rtw[RT_E + 2 * row + 1] = (unsigned)e1; rtw[RT_SLOT + 2 * row] = sl0; rtw[RT_SLOT + 2 * row + 1] = sl1;
                rtw[RT_W + 2 * row] = __float_as_uint(p0); rtw[RT_W + 2 * row + 1] = __float_as_uint(p1); }
        }
    }
    if (ROUTE) __syncthreads();
}

DI void p_moe_gather(Frame& F) {
    const unsigned* cnt = F.ctl + CW_CNT; unsigned* rt = (unsigned*)(F.ws + WS_ROUTE);
    const bf16* x1b = (const bf16*)(F.ws + WS_X1B); bf16* am = (bf16*)(F.ws + WS_AMOE);
    int ts[9]; ts[0] = 0;
#pragma unroll
    for (int e = 0; e < 8; ++e) ts[e + 1] = ts[e] + (((int)cnt[e] + 255) >> 8);
    const int gw = F.bid * 8 + F.wave, NGW = F.G * 8, lane = F.lane;
    for (int a = gw; a < MTOK * 2; a += NGW) {
        const int tok = a >> 1; const int e = (int)rt[RT_E + a], slot = (int)rt[RT_SLOT + a]; int tse = 0;
#pragma unroll
        for (int k = 0; k < 8; ++k) tse = (e == k) ? ts[k] : tse;
        const int row = tse * 256 + slot;
        const u32x4* s = (const u32x4*)(x1b + (size_t)tok * DM); u32x4* d = (u32x4*)(am + (size_t)row * DM);
#pragma unroll
        for (int i = 0; i < 4; ++i) d[lane + 64 * i] = s[lane + 64 * i];
        if (lane == 0) rt[RT_ROW + a] = (unsigned)row;
    }
    for (int pr = gw; pr < 8 * 256; pr += NGW) { const int e = pr >> 8, i = pr & 255; int tse = 0, tn = 0, ce = 0;
#pragma unroll
        for (int k = 0; k < 8; ++k) { tse = (e == k) ? ts[k] : tse; tn = (e == k) ? ts[k + 1] : tn; ce = (e == k) ? (int)cnt[k] : ce; }
        const int row = tse * 256 + ce + i;
        if (row < tn * 256) { u32x4* d = (u32x4*)(am + (size_t)row * DM);
#pragma unroll
            for (int q = 0; q < 4; ++q) d[lane + 64 * q] = (u32x4){0u, 0u, 0u, 0u}; } }
}

constexpr int NPH_LAYER = 12;
constexpr int NPHASES = 1 + 2 * NPH_LAYER;
#define IN(k) (lo <= (k) && (k) < hi)
#define RELAUNDER() do { int l_ = lane_id_(); asm volatile("" : "+v"(l_)); F.lane = l_; F.tid = F.wave * 64 + l_; } while (0)
#define SEAM(k) do { if (IN(k) && IN((k) + 1)) xcd_barrier(bar); } while (0)
template <int LAYER>
DI void run_layer(Frame& F, const Args& args, const XcdBarrier& bar, const int lo, const int hi) {
    constexpr int P = 1 + NPH_LAYER * LAYER;
    bf16* proj = (bf16*)(F.ws + WS_PROJ); bf16* xb = (bf16*)(F.ws + WS_XB); bf16* mrg = (bf16*)(F.ws + WS_MRG);
    float* x1 = (float*)(F.ws + WS_X1); bf16* x1b = (bf16*)(F.ws + WS_X1B); float* x2 = (float*)(F.ws + WS_X2); float* pre = (float*)(F.ws + WS_PRE);
    if (IN(P + 0)) {
        pg8::Gemm g{xb, (const bf16*)(F.ws + WS_WIN) + (size_t)LAYER * NINP * DM, DM, DM, DM};
        pg8::TileOrder S; S.init(MTOK / 256, NINP / 256, F.G, F.bid, (size_t)256 * DM * 2, (size_t)256 * DM * 2);
        pg8::EpiBf16 E{proj, NINP};
        pg8::gemm_phase(F.lds, g, S, E, F.wave);
    }
    SEAM(P + 0);
    if (IN(P + 1)) { RELAUNDER(); p2_prep(F, args, LAYER); }
    SEAM(P + 1);
    if (IN(P + 2)) {
        { pg8::Gemm g{(const bf16*)(F.ws + WS_DIFF), (const bf16*)(F.ws + WS_WPOOL) + (size_t)LAYER * 2048 * 512, DM, 512, 512};
          pg8::TileOrder S; S.init(MTOK / 256, 8, F.G, F.bid, (size_t)256 * DM * 2, (size_t)256 * 512 * 2, 2, (size_t)512 * 2);
          pg8::EpiPool E{mrg, proj, INF(5) + (size_t)LAYER * DM};
          pg8::gemm_phase(F.lds, g, S, E, F.wave); }
        { pg8::Gemm g{(const bf16*)(F.ws + WS_XC), (const bf16*)(F.ws + WS_WLRU) + (size_t)LAYER * 4096 * 256, DM, 256, 256};
          pg8::TileOrder S; S.init(MTOK / 256, 16, F.G, F.bid, (size_t)256 * DM * 2, (size_t)256 * 256 * 2, 2, (size_t)256 * 2);
          pg8::EpiLru E{(float*)(F.ws + WS_A), (float*)(F.ws + WS_B), (const bf16*)(F.ws + WS_XC), INF(9) + (size_t)LAYER * DM, INF(11) + (size_t)LAYER * DM, (const float*)(F.ws + WS_LRUC) + (size_t)LAYER * DM};
          pg8::gemm_phase(F.lds, g, S, E, F.wave); }
        RELAUNDER(); p3_indexer(F);
    }
    SEAM(P + 2);
    if (IN(P + 3)) { RELAUNDER(); p4_select(F); RELAUNDER(); p4_lru_pass1(F); }
    SEAM(P + 3);
    if (IN(P + 4)) { RELAUNDER(); p5_attention(F); RELAUNDER(); p5_lru_pass2(F); }
    SEAM(P + 4);
    if (IN(P + 5)) {
        pg8::Gemm g{mrg, (const bf16*)(F.ws + WS_WOUT) + (size_t)LAYER * DM * MIXW, MIXW, MIXW, MIXW};
        pg8::TileOrder S; S.init(MTOK / 256, DM / 256, F.G, F.bid, (size_t)256 * MIXW * 2, (size_t)256 * MIXW * 2);
        pg8::EpiRes E{pre, LAYER == 0 ? INF(0) : (const float*)x2, DM};
        pg8::gemm_phase(F.lds, g, S, E, F.wave);
    }
    SEAM(P + 5);
    if (IN(P + 6)) { RELAUNDER(); } if (IN(P + 6)) p_layernorm<0, LAYER == 1, true>(F, args, pre, INF(13) + LAYER * DM, INF(14) + LAYER * DM, x1, x1b);
    SEAM(P + 6);
    if constexpr (LAYER == 0) {
        if (IN(P + 7)) {
            pg8::Gemm g{x1b, (const bf16*)(F.ws + WS_WGU), DM, DM, DM};
            pg8::TileOrder S; S.init(MTOK / 256, 2 * DFF / 256, F.G, F.bid, (size_t)256 * DM * 2, (size_t)256 * DM * 2);
            pg8::EpiSwiglu E{(bf16*)(F.ws + WS_H), DFF};
            pg8::gemm_phase(F.lds, g, S, E, F.wave);
        }
        SEAM(P + 7);
        if (IN(P + 8)) {
            pg8::Gemm g{(const bf16*)(F.ws + WS_H), (const bf16*)(F.ws + WS_WDN), DFF, DFF, DFF};
            pg8::TileOrder S; S.init(MTOK / 256, DM / 256, F.G, F.bid, (size_t)256 * DFF * 2, (size_t)256 * DFF * 2);
            pg8::EpiRes E{pre, x1, DM};
            pg8::gemm_phase(F.lds, g, S, E, F.wave);
        }
        SEAM(P + 8);
        if (IN(P + 9)) { RELAUNDER(); } if (IN(P + 9)) p_layernorm<0, false, true>(F, args, pre, INF(15), INF(16), x2, xb);
        if (IN(P + 9) && IN(P + 12)) xcd_barrier(bar);
    } else {
        if (IN(P + 7)) { RELAUNDER(); p_convert_moe(F, args); RELAUNDER(); p_moe_gather(F); }
        SEAM(P + 7);
        if (IN(P + 8)) {
            pg8::Gemm g{(const bf16*)(F.ws + WS_AMOE), (const bf16*)(F.ws + WS_MWGU), DM, DM, DM};
            pg8::MoeOrder S; S.init(F.ctl + CW_CNT, 2 * DEXP / 256, F.G, F.bid, (size_t)256 * DM * 2, (size_t)2 * DEXP * DM * 2, (size_t)256 * DM * 2);
            pg8::EpiSwiglu E{(bf16*)(F.ws + WS_HMOE), DEXP};
            pg8::gemm_phase(F.lds, g, S, E, F.wave);
        }
        SEAM(P + 8);
        if (IN(P + 9)) {
            pg8::Gemm g{(const bf16*)(F.ws + WS_HMOE), (const bf16*)(F.ws + WS_MWDN), DEXP, DEXP, DEXP};
            pg8::MoeOrder S; S.init(F.ctl + CW_CNT, DM / 256, F.G, F.bid, (size_t)256 * DEXP * 2, (size_t)DM * DEXP * 2, (size_t)256 * DEXP * 2);
            pg8::EpiF32 E{(float*)(F.ws + WS_YB), DM};
            pg8::gemm_phase(F.lds, g, S, E, F.wave);
        }
        SEAM(P + 9);
        if (IN(P + 10)) { RELAUNDER(); } if (IN(P + 10)) p_layernorm<1, false, false>(F, args, x1, INF(15) + DM, INF(16) + DM, args.out, nullptr);
    }
}
__global__ void __launch_bounds__(512, 2) fwd_kernel(Args args) {
    extern __shared__ __attribute__((aligned(16))) unsigned char lds_raw[];
    Frame F;
    F.lds = (LAS unsigned char*)lds_raw; F.ws = args.ws; F.ctl = (unsigned*)(args.ws + WS_CTL);
    F.wave = __builtin_amdgcn_readfirstlane((int)threadIdx.x >> 6); F.lane = lane_id_(); F.tid = F.wave * 64 + F.lane; F.G = gridDim.x; F.bid = blockIdx.x;
    volatile LAS unsigned* MISC = (volatile LAS unsigned*)(F.lds + LDSCTL_OFF);
    for (int u = F.tid; u < (LDS_BYTES - LDSCTL_OFF) / 4; u += 512) ((LAS unsigned*)(F.lds + LDSCTL_OFF))[u] = 0u;
    __syncthreads();
    const int lo = args.ph_lo, hi = args.ph_hi;
    XcdBarrier bar; bar.bar = F.ctl + CW_BAR; bar.x = 0; bar.st = nullptr; bar.wave = F.wave;
    if ((hi - lo) > 1) bar = xcd_barrier_post(F.ctl + CW_BAR, MISC + 8, F.wave);
    if (IN(0)) { RELAUNDER(); p0_prologue(F, args); __syncthreads(); }
    SEAM(0);
    run_layer<0>(F, args, bar, lo, hi);
    run_layer<1>(F, args, bar, lo, hi);
}
#undef IN
#undef SEAM

extern "C" void kernel_launch(void* const* d_in, const int* in_sizes, int n_in, void* d_out, int out_size, void* d_ws, size_t ws_size, hipStream_t stream) {
    static int grid = 0;
    if (grid == 0) {
        if (n_in != 24 || out_size != MTOK * DM || ws_size < WS_END) { fprintf(stderr, "kernel_launch: unexpected problem (n_in %d, out %d, ws %zu, need %zu)\n", n_in, out_size, ws_size, (size_t)WS_END); grid = -1; return; }
        int dev = 0, cus = 0, per_cu = 0;
        if (hipGetDevice(&dev) != hipSuccess || hipDeviceGetAttribute(&cus, hipDeviceAttributeMultiprocessorCount, dev) != hipSuccess) { grid = -1; return; }
        if (hipFuncSetAttribute((const void*)fwd_kernel, hipFuncAttributeMaxDynamicSharedMemorySize, LDS_BYTES) != hipSuccess) { fprintf(stderr, "kernel_launch: hipFuncSetAttribute failed\n"); grid = -1; return; }
        if (hipOccupancyMaxActiveBlocksPerMultiprocessor(&per_cu, (const void*)fwd_kernel, 512, LDS_BYTES) != hipSuccess || per_cu < 1) fprintf(stderr, "kernel_launch: occupancy query reports %d\n", per_cu);
        (void)hipGetLastError();
        grid = cus;
    }
    if (grid < 0) return;
    (void)hipMemsetAsync((char*)d_ws + WS_CTL, 0, CTL_ZERO_BYTES, stream);
    Args a{};
    for (int i = 0; i < 24; ++i) a.in[i] = d_in[i];
    a.out = (float*)d_out; a.ws = (unsigned char*)d_ws;
#if MK_N_LAUNCHES == 1
    a.ph_lo = 0; a.ph_hi = NPHASES;
    hipLaunchKernelGGL(fwd_kernel, dim3(grid), dim3(512), LDS_BYTES, stream, a);
#else
    const int plist[] = {0, 1, 2, 3, 4, 5, 6, 7, 8, 9, 10, 13, 14, 15, 16, 17, 18, 19, 20, 21, 22, 23};
    for (int i = 0; i < (int)(sizeof(plist) / sizeof(int)); ++i) { a.ph_lo = plist[i]; a.ph_hi = plist[i] + 1; hipLaunchKernelGGL(fwd_kernel, dim3(grid), dim3(512), LDS_BYTES, stream, a); }
#endif
}
```

```cpp
#include <hip/hip_runtime.h>
#include <cstdio>
#include <cstdint>

#ifndef MK_N_LAUNCHES
#define MK_N_LAUNCHES 1
#endif

#ifndef STAMP_PROBE
#define STAMP_PROBE 0
#endif
#ifndef STAMP_A_LO
#define STAMP_A_LO 0
#define STAMP_A_HI 1
#define STAMP_B_LO 1
#define STAMP_B_HI 2
#endif
#define DI __device__ __forceinline__
#define LAS __attribute__((address_space(3)))
#define GAS __attribute__((address_space(1)))
typedef unsigned short bf16;
typedef short bf16x8 __attribute__((ext_vector_type(8)));
typedef float f32x2 __attribute__((ext_vector_type(2)));
typedef float f32x4 __attribute__((ext_vector_type(4)));
typedef float f32x16 __attribute__((ext_vector_type(16)));
typedef unsigned u32x2 __attribute__((ext_vector_type(2)));
typedef unsigned u32x4 __attribute__((ext_vector_type(4)));
typedef __bf16 bf16x2_t __attribute__((ext_vector_type(2)));

#define LDS_WAIT() asm volatile("s_waitcnt lgkmcnt(0)" ::: "memory")
#define VM_WAIT() asm volatile("s_waitcnt vmcnt(0)" ::: "memory")

DI unsigned pk2(float lo, float hi) { f32x2 v = {lo, hi}; return __builtin_bit_cast(unsigned, __builtin_convertvector(v, bf16x2_t)); }
DI float bflo(unsigned w) { return __uint_as_float(w << 16); }
DI float bfhi(unsigned w) { return __uint_as_float(w & 0xffff0000u); }
DI float bf2f(bf16 b) { return __uint_as_float(((unsigned)b) << 16); }
DI float rcp_(float x) { return __builtin_amdgcn_rcpf(x); }
DI float sigmoidf_(float x) { return rcp_(1.0f + __expf(-x)); }
DI float siluf_(float x) { return x * rcp_(1.0f + __expf(-x)); }
DI float gelu_tanh_(float x) { const float u = 0.7978845608028654f * (x + 0.044715f * x * x * x); const float t = 1.0f - 2.0f * rcp_(1.0f + __expf(2.0f * u)); return 0.5f * x * (1.0f + t); }
DI float one_minus_exp_(float x) {
    const float p = -x * (1.0f + x * 0.5f * (1.0f + x * (1.0f / 3.0f) * (1.0f + x * 0.25f * (1.0f + x * 0.2f * (1.0f + x * (1.0f / 6.0f) * (1.0f + x * (1.0f / 7.0f)))))));
    return x > -0.5f ? p : 1.0f - __expf(x);
}
DI int lane_id_() { int l; asm volatile("v_mbcnt_lo_u32_b32 %0, -1, 0\n\tv_mbcnt_hi_u32_b32 %0, -1, %0" : "=v"(l)); return l; }

constexpr int DM = 2048, BATCH = 4, SEQ = 2048, MTOK = BATCH * SEQ;
constexpr int NIN = 16464, NINP = 16640;
constexpr int C_Q = 0, C_K = 2048, C_V = 2560, C_QI = 3072, C_KI = 4096, C_WI = 4160, C_PADLO = 4176, C_P = 4352, C_XR = 6400, C_GR = 8448, C_G = 10496;
constexpr int MIXW = 6144, DFF = 5504, NEXP = 8, DEXP = 7168;
constexpr int MOE_ROWS_MAX = (MTOK * 2 / 256 + NEXP) * 256;
constexpr float ALPHA = 1.4142135623730951f, LN_EPS = 1e-5f;

constexpr size_t MiB = 1u << 20;
constexpr size_t WS_CTL = 0, CTL_ZERO_BYTES = 1 * MiB;
constexpr size_t WS_COSA = 1 * MiB, WS_SINA = 3 * MiB, WS_COSI = 5 * MiB, WS_SINI = 6 * MiB;
constexpr size_t WS_CARRY = 7 * MiB;
constexpr size_t WS_ROUTE = 9 * MiB;
constexpr size_t WS_MASK = 10 * MiB;
constexpr size_t WS_LRUC = 9 * MiB + 512 * 1024;
constexpr size_t WS_WIN = 12 * MiB;
constexpr size_t WS_WOUT = 142 * MiB;
constexpr size_t WS_WPOOL = 190 * MiB;
constexpr size_t WS_WLRU = 194 * MiB;
constexpr size_t WS_WGU = 198 * MiB;
constexpr size_t WS_WDN = 241 * MiB;
constexpr size_t WS_XB = 263 * MiB;
constexpr size_t WS_X1 = 295 * MiB;
constexpr size_t WS_X1B = 359 * MiB;
constexpr size_t WS_X2 = 391 * MiB;
constexpr size_t WS_PRE = 455 * MiB;
constexpr size_t WS_OV = 519 * MiB;
constexpr size_t WS_PROJ = WS_OV;
constexpr size_t WS_DIFF = WS_OV + 260 * MiB;
constexpr size_t WS_XC = WS_OV + 292 * MiB;
constexpr size_t WS_A = WS_OV + 324 * MiB;
constexpr size_t WS_B = WS_OV + 388 * MiB;
constexpr size_t WS_SC = WS_OV + 452 * MiB;
constexpr size_t WS_MRG = WS_OV + 516 * MiB;
constexpr size_t WS_H = WS_OV;
constexpr size_t WS_MWGU = WS_OV;
constexpr size_t WS_MWDN = WS_OV + 448 * MiB;
constexpr size_t WS_AMOE = WS_OV + 672 * MiB;
constexpr size_t WS_HMOE = WS_OV + 744 * MiB;
constexpr size_t WS_YB = WS_OV + 996 * MiB;
constexpr size_t WS_END = WS_OV + 1284 * MiB;
constexpr int CW_BAR = 4096, CW_CNT = 16384;
constexpr int RT_E = 0, RT_SLOT = 2 * MTOK, RT_W = 4 * MTOK, RT_ROW = 6 * MTOK, RT_WGC = 8 * MTOK;

constexpr int RING_BYTES = 131072, LDSCTL_OFF = RING_BYTES, LDS_BYTES = 147456;

#define XB_TMO      128
#define XB_XCNT(j)  (256  + 64 * (j))
#define XB_XSUB(j)  (1280 + 64 * (j))
#define XB_XGEN(j)  (2304 + 64 * (j))
#define XB_TOP      3328
#define XB_TOPGEN   3392
#define XCD_BAR_WORDS 3456
#define XB_SPIN_CAP (1u << 18)
DI unsigned xb_ld(unsigned* p)              { return __hip_atomic_load(p, __ATOMIC_RELAXED, __HIP_MEMORY_SCOPE_AGENT); }
DI unsigned xb_add(unsigned* p, unsigned v) { return __hip_atomic_fetch_add(p, v, __ATOMIC_RELAXED, __HIP_MEMORY_SCOPE_AGENT); }
DI unsigned xb_xcc_id() { return (unsigned)__builtin_amdgcn_s_getreg((3 << 11) | 20) & 0xFu; }
#define XB_SPIN(cond, bar) do { unsigned _sp = 0; while (cond) { __builtin_amdgcn_s_sleep(1); \
    if ((++_sp & 255u) == 0u) { if (xb_ld(&(bar)[XB_TMO])) break; if (_sp > XB_SPIN_CAP) { atomicAdd(&(bar)[XB_TMO], 1u); break; } } } } while (0)
struct XcdBarrier { unsigned* bar; unsigned x; volatile LAS unsigned* st; int wave; };
DI bool xb_t0(int wave) { return wave == 0 && lane_id_() == 0; }
DI XcdBarrier xcd_barrier_post(unsigned* bar, volatile LAS unsigned* st, int wave) {
    XcdBarrier b; b.bar = bar; b.x = xb_xcc_id(); b.st = st; b.wave = wave;
    if (xb_t0(wave)) (void)xb_add(&bar[XB_XCNT(b.x)], 1u);
    return b;
}
DI void xcd_barrier_complete(unsigned* bar, unsigned x, unsigned& nloc, unsigned& nx) {
    const unsigned G = gridDim.x * gridDim.y * gridDim.z;
    unsigned sum, cnt, mine, sp = 0u;
    for (;;) {
        sum = 0u; cnt = 0u; mine = 0u;
#pragma unroll
        for (unsigned j = 0; j < 16; ++j) { const unsigned c = xb_ld(&bar[XB_XCNT(j)]); sum += c; cnt += (c > 0u) ? 1u : 0u; mine = (j == x) ? c : mine; }
        if (sum == G) break;
        __builtin_amdgcn_s_sleep(1);
        if ((++sp & 255u) == 0u) { if (xb_ld(&bar[XB_TMO])) break; if (sp > XB_SPIN_CAP) { atomicAdd(&bar[XB_TMO], 1u); break; } }
    }
    nloc = mine > 0u ? mine : 1u; nx = cnt > 0u ? cnt : 1u;
}
DI void xcd_barrier(const XcdBarrier& b) {
    asm volatile("s_waitcnt vmcnt(0)" ::: "memory");
    __syncthreads();
    if (xb_t0(b.wave)) {
        unsigned* bar = b.bar;
        __builtin_amdgcn_s_waitcnt(0);
        unsigned nloc = b.st[0], nx = b.st[1];
        if (nloc == 0u) { xcd_barrier_complete(bar, b.x, nloc, nx); b.st[0] = nloc; b.st[1] = nx; }
        const unsigned old = xb_add(&bar[XB_XSUB(b.x)], 1u);
        const unsigned gen = old / nloc;
        if (old + 1u == (gen + 1u) * nloc) {
            __builtin_amdgcn_fence(__ATOMIC_RELEASE, "agent");
            asm volatile("s_waitcnt vmcnt(0)" ::: "memory");
            const unsigned og = xb_add(&bar[XB_TOP], 1u);
            const unsigned tg = og / nx;
            if (og + 1u == (tg + 1u) * nx) xb_add(&bar[XB_TOPGEN], 1u);
            else XB_SPIN(xb_ld(&bar[XB_TOPGEN]) == tg, bar);
            __builtin_amdgcn_fence(__ATOMIC_ACQUIRE, "agent");
            xb_add(&bar[XB_XGEN(b.x)], 1u);
            asm volatile("s_waitcnt vmcnt(0)" ::: "memory");
        } else {
            XB_SPIN(xb_ld(&bar[XB_XGEN(b.x)]) == gen, bar);
            __builtin_amdgcn_fence(__ATOMIC_ACQUIRE, "agent");
            asm volatile("s_waitcnt vmcnt(0)" ::: "memory");
        }
    }
    __syncthreads();
}

namespace pg8 {
constexpr int BM = 256, BK = 64, HALF = 128, HTB = HALF * BK * 2, STAGE_BYTES = 8 * HTB, NXCD = 8, WGM = 8;
DI int lds_byte(int r, int c) { const int st = (r >> 4) * 2 + (c >> 5), rr = r & 15, cc = c & 31, ob = rr * 64 + cc * 2; return st * 1024 + (ob ^ (((ob >> 9) & 1) << 5)); }
DI void stage_rc(int b, int& R, int& C) { const int st = b / 1024, sb = b % 1024, swz = sb ^ (((sb >> 9) & 1) << 5); R = (st >> 1) * 16 + swz / 64; C = (st & 1) * 32 + (swz % 64) / 2; }
DI int perm32(int rho) { const int n = rho >> 4, i = rho & 15; return 8 * (i >> 2) + 4 * n + (i & 3); }

struct Unit { int pm, pn, e, ks; };
struct Gemm { const bf16* A; const bf16* Bt; int lda, ldb, K; };

struct TileOrder {
    int nM, nN, nwg, G, c, a_div; size_t a_pm, a_pn, b_pn;
    DI void init(int nM_, int nN_, int G_, int c_, size_t a_pm_, size_t b_pn_, int a_div_ = 1, size_t a_pn_ = 0) { nM = nM_; nN = nN_; nwg = nM * nN; G = G_; c = c_; a_pm = a_pm_; b_pn = b_pn_; a_div = a_div_; a_pn = a_pn_; }
    DI bool next(int i, Unit& u) const {
        const long L = (long)i * G + c; if (L >= nwg) return false;
        int wgid = (int)L; { const int q = nwg / NXCD, r = nwg % NXCD, xcd = wgid % NXCD, off = wgid / NXCD; wgid = (xcd < r ? xcd * (q + 1) : r * (q + 1) + (xcd - r) * q) + off; }
        const int nig = WGM * nN, gid = wgid / nig, fm = gid * WGM, gsz = (nM - fm) < WGM ? (nM - fm) : WGM;
        u.pm = fm + ((wgid % nig) % gsz); u.pn = (wgid % nig) / gsz; u.e = 0; u.ks = 0; return true;
    }
    DI size_t aoff(const Unit& u) const { return (size_t)u.pm * a_pm + (size_t)(u.pn / a_div) * a_pn; }
    DI size_t boff(const Unit& u) const { return (size_t)u.pn * b_pn; }
};
struct MoeOrder {
    int nN, nNk, nwg, G, c; int t1, t2, t3, t4, t5, t6, t7, t8; size_t a_pm, b_e, b_pn, ks_step;
    DI void init(const unsigned* cnt, int nN_, int ksplit, int G_, int c_, size_t a_pm_, size_t b_e_, size_t b_pn_, size_t ks_step_) {
        nN = nN_; nNk = nN_ * ksplit; G = G_; c = c_; a_pm = a_pm_; b_e = b_e_; b_pn = b_pn_; ks_step = ks_step_;
        int s = 0; s += ((int)cnt[0] + 255) >> 8; t1 = s; s += ((int)cnt[1] + 255) >> 8; t2 = s; s += ((int)cnt[2] + 255) >> 8; t3 = s; s += ((int)cnt[3] + 255) >> 8; t4 = s;
        s += ((int)cnt[4] + 255) >> 8; t5 = s; s += ((int)cnt[5] + 255) >> 8; t6 = s; s += ((int)cnt[6] + 255) >> 8; t7 = s; s += ((int)cnt[7] + 255) >> 8; t8 = s;
        nwg = t8 * nNk;
    }
    DI bool next(int i, Unit& u) const {
        const long L = (long)i * G + c; if (L >= nwg) return false;
        int wgid = (int)L; { const int q = nwg / NXCD, r = nwg % NXCD, xcd = wgid % NXCD, off = wgid / NXCD; wgid = (xcd < r ? xcd * (q + 1) : r * (q + 1) + (xcd - r) * q) + off; }
        int e = 0, ts = 0, nt = t1;
        if (wgid >= t1 * nNk) { e = 1; ts = t1; nt = t2 - t1; }
        if (wgid >= t2 * nNk) { e = 2; ts = t2; nt = t3 - t2; }
        if (wgid >= t3 * nNk) { e = 3; ts = t3; nt = t4 - t3; }
        if (wgid >= t4 * nNk) { e = 4; ts = t4; nt = t5 - t4; }
        if (wgid >= t5 * nNk) { e = 5; ts = t5; nt = t6 - t5; }
        if (wgid >= t6 * nNk) { e = 6; ts = t6; nt = t7 - t6; }
        if (wgid >= t7 * nNk) { e = 7; ts = t7; nt = t8 - t7; }
        const int loc = wgid - ts * nNk; nt = nt > 0 ? nt : 1;
        const int pn2 = loc / nt;
        u.pm = ts + loc % nt; u.pn = pn2 % nN; u.ks = pn2 / nN; u.e = e; return true;
    }
    DI size_t aoff(const Unit& u) const { return (size_t)u.pm * a_pm + (size_t)u.ks * ks_step; }
    DI size_t boff(const Unit& u) const { return (size_t)u.e * b_e + (size_t)u.pn * b_pn + (size_t)u.ks * ks_step; }
};

struct EpiBf16 {
    static constexpr bool PERM = true;
    bf16* O; int ldc; size_t ks_stride;
    DI void operator()(const f32x4 (&acc)[2][2][4][2], const Unit& u, int wr, int wc, int fr, int fq) const {
        const int row0 = u.pm * BM + wr * 64 + fr, col0 = u.pn * BM + wc * 32 + 8 * fq;
#pragma unroll
        for (int ai = 0; ai < 2; ++ai)
#pragma unroll
            for (int m = 0; m < 4; ++m) { bf16* rowp = O + (size_t)u.ks * ks_stride + (size_t)(row0 + ai * HALF + m * 16) * ldc + col0;
#pragma unroll
                for (int bj = 0; bj < 2; ++bj) { const f32x4 v0 = acc[ai][bj][m][0], v1 = acc[ai][bj][m][1];
                    u32x4 w; w.x = pk2(v0[0], v0[1]); w.y = pk2(v0[2], v0[3]); w.z = pk2(v1[0], v1[1]); w.w = pk2(v1[2], v1[3]);
                    *(u32x4*)(rowp + bj * HALF) = w; } }
    }
};
struct EpiF32 {
    static constexpr bool PERM = false;
    float* C; int ldc;
    DI void operator()(const f32x4 (&acc)[2][2][4][2], const Unit& u, int wr, int wc, int fr, int fq) const {
        const int row0 = u.pm * BM + wr * 64 + fr, col0 = u.pn * BM + wc * 32 + 4 * fq;
#pragma unroll
        for (int ai = 0; ai < 2; ++ai)
#pragma unroll
            for (int m = 0; m < 4; ++m) { float* rowp = C + (size_t)(row0 + ai * HALF + m * 16) * ldc + col0;
#pragma unroll
                for (int bj = 0; bj < 2; ++bj)
#pragma unroll
                    for (int n = 0; n < 2; ++n) *(f32x4*)(rowp + bj * HALF + n * 16) = acc[ai][bj][m][n]; }
    }
};
struct EpiRes {
    static constexpr bool PERM = false;
    float* C; const float* res; int ldc;
    DI void operator()(const f32x4 (&acc)[2][2][4][2], const Unit& u, int wr, int wc, int fr, int fq) const {
        const int row0 = u.pm * BM + wr * 64 + fr, col0 = u.pn * BM + wc * 32 + 4 * fq;
#pragma unroll
        for (int ai = 0; ai < 2; ++ai)
#pragma unroll
            for (int m = 0; m < 4; ++m) { const size_t off = (size_t)(row0 + ai * HALF + m * 16) * ldc + col0;
#pragma unroll
                for (int bj = 0; bj < 2; ++bj)
#pragma unroll
                    for (int n = 0; n < 2; ++n) { const f32x4 rv = *(const f32x4*)(res + off + bj * HALF + n * 16); *(f32x4*)(C + off + bj * HALF + n * 16) = acc[ai][bj][m][n] + rv * ALPHA; }
                asm volatile("" ::: "memory"); }
    }
};
struct EpiSwiglu {
    static constexpr bool PERM = true;
    bf16* H; int ldc;
    DI void operator()(const f32x4 (&acc)[2][2][4][2], const Unit& u, int wr, int wc, int fr, int fq) const {
        const int row0 = u.pm * BM + wr * 64 + fr, col0 = u.pn * HALF + wc * 32 + 8 * fq;
#pragma unroll
        for (int ai = 0; ai < 2; ++ai)
#pragma unroll
            for (int m = 0; m < 4; ++m) { bf16* rowp = H + (size_t)(row0 + ai * HALF + m * 16) * ldc + col0;
                const f32x4 g0 = acc[ai][0][m][0], g1 = acc[ai][0][m][1], u0 = acc[ai][1][m][0], u1 = acc[ai][1][m][1];
                u32x4 w; w.x = pk2(siluf_(g0[0]) * u0[0], siluf_(g0[1]) * u0[1]); w.y = pk2(siluf_(g0[2]) * u0[2], siluf_(g0[3]) * u0[3]);
                w.z = pk2(siluf_(g1[0]) * u1[0], siluf_(g1[1]) * u1[1]); w.w = pk2(siluf_(g1[2]) * u1[2], siluf_(g1[3]) * u1[3]);
                *(u32x4*)rowp = w; asm volatile("" ::: "memory"); }
    }
};
struct EpiPool {
    static constexpr bool PERM = true;
    bf16* mrg; const bf16* proj; const float* scale;
    DI void operator()(const f32x4 (&acc)[2][2][4][2], const Unit& u, int wr, int wc, int fr, int fq) const {
        const int row0 = u.pm * BM + wr * 64 + fr, col0 = u.pn * BM + wc * 32 + 8 * fq;
#pragma unroll
        for (int bj = 0; bj < 2; ++bj) { const int c = col0 + bj * HALF; const f32x4 s0 = *(const f32x4*)(scale + c), s1 = *(const f32x4*)(scale + c + 4);
#pragma unroll
            for (int ai = 0; ai < 2; ++ai)
#pragma unroll
                for (int m = 0; m < 4; ++m) { const size_t row = (size_t)(row0 + ai * HALF + m * 16);
                    const u32x4 gv = *(const u32x4*)(proj + row * NINP + C_G + 2048 + c);
                    const f32x4 v0 = acc[ai][bj][m][0] * s0, v1 = acc[ai][bj][m][1] * s1;
                    u32x4 w; w.x = pk2(v0[0] * sigmoidf_(bflo(gv.x)), v0[1] * sigmoidf_(bfhi(gv.x))); w.y = pk2(v0[2] * sigmoidf_(bflo(gv.y)), v0[3] * sigmoidf_(bfhi(gv.y)));
                    w.z = pk2(v1[0] * sigmoidf_(bflo(gv.z)), v1[1] * sigmoidf_(bfhi(gv.z))); w.w = pk2(v1[2] * sigmoidf_(bflo(gv.w)), v1[3] * sigmoidf_(bfhi(gv.w)));
                    *(u32x4*)(mrg + row * MIXW + 2048 + c) = w; asm volatile("" ::: "memory"); } }
    }
};
struct EpiLru {
    static constexpr bool PERM = false;
    float* Aout; float* Bout; const bf16* xc; const float* ba; const float* bx; const float* c8sp;
    DI void operator()(const f32x4 (&acc)[2][2][4][2], const Unit& u, int wr, int wc, int fr, int fq) const {
        const int row0 = u.pm * BM + wr * 64 + fr, ch0 = u.pn * HALF + wc * 32 + 4 * fq;
#pragma unroll
        for (int n = 0; n < 2; ++n) { const int ch = ch0 + n * 16; const f32x4 vba = *(const f32x4*)(ba + ch), vbx = *(const f32x4*)(bx + ch), vsp = *(const f32x4*)(c8sp + ch);
#pragma unroll
            for (int ai = 0; ai < 2; ++ai)
#pragma unroll
                for (int m = 0; m < 4; ++m) { const size_t off = (size_t)(row0 + ai * HALF + m * 16) * DM + ch;
                    const u32x2 xv = *(const u32x2*)(xc + off); const float xf[4] = {bflo(xv.x), bfhi(xv.x), bflo(xv.y), bfhi(xv.y)};
                    f32x4 av, bv;
#pragma unroll
                    for (int j = 0; j < 4; ++j) { const float r = sigmoidf_(acc[ai][0][m][n][j] + vba[j]), ig = sigmoidf_(acc[ai][1][m][n][j] + vbx[j]);
                        const float la = -vsp[j] * r; av[j] = __expf(la); bv[j] = __builtin_amdgcn_sqrtf(fmaxf(one_minus_exp_(2.0f * la), 0.f)) * ig * xf[j]; }
                    *(f32x4*)(Aout + off) = av; *(f32x4*)(Bout + off) = bv; asm volatile("" ::: "memory"); } }
    }
};

template <class Epi, class Sched, bool ALIGN_EPI = true, bool SP2 = true>
DI void gemm_phase(LAS unsigned char* lds, const Gemm g, const Sched& S, const Epi& E, const int wave_id) {
    int lane_ = lane_id_(); asm volatile("" : "+v"(lane_));
    const int wid = wave_id, lane = lane_, tid = wid * 64 + lane, wr = wid >> 2, wc = wid & 3, fr = lane & 15, fq = lane >> 4;
    const int nt = g.K / BK;
    unsigned voffA[2], voffB[2];
#pragma unroll
    for (int i = 0; i < 2; ++i) { int R, C; stage_rc(tid * 16 + i * 8192, R, C); const int Rb = Epi::PERM ? ((R & ~31) + perm32(R & 31)) : R;
        voffA[i] = (unsigned)(R * g.lda + C) * 2u; voffB[i] = (unsigned)(Rb * g.ldb + C) * 2u; }
    const size_t kstep = (size_t)(BK * 2);
    const size_t hstepA = (size_t)HALF * g.lda * 2, hstepB = (size_t)HALF * g.ldb * 2;
    const unsigned ldsw = (unsigned)wid * 1024u;
    const int aoff = lds_byte(wr * 64 + fr, fq * 8), boff = lds_byte(wc * 32 + fr, fq * 8);
#define PG8_SA(b, h) (((b) * 2 + (h)) * HTB)
#define PG8_SB(b, h) ((4 + (b) * 2 + (h)) * HTB)
#define PG8_STAGE(bufoff, gbase, voff) do { _Pragma("unroll") for (int _i = 0; _i < 2; ++_i) \
        __builtin_amdgcn_global_load_lds((const unsigned*)((const char*)(gbase) + (voff)[_i]), (LAS unsigned*)(lds + (bufoff) + ldsw + _i * 8192), 16, 0, 0); } while (0)
#define PG8_LDA(dst, b, h) do { _Pragma("unroll") for (int m = 0; m < 4; ++m) _Pragma("unroll") for (int k = 0; k < 2; ++k) dst[m][k] = *(const LAS bf16x8*)(lds + PG8_SA(b, h) + aoff + m * 2048 + k * 1024); } while (0)
#define PG8_LDB(dst, b, h) do { _Pragma("unroll") for (int n = 0; n < 2; ++n) _Pragma("unroll") for (int k = 0; k < 2; ++k) dst[n][k] = *(const LAS bf16x8*)(lds + PG8_SB(b, h) + boff + n * 2048 + k * 1024); } while (0)
#define PG8_MMA(ai, bj, At, Bt) do { __builtin_amdgcn_s_setprio(1); _Pragma("unroll") for (int m = 0; m < 4; ++m) _Pragma("unroll") for (int n = 0; n < 2; ++n) _Pragma("unroll") for (int k = 0; k < 2; ++k) \
        acc[ai][bj][m][n] = __builtin_amdgcn_mfma_f32_16x16x32_bf16(Bt[n][k], At[m][k], acc[ai][bj][m][n], 0, 0, 0); __builtin_amdgcn_s_setprio(0); } while (0)
#define PG8_WAIT_V(n) asm volatile("s_waitcnt vmcnt(" #n ")" ::: "memory")
#define PG8_WAIT_L(n) asm volatile("s_waitcnt lgkmcnt(" #n ")" ::: "memory")
#define PG8_BAR __builtin_amdgcn_s_barrier()
#define PG8_SCHED __builtin_amdgcn_sched_barrier(0)
    Unit cur, nxt; int ui = 0;
    if (!S.next(0, cur)) return;
    f32x4 acc[2][2][4][2];
#pragma unroll
    for (int a = 0; a < 2; ++a)
#pragma unroll
        for (int b = 0; b < 2; ++b)
#pragma unroll
            for (int m = 0; m < 4; ++m)
#pragma unroll
                for (int n = 0; n < 2; ++n) acc[a][b][m][n] = (f32x4){0.f, 0.f, 0.f, 0.f};
    bf16x8 At[4][2], B0[2][2], B1[2][2];
    const char* cA = (const char*)g.A + S.aoff(cur); const char* cB = (const char*)g.Bt + S.boff(cur);
    if constexpr (SP2) {
        PG8_STAGE(PG8_SB(0, 0), cB, voffB); PG8_STAGE(PG8_SB(0, 1), cB + hstepB, voffB); PG8_STAGE(PG8_SA(0, 0), cA, voffA); PG8_STAGE(PG8_SA(0, 1), cA + hstepA, voffA);
        if (wr == 1) PG8_BAR;
        PG8_WAIT_V(2); PG8_BAR;
        PG8_STAGE(PG8_SB(1, 0), cB + kstep, voffB); PG8_STAGE(PG8_SA(1, 0), cA + kstep, voffA); PG8_STAGE(PG8_SB(1, 1), cB + hstepB + kstep, voffB);
        PG8_WAIT_V(6); PG8_BAR;
    } else {
        PG8_STAGE(PG8_SB(0, 0), cB, voffB); PG8_STAGE(PG8_SA(0, 0), cA, voffA); PG8_STAGE(PG8_SB(0, 1), cB + hstepB, voffB); PG8_STAGE(PG8_SA(0, 1), cA + hstepA, voffA);
        if (wr == 1) PG8_BAR;
        PG8_WAIT_V(4); PG8_BAR;
        PG8_STAGE(PG8_SB(1, 0), cB + kstep, voffB); PG8_STAGE(PG8_SA(1, 0), cA + kstep, voffA); PG8_STAGE(PG8_SB(1, 1), cB + hstepB + kstep, voffB);
        PG8_WAIT_V(6); PG8_BAR;
    }
    for (;;) {
        const bool has_next = S.next(ui + 1, nxt);
        const char* nA = has_next ? (const char*)g.A + S.aoff(nxt) : cA; const char* nB = has_next ? (const char*)g.Bt + S.boff(nxt) : cB;
#pragma nounroll
        for (int t = 0; t < nt; t += 2) {
            const bool last = (t == nt - 2);
            const char* a1 = cA + (size_t)(t + 1) * kstep;
            const char* a2 = last ? nA : cA + (size_t)(t + 2) * kstep; const char* b2 = last ? nB : cB + (size_t)(t + 2) * kstep;
            const char* a3 = a2 + kstep; const char* b3 = b2 + kstep;
            if constexpr (SP2) {
            PG8_LDB(B0, 0, 0); PG8_LDB(B1, 0, 1); PG8_SCHED; PG8_LDA(At, 0, 0); PG8_STAGE(PG8_SA(1, 1), a1 + hstepA, voffA);
            PG8_WAIT_V(8); PG8_WAIT_L(0); PG8_BAR; PG8_MMA(0, 0, At, B0); PG8_MMA(0, 1, At, B1); PG8_BAR; PG8_SCHED;
            PG8_LDA(At, 0, 1); PG8_STAGE(PG8_SB(0, 0), b2, voffB); PG8_STAGE(PG8_SB(0, 1), b2 + hstepB, voffB); PG8_STAGE(PG8_SA(0, 0), a2, voffA);
            PG8_WAIT_V(8); PG8_WAIT_L(0); PG8_BAR; PG8_MMA(1, 0, At, B0); PG8_MMA(1, 1, At, B1); PG8_BAR; PG8_SCHED;
            PG8_LDB(B0, 1, 0); PG8_LDB(B1, 1, 1); PG8_SCHED; PG8_LDA(At, 1, 0); PG8_STAGE(PG8_SA(0, 1), a2 + hstepA, voffA);
            PG8_WAIT_V(8); PG8_WAIT_L(0); PG8_BAR; PG8_MMA(0, 0, At, B0); PG8_MMA(0, 1, At, B1); PG8_BAR; PG8_SCHED;
            PG8_LDA(At, 1, 1); PG8_STAGE(PG8_SB(1, 0), b3, voffB); PG8_STAGE(PG8_SB(1, 1), b3 + hstepB, voffB); PG8_STAGE(PG8_SA(1, 0), a3, voffA);
            PG8_WAIT_V(8); PG8_WAIT_L(0); PG8_BAR; PG8_MMA(1, 0, At, B0); PG8_MMA(1, 1, At, B1); PG8_BAR; PG8_SCHED;
            } else {
            PG8_LDB(B0, 0, 0); PG8_SCHED; PG8_LDA(At, 0, 0); PG8_STAGE(PG8_SA(1, 1), a1 + hstepA, voffA);
            PG8_WAIT_L(8); PG8_BAR; PG8_WAIT_L(0); PG8_MMA(0, 0, At, B0); PG8_BAR; PG8_SCHED;
            PG8_LDB(B1, 0, 1); PG8_STAGE(PG8_SB(0, 0), b2, voffB);
            PG8_BAR; PG8_WAIT_L(0); PG8_MMA(0, 1, At, B1); PG8_BAR;
            PG8_LDA(At, 0, 1); PG8_STAGE(PG8_SA(0, 0), a2, voffA);
            PG8_BAR; PG8_WAIT_L(0); PG8_MMA(1, 0, At, B0); PG8_BAR; PG8_SCHED;
            PG8_STAGE(PG8_SB(0, 1), b2 + hstepB, voffB);
            PG8_WAIT_V(6); PG8_BAR; PG8_MMA(1, 1, At, B1); PG8_BAR;
            PG8_LDB(B0, 1, 0); PG8_SCHED; PG8_LDA(At, 1, 0); PG8_STAGE(PG8_SA(0, 1), a2 + hstepA, voffA);
            PG8_WAIT_L(8); PG8_BAR; PG8_WAIT_L(0); PG8_MMA(0, 0, At, B0); PG8_BAR; PG8_SCHED;
            PG8_LDB(B1, 1, 1); PG8_STAGE(PG8_SB(1, 0), b3, voffB);
            PG8_BAR; PG8_WAIT_L(0); PG8_MMA(0, 1, At, B1); PG8_BAR;
            PG8_LDA(At, 1, 1); PG8_STAGE(PG8_SA(1, 0), a3, voffA);
            PG8_BAR; PG8_WAIT_L(0); PG8_MMA(1, 0, At, B0); PG8_BAR; PG8_SCHED;
            PG8_STAGE(PG8_SB(1, 1), b3 + hstepB, voffB);
            PG8_WAIT_V(6); PG8_BAR; PG8_MMA(1, 1, At, B1); PG8_BAR;
            }
        }
        if constexpr (ALIGN_EPI) { if (wr == 0) PG8_BAR; }
        E(acc, cur, wr, wc, fr, fq);
        if (!has_next) break;
#pragma unroll
        for (int a = 0; a < 2; ++a)
#pragma unroll
            for (int b = 0; b < 2; ++b)
#pragma unroll
                for (int m = 0; m < 4; ++m)
#pragma unroll
                    for (int n = 0; n < 2; ++n) acc[a][b][m][n] = (f32x4){0.f, 0.f, 0.f, 0.f};
        cur = nxt; cA = nA; cB = nB; ++ui;
        if constexpr (ALIGN_EPI) { if (wr == 1) PG8_BAR; }
    }
    PG8_WAIT_V(0);
    if constexpr (!ALIGN_EPI) { if (wr == 0) PG8_BAR; }
    PG8_BAR;
#undef PG8_SA
#undef PG8_SB
#undef PG8_STAGE
#undef PG8_LDA
#undef PG8_LDB
#undef PG8_MMA
#undef PG8_WAIT_V
#undef PG8_WAIT_L
#undef PG8_BAR
#undef PG8_SCHED
}
}

struct Args { const void* in[24]; float* out; unsigned char* ws; int ph_lo, ph_hi; };
struct Frame {
    LAS unsigned char* lds; unsigned* ctl; unsigned char* ws;
    int tid, lane, wave, G, bid;
};
#define INF(k) ((const float*)args.in[k])
DI float wave_sum(float v) {
#pragma unroll
    for (int o = 1; o < 64; o <<= 1) v += __shfl_xor(v, o);
    return v;
}

template <class RM>
DI void tr_item(const float* W, int ldS, int Nvalid, bf16* WT, int ldD, int koff, RM rowmap, LAS float* scr, int k0, int n0, int lane) {
    const int nl = n0 + (lane & 31);
    float tv[32]; const float* wp = W + (size_t)(k0 + (lane >> 5)) * ldS + nl; const bool ok = nl < Nvalid;
#pragma unroll
    for (int i = 0; i < 32; ++i) tv[i] = ok ? __builtin_nontemporal_load(wp + (size_t)(2 * i) * ldS) : 0.f;
#pragma unroll
    for (int i = 0; i < 32; ++i) scr[(2 * i + (lane >> 5)) * 33 + (lane & 31)] = tv[i];
    LDS_WAIT(); asm volatile("" ::: "memory");
    const int c = lane & 7;
#pragma unroll
    for (int j = 0; j < 4; ++j) { const int nn = (lane >> 3) + 8 * j, n = n0 + nn; const LAS float* s = scr + (8 * c) * 33 + nn;
        u32x4 o; o.x = pk2(s[0 * 33], s[1 * 33]); o.y = pk2(s[2 * 33], s[3 * 33]); o.z = pk2(s[4 * 33], s[5 * 33]); o.w = pk2(s[6 * 33], s[7 * 33]);
        if (n < Nvalid) *(u32x4*)(WT + (size_t)rowmap(n) * ldD + koff + k0 + 8 * c) = o; }
    LDS_WAIT(); asm volatile("" ::: "memory");
}
struct RmIn { DI int operator()(int n) const { return n < C_PADLO ? n : n + (C_P - C_PADLO); } };
struct RmId { int off; DI int operator()(int n) const { return off + n; } };
struct RmGU { int off; DI int operator()(int n) const { return ((n >> 7) << 8) + off + (n & 127); } };

DI void p0_prologue(Frame& F, const Args& args) {
    LAS float* scr = (LAS float*)(F.lds + F.wave * 16384);
    const int gw = F.bid * 8 + F.wave, NGW = F.G * 8;
    bf16* Win = (bf16*)(F.ws + WS_WIN); bf16* Wout = (bf16*)(F.ws + WS_WOUT); bf16* Wpool = (bf16*)(F.ws + WS_WPOOL); bf16* Wlru = (bf16*)(F.ws + WS_WLRU);
    bf16* Wgu = (bf16*)(F.ws + WS_WGU); bf16* Wdn = (bf16*)(F.ws + WS_WDN);
    constexpr int NB_IN = (NIN + 31) / 32;
    constexpr int I_IN = 32 * NB_IN, I_OUT = 96 * 64, I_POOL = 8 * 16, I_LRU = 2 * 4, I_G = 32 * 172, I_D = 86 * 64;
    constexpr int T_IN = 2 * I_IN, T_OUT = 2 * I_OUT, T_POOL = 8 * I_POOL, T_LRU = 64 * I_LRU, T_G = 2 * I_G, T_D = I_D;
    constexpr int NITEMS = T_IN + T_OUT + T_POOL + T_LRU + T_G + T_D;
    for (int it = gw; it < NITEMS; it += NGW) {
        int r = it;
        if (r < T_IN) { const int l = r / I_IN, q = r % I_IN, kb = q / NB_IN, nb = q % NB_IN;
            tr_item(INF(2) + (size_t)l * DM * NIN, NIN, NIN, Win + (size_t)l * NINP * DM, DM, 0, RmIn{}, scr, 64 * kb, 32 * nb, F.lane); continue; } r -= T_IN;
        if (r < T_OUT) { const int l = r / I_OUT, q = r % I_OUT, kb = q / 64, nb = q % 64;
            tr_item(INF(3) + (size_t)l * MIXW * DM, DM, DM, Wout + (size_t)l * DM * MIXW, MIXW, 0, RmId{0}, scr, 64 * kb, 32 * nb, F.lane); continue; } r -= T_OUT;
        if (r < T_POOL) { const int lg = r / I_POOL, q = r % I_POOL, kb = q / 16, nb = q % 16, l = lg >> 2, g = lg & 3;
            tr_item(INF(4) + (size_t)lg * 512 * 512, 512, 512, Wpool + (size_t)l * 2048 * 512, 512, 0, RmId{g * 512}, scr, 64 * kb, 32 * nb, F.lane); continue; } r -= T_POOL;
        if (r < T_LRU) { const int cmb = r / I_LRU, q = r % I_LRU, kb = q / 4, nb = q % 4, l = cmb >> 5, which = (cmb >> 4) & 1, n = cmb & 15;
            const float* src = (which ? INF(10) : INF(8)) + ((size_t)l * 16 + n) * 128 * 128;
            tr_item(src, 128, 128, Wlru + (size_t)l * 4096 * 256, 256, (n & 1) * 128, RmId{n * 256 + which * 128}, scr, 64 * kb, 32 * nb, F.lane); continue; } r -= T_LRU;
        if (r < T_G) { const int which = r / I_G, q = r % I_G, kb = q / 172, nb = q % 172;
            tr_item(which ? INF(18) : INF(17), DFF, DFF, Wgu, DM, 0, RmGU{which * 128}, scr, 64 * kb, 32 * nb, F.lane); continue; } r -= T_G;
        { const int kb = r / 64, nb = r % 64; tr_item(INF(19), DM, DM, Wdn, DFF, 0, RmId{0}, scr, 64 * kb, 32 * nb, F.lane); }
    }
    const int gt = F.bid * 512 + F.tid, NT = F.G * 512;
    for (int i = gt; i < 2 * 4096 * 16; i += NT) { const int row = i >> 4, ch = i & 15, n = (row & 4095) >> 8;
        *(u32x4*)(Wlru + (size_t)row * 256 + ((n + 1) & 1) * 128 + ch * 8) = (u32x4){0u, 0u, 0u, 0u}; }
    float* cosA = (float*)(F.ws + WS_COSA); float* sinA = (float*)(F.ws + WS_SINA); float* cosI = (float*)(F.ws + WS_COSI); float* sinI = (float*)(F.ws + WS_SINI);
    for (int i = gt; i < MTOK * 96; i += NT) {
        const int tok = i / 96, j = i % 96; const bool isA = j < 64; const int fi = isA ? j : j - 64; const double dim = isA ? 128.0 : 64.0;
        const float inv = (float)pow(10000.0, -(double)(2 * fi) / dim);
        const float ang = (float)((const int*)args.in[1])[tok] * inv; const double a = (double)ang; const double nrev = rint(a * 0.15915494309189535); const double rr = a - nrev * 6.283185307179586;
        const float cv = (float)cos(rr), sv = (float)sin(rr);
        if (isA) { cosA[tok * 64 + fi] = cv; sinA[tok * 64 + fi] = sv; } else { cosI[tok * 32 + fi] = cv; sinI[tok * 32 + fi] = sv; }
    }
    float* c8 = (float*)(F.ws + WS_LRUC);
    for (int i = gt; i < 2 * DM; i += NT) { const float lam = INF(12)[i]; c8[i] = 8.0f * log1pf(expf(-lam)); }
    bf16* xb = (bf16*)(F.ws + WS_XB);
    for (int i = gt; i < MTOK * DM / 8; i += NT) { const f32x4 a = *(const f32x4*)(INF(0) + (size_t)i * 8), b = *(const f32x4*)(INF(0) + (size_t)i * 8 + 4);
        u32x4 o; o.x = pk2(a[0], a[1]); o.y = pk2(a[2], a[3]); o.z = pk2(b[0], b[1]); o.w = pk2(b[2], b[3]); *(u32x4*)(xb + (size_t)i * 8) = o; }
}
DI void p_convert_moe(Frame& F, const Args& args) {
    LAS float* scr = (LAS float*)(F.lds + F.wave * 16384);
    const int gw = F.bid * 8 + F.wave, NGW = F.G * 8;
    bf16* Wgu = (bf16*)(F.ws + WS_MWGU); bf16* Wdn = (bf16*)(F.ws + WS_MWDN);
    constexpr int I_G = 32 * 224, I_D = 112 * 64;
    constexpr int T_G = 16 * I_G, T_D = 8 * I_D;
    for (int it = gw; it < T_G + T_D; it += NGW) {
        int r = it;
        if (r < T_G) { const int ew = r / I_G, q = r % I_G, kb = q / 224, nb = q % 224, e = ew >> 1, which = ew & 1;
            tr_item((which ? INF(22) : INF(21)) + (size_t)e * DM * DEXP, DEXP, DEXP, Wgu + (size_t)e * 2 * DEXP * DM, DM, 0, RmGU{which * 128}, scr, 64 * kb, 32 * nb, F.lane); continue; } r -= T_G;
        { const int e = r / I_D, q = r % I_D, kb = q / 64, nb = q % 64;
          tr_item(INF(23) + (size_t)e * DEXP * DM, DM, DM, Wdn + (size_t)e * DM * DEXP, DEXP, 0, RmId{0}, scr, 64 * kb, 32 * nb, F.lane); }
    }
}

DI void ld8(const bf16* p, float (&v)[8]) { const u32x4 w = *(const u32x4*)p; v[0] = bflo(w.x); v[1] = bfhi(w.x); v[2] = bflo(w.y); v[3] = bfhi(w.y); v[4] = bflo(w.z); v[5] = bfhi(w.z); v[6] = bflo(w.w); v[7] = bfhi(w.w); }
DI void st8(bf16* p, const float (&v)[8]) { u32x4 o; o.x = pk2(v[0], v[1]); o.y = pk2(v[2], v[3]); o.z = pk2(v[4], v[5]); o.w = pk2(v[6], v[7]); *(u32x4*)p = o; }

template <int G>
DI void pool_group(const bf16* proj, bf16* diff, int gt, int NT) {
    constexpr int W = 2 << G;
#pragma unroll 2
    for (int it = gt; it < MTOK * 64; it += NT) {
        const int tok = it >> 6, c = G * 512 + (it & 63) * 8, tpos = tok & (SEQ - 1), cnt = (tpos + 1) < W ? (tpos + 1) : W;
        const bf16* pp = proj + (size_t)tok * NINP + C_P + c;
        u32x4 r[W];
#pragma unroll
        for (int j = 0; j < W; ++j) r[j] = *(const u32x4*)(pp - (size_t)(j < cnt ? j : 0) * NINP);
        float sum[8];
#pragma unroll
        for (int i = 0; i < 8; ++i) sum[i] = 0.f;
#pragma unroll
        for (int j = 0; j < W; ++j) { const float m = j < cnt ? 1.f : 0.f;
            sum[0] += m * bflo(r[j].x); sum[1] += m * bfhi(r[j].x); sum[2] += m * bflo(r[j].y); sum[3] += m * bfhi(r[j].y);
            sum[4] += m * bflo(r[j].z); sum[5] += m * bfhi(r[j].z); sum[6] += m * bflo(r[j].w); sum[7] += m * bfhi(r[j].w); }
        const float rc = 1.0f / (float)cnt; float v[8];
        v[0] = sum[0] * rc - bflo(r[0].x); v[1] = sum[1] * rc - bfhi(r[0].x); v[2] = sum[2] * rc - bflo(r[0].y); v[3] = sum[3] * rc - bfhi(r[0].y);
        v[4] = sum[4] * rc - bflo(r[0].z); v[5] = sum[5] * rc - bfhi(r[0].z); v[6] = sum[6] * rc - bflo(r[0].w); v[7] = sum[7] * rc - bfhi(r[0].w);
        st8(diff + (size_t)tok * DM + c, v);
    }
}
DI void p2_prep(Frame& F, const Args& args, int layer) {
    bf16* proj = (bf16*)(F.ws + WS_PROJ); bf16* diff = (bf16*)(F.ws + WS_DIFF); bf16* xc = (bf16*)(F.ws + WS_XC);
    const float* cosA = (const float*)(F.ws + WS_COSA); const float* sinA = (const float*)(F.ws + WS_SINA); const float* cosI = (const float*)(F.ws + WS_COSI); const float* sinI = (const float*)(F.ws + WS_SINI);
    const int gt = F.bid * 512 + F.tid, NT = F.G * 512;
#pragma unroll 2
    for (int it = gt; it < MTOK * 256; it += NT) {
        const int tok = it >> 8, j = it & 255; if (j >= 228) continue;
        int col, half, d; const float *ct, *st;
        if (j < 128) { d = (j & 7) * 8; col = C_Q + (j >> 3) * 128 + d; half = 64; ct = cosA + tok * 64 + d; st = sinA + tok * 64 + d; }
        else if (j < 160) { const int jj = j - 128; d = (jj & 7) * 8; col = C_K + (jj >> 3) * 128 + d; half = 64; ct = cosA + tok * 64 + d; st = sinA + tok * 64 + d; }
        else if (j < 224) { const int jj = j - 160; d = (jj & 3) * 8; col = C_QI + (jj >> 2) * 64 + d; half = 32; ct = cosI + tok * 32 + d; st = sinI + tok * 32 + d; }
        else { d = (j - 224) * 8; col = C_KI + d; half = 32; ct = cosI + tok * 32 + d; st = sinI + tok * 32 + d; }
        bf16* p1 = proj + (size_t)tok * NINP + col; bf16* p2 = p1 + half;
        float x1[8], x2[8], y1[8], y2[8]; ld8(p1, x1); ld8(p2, x2);
        const f32x4 c0 = *(const f32x4*)ct, c1 = *(const f32x4*)(ct + 4), s0 = *(const f32x4*)st, s1 = *(const f32x4*)(st + 4);
#pragma unroll
        for (int i = 0; i < 8; ++i) { const float c = i < 4 ? c0[i & 3] : c1[i & 3], s = i < 4 ? s0[i & 3] : s1[i & 3]; y1[i] = x1[i] * c - x2[i] * s; y2[i] = x2[i] * c + x1[i] * s; }
        st8(p1, y1); st8(p2, y2);
    }
    pool_group<0>(proj, diff, gt, NT); pool_group<1>(proj, diff, gt, NT); pool_group<2>(proj, diff, gt, NT); pool_group<3>(proj, diff, gt, NT);
    const float* cw = INF(6) + (size_t)layer * 4 * DM; const float* cb = INF(7) + (size_t)layer * DM;
#pragma unroll 2
    for (int it = gt; it < MTOK * 256; it += NT) {
        const int tok = it >> 8, c = (it & 255) * 8, tpos = tok & (SEQ - 1);
        const bf16* px = proj + (size_t)tok * NINP + C_XR + c;
        u32x4 r[4];
#pragma unroll
        for (int jj = 0; jj < 4; ++jj) { const int back = 3 - jj; r[jj] = *(const u32x4*)(px - (size_t)(tpos >= back ? back : 0) * NINP); }
        float acc[8]; const f32x4 b0 = *(const f32x4*)(cb + c), b1 = *(const f32x4*)(cb + c + 4);
#pragma unroll
        for (int i = 0; i < 8; ++i) acc[i] = i < 4 ? b0[i & 3] : b1[i & 3];
#pragma unroll
        for (int jj = 0; jj < 4; ++jj) { const float m = (tpos >= 3 - jj) ? 1.f : 0.f;
            const f32x4 w0 = *(const f32x4*)(cw + jj * DM + c) * m, w1 = *(const f32x4*)(cw + jj * DM + c + 4) * m;
            acc[0] += bflo(r[jj].x) * w0[0]; acc[1] += bfhi(r[jj].x) * w0[1]; acc[2] += bflo(r[jj].y) * w0[2]; acc[3] += bfhi(r[jj].y) * w0[3];
            acc[4] += bflo(r[jj].z) * w1[0]; acc[5] += bfhi(r[jj].z) * w1[1]; acc[6] += bflo(r[jj].w) * w1[2]; acc[7] += bfhi(r[jj].w) * w1[3]; }
        st8(xc + (size_t)tok * DM + c, acc);
    }
}

DI void p3_indexer(Frame& F) {
    const bf16* proj = (const bf16*)(F.ws + WS_PROJ); float* sc = (float*)(F.ws + WS_SC);
    const int gw = F.bid * 8 + F.wave, NGW = F.G * 8, l15 = F.lane & 15, l4 = F.lane >> 4;
    for (int u = gw; u < BATCH * 576; u += NGW) {
        const int b = u / 576, r = u % 576; int g8 = 0;
#pragma unroll
        for (int k = 1; k < 8; ++k) g8 = (r >= 8 * k * (k + 1)) ? k : g8;
        const int rr = r - 8 * g8 * (g8 + 1), sp = rr % (g8 + 1), qq = rr / (g8 + 1), qb16 = g8 * 16 + qq, c = qb16 >> 2;
        const int limit = (c + 1) * 64, kbeg = sp * 256, kend = (kbeg + 256) < limit ? (kbeg + 256) : limit;
        const int qtok = b * SEQ + qb16 * 16 + l15;
        const bf16* qrow = proj + (size_t)qtok * NINP;
        bf16x8 qf[16][2]; float w[16];
        { const u32x4 w0 = *(const u32x4*)(qrow + C_WI), w1 = *(const u32x4*)(qrow + C_WI + 8); const float s = 0.125f * 0.25f;
          w[0] = bflo(w0.x) * s; w[1] = bfhi(w0.x) * s; w[2] = bflo(w0.y) * s; w[3] = bfhi(w0.y) * s; w[4] = bflo(w0.z) * s; w[5] = bfhi(w0.z) * s; w[6] = bflo(w0.w) * s; w[7] = bfhi(w0.w) * s;
          w[8] = bflo(w1.x) * s; w[9] = bfhi(w1.x) * s; w[10] = bflo(w1.y) * s; w[11] = bfhi(w1.y) * s; w[12] = bflo(w1.z) * s; w[13] = bfhi(w1.z) * s; w[14] = bflo(w1.w) * s; w[15] = bfhi(w1.w) * s; }
#pragma unroll
        for (int h = 0; h < 16; ++h)
#pragma unroll
            for (int ks = 0; ks < 2; ++ks) qf[h][ks] = *(const bf16x8*)(qrow + C_QI + h * 64 + ks * 32 + l4 * 8);
        for (int k0 = kbeg; k0 < kend; k0 += 16) {
            const bf16* krow = proj + (size_t)(b * SEQ + k0 + l15) * NINP + C_KI + l4 * 8;
            const bf16x8 ka0 = *(const bf16x8*)krow, ka1 = *(const bf16x8*)(krow + 32);
            f32x4 tot = {0.f, 0.f, 0.f, 0.f};
#pragma unroll
            for (int h = 0; h < 16; ++h) { f32x4 s = {0.f, 0.f, 0.f, 0.f};
                s = __builtin_amdgcn_mfma_f32_16x16x32_bf16(ka0, qf[h][0], s, 0, 0, 0); s = __builtin_amdgcn_mfma_f32_16x16x32_bf16(ka1, qf[h][1], s, 0, 0, 0);
#pragma unroll
                for (int j = 0; j < 4; ++j) tot[j] += w[h] * fmaxf(s[j], 0.f); }
            *(f32x4*)(sc + (size_t)qtok * SEQ + k0 + 4 * l4) = tot;
        }
    }
}

DI void p4_select(Frame& F) {
    const float* sc = (const float*)(F.ws + WS_SC); unsigned* mask = (unsigned*)(F.ws + WS_MASK);
    const int gw = F.bid * 8 + F.wave, NGW = F.G * 8, lane = F.lane;
    for (int tok = gw; tok < MTOK; tok += NGW) {
        const int tpos = tok & (SEQ - 1), limit = ((tpos >> 6) + 1) * 64, nw = limit >> 5;
        unsigned mw = 0u;
        if (limit <= 256) { mw = lane < nw ? 0xffffffffu : 0u; }
        else {
            unsigned key[32];
            if (lane < nw) { const float* p = sc + (size_t)tok * SEQ + lane * 32;
#pragma unroll
                for (int q = 0; q < 8; ++q) { const f32x4 v = *(const f32x4*)(p + 4 * q);
#pragma unroll
                    for (int j = 0; j < 4; ++j) { const unsigned uu = __float_as_uint(v[j]); key[4 * q + j] = (uu & 0x80000000u) ? ~uu : (uu | 0x80000000u); } } }
            else {
#pragma unroll
                for (int j = 0; j < 32; ++j) key[j] = 0u; }
            unsigned T = 0u; bool exact = false;
            for (int bit = 31; bit >= 0; --bit) {
                const unsigned cand = T | (1u << bit); int cnt = 0;
#pragma unroll
                for (int j = 0; j < 32; ++j) cnt += __popcll(__ballot(key[j] >= cand));
                if (cnt >= 256) { T = cand; if (cnt == 256) { exact = true; break; } }
            }
            unsigned gtw = 0u, eqw = 0u;
#pragma unroll
            for (int j = 0; j < 32; ++j) { gtw |= (key[j] > T) ? (1u << j) : 0u; eqw |= (key[j] == T) ? (1u << j) : 0u; }
            if (exact) { mw = gtw | eqw; }
            else {
                int ngt = 0;
#pragma unroll
                for (int j = 0; j < 32; ++j) ngt += __popcll(__ballot(key[j] > T));
                const int need = 256 - ngt; const int el = __popc(eqw);
                int pre = el;
#pragma unroll
                for (int o = 1; o < 64; o <<= 1) { const int t = __shfl_up(pre, o); pre += (lane >= o) ? t : 0; }
                int take = need - (pre - el); take = take < 0 ? 0 : (take > el ? el : take);
                unsigned sel = 0u, rem = eqw;
                for (int t = 0; t < 32; ++t) { if (t < take) { const unsigned low = rem & (0u - rem); sel |= low; rem ^= low; } }
                mw = gtw | sel;
            }
        }
        mask[(size_t)tok * 64 + lane] = mw;
    }
}

DI void p4_lru_pass1(Frame& F) {
    const float* A = (const float*)(F.ws + WS_A); const float* B = (const float*)(F.ws + WS_B); float* CP = (float*)(F.ws + WS_CARRY); float* CH = CP + BATCH * 32 * DM;
    for (int u = F.bid; u < BATCH * 32 * 2; u += F.G) {
        const int hh = u & 1, j = (u >> 1) & 31, b = u >> 6, c = hh * 1024 + 2 * F.tid;
        const size_t base = ((size_t)b * SEQ + j * 64) * DM + c;
        f32x2 P = {1.f, 1.f}, H = {0.f, 0.f};
#pragma unroll 8
        for (int t = 0; t < 64; ++t) { const f32x2 a = *(const f32x2*)(A + base + (size_t)t * DM), bb = *(const f32x2*)(B + base + (size_t)t * DM); H = a * H + bb; P = P * a; }
        *(f32x2*)(CP + ((size_t)b * 32 + j) * DM + c) = P; *(f32x2*)(CH + ((size_t)b * 32 + j) * DM + c) = H;
    }
}
DI void p5_lru_pass2(Frame& F) {
    const float* A = (const float*)(F.ws + WS_A); const float* B = (const float*)(F.ws + WS_B); const float* CP = (const float*)(F.ws + WS_CARRY); const float* CH = CP + BATCH * 32 * DM;
    const bf16* proj = (const bf16*)(F.ws + WS_PROJ); bf16* mrg = (bf16*)(F.ws + WS_MRG);
    for (int u = F.bid; u < BATCH * 32 * 2; u += F.G) {
        const int hh = u & 1, j = (u >> 1) & 31, b = u >> 6, c = hh * 1024 + 2 * F.tid;
        f32x2 h = {0.f, 0.f};
        for (int jj = 0; jj < j; ++jj) { const f32x2 p = *(const f32x2*)(CP + ((size_t)b * 32 + jj) * DM + c), q = *(const f32x2*)(CH + ((size_t)b * 32 + jj) * DM + c); h = p * h + q; }
        const size_t tok0 = (size_t)b * SEQ + j * 64;
#pragma unroll 4
        for (int t = 0; t < 64; ++t) { const size_t tok = tok0 + t; const f32x2 a = *(const f32x2*)(A + tok * DM + c), bb = *(const f32x2*)(B + tok * DM + c); h = a * h + bb;
            const unsigned gr = *(const unsigned*)(proj + tok * NINP + C_GR + c), gg = *(const unsigned*)(proj + tok * NINP + C_G + 4096 + c);
            const float y0 = h[0] * gelu_tanh_(bflo(gr)) * sigmoidf_(bflo(gg)), y1 = h[1] * gelu_tanh_(bfhi(gr)) * sigmoidf_(bfhi(gg));
            *(unsigned*)(mrg + tok * MIXW + 4096 + c) = pk2(y0, y1); }
    }
}

constexpr int KS_STRIDE = 272, VT_STRIDE = 136;
constexpr int ATT_KS = 0, ATT_VT = 64 * KS_STRIDE;
DI void p5_attention(Frame& F) {
    const bf16* proj = (const bf16*)(F.ws + WS_PROJ); const unsigned* mask = (const unsigned*)(F.ws + WS_MASK); bf16* mrg = (bf16*)(F.ws + WS_MRG);
    LAS unsigned char* Ks = F.lds + ATT_KS; LAS unsigned char* Vt = F.lds + ATT_VT;
    const int lane = F.lane, l31 = lane & 31, hf = lane >> 5, wave = F.wave, hh = wave >> 1, qh = wave & 1, tid = F.tid;
    const float sc2 = 0.08838834764831845f * 1.4426950408889634f;
    for (int u = F.bid; u < BATCH * 16 * 4; u += F.G) {
        const int g = u & 3, cp = (u >> 2) & 15, b = u >> 6;
        for (int half = 0; half < 2; ++half) {
            const int c = half ? (31 - cp) : cp, nkt = c + 1, head = g * 4 + hh;
            const int qtok = b * SEQ + c * 64 + qh * 32 + l31;
            const bf16* qrow = proj + (size_t)qtok * NINP + C_Q + head * 128 + hf * 8;
            bf16x8 qf[8];
#pragma unroll
            for (int ks = 0; ks < 8; ++ks) qf[ks] = *(const bf16x8*)(qrow + ks * 16);
            f32x16 o[4];
#pragma unroll
            for (int db = 0; db < 4; ++db)
#pragma unroll
                for (int i = 0; i < 16; ++i) o[db][i] = 0.f;
            float mrun = -1e30f, lrun = 0.f;
            const int sr0 = tid >> 4, sch = tid & 15;
            const bf16* kg = proj + (size_t)(b * SEQ + sr0) * NINP + C_K + g * 128 + sch * 8;
            const bf16* vg = proj + (size_t)(b * SEQ + sr0) * NINP + C_V + g * 128 + sch * 8;
            u32x4 kr0 = *(const u32x4*)kg, kr1 = *(const u32x4*)(kg + (size_t)32 * NINP), vr0 = *(const u32x4*)vg, vr1 = *(const u32x4*)(vg + (size_t)32 * NINP);
            const unsigned* mrow = mask + (size_t)qtok * 64;
            unsigned mw0 = mrow[0], mw1 = mrow[1];
            for (int kt = 0; kt < nkt; ++kt) {
                __syncthreads();
                *(LAS u32x4*)(Ks + sr0 * KS_STRIDE + sch * 16) = kr0; *(LAS u32x4*)(Ks + (sr0 + 32) * KS_STRIDE + sch * 16) = kr1;
                { const unsigned vv0[4] = {vr0.x, vr0.y, vr0.z, vr0.w}, vv1[4] = {vr1.x, vr1.y, vr1.z, vr1.w};
#pragma unroll
                  for (int i = 0; i < 4; ++i) { LAS unsigned char* d0 = Vt + (sch * 8 + 2 * i) * VT_STRIDE;
                      *(LAS bf16*)(d0 + sr0 * 2) = (bf16)(vv0[i] & 0xffffu); *(LAS bf16*)(d0 + VT_STRIDE + sr0 * 2) = (bf16)(vv0[i] >> 16);
                      *(LAS bf16*)(d0 + (sr0 + 32) * 2) = (bf16)(vv1[i] & 0xffffu); *(LAS bf16*)(d0 + VT_STRIDE + (sr0 + 32) * 2) = (bf16)(vv1[i] >> 16); } }
                __syncthreads();
                const unsigned cm0 = mw0, cm1 = mw1;
                if (kt + 1 < nkt) { const size_t adv = (size_t)(kt + 1) * 64 * NINP;
                    kr0 = *(const u32x4*)(kg + adv); kr1 = *(const u32x4*)(kg + adv + (size_t)32 * NINP); vr0 = *(const u32x4*)(vg + adv); vr1 = *(const u32x4*)(vg + adv + (size_t)32 * NINP);
                    mw0 = mrow[2 * kt + 2]; mw1 = mrow[2 * kt + 3]; }
                f32x16 s0, s1;
#pragma unroll
                for (int i = 0; i < 16; ++i) { s0[i] = 0.f; s1[i] = 0.f; }
#pragma unroll
                for (int ks = 0; ks < 8; ++ks) {
                    const bf16x8 ka = *(const LAS bf16x8*)(Ks + l31 * KS_STRIDE + ks * 32 + hf * 16);
                    const bf16x8 kb = *(const LAS bf16x8*)(Ks + (32 + l31) * KS_STRIDE + ks * 32 + hf * 16);
                    s0 = __builtin_amdgcn_mfma_f32_32x32x16_bf16(ka, qf[ks], s0, 0, 0, 0);
                    s1 = __builtin_amdgcn_mfma_f32_32x32x16_bf16(kb, qf[ks], s1, 0, 0, 0);
                }
                const unsigned sm0 = cm0 >> (4 * hf), sm1 = cm1 >> (4 * hf);
                float tmax = -INFINITY;
#pragma unroll
                for (int i = 0; i < 16; ++i) { const unsigned bit = 1u << ((i & 3) + 8 * (i >> 2));
                    s0[i] = (sm0 & bit) ? s0[i] * sc2 : -INFINITY; s1[i] = (sm1 & bit) ? s1[i] * sc2 : -INFINITY; tmax = fmaxf(tmax, fmaxf(s0[i], s1[i])); }
                tmax = fmaxf(tmax, __shfl_xor(tmax, 32));
                const float mnew = fmaxf(mrun, tmax), alpha = exp2f(mrun - mnew); mrun = mnew;
                float psum = 0.f;
#pragma unroll
                for (int i = 0; i < 16; ++i) { s0[i] = exp2f(s0[i] - mnew); s1[i] = exp2f(s1[i] - mnew); psum += s0[i] + s1[i]; }
                lrun = lrun * alpha + psum;
#pragma unroll
                for (int db = 0; db < 4; ++db)
#pragma unroll
                    for (int i = 0; i < 16; ++i) o[db][i] *= alpha;
#pragma unroll
                for (int kb = 0; kb < 2; ++kb)
#pragma unroll
                    for (int s = 0; s < 2; ++s) {
                        u32x4 pw;
                        if (kb == 0) { pw.x = pk2(s0[8 * s], s0[8 * s + 1]); pw.y = pk2(s0[8 * s + 2], s0[8 * s + 3]); pw.z = pk2(s0[8 * s + 4], s0[8 * s + 5]); pw.w = pk2(s0[8 * s + 6], s0[8 * s + 7]); }
                        else { pw.x = pk2(s1[8 * s], s1[8 * s + 1]); pw.y = pk2(s1[8 * s + 2], s1[8 * s + 3]); pw.z = pk2(s1[8 * s + 4], s1[8 * s + 5]); pw.w = pk2(s1[8 * s + 6], s1[8 * s + 7]); }
                        const bf16x8 pf = __builtin_bit_cast(bf16x8, pw);
#pragma unroll
                        for (int db = 0; db < 4; ++db) {
                            const LAS unsigned char* vp = Vt + (db * 32 + l31) * VT_STRIDE + (kb * 32 + 16 * s + 4 * hf) * 2;
                            const u32x2 lo = *(const LAS u32x2*)vp, hi = *(const LAS u32x2*)(vp + 16);
                            const u32x4 vw = {lo.x, lo.y, hi.x, hi.y};
                            o[db] = __builtin_amdgcn_mfma_f32_32x32x16_bf16(__builtin_bit_cast(bf16x8, vw), pf, o[db], 0, 0, 0);
                        }
                    }
            }
            const float ltot = lrun + __shfl_xor(lrun, 32), rl = 1.0f / ltot;
            const bf16* grow = proj + (size_t)qtok * NINP + C_G + head * 128; bf16* orow = mrg + (size_t)qtok * MIXW + head * 128;
#pragma unroll
            for (int db = 0; db < 4; ++db)
#pragma unroll
                for (int q4 = 0; q4 < 4; ++q4) { const int d0 = db * 32 + q4 * 8 + hf * 4; const u32x2 gv = *(const u32x2*)(grow + d0);
                    u32x2 w; w.x = pk2(o[db][4 * q4] * rl * sigmoidf_(bflo(gv.x)), o[db][4 * q4 + 1] * rl * sigmoidf_(bfhi(gv.x)));
                    w.y = pk2(o[db][4 * q4 + 2] * rl * sigmoidf_(bflo(gv.y)), o[db][4 * q4 + 3] * rl * sigmoidf_(bfhi(gv.y)));
                    *(u32x2*)(orow + d0) = w; }
        }
    }
    __syncthreads();
}

template <int MODE, bool ROUTE, bool WRITE_BF>
DI void p_layernorm(Frame& F, const Args& args, const float* src, const float* gam, const float* bet, float* outf, bf16* outb) {
    const int gw = F.bid * 8 + F.wave, NGW = F.G * 8, lane = F.lane;
    const unsigned* rt = (const unsigned*)(F.ws + WS_ROUTE); unsigned* rtw = (unsigned*)(F.ws + WS_ROUTE);
    LAS float* wr_l = (LAS float*)F.lds;
    LAS unsigned* cl = (LAS unsigned*)(F.lds + 65536);
    if (ROUTE) { for (int i = F.tid; i < DM * NEXP / 4; i += 512) *(LAS f32x4*)(wr_l + 4 * i) = *(const f32x4*)(INF(20) + 4 * i); if (F.tid < 8) cl[F.tid] = 0u; __syncthreads(); }
#define LN_COL(jj) (MODE == 1 ? (8 * lane + 512 * ((jj) >> 1) + 4 * ((jj) & 1)) : (4 * lane + 256 * (jj)))
    for (int row = gw; row < MTOK; row += NGW) {
        f32x4 v[8]; float s = 0.f;
        if (MODE == 0) {
#pragma unroll
            for (int j = 0; j < 8; ++j) v[j] = *(const f32x4*)(src + (size_t)row * DM + LN_COL(j));
        } else {
            const unsigned r0 = rt[RT_ROW + 2 * row], r1 = rt[RT_ROW + 2 * row + 1]; const float w0 = __uint_as_float(rt[RT_W + 2 * row]), w1 = __uint_as_float(rt[RT_W + 2 * row + 1]);
            const bf16* yb = (const bf16*)(F.ws + WS_YB);
            u32x4 pa[4][4], pb[4][4];
#pragma unroll
            for (int j = 0; j < 4; ++j)
#pragma unroll
                for (int ks = 0; ks < 4; ++ks) { pa[j][ks] = *(const u32x4*)(yb + ((size_t)ks * MOE_ROWS_MAX + r0) * DM + 8 * lane + 512 * j); pb[j][ks] = *(const u32x4*)(yb + ((size_t)ks * MOE_ROWS_MAX + r1) * DM + 8 * lane + 512 * j); }
#pragma unroll
            for (int j = 0; j < 4; ++j) { f32x4 a0 = {0.f, 0.f, 0.f, 0.f}, a1 = a0, b0 = a0, b1 = a0;
#pragma unroll
                for (int ks = 0; ks < 4; ++ks) { const u32x4 a = pa[j][ks], b = pb[j][ks];
                    a0 += (f32x4){bflo(a.x), bfhi(a.x), bflo(a.y), bfhi(a.y)}; a1 += (f32x4){bflo(a.z), bfhi(a.z), bflo(a.w), bfhi(a.w)};
                    b0 += (f32x4){bflo(b.x), bfhi(b.x), bflo(b.y), bfhi(b.y)}; b1 += (f32x4){bflo(b.z), bfhi(b.z), bflo(b.w), bfhi(b.w)}; }
                v[2 * j] = *(const f32x4*)(src + (size_t)row * DM + LN_COL(2 * j)) * ALPHA + a0 * w0 + b0 * w1;
                v[2 * j + 1] = *(const f32x4*)(src + (size_t)row * DM + LN_COL(2 * j + 1)) * ALPHA + a1 * w0 + b1 * w1; }
        }
#pragma unroll
        for (int j = 0; j < 8; ++j) s += (v[j][0] + v[j][1]) + (v[j][2] + v[j][3]);
        const float mean = wave_sum(s) * (1.f / DM); float s2 = 0.f;
#pragma unroll
        for (int j = 0; j < 8; ++j) { v[j] = v[j] - mean; s2 += (v[j][0] * v[j][0] + v[j][1] * v[j][1]) + (v[j][2] * v[j][2] + v[j][3] * v[j][3]); }
        const float rstd = 1.0f / sqrtf(wave_sum(s2) * (1.f / DM) + LN_EPS);
        float lg[8];
#pragma unroll
        for (int e = 0; e < 8; ++e) lg[e] = 0.f;
#pragma unroll
        for (int j = 0; j < 8; ++j) { const int cc = LN_COL(j); const f32x4 gv = *(const f32x4*)(gam + cc), bv = *(const f32x4*)(bet + cc);
            const f32x4 y = v[j] * rstd * gv + bv; *(f32x4*)(outf + (size_t)row * DM + cc) = y;
            if (WRITE_BF) { u32x2 w; w.x = pk2(y[0], y[1]); w.y = pk2(y[2], y[3]); *(u32x2*)(outb + (size_t)row * DM + cc) = w; }
            if (ROUTE) {
#pragma unroll
                for (int i = 0; i < 4; ++i) { const LAS float* wp = wr_l + (size_t)(cc + i) * 8; const f32x4 wa = *(const LAS f32x4*)wp, wb = *(const LAS f32x4*)(wp + 4); const float xv = y[i];
                    lg[0] += xv * wa[0]; lg[1] += xv * wa[1]; lg[2] += xv * wa[2]; lg[3] += xv * wa[3]; lg[4] += xv * wb[0]; lg[5] += xv * wb[1]; lg[6] += xv * wb[2]; lg[7] += xv * wb[3]; }
            }
            asm volatile("" ::: "memory"); }
        if (ROUTE) {
#pragma unroll
            for (int e = 0; e < 8; ++e) lg[e] = wave_sum(lg[e]);
            int e0 = 0; float l0 = lg[0];
#pragma unroll
            for (int e = 1; e < 8; ++e) if (lg[e] > l0) { l0 = lg[e]; e0 = e; }
            int e1 = 0; float l1 = -INFINITY;
#pragma unroll
            for (int e = 0; e < 8; ++e) if (e != e0 && lg[e] > l1) { l1 = lg[e]; e1 = e; }
            const float p1 = 1.0f / (1.0f + expf(l0 - l1)), p0 = 1.0f - p1;
            if (lane == 0) { const unsigned sl0 = __hip_atomic_fetch_add(cl + e0, 1u, __ATOMIC_RELAXED, __HIP_MEMORY_SCOPE_WORKGROUP), sl1 = __hip_atomic_fetch_add(cl + e1, 1u, __ATOMIC_RELAXED, __HIP_MEMORY_SCOPE_WORKGROUP);
                rtw[RT_E + 2 * row] = (unsigned)e0; rtw[RT_E + 2 * row + 1] = (unsigned)e1; rtw[RT_SLOT + 2 * row] = sl0; rtw[RT_SLOT + 2 * row + 1] = sl1;
                rtw[RT_W + 2 * row] = __float_as_uint(p0); rtw[RT_W + 2 * row + 1] = __float_as_uint(p1); }
        }
    }
#undef LN_COL
    if (ROUTE) { __syncthreads(); const int t2 = F.wave * 64 + lane_id_(); if (t2 < 8) rtw[RT_WGC + F.bid * 8 + t2] = cl[t2]; __syncthreads(); }
}

DI void p_moe_gather(Frame& F) {
    unsigned* rt = (unsigned*)(F.ws + WS_ROUTE);
    const bf16* x1b = (const bf16*)(F.ws + WS_X1B); bf16* am = (bf16*)(F.ws + WS_AMOE);
    LAS unsigned* pre = (LAS unsigned*)F.lds;
    LAS unsigned* tot = pre + 2048;
    const int lane = F.lane;
    __syncthreads();
    { const int e = F.wave; unsigned c[4]; unsigned s = 0u;
#pragma unroll
      for (int i = 0; i < 4; ++i) { const int b = 4 * lane + i; c[i] = b < F.G ? rt[RT_WGC + b * 8 + e] : 0u; s += c[i]; }
      unsigned inc = s;
#pragma unroll
      for (int o = 1; o < 64; o <<= 1) { const unsigned t = __shfl_up(inc, o); inc += (lane >= o) ? t : 0u; }
      unsigned ex = inc - s;
#pragma unroll
      for (int i = 0; i < 4; ++i) { pre[(4 * lane + i) * 8 + e] = ex; ex += c[i]; }
      if (lane == 63) tot[e] = inc; }
    __syncthreads();
    if (F.tid == 0) { unsigned t = 0u; for (int e = 0; e < 8; ++e) { tot[8 + e] = t; t += (tot[e] + 255u) >> 8; } }
    __syncthreads();
    if (F.bid == 0 && F.tid < 8) F.ctl[CW_CNT + F.tid] = tot[F.tid];
    const int gw = F.bid * 8 + F.wave, NGW = F.G * 8;
    for (int a = gw; a < MTOK * 2; a += NGW) {
        const int tok = a >> 1; const int e = (int)rt[RT_E + a], slot = (int)rt[RT_SLOT + a];
        const int bsrc = (tok % NGW) >> 3;
        const int row = (int)tot[8 + e] * 256 + (int)pre[bsrc * 8 + e] + slot;
        const u32x4* s = (const u32x4*)(x1b + (size_t)tok * DM); u32x4* d = (u32x4*)(am + (size_t)row * DM);
#pragma unroll
        for (int i = 0; i < 4; ++i) d[lane + 64 * i] = s[lane + 64 * i];
        if (lane == 0) rt[RT_ROW + a] = (unsigned)row;
    }
    for (int pr = gw; pr < 8 * 256; pr += NGW) { const int e = pr >> 8, i = pr & 255;
        const int row = (int)tot[8 + e] * 256 + (int)tot[e] + i, rend = ((int)tot[8 + e] + (((int)tot[e] + 255) >> 8)) * 256;
        if (row < rend) { u32x4* d = (u32x4*)(am + (size_t)row * DM);
#pragma unroll
            for (int q = 0; q < 4; ++q) d[lane + 64 * q] = (u32x4){0u, 0u, 0u, 0u}; } }
    __syncthreads();
}

constexpr int NPH_LAYER = 12;
constexpr int NPHASES = 1 + 2 * NPH_LAYER;
#define IN(k) (lo <= (k) && (k) < hi)
#define RELAUNDER() do { int l_ = lane_id_(); asm volatile("" : "+v"(l_)); F.lane = l_; F.tid = F.wave * 64 + l_; } while (0)
#define STAMP(k) do { if (STAMP_PROBE && F.bid == 0 && xb_t0(F.wave)) ((volatile LAS unsigned*)(F.lds + LDSCTL_OFF + 512))[k] = (unsigned)__builtin_amdgcn_s_memrealtime(); } while (0)
#define SEAM(k) do { if (IN(k) && IN((k) + 1)) { xcd_barrier(bar); STAMP((k) + 1); } } while (0)
template <int LAYER>
DI void run_layer(Frame& F, const Args& args, const XcdBarrier& bar, const int lo, const int hi) {
    constexpr int P = 1 + NPH_LAYER * LAYER;
    bf16* proj = (bf16*)(F.ws + WS_PROJ); bf16* xb = (bf16*)(F.ws + WS_XB); bf16* mrg = (bf16*)(F.ws + WS_MRG);
    float* x1 = (float*)(F.ws + WS_X1); bf16* x1b = (bf16*)(F.ws + WS_X1B); float* x2 = (float*)(F.ws + WS_X2); float* pre = (float*)(F.ws + WS_PRE);
    if (IN(P + 0)) {
        pg8::Gemm g{xb, (const bf16*)(F.ws + WS_WIN) + (size_t)LAYER * NINP * DM, DM, DM, DM};
        pg8::TileOrder S; S.init(MTOK / 256, NINP / 256, F.G, F.bid, (size_t)256 * DM * 2, (size_t)256 * DM * 2);
        pg8::EpiBf16 E{proj, NINP, 0};
        pg8::gemm_phase(F.lds, g, S, E, F.wave);
    }
    SEAM(P + 0);
    if (IN(P + 1)) { RELAUNDER(); p2_prep(F, args, LAYER); }
    SEAM(P + 1);
    if (IN(P + 2)) {
        { pg8::Gemm g{(const bf16*)(F.ws + WS_DIFF), (const bf16*)(F.ws + WS_WPOOL) + (size_t)LAYER * 2048 * 512, DM, 512, 512};
          pg8::TileOrder S; S.init(MTOK / 256, 8, F.G, F.bid, (size_t)256 * DM * 2, (size_t)256 * 512 * 2, 2, (size_t)512 * 2);
          pg8::EpiPool E{mrg, proj, INF(5) + (size_t)LAYER * DM};
          pg8::gemm_phase(F.lds, g, S, E, F.wave); }
        { pg8::Gemm g{(const bf16*)(F.ws + WS_XC), (const bf16*)(F.ws + WS_WLRU) + (size_t)LAYER * 4096 * 256, DM, 256, 256};
          pg8::TileOrder S; S.init(MTOK / 256, 16, F.G, F.bid, (size_t)256 * DM * 2, (size_t)256 * 256 * 2, 2, (size_t)256 * 2);
          pg8::EpiLru E{(float*)(F.ws + WS_A), (float*)(F.ws + WS_B), (const bf16*)(F.ws + WS_XC), INF(9) + (size_t)LAYER * DM, INF(11) + (size_t)LAYER * DM, (const float*)(F.ws + WS_LRUC) + (size_t)LAYER * DM};
          pg8::gemm_phase(F.lds, g, S, E, F.wave); }
        RELAUNDER(); p3_indexer(F);
    }
    SEAM(P + 2);
    if (IN(P + 3)) { RELAUNDER(); p4_select(F); RELAUNDER(); p4_lru_pass1(F); }
    SEAM(P + 3);
    if (IN(P + 4)) { RELAUNDER(); p5_attention(F); RELAUNDER(); p5_lru_pass2(F); }
    SEAM(P + 4);
    if (IN(P + 5)) {
        pg8::Gemm g{mrg, (const bf16*)(F.ws + WS_WOUT) + (size_t)LAYER * DM * MIXW, MIXW, MIXW, MIXW};
        pg8::TileOrder S; S.init(MTOK / 256, DM / 256, F.G, F.bid, (size_t)256 * MIXW * 2, (size_t)256 * MIXW * 2);
        pg8::EpiRes E{pre, LAYER == 0 ? INF(0) : (const float*)x2, DM};
        pg8::gemm_phase(F.lds, g, S, E, F.wave);
    }
    SEAM(P + 5);
    if (IN(P + 6)) { RELAUNDER(); } if (IN(P + 6)) p_layernorm<0, LAYER == 1, true>(F, args, pre, INF(13) + LAYER * DM, INF(14) + LAYER * DM, x1, x1b);
    SEAM(P + 6);
    if constexpr (LAYER == 0) {
        if (IN(P + 7)) {
            pg8::Gemm g{x1b, (const bf16*)(F.ws + WS_WGU), DM, DM, DM};
            pg8::TileOrder S; S.init(MTOK / 256, 2 * DFF / 256, F.G, F.bid, (size_t)256 * DM * 2, (size_t)256 * DM * 2);
            pg8::EpiSwiglu E{(bf16*)(F.ws + WS_H), DFF};
            pg8::gemm_phase(F.lds, g, S, E, F.wave);
        }
        SEAM(P + 7);
        if (IN(P + 8)) {
            pg8::Gemm g{(const bf16*)(F.ws + WS_H), (const bf16*)(F.ws + WS_WDN), DFF, DFF, DFF};
            pg8::TileOrder S; S.init(MTOK / 256, DM / 256, F.G, F.bid, (size_t)256 * DFF * 2, (size_t)256 * DFF * 2);
            pg8::EpiRes E{pre, x1, DM};
            pg8::gemm_phase(F.lds, g, S, E, F.wave);
        }
        SEAM(P + 8);
        if (IN(P + 9)) { RELAUNDER(); } if (IN(P + 9)) p_layernorm<0, false, true>(F, args, pre, INF(15), INF(16), x2, xb);
        if (IN(P + 9) && IN(P + 12)) { xcd_barrier(bar); STAMP(P + 10); STAMP(P + 11); STAMP(P + 12); }
    } else {
        if (IN(P + 7)) { RELAUNDER(); p_convert_moe(F, args); RELAUNDER(); p_moe_gather(F); }
        SEAM(P + 7);
        if (IN(P + 8)) {
            pg8::Gemm g{(const bf16*)(F.ws + WS_AMOE), (const bf16*)(F.ws + WS_MWGU), DM, DM, DM};
            pg8::MoeOrder S; S.init(F.ctl + CW_CNT, 2 * DEXP / 256, 1, F.G, F.bid, (size_t)256 * DM * 2, (size_t)2 * DEXP * DM * 2, (size_t)256 * DM * 2, 0);
            pg8::EpiSwiglu E{(bf16*)(F.ws + WS_HMOE), DEXP};
            pg8::gemm_phase(F.lds, g, S, E, F.wave);
        }
        SEAM(P + 8);
        if (IN(P + 9)) {
            pg8::Gemm g{(const bf16*)(F.ws + WS_HMOE), (const bf16*)(F.ws + WS_MWDN), DEXP, DEXP, DEXP / 4};
            pg8::MoeOrder S; S.init(F.ctl + CW_CNT, DM / 256, 4, F.G, F.bid, (size_t)256 * DEXP * 2, (size_t)DM * DEXP * 2, (size_t)256 * DEXP * 2, (size_t)(DEXP / 4) * 2);
            pg8::EpiBf16 E{(bf16*)(F.ws + WS_YB), DM, (size_t)MOE_ROWS_MAX * DM};
            pg8::gemm_phase(F.lds, g, S, E, F.wave);
        }
        SEAM(P + 9);
        if (IN(P + 10)) { RELAUNDER(); } if (IN(P + 10)) p_layernorm<1, false, false>(F, args, x1, INF(15) + DM, INF(16) + DM, args.out, nullptr);
    }
}
__global__ void __launch_bounds__(512, 2) fwd_kernel(Args args) {
    extern __shared__ __attribute__((aligned(16))) unsigned char lds_raw[];
    Frame F;
    F.lds = (LAS unsigned char*)lds_raw; F.ws = args.ws; F.ctl = (unsigned*)(args.ws + WS_CTL);
    F.wave = __builtin_amdgcn_readfirstlane((int)threadIdx.x >> 6); F.lane = lane_id_(); F.tid = F.wave * 64 + F.lane; F.G = gridDim.x; F.bid = blockIdx.x;
    volatile LAS unsigned* MISC = (volatile LAS unsigned*)(F.lds + LDSCTL_OFF);
    for (int u = F.tid; u < (LDS_BYTES - LDSCTL_OFF) / 4; u += 512) ((LAS unsigned*)(F.lds + LDSCTL_OFF))[u] = 0u;
    __syncthreads();
    const int lo = args.ph_lo, hi = args.ph_hi;
    XcdBarrier bar; bar.bar = F.ctl + CW_BAR; bar.x = 0; bar.st = nullptr; bar.wave = F.wave;
    if ((hi - lo) > 1) bar = xcd_barrier_post(F.ctl + CW_BAR, MISC + 8, F.wave);
    if (IN(0)) { RELAUNDER(); p0_prologue(F, args); __syncthreads(); }
    SEAM(0);
    STAMP(0);
    run_layer<0>(F, args, bar, lo, hi);
    run_layer<1>(F, args, bar, lo, hi);
#if STAMP_PROBE
    RELAUNDER();
    if (F.bid == 0) {
        asm volatile("s_waitcnt vmcnt(0)" ::: "memory"); __syncthreads();
        if (xb_t0(F.wave)) ((volatile LAS unsigned*)(F.lds + LDSCTL_OFF + 512))[NPHASES - 1] = (unsigned)__builtin_amdgcn_s_memrealtime();
        __syncthreads();
        volatile LAS unsigned* st = (volatile LAS unsigned*)(F.lds + LDSCTL_OFF + 512);
        const float ta = (float)(st[STAMP_A_HI] - st[STAMP_A_LO]) * 0.01f, tb = (float)(st[STAMP_B_HI] - st[STAMP_B_LO]) * 0.01f;
        const float da = __builtin_amdgcn_sqrtf(ta * 0.005f);
        for (int i = F.tid; i < DM; i += 512) args.out[i] += da;
        if (F.tid == 0) args.out[DM] += tb * 0.1f;
    }
#endif
}
#undef IN
#undef SEAM

extern "C" void kernel_launch(void* const* d_in, const int* in_sizes, int n_in, void* d_out, int out_size, void* d_ws, size_t ws_size, hipStream_t stream) {
    static int grid = 0;
    if (grid == 0) {
        if (n_in != 24 || out_size != MTOK * DM || ws_size < WS_END) { fprintf(stderr, "kernel_launch: unexpected problem (n_in %d, out %d, ws %zu, need %zu)\n", n_in, out_size, ws_size, (size_t)WS_END); grid = -1; return; }
        int dev = 0, cus = 0, per_cu = 0;
        if (hipGetDevice(&dev) != hipSuccess || hipDeviceGetAttribute(&cus, hipDeviceAttributeMultiprocessorCount, dev) != hipSuccess) { grid = -1; return; }
        if (hipFuncSetAttribute((const void*)fwd_kernel, hipFuncAttributeMaxDynamicSharedMemorySize, LDS_BYTES) != hipSuccess) { fprintf(stderr, "kernel_launch: hipFuncSetAttribute failed\n"); grid = -1; return; }
        if (hipOccupancyMaxActiveBlocksPerMultiprocessor(&per_cu, (const void*)fwd_kernel, 512, LDS_BYTES) != hipSuccess || per_cu < 1) fprintf(stderr, "kernel_launch: occupancy query reports %d\n", per_cu);
        (void)hipGetLastError();
        grid = cus;
    }
    if (grid < 0) return;
    (void)hipMemsetAsync((char*)d_ws + WS_CTL, 0, CTL_ZERO_BYTES, stream);
    Args a{};
    for (int i = 0; i < 24; ++i) a.in[i] = d_in[i];
    a.out = (float*)d_out; a.ws = (unsigned char*)d_ws;
#if MK_N_LAUNCHES == 1
    a.ph_lo = 0; a.ph_hi = NPHASES;
    hipLaunchKernelGGL(fwd_kernel, dim3(grid), dim3(512), LDS_BYTES, stream, a);
#else
    const int plist[] = {0, 1, 2, 3, 4, 5, 6, 7, 8, 9, 10, 13, 14, 15, 16, 17, 18, 19, 20, 21, 22, 23};
    for (int i = 0; i < (int)(sizeof(plist) / sizeof(int)); ++i) { a.ph_lo = plist[i]; a.ph_hi = plist[i] + 1; hipLaunchKernelGGL(fwd_kernel, dim3(grid), dim3(512), LDS_BYTES, stream, a); }
#endif
}
```

```cpp
#include <hip/hip_runtime.h>
#include <cstdio>
#include <cstdint>

#ifndef MK_N_LAUNCHES
#define MK_N_LAUNCHES 1
#endif

#ifndef STAMP_PROBE
#define STAMP_PROBE 0
#endif
#ifndef STAMP_A_LO
#define STAMP_A_LO 0
#define STAMP_A_HI 1
#define STAMP_B_LO 1
#define STAMP_B_HI 2
#endif
#define DI __device__ __forceinline__
#define LAS __attribute__((address_space(3)))
#define GAS __attribute__((address_space(1)))
typedef unsigned short bf16;
typedef short bf16x8 __attribute__((ext_vector_type(8)));
typedef float f32x2 __attribute__((ext_vector_type(2)));
typedef float f32x4 __attribute__((ext_vector_type(4)));
typedef float f32x16 __attribute__((ext_vector_type(16)));
typedef unsigned u32x2 __attribute__((ext_vector_type(2)));
typedef unsigned u32x4 __attribute__((ext_vector_type(4)));
typedef __bf16 bf16x2_t __attribute__((ext_vector_type(2)));

#define LDS_WAIT() asm volatile("s_waitcnt lgkmcnt(0)" ::: "memory")
#define VM_WAIT() asm volatile("s_waitcnt vmcnt(0)" ::: "memory")

DI unsigned pk2(float lo, float hi) { f32x2 v = {lo, hi}; return __builtin_bit_cast(unsigned, __builtin_convertvector(v, bf16x2_t)); }
DI float bflo(unsigned w) { return __uint_as_float(w << 16); }
DI float bfhi(unsigned w) { return __uint_as_float(w & 0xffff0000u); }
DI float bf2f(bf16 b) { return __uint_as_float(((unsigned)b) << 16); }
DI float rcp_(float x) { return __builtin_amdgcn_rcpf(x); }
DI float sigmoidf_(float x) { return rcp_(1.0f + __expf(-x)); }
DI float siluf_(float x) { return x * rcp_(1.0f + __expf(-x)); }
DI float gelu_tanh_(float x) { const float u = 0.7978845608028654f * (x + 0.044715f * x * x * x); const float t = 1.0f - 2.0f * rcp_(1.0f + __expf(2.0f * u)); return 0.5f * x * (1.0f + t); }
DI float one_minus_exp_(float x) {
    const float p = -x * (1.0f + x * 0.5f * (1.0f + x * (1.0f / 3.0f) * (1.0f + x * 0.25f * (1.0f + x * 0.2f * (1.0f + x * (1.0f / 6.0f) * (1.0f + x * (1.0f / 7.0f)))))));
    const float e = 1.0f - __expf(x);
    return x > -0.5f ? p : e;
}
DI int lane_id_() { int l; asm volatile("v_mbcnt_lo_u32_b32 %0, -1, 0\n\tv_mbcnt_hi_u32_b32 %0, -1, %0" : "=v"(l)); return l; }

constexpr int DM = 2048, BATCH = 4, SEQ = 2048, MTOK = BATCH * SEQ;
constexpr int NIN = 16464, NINP = 16640;
constexpr int C_Q = 0, C_K = 2048, C_V = 2560, C_QI = 3072, C_KI = 4096, C_WI = 4160, C_PADLO = 4176, C_P = 4352, C_XR = 6400, C_GR = 8448, C_G = 10496;
constexpr int MIXW = 6144, DFF = 5504, NEXP = 8, DEXP = 7168;
constexpr int MOE_ROWS_MAX = (MTOK * 2 / 256 + NEXP) * 256;
constexpr float ALPHA = 1.4142135623730951f, LN_EPS = 1e-5f;

constexpr size_t MiB = 1u << 20;
constexpr size_t WS_CTL = 0, CTL_ZERO_BYTES = 1 * MiB;
constexpr size_t WS_COSA = 1 * MiB, WS_SINA = 3 * MiB, WS_COSI = 5 * MiB, WS_SINI = 6 * MiB;
constexpr size_t WS_ROUTE = 9 * MiB;
constexpr size_t WS_MASK = 10 * MiB;
constexpr size_t WS_LRUC = 9 * MiB + 512 * 1024;
constexpr size_t WS_WIN = 12 * MiB;
constexpr size_t WS_WOUT = 142 * MiB;
constexpr size_t WS_WPOOL = 190 * MiB;
constexpr size_t WS_WLRU = 194 * MiB;
constexpr size_t WS_WGU = 198 * MiB;
constexpr size_t WS_WDN = 241 * MiB;
constexpr size_t WS_XB = 263 * MiB;
constexpr size_t WS_X1 = 295 * MiB;
constexpr size_t WS_X1B = 359 * MiB;
constexpr size_t WS_X2 = 391 * MiB;
constexpr size_t WS_PRE = 455 * MiB;
constexpr size_t WS_MWGU = 519 * MiB;
constexpr size_t WS_MWDN = 967 * MiB;
constexpr size_t WS_OV = 1191 * MiB;
constexpr size_t WS_PROJ = WS_OV;
constexpr size_t WS_DIFF = WS_OV + 260 * MiB;
constexpr size_t WS_XC = WS_OV + 292 * MiB;
constexpr size_t WS_A = WS_OV + 324 * MiB;
constexpr size_t WS_CARRY = WS_OV + 388 * MiB;
constexpr size_t WS_SC = WS_OV + 452 * MiB;
constexpr size_t WS_MRG = WS_OV + 516 * MiB;
constexpr size_t WS_H = WS_OV;
constexpr size_t WS_AMOE = WS_OV;
constexpr size_t WS_HMOE = WS_OV + 72 * MiB;
constexpr size_t WS_YB = WS_OV + 324 * MiB;
constexpr size_t WS_END = WS_OV + 612 * MiB;
constexpr int CW_BAR = 4096, CW_CNT = 16384;
constexpr int RT_E = 0, RT_SLOT = 2 * MTOK, RT_W = 4 * MTOK, RT_ROW = 6 * MTOK, RT_WGC = 8 * MTOK;

constexpr int RING_BYTES = 131072, LDSCTL_OFF = RING_BYTES, LDS_BYTES = 147456;

#define XB_TMO      128
#define XB_XCNT(j)  (256  + 64 * (j))
#define XB_XSUB(j)  (1280 + 64 * (j))
#define XB_XGEN(j)  (2304 + 64 * (j))
#define XB_TOP      3328
#define XB_TOPGEN   3392
#define XCD_BAR_WORDS 3456
#define XB_SPIN_CAP (1u << 18)
DI unsigned xb_ld(unsigned* p)              { return __hip_atomic_load(p, __ATOMIC_RELAXED, __HIP_MEMORY_SCOPE_AGENT); }
DI unsigned xb_add(unsigned* p, unsigned v) { return __hip_atomic_fetch_add(p, v, __ATOMIC_RELAXED, __HIP_MEMORY_SCOPE_AGENT); }
DI unsigned xb_xcc_id() { return (unsigned)__builtin_amdgcn_s_getreg((3 << 11) | 20) & 0xFu; }
#define XB_SPIN(cond, bar) do { unsigned _sp = 0; while (cond) { __builtin_amdgcn_s_sleep(1); \
    if ((++_sp & 255u) == 0u) { if (xb_ld(&(bar)[XB_TMO])) break; if (_sp > XB_SPIN_CAP) { atomicAdd(&(bar)[XB_TMO], 1u); break; } } } } while (0)
struct XcdBarrier { unsigned* bar; unsigned x; volatile LAS unsigned* st; int wave; };
DI bool xb_t0(int wave) { return wave == 0 && lane_id_() == 0; }
DI XcdBarrier xcd_barrier_post(unsigned* bar, volatile LAS unsigned* st, int wave) {
    XcdBarrier b; b.bar = bar; b.x = xb_xcc_id(); b.st = st; b.wave = wave;
    if (xb_t0(wave)) (void)xb_add(&bar[XB_XCNT(b.x)], 1u);
    return b;
}
DI void xcd_barrier_complete(unsigned* bar, unsigned x, unsigned& nloc, unsigned& nx) {
    const unsigned G = gridDim.x * gridDim.y * gridDim.z;
    unsigned sum, cnt, mine, sp = 0u;
    for (;;) {
        sum = 0u; cnt = 0u; mine = 0u;
#pragma unroll
        for (unsigned j = 0; j < 16; ++j) { const unsigned c = xb_ld(&bar[XB_XCNT(j)]); sum += c; cnt += (c > 0u) ? 1u : 0u; mine = (j == x) ? c : mine; }
        if (sum == G) break;
        __builtin_amdgcn_s_sleep(1);
        if ((++sp & 255u) == 0u) { if (xb_ld(&bar[XB_TMO])) break; if (sp > XB_SPIN_CAP) { atomicAdd(&bar[XB_TMO], 1u); break; } }
    }
    nloc = mine > 0u ? mine : 1u; nx = cnt > 0u ? cnt : 1u;
}
DI void xcd_barrier(const XcdBarrier& b) {
    asm volatile("s_waitcnt vmcnt(0)" ::: "memory");
    __syncthreads();
    if (xb_t0(b.wave)) {
        unsigned* bar = b.bar;
        __builtin_amdgcn_s_waitcnt(0);
        unsigned nloc = b.st[0], nx = b.st[1];
        if (nloc == 0u) { xcd_barrier_complete(bar, b.x, nloc, nx); b.st[0] = nloc; b.st[1] = nx; }
        const unsigned old = xb_add(&bar[XB_XSUB(b.x)], 1u);
        const unsigned gen = old / nloc;
        if (old + 1u == (gen + 1u) * nloc) {
            __builtin_amdgcn_fence(__ATOMIC_RELEASE, "agent");
            asm volatile("s_waitcnt vmcnt(0)" ::: "memory");
            const unsigned og = xb_add(&bar[XB_TOP], 1u);
            const unsigned tg = og / nx;
            if (og + 1u == (tg + 1u) * nx) xb_add(&bar[XB_TOPGEN], 1u);
            else XB_SPIN(xb_ld(&bar[XB_TOPGEN]) == tg, bar);
            __builtin_amdgcn_fence(__ATOMIC_ACQUIRE, "agent");
            xb_add(&bar[XB_XGEN(b.x)], 1u);
            asm volatile("s_waitcnt vmcnt(0)" ::: "memory");
        } else {
            XB_SPIN(xb_ld(&bar[XB_XGEN(b.x)]) == gen, bar);
            __builtin_amdgcn_fence(__ATOMIC_ACQUIRE, "agent");
            asm volatile("s_waitcnt vmcnt(0)" ::: "memory");
        }
    }
    __syncthreads();
}

namespace pg8 {
constexpr int BM = 256, BK = 64, HALF = 128, HTB = HALF * BK * 2, STAGE_BYTES = 8 * HTB, NXCD = 8, WGM = 8;
DI int lds_byte(int r, int c) { const int st = (r >> 4) * 2 + (c >> 5), rr = r & 15, cc = c & 31, ob = rr * 64 + cc * 2; return st * 1024 + (ob ^ (((ob >> 9) & 1) << 5)); }
DI void stage_rc(int b, int& R, int& C) { const int st = b / 1024, sb = b % 1024, swz = sb ^ (((sb >> 9) & 1) << 5); R = (st >> 1) * 16 + swz / 64; C = (st & 1) * 32 + (swz % 64) / 2; }
DI int perm32(int rho) { const int n = rho >> 4, i = rho & 15; return 8 * (i >> 2) + 4 * n + (i & 3); }

struct Unit { int pm, pn, e, ks; };
struct Gemm { const bf16* A; const bf16* Bt; int lda, ldb, K; };

struct TileOrder {
    int nM, nN, nwg, G, c, a_div; size_t a_pm, a_pn, b_pn;
    DI void init(int nM_, int nN_, int G_, int c_, size_t a_pm_, size_t b_pn_, int a_div_ = 1, size_t a_pn_ = 0) { nM = nM_; nN = nN_; nwg = nM * nN; G = G_; c = c_; a_pm = a_pm_; b_pn = b_pn_; a_div = a_div_; a_pn = a_pn_; }
    DI bool next(int i, Unit& u) const {
        const long L = (long)i * G + c; if (L >= nwg) return false;
        int wgid = (int)L; { const int q = nwg / NXCD, r = nwg % NXCD, xcd = wgid % NXCD, off = wgid / NXCD; wgid = (xcd < r ? xcd * (q + 1) : r * (q + 1) + (xcd - r) * q) + off; }
        const int nig = WGM * nN, gid = wgid / nig, fm = gid * WGM, gsz = (nM - fm) < WGM ? (nM - fm) : WGM;
        u.pm = fm + ((wgid % nig) % gsz); u.pn = (wgid % nig) / gsz; u.e = 0; u.ks = 0; return true;
    }
    DI size_t aoff(const Unit& u) const { return (size_t)u.pm * a_pm + (size_t)(u.pn / a_div) * a_pn; }
    DI size_t boff(const Unit& u) const { return (size_t)u.pn * b_pn; }
};
struct MoeOrder {
    int nN, nNk, nwg, G, c; int t1, t2, t3, t4, t5, t6, t7, t8; size_t a_pm, b_e, b_pn, ks_step;
    DI void init(const unsigned* cnt, int nN_, int ksplit, int G_, int c_, size_t a_pm_, size_t b_e_, size_t b_pn_, size_t ks_step_) {
        nN = nN_; nNk = nN_ * ksplit; G = G_; c = c_; a_pm = a_pm_; b_e = b_e_; b_pn = b_pn_; ks_step = ks_step_;
        int s = 0; s += ((int)cnt[0] + 255) >> 8; t1 = s; s += ((int)cnt[1] + 255) >> 8; t2 = s; s += ((int)cnt[2] + 255) >> 8; t3 = s; s += ((int)cnt[3] + 255) >> 8; t4 = s;
        s += ((int)cnt[4] + 255) >> 8; t5 = s; s += ((int)cnt[5] + 255) >> 8; t6 = s; s += ((int)cnt[6] + 255) >> 8; t7 = s; s += ((int)cnt[7] + 255) >> 8; t8 = s;
        nwg = t8 * nNk;
    }
    DI bool next(int i, Unit& u) const {
        const long L = (long)i * G + c; if (L >= nwg) return false;
        int wgid = (int)L; { const int q = nwg / NXCD, r = nwg % NXCD, xcd = wgid % NXCD, off = wgid / NXCD; wgid = (xcd < r ? xcd * (q + 1) : r * (q + 1) + (xcd - r) * q) + off; }
        int e = 0, ts = 0, nt = t1;
        if (wgid >= t1 * nNk) { e = 1; ts = t1; nt = t2 - t1; }
        if (wgid >= t2 * nNk) { e = 2; ts = t2; nt = t3 - t2; }
        if (wgid >= t3 * nNk) { e = 3; ts = t3; nt = t4 - t3; }
        if (wgid >= t4 * nNk) { e = 4; ts = t4; nt = t5 - t4; }
        if (wgid >= t5 * nNk) { e = 5; ts = t5; nt = t6 - t5; }
        if (wgid >= t6 * nNk) { e = 6; ts = t6; nt = t7 - t6; }
        if (wgid >= t7 * nNk) { e = 7; ts = t7; nt = t8 - t7; }
        const int loc = wgid - ts * nNk; nt = nt > 0 ? nt : 1;
        const int pn2 = loc / nt;
        u.pm = ts + loc % nt; u.pn = pn2 % nN; u.ks = pn2 / nN; u.e = e; return true;
    }
    DI size_t aoff(const Unit& u) const { return (size_t)u.pm * a_pm + (size_t)u.ks * ks_step; }
    DI size_t boff(const Unit& u) const { return (size_t)u.e * b_e + (size_t)u.pn * b_pn + (size_t)u.ks * ks_step; }
};

struct EpiBf16 {
    static constexpr bool PERM = true;
    bf16* O; int ldc; size_t ks_stride;
    DI void operator()(const f32x4 (&acc)[2][2][4][2], const Unit& u, int wr, int wc, int fr, int fq) const {
        const int row0 = u.pm * BM + wr * 64 + fr, col0 = u.pn * BM + wc * 32 + 8 * fq;
#pragma unroll
        for (int ai = 0; ai < 2; ++ai)
#pragma unroll
            for (int m = 0; m < 4; ++m) { bf16* rowp = O + (size_t)u.ks * ks_stride + (size_t)(row0 + ai * HALF + m * 16) * ldc + col0;
#pragma unroll
                for (int bj = 0; bj < 2; ++bj) { const f32x4 v0 = acc[ai][bj][m][0], v1 = acc[ai][bj][m][1];
                    u32x4 w; w.x = pk2(v0[0], v0[1]); w.y = pk2(v0[2], v0[3]); w.z = pk2(v1[0], v1[1]); w.w = pk2(v1[2], v1[3]);
                    *(u32x4*)(rowp + bj * HALF) = w; } }
    }
};
struct EpiF32 {
    static constexpr bool PERM = false;
    float* C; int ldc;
    DI void operator()(const f32x4 (&acc)[2][2][4][2], const Unit& u, int wr, int wc, int fr, int fq) const {
        const int row0 = u.pm * BM + wr * 64 + fr, col0 = u.pn * BM + wc * 32 + 4 * fq;
#pragma unroll
        for (int ai = 0; ai < 2; ++ai)
#pragma unroll
            for (int m = 0; m < 4; ++m) { float* rowp = C + (size_t)(row0 + ai * HALF + m * 16) * ldc + col0;
#pragma unroll
                for (int bj = 0; bj < 2; ++bj)
#pragma unroll
                    for (int n = 0; n < 2; ++n) *(f32x4*)(rowp + bj * HALF + n * 16) = acc[ai][bj][m][n]; }
    }
};
struct EpiRes {
    static constexpr bool PERM = false;
    float* C; const float* res; int ldc;
    DI void operator()(const f32x4 (&acc)[2][2][4][2], const Unit& u, int wr, int wc, int fr, int fq) const {
        const int row0 = u.pm * BM + wr * 64 + fr, col0 = u.pn * BM + wc * 32 + 4 * fq;
#pragma unroll
        for (int ai = 0; ai < 2; ++ai)
#pragma unroll
            for (int m = 0; m < 4; ++m) { const size_t off = (size_t)(row0 + ai * HALF + m * 16) * ldc + col0;
#pragma unroll
                for (int bj = 0; bj < 2; ++bj)
#pragma unroll
                    for (int n = 0; n < 2; ++n) { const f32x4 rv = *(const f32x4*)(res + off + bj * HALF + n * 16); *(f32x4*)(C + off + bj * HALF + n * 16) = acc[ai][bj][m][n] + rv * ALPHA; }
                asm volatile("" ::: "memory"); }
    }
};
struct EpiSwiglu {
    static constexpr bool PERM = true;
    bf16* H; int ldc;
    DI void operator()(const f32x4 (&acc)[2][2][4][2], const Unit& u, int wr, int wc, int fr, int fq) const {
        const int row0 = u.pm * BM + wr * 64 + fr, col0 = u.pn * HALF + wc * 32 + 8 * fq;
#pragma unroll
        for (int ai = 0; ai < 2; ++ai)
#pragma unroll
            for (int m = 0; m < 4; ++m) { bf16* rowp = H + (size_t)(row0 + ai * HALF + m * 16) * ldc + col0;
                const f32x4 g0 = acc[ai][0][m][0], g1 = acc[ai][0][m][1], u0 = acc[ai][1][m][0], u1 = acc[ai][1][m][1];
                u32x4 w; w.x = pk2(siluf_(g0[0]) * u0[0], siluf_(g0[1]) * u0[1]); w.y = pk2(siluf_(g0[2]) * u0[2], siluf_(g0[3]) * u0[3]);
                w.z = pk2(siluf_(g1[0]) * u1[0], siluf_(g1[1]) * u1[1]); w.w = pk2(siluf_(g1[2]) * u1[2], siluf_(g1[3]) * u1[3]);
                *(u32x4*)rowp = w; asm volatile("" ::: "memory"); }
    }
};
struct EpiPool {
    static constexpr bool PERM = true;
    bf16* mrg; const bf16* proj; const float* scale;
    DI void operator()(const f32x4 (&acc)[2][2][4][2], const Unit& u, int wr, int wc, int fr, int fq) const {
        const int row0 = u.pm * BM + wr * 64 + fr, col0 = u.pn * BM + wc * 32 + 8 * fq;
#pragma unroll
        for (int bj = 0; bj < 2; ++bj) { const int c = col0 + bj * HALF; const f32x4 s0 = *(const f32x4*)(scale + c), s1 = *(const f32x4*)(scale + c + 4);
#pragma unroll
            for (int ai = 0; ai < 2; ++ai)
#pragma unroll
                for (int m = 0; m < 4; ++m) { const size_t row = (size_t)(row0 + ai * HALF + m * 16);
                    const u32x4 gv = *(const u32x4*)(proj + row * NINP + C_G + 2048 + c);
                    const f32x4 v0 = acc[ai][bj][m][0] * s0, v1 = acc[ai][bj][m][1] * s1;
                    u32x4 w; w.x = pk2(v0[0] * sigmoidf_(bflo(gv.x)), v0[1] * sigmoidf_(bfhi(gv.x))); w.y = pk2(v0[2] * sigmoidf_(bflo(gv.y)), v0[3] * sigmoidf_(bfhi(gv.y)));
                    w.z = pk2(v1[0] * sigmoidf_(bflo(gv.z)), v1[1] * sigmoidf_(bfhi(gv.z))); w.w = pk2(v1[2] * sigmoidf_(bflo(gv.w)), v1[3] * sigmoidf_(bfhi(gv.w)));
                    *(u32x4*)(mrg + row * MIXW + 2048 + c) = w; asm volatile("" ::: "memory"); } }
    }
};
struct EpiLru {
    static constexpr bool PERM = false;
    unsigned* AB; const bf16* xc; const float* ba; const float* bx; const float* c8sp;
    DI void operator()(const f32x4 (&acc)[2][2][4][2], const Unit& u, int wr, int wc, int fr, int fq) const {
        const int row0 = u.pm * BM + wr * 64 + fr, ch0 = u.pn * HALF + wc * 32 + 4 * fq;
#pragma unroll
        for (int n = 0; n < 2; ++n) { const int ch = ch0 + n * 16; const f32x4 vba = *(const f32x4*)(ba + ch), vbx = *(const f32x4*)(bx + ch), vsp = *(const f32x4*)(c8sp + ch);
#pragma unroll
            for (int ai = 0; ai < 2; ++ai)
#pragma unroll
                for (int m = 0; m < 4; ++m) { const size_t off = (size_t)(row0 + ai * HALF + m * 16) * DM + ch;
                    const u32x2 xv = *(const u32x2*)(xc + off); const float xf[4] = {bflo(xv.x), bfhi(xv.x), bflo(xv.y), bfhi(xv.y)};
                    u32x4 w;
#pragma unroll
                    for (int j = 0; j < 4; ++j) { const float r = sigmoidf_(acc[ai][0][m][n][j] + vba[j]), ig = sigmoidf_(acc[ai][1][m][n][j] + vbx[j]);
                        const float la = -vsp[j] * r; w[j] = pk2(la, __builtin_amdgcn_sqrtf(fmaxf(one_minus_exp_(2.0f * la), 0.f)) * ig * xf[j]); }
                    *(u32x4*)(AB + off) = w; asm volatile("" ::: "memory"); } }
    }
};

template <class Epi, class Sched, bool ALIGN_EPI = true, bool SP2 = true>
DI void gemm_phase(LAS unsigned char* lds, const Gemm g, const Sched& S, const Epi& E, const int wave_id) {
    int lane_ = lane_id_(); asm volatile("" : "+v"(lane_));
    const int wid = wave_id, lane = lane_, tid = wid * 64 + lane, wr = wid >> 2, wc = wid & 3, fr = lane & 15, fq = lane >> 4;
    const int nt = g.K / BK;
    unsigned voffA[2], voffB[2];
#pragma unroll
    for (int i = 0; i < 2; ++i) { int R, C; stage_rc(tid * 16 + i * 8192, R, C); const int Rb = Epi::PERM ? ((R & ~31) + perm32(R & 31)) : R;
        voffA[i] = (unsigned)(R * g.lda + C) * 2u; voffB[i] = (unsigned)(Rb * g.ldb + C) * 2u; }
    const size_t kstep = (size_t)(BK * 2);
    const size_t hstepA = (size_t)HALF * g.lda * 2, hstepB = (size_t)HALF * g.ldb * 2;
    const unsigned ldsw = (unsigned)wid * 1024u;
    const int aoff = lds_byte(wr * 64 + fr, fq * 8), boff = lds_byte(wc * 32 + fr, fq * 8);
#define PG8_SA(b, h) (((b) * 2 + (h)) * HTB)
#define PG8_SB(b, h) ((4 + (b) * 2 + (h)) * HTB)
#define PG8_STAGE(bufoff, gbase, voff) do { _Pragma("unroll") for (int _i = 0; _i < 2; ++_i) \
        __builtin_amdgcn_global_load_lds((const unsigned*)((const char*)(gbase) + (voff)[_i]), (LAS unsigned*)(lds + (bufoff) + ldsw + _i * 8192), 16, 0, 0); } while (0)
#define PG8_LDA(dst, b, h) do { _Pragma("unroll") for (int m = 0; m < 4; ++m) _Pragma("unroll") for (int k = 0; k < 2; ++k) dst[m][k] = *(const LAS bf16x8*)(lds + PG8_SA(b, h) + aoff + m * 2048 + k * 1024); } while (0)
#define PG8_LDB(dst, b, h) do { _Pragma("unroll") for (int n = 0; n < 2; ++n) _Pragma("unroll") for (int k = 0; k < 2; ++k) dst[n][k] = *(const LAS bf16x8*)(lds + PG8_SB(b, h) + boff + n * 2048 + k * 1024); } while (0)
#define PG8_MMA(ai, bj, At, Bt) do { __builtin_amdgcn_s_setprio(1); _Pragma("unroll") for (int m = 0; m < 4; ++m) _Pragma("unroll") for (int n = 0; n < 2; ++n) _Pragma("unroll") for (int k = 0; k < 2; ++k) \
        acc[ai][bj][m][n] = __builtin_amdgcn_mfma_f32_16x16x32_bf16(Bt[n][k], At[m][k], acc[ai][bj][m][n], 0, 0, 0); __builtin_amdgcn_s_setprio(0); } while (0)
#define PG8_WAIT_V(n) asm volatile("s_waitcnt vmcnt(" #n ")" ::: "memory")
#define PG8_WAIT_L(n) asm volatile("s_waitcnt lgkmcnt(" #n ")" ::: "memory")
#define PG8_BAR __builtin_amdgcn_s_barrier()
#define PG8_SCHED __builtin_amdgcn_sched_barrier(0)
    Unit cur, nxt; int ui = 0;
    if (!S.next(0, cur)) return;
    f32x4 acc[2][2][4][2];
#pragma unroll
    for (int a = 0; a < 2; ++a)
#pragma unroll
        for (int b = 0; b < 2; ++b)
#pragma unroll
            for (int m = 0; m < 4; ++m)
#pragma unroll
                for (int n = 0; n < 2; ++n) acc[a][b][m][n] = (f32x4){0.f, 0.f, 0.f, 0.f};
    bf16x8 At[4][2], B0[2][2], B1[2][2];
    const char* cA = (const char*)g.A + S.aoff(cur); const char* cB = (const char*)g.Bt + S.boff(cur);
    if constexpr (SP2) {
        PG8_STAGE(PG8_SB(0, 0), cB, voffB); PG8_STAGE(PG8_SB(0, 1), cB + hstepB, voffB); PG8_STAGE(PG8_SA(0, 0), cA, voffA); PG8_STAGE(PG8_SA(0, 1), cA + hstepA, voffA);
        if (wr == 1) PG8_BAR;
        PG8_WAIT_V(2); PG8_BAR;
        PG8_STAGE(PG8_SB(1, 0), cB + kstep, voffB); PG8_STAGE(PG8_SA(1, 0), cA + kstep, voffA); PG8_STAGE(PG8_SB(1, 1), cB + hstepB + kstep, voffB);
        PG8_WAIT_V(6); PG8_BAR;
    } else {
        PG8_STAGE(PG8_SB(0, 0), cB, voffB); PG8_STAGE(PG8_SA(0, 0), cA, voffA); PG8_STAGE(PG8_SB(0, 1), cB + hstepB, voffB); PG8_STAGE(PG8_SA(0, 1), cA + hstepA, voffA);
        if (wr == 1) PG8_BAR;
        PG8_WAIT_V(4); PG8_BAR;
        PG8_STAGE(PG8_SB(1, 0), cB + kstep, voffB); PG8_STAGE(PG8_SA(1, 0), cA + kstep, voffA); PG8_STAGE(PG8_SB(1, 1), cB + hstepB + kstep, voffB);
        PG8_WAIT_V(6); PG8_BAR;
    }
    for (;;) {
        const bool has_next = S.next(ui + 1, nxt);
        const char* nA = has_next ? (const char*)g.A + S.aoff(nxt) : cA; const char* nB = has_next ? (const char*)g.Bt + S.boff(nxt) : cB;
#pragma nounroll
        for (int t = 0; t < nt; t += 2) {
            const bool last = (t == nt - 2);
            const char* a1 = cA + (size_t)(t + 1) * kstep;
            const char* a2 = last ? nA : cA + (size_t)(t + 2) * kstep; const char* b2 = last ? nB : cB + (size_t)(t + 2) * kstep;
            const char* a3 = a2 + kstep; const char* b3 = b2 + kstep;
            if constexpr (SP2) {
            PG8_LDB(B0, 0, 0); PG8_LDB(B1, 0, 1); PG8_SCHED; PG8_LDA(At, 0, 0); PG8_STAGE(PG8_SA(1, 1), a1 + hstepA, voffA);
            PG8_WAIT_V(8); PG8_WAIT_L(0); PG8_BAR; PG8_MMA(0, 0, At, B0); PG8_MMA(0, 1, At, B1); PG8_BAR; PG8_SCHED;
            PG8_LDA(At, 0, 1); PG8_STAGE(PG8_SB(0, 0), b2, voffB); PG8_STAGE(PG8_SB(0, 1), b2 + hstepB, voffB); PG8_STAGE(PG8_SA(0, 0), a2, voffA);
            PG8_WAIT_V(8); PG8_WAIT_L(0); PG8_BAR; PG8_MMA(1, 0, At, B0); PG8_MMA(1, 1, At, B1); PG8_BAR; PG8_SCHED;
            PG8_LDB(B0, 1, 0); PG8_LDB(B1, 1, 1); PG8_SCHED; PG8_LDA(At, 1, 0); PG8_STAGE(PG8_SA(0, 1), a2 + hstepA, voffA);
            PG8_WAIT_V(8); PG8_WAIT_L(0); PG8_BAR; PG8_MMA(0, 0, At, B0); PG8_MMA(0, 1, At, B1); PG8_BAR; PG8_SCHED;
            PG8_LDA(At, 1, 1); PG8_STAGE(PG8_SB(1, 0), b3, voffB); PG8_STAGE(PG8_SB(1, 1), b3 + hstepB, voffB); PG8_STAGE(PG8_SA(1, 0), a3, voffA);
            PG8_WAIT_V(8); PG8_WAIT_L(0); PG8_BAR; PG8_MMA(1, 0, At, B0); PG8_MMA(1, 1, At, B1); PG8_BAR; PG8_SCHED;
            } else {
            PG8_LDB(B0, 0, 0); PG8_SCHED; PG8_LDA(At, 0, 0); PG8_STAGE(PG8_SA(1, 1), a1 + hstepA, voffA);
            PG8_WAIT_L(8); PG8_BAR; PG8_WAIT_L(0); PG8_MMA(0, 0, At, B0); PG8_BAR; PG8_SCHED;
            PG8_LDB(B1, 0, 1); PG8_STAGE(PG8_SB(0, 0), b2, voffB);
            PG8_BAR; PG8_WAIT_L(0); PG8_MMA(0, 1, At, B1); PG8_BAR;
            PG8_LDA(At, 0, 1); PG8_STAGE(PG8_SA(0, 0), a2, voffA);
            PG8_BAR; PG8_WAIT_L(0); PG8_MMA(1, 0, At, B0); PG8_BAR; PG8_SCHED;
            PG8_STAGE(PG8_SB(0, 1), b2 + hstepB, voffB);
            PG8_WAIT_V(6); PG8_BAR; PG8_MMA(1, 1, At, B1); PG8_BAR;
            PG8_LDB(B0, 1, 0); PG8_SCHED; PG8_LDA(At, 1, 0); PG8_STAGE(PG8_SA(0, 1), a2 + hstepA, voffA);
            PG8_WAIT_L(8); PG8_BAR; PG8_WAIT_L(0); PG8_MMA(0, 0, At, B0); PG8_BAR; PG8_SCHED;
            PG8_LDB(B1, 1, 1); PG8_STAGE(PG8_SB(1, 0), b3, voffB);
            PG8_BAR; PG8_WAIT_L(0); PG8_MMA(0, 1, At, B1); PG8_BAR;
            PG8_LDA(At, 1, 1); PG8_STAGE(PG8_SA(1, 0), a3, voffA);
            PG8_BAR; PG8_WAIT_L(0); PG8_MMA(1, 0, At, B0); PG8_BAR; PG8_SCHED;
            PG8_STAGE(PG8_SB(1, 1), b3 + hstepB, voffB);
            PG8_WAIT_V(6); PG8_BAR; PG8_MMA(1, 1, At, B1); PG8_BAR;
            }
        }
        if constexpr (ALIGN_EPI) { if (wr == 0) PG8_BAR; }
        E(acc, cur, wr, wc, fr, fq);
        if (!has_next) break;
#pragma unroll
        for (int a = 0; a < 2; ++a)
#pragma unroll
            for (int b = 0; b < 2; ++b)
#pragma unroll
                for (int m = 0; m < 4; ++m)
#pragma unroll
                    for (int n = 0; n < 2; ++n) acc[a][b][m][n] = (f32x4){0.f, 0.f, 0.f, 0.f};
        cur = nxt; cA = nA; cB = nB; ++ui;
        if constexpr (ALIGN_EPI) { if (wr == 1) PG8_BAR; }
    }
    PG8_WAIT_V(0);
    if constexpr (!ALIGN_EPI) { if (wr == 0) PG8_BAR; }
    PG8_BAR;
#undef PG8_SA
#undef PG8_SB
#undef PG8_STAGE
#undef PG8_LDA
#undef PG8_LDB
#undef PG8_MMA
#undef PG8_WAIT_V
#undef PG8_WAIT_L
#undef PG8_BAR
#undef PG8_SCHED
}
}

struct Args { const void* in[24]; float* out; unsigned char* ws; int ph_lo, ph_hi; };
struct Frame {
    LAS unsigned char* lds; unsigned* ctl; unsigned char* ws;
    int tid, lane, wave, G, bid;
};
#define INF(k) ((const float*)args.in[k])
DI float wave_sum(float v) {
#pragma unroll
    for (int o = 1; o < 64; o <<= 1) v += __shfl_xor(v, o);
    return v;
}

DI void tr_item(const float* W, int ldS, int Nvalid, bf16* WT, int ldD, int koff, int mode, int roff, LAS float* scr, int k0, int n0, int lane) {
    const int nl = n0 + (lane & 31);
    float tv[32]; const float* wp = W + (size_t)(k0 + (lane >> 5)) * ldS + nl; const bool ok = nl < Nvalid;
#pragma unroll
    for (int i = 0; i < 32; ++i) tv[i] = ok ? __builtin_nontemporal_load(wp + (size_t)(2 * i) * ldS) : 0.f;
#pragma unroll
    for (int i = 0; i < 32; ++i) scr[(2 * i + (lane >> 5)) * 33 + (lane & 31)] = tv[i];
    LDS_WAIT(); asm volatile("" ::: "memory");
    const int c = lane & 7;
#pragma unroll
    for (int j = 0; j < 4; ++j) { const int nn = (lane >> 3) + 8 * j, n = n0 + nn; const LAS float* s = scr + (8 * c) * 33 + nn;
        u32x4 o; o.x = pk2(s[0 * 33], s[1 * 33]); o.y = pk2(s[2 * 33], s[3 * 33]); o.z = pk2(s[4 * 33], s[5 * 33]); o.w = pk2(s[6 * 33], s[7 * 33]);
        const int row = mode == 0 ? roff + n : (mode == 1 ? (n < C_PADLO ? n : n + (C_P - C_PADLO)) : ((n >> 7) << 8) + roff + (n & 127));
        if (n < Nvalid) *(u32x4*)(WT + (size_t)row * ldD + koff + k0 + 8 * c) = o; }
    LDS_WAIT(); asm volatile("" ::: "memory");
}
constexpr int NB_IN = (NIN + 31) / 32;
constexpr int CI_IN = 32 * NB_IN, CI_OUT = 96 * 64, CI_POOL = 8 * 8 * 16, CI_LRU = 64 * 8, CI_GU = 2 * 32 * 172, CI_DN = 86 * 64, CI_MGU = 16 * 32 * 224, CI_MDN = 8 * 112 * 64;
constexpr int CE_0 = CI_IN + CI_POOL + CI_LRU;
constexpr int CE_1 = CE_0 + CI_OUT;
constexpr int CE_2 = CE_1 + CI_GU;
constexpr int CE_3 = CE_2 + CI_DN;
constexpr int CE_4 = CE_3 + CI_IN;
constexpr int CE_5 = CE_4 + CI_OUT;
constexpr int CE_6 = CE_5 + CI_MGU;
constexpr int CE_7 = CE_6 + CI_MDN;
constexpr int MOE_EARLY = 224 * 8 * 14;
DI void conv_item(unsigned char* ws, const Args& args, int idx, LAS float* scr, int lane) {
    const float* W; bf16* WT; int ldS, Nv, ldD, koff = 0, mode = 0, roff = 0, kb, nb; int r = idx;
    if (r < CI_IN) { kb = r / NB_IN; nb = r % NB_IN; W = INF(2); ldS = NIN; Nv = NIN; WT = (bf16*)(ws + WS_WIN); ldD = DM; mode = 1; }
    else if ((r -= CI_IN) < CI_POOL) { const int lg = r >> 7, q = r & 127; kb = q >> 4; nb = q & 15; W = INF(4) + (size_t)lg * 512 * 512; ldS = 512; Nv = 512; WT = (bf16*)(ws + WS_WPOOL) + (size_t)(lg >> 2) * 2048 * 512; ldD = 512; roff = (lg & 3) * 512; }
    else if ((r -= CI_POOL) < CI_LRU) { const int cmb = r >> 3, q = r & 7, l = cmb >> 5, which = (cmb >> 4) & 1, n = cmb & 15; kb = q >> 2; nb = q & 3;
        W = (which ? INF(10) : INF(8)) + ((size_t)l * 16 + n) * 128 * 128; ldS = 128; Nv = 128; WT = (bf16*)(ws + WS_WLRU) + (size_t)l * 4096 * 256; ldD = 256; koff = (n & 1) * 128; roff = n * 256 + which * 128; }
    else if ((r -= CI_LRU) < CI_OUT) { kb = r >> 6; nb = r & 63; W = INF(3); ldS = DM; Nv = DM; WT = (bf16*)(ws + WS_WOUT); ldD = MIXW; }
    else if ((r -= CI_OUT) < CI_GU) { const int which = r / (32 * 172), q = r % (32 * 172); kb = q / 172; nb = q % 172; W = which ? INF(18) : INF(17); ldS = DFF; Nv = DFF; WT = (bf16*)(ws + WS_WGU); ldD = DM; mode = 2; roff = which * 128; }
    else if ((r -= CI_GU) < CI_DN) { kb = r >> 6; nb = r & 63; W = INF(19); ldS = DM; Nv = DM; WT = (bf16*)(ws + WS_WDN); ldD = DFF; }
    else if ((r -= CI_DN) < CI_IN) { kb = r / NB_IN; nb = r % NB_IN; W = INF(2) + (size_t)DM * NIN; ldS = NIN; Nv = NIN; WT = (bf16*)(ws + WS_WIN) + (size_t)NINP * DM; ldD = DM; mode = 1; }
    else if ((r -= CI_IN) < CI_OUT) { kb = r >> 6; nb = r & 63; W = INF(3) + (size_t)MIXW * DM; ldS = DM; Nv = DM; WT = (bf16*)(ws + WS_WOUT) + (size_t)DM * MIXW; ldD = MIXW; }
    else if ((r -= CI_OUT) < CI_MGU) { const int ew = r / (32 * 224), q = r % (32 * 224), e = ew >> 1, which = ew & 1; kb = q / 224; nb = q % 224;
        W = (which ? INF(22) : INF(21)) + (size_t)e * DM * DEXP; ldS = DEXP; Nv = DEXP; WT = (bf16*)(ws + WS_MWGU) + (size_t)e * 2 * DEXP * DM; ldD = DM; mode = 2; roff = which * 128; }
    else { r -= CI_MGU; const int e = r / (112 * 64), q = r % (112 * 64); kb = q >> 6; nb = q & 63; W = INF(23) + (size_t)e * DEXP * DM; ldS = DM; Nv = DM; WT = (bf16*)(ws + WS_MWDN) + (size_t)e * DM * DEXP; ldD = DEXP; }
    tr_item(W, ldS, Nv, WT, ldD, koff, mode, roff, scr, 64 * kb, 32 * nb, lane);
}
DI void conv_range(Frame& F, const Args& args, int i0, int i1, int wg0) {
    if (F.bid < wg0) return;
    LAS float* scr = (LAS float*)(F.lds + F.wave * 16384);
    const int gw = (F.bid - wg0) * 8 + F.wave, NGW = (F.G - wg0) * 8;
    for (int it = i0 + gw; it < i1; it += NGW) conv_item(F.ws, args, it, scr, F.lane);
}
DI void p0_prologue(Frame& F, const Args& args) {
    conv_range(F, args, 0, CE_0, 0);
    bf16* Wlru = (bf16*)(F.ws + WS_WLRU);
    const int gt = F.bid * 512 + F.tid, NT = F.G * 512;
    for (int i = gt; i < 2 * 4096 * 16; i += NT) { const int row = i >> 4, ch = i & 15, n = (row & 4095) >> 8;
        *(u32x4*)(Wlru + (size_t)row * 256 + ((n + 1) & 1) * 128 + ch * 8) = (u32x4){0u, 0u, 0u, 0u}; }
    float* cosA = (float*)(F.ws + WS_COSA); float* sinA = (float*)(F.ws + WS_SINA); float* cosI = (float*)(F.ws + WS_COSI); float* sinI = (float*)(F.ws + WS_SINI);
    for (int i = gt; i < MTOK * 96; i += NT) {
        const int tok = i / 96, j = i % 96; const bool isA = j < 64; const int fi = isA ? j : j - 64; const double dim = isA ? 128.0 : 64.0;
        const float inv = (float)pow(10000.0, -(double)(2 * fi) / dim);
        const float ang = (float)((const int*)args.in[1])[tok] * inv; const double a = (double)ang; const double nrev = rint(a * 0.15915494309189535); const double rr = a - nrev * 6.283185307179586;
        const float cv = (float)cos(rr), sv = (float)sin(rr);
        if (isA) { cosA[tok * 64 + fi] = cv; sinA[tok * 64 + fi] = sv; } else { cosI[tok * 32 + fi] = cv; sinI[tok * 32 + fi] = sv; }
    }
    float* c8 = (float*)(F.ws + WS_LRUC);
    for (int i = gt; i < 2 * DM; i += NT) { const float lam = INF(12)[i]; c8[i] = 8.0f * log1pf(expf(-lam)); }
    bf16* xb = (bf16*)(F.ws + WS_XB);
    for (int i = gt; i < MTOK * DM / 8; i += NT) { const f32x4 a = *(const f32x4*)(INF(0) + (size_t)i * 8), b = *(const f32x4*)(INF(0) + (size_t)i * 8 + 4);
        u32x4 o; o.x = pk2(a[0], a[1]); o.y = pk2(a[2], a[3]); o.z = pk2(b[0], b[1]); o.w = pk2(b[2], b[3]); *(u32x4*)(xb + (size_t)i * 8) = o; }
}

DI void ld8(const bf16* p, float (&v)[8]) { const u32x4 w = *(const u32x4*)p; v[0] = bflo(w.x); v[1] = bfhi(w.x); v[2] = bflo(w.y); v[3] = bfhi(w.y); v[4] = bflo(w.z); v[5] = bfhi(w.z); v[6] = bflo(w.w); v[7] = bfhi(w.w); }
DI void st8(bf16* p, const float (&v)[8]) { u32x4 o; o.x = pk2(v[0], v[1]); o.y = pk2(v[2], v[3]); o.z = pk2(v[4], v[5]); o.w = pk2(v[6], v[7]); *(u32x4*)p = o; }

template <int G>
DI void pool_group(const bf16* proj, bf16* diff, int gt, int NT) {
    constexpr int W = 2 << G, NB = (G == 3) ? 1 : (G == 2 ? 2 : 4);
    for (int it0 = gt; it0 < MTOK * 64; it0 += NB * NT) {
        u32x4 r[NB][W];
#pragma unroll
        for (int q = 0; q < NB; ++q) { const int it = it0 + q * NT, tok = it >> 6, c = G * 512 + (it & 63) * 8, tpos = tok & (SEQ - 1), cnt = (tpos + 1) < W ? (tpos + 1) : W;
            const bf16* pp = proj + (size_t)tok * NINP + C_P + c;
#pragma unroll
            for (int j = 0; j < W; ++j) r[q][j] = *(const u32x4*)(pp - (size_t)(j < cnt ? j : 0) * NINP); }
#pragma unroll
        for (int q = 0; q < NB; ++q) { const int it = it0 + q * NT, tok = it >> 6, c = G * 512 + (it & 63) * 8, tpos = tok & (SEQ - 1), cnt = (tpos + 1) < W ? (tpos + 1) : W;
            float sum[8];
#pragma unroll
            for (int i = 0; i < 8; ++i) sum[i] = 0.f;
#pragma unroll
            for (int j = 0; j < W; ++j) { const float m = j < cnt ? 1.f : 0.f;
                sum[0] += m * bflo(r[q][j].x); sum[1] += m * bfhi(r[q][j].x); sum[2] += m * bflo(r[q][j].y); sum[3] += m * bfhi(r[q][j].y);
                sum[4] += m * bflo(r[q][j].z); sum[5] += m * bfhi(r[q][j].z); sum[6] += m * bflo(r[q][j].w); sum[7] += m * bfhi(r[q][j].w); }
            const float rc = 1.0f / (float)cnt; float v[8];
            v[0] = sum[0] * rc - bflo(r[q][0].x); v[1] = sum[1] * rc - bfhi(r[q][0].x); v[2] = sum[2] * rc - bflo(r[q][0].y); v[3] = sum[3] * rc - bfhi(r[q][0].y);
            v[4] = sum[4] * rc - bflo(r[q][0].z); v[5] = sum[5] * rc - bfhi(r[q][0].z); v[6] = sum[6] * rc - bflo(r[q][0].w); v[7] = sum[7] * rc - bfhi(r[q][0].w);
            st8(diff + (size_t)tok * DM + c, v); }
    }
}
DI void p2_prep(Frame& F, const Args& args, int layer) {
    bf16* proj = (bf16*)(F.ws + WS_PROJ); bf16* diff = (bf16*)(F.ws + WS_DIFF); bf16* xc = (bf16*)(F.ws + WS_XC);
    const float* cosA = (const float*)(F.ws + WS_COSA); const float* sinA = (const float*)(F.ws + WS_SINA); const float* cosI = (const float*)(F.ws + WS_COSI); const float* sinI = (const float*)(F.ws + WS_SINI);
    const int gt = F.bid * 512 + F.tid, NT = F.G * 512;
    for (int it0 = gt; it0 < MTOK * 256; it0 += 4 * NT) {
        u32x4 xa[4], xb_[4]; f32x4 c0[4], c1[4], s0[4], s1[4]; bf16* p1[4]; int hv[4]; bool act[4];
#pragma unroll
        for (int q = 0; q < 4; ++q) { const int it = it0 + q * NT, tok = it >> 8, j = it & 255; act[q] = j < 228;
            int col, half, d; const float *ct, *st;
            if (j < 128) { d = (j & 7) * 8; col = C_Q + (j >> 3) * 128 + d; half = 64; ct = cosA + tok * 64 + d; st = sinA + tok * 64 + d; }
            else if (j < 160) { const int jj = j - 128; d = (jj & 7) * 8; col = C_K + (jj >> 3) * 128 + d; half = 64; ct = cosA + tok * 64 + d; st = sinA + tok * 64 + d; }
            else if (j < 224) { const int jj = j - 160; d = (jj & 3) * 8; col = C_QI + (jj >> 2) * 64 + d; half = 32; ct = cosI + tok * 32 + d; st = sinI + tok * 32 + d; }
            else { const int jj = j < 228 ? j - 224 : 0; d = jj * 8; col = C_KI + d; half = 32; ct = cosI + tok * 32 + d; st = sinI + tok * 32 + d; }
            p1[q] = proj + (size_t)tok * NINP + col; hv[q] = half;
            xa[q] = *(const u32x4*)p1[q]; xb_[q] = *(const u32x4*)(p1[q] + half);
            c0[q] = *(const f32x4*)ct; c1[q] = *(const f32x4*)(ct + 4); s0[q] = *(const f32x4*)st; s1[q] = *(const f32x4*)(st + 4); }
#pragma unroll
        for (int q = 0; q < 4; ++q) { if (act[q]) {
            const float x1[8] = {bflo(xa[q].x), bfhi(xa[q].x), bflo(xa[q].y), bfhi(xa[q].y), bflo(xa[q].z), bfhi(xa[q].z), bflo(xa[q].w), bfhi(xa[q].w)};
            const float x2[8] = {bflo(xb_[q].x), bfhi(xb_[q].x), bflo(xb_[q].y), bfhi(xb_[q].y), bflo(xb_[q].z), bfhi(xb_[q].z), bflo(xb_[q].w), bfhi(xb_[q].w)};
            float y1[8], y2[8];
#pragma unroll
            for (int i = 0; i < 8; ++i) { const float c = i < 4 ? c0[q][i & 3] : c1[q][i & 3], s = i < 4 ? s0[q][i & 3] : s1[q][i & 3]; y1[i] = x1[i] * c - x2[i] * s; y2[i] = x2[i] * c + x1[i] * s; }
            st8(p1[q], y1); st8(p1[q] + hv[q], y2); } }
    }
    pool_group<0>(proj, diff, gt, NT); pool_group<1>(proj, diff, gt, NT); pool_group<2>(proj, diff, gt, NT); pool_group<3>(proj, diff, gt, NT);
    const float* cw = INF(6) + (size_t)layer * 4 * DM; const float* cb = INF(7) + (size_t)layer * DM;
    for (int it0 = gt; it0 < MTOK * 256; it0 += 4 * NT) {
        u32x4 r[4][4];
#pragma unroll
        for (int q = 0; q < 4; ++q) { const int it = it0 + q * NT, tok = it >> 8, c = (it & 255) * 8, tpos = tok & (SEQ - 1); const bf16* px = proj + (size_t)tok * NINP + C_XR + c;
#pragma unroll
            for (int jj = 0; jj < 4; ++jj) { const int back = 3 - jj; r[q][jj] = *(const u32x4*)(px - (size_t)(tpos >= back ? back : 0) * NINP); } }
#pragma unroll
        for (int q = 0; q < 4; ++q) { const int it = it0 + q * NT, tok = it >> 8, c = (it & 255) * 8, tpos = tok & (SEQ - 1);
            float acc[8]; const f32x4 b0 = *(const f32x4*)(cb + c), b1 = *(const f32x4*)(cb + c + 4);
#pragma unroll
            for (int i = 0; i < 8; ++i) acc[i] = i < 4 ? b0[i & 3] : b1[i & 3];
#pragma unroll
            for (int jj = 0; jj < 4; ++jj) { const float m = (tpos >= 3 - jj) ? 1.f : 0.f;
                const f32x4 w0 = *(const f32x4*)(cw + jj * DM + c) * m, w1 = *(const f32x4*)(cw + jj * DM + c + 4) * m;
                acc[0] += bflo(r[q][jj].x) * w0[0]; acc[1] += bfhi(r[q][jj].x) * w0[1]; acc[2] += bflo(r[q][jj].y) * w0[2]; acc[3] += bfhi(r[q][jj].y) * w0[3];
                acc[4] += bflo(r[q][jj].z) * w1[0]; acc[5] += bfhi(r[q][jj].z) * w1[1]; acc[6] += bflo(r[q][jj].w) * w1[2]; acc[7] += bfhi(r[q][jj].w) * w1[3]; }
            st8(xc + (size_t)tok * DM + c, acc); }
    }
}

DI void p3_indexer(Frame& F) {
    const bf16* proj = (const bf16*)(F.ws + WS_PROJ); float* sc = (float*)(F.ws + WS_SC);
    const int gw = F.bid * 8 + F.wave, NGW = F.G * 8, l15 = F.lane & 15, l4 = F.lane >> 4;
    for (int u = gw; u < BATCH * 576; u += NGW) {
        const int b = u / 576, r = u % 576; int g8 = 0;
#pragma unroll
        for (int k = 1; k < 8; ++k) g8 = (r >= 8 * k * (k + 1)) ? k : g8;
        const int rr = r - 8 * g8 * (g8 + 1), sp = rr % (g8 + 1), qq = rr / (g8 + 1), qb16 = g8 * 16 + qq, c = qb16 >> 2;
        const int limit = (c + 1) * 64, kbeg = sp * 256, kend = (kbeg + 256) < limit ? (kbeg + 256) : limit;
        const int qtok = b * SEQ + qb16 * 16 + l15;
        const bf16* qrow = proj + (size_t)qtok * NINP;
        bf16x8 qf[16][2]; float w[16];
        { const u32x4 w0 = *(const u32x4*)(qrow + C_WI), w1 = *(const u32x4*)(qrow + C_WI + 8); const float s = 0.125f * 0.25f;
          w[0] = bflo(w0.x) * s; w[1] = bfhi(w0.x) * s; w[2] = bflo(w0.y) * s; w[3] = bfhi(w0.y) * s; w[4] = bflo(w0.z) * s; w[5] = bfhi(w0.z) * s; w[6] = bflo(w0.w) * s; w[7] = bfhi(w0.w) * s;
          w[8] = bflo(w1.x) * s; w[9] = bfhi(w1.x) * s; w[10] = bflo(w1.y) * s; w[11] = bfhi(w1.y) * s; w[12] = bflo(w1.z) * s; w[13] = bfhi(w1.z) * s; w[14] = bflo(w1.w) * s; w[15] = bfhi(w1.w) * s; }
#pragma unroll
        for (int h = 0; h < 16; ++h)
#pragma unroll
            for (int ks = 0; ks < 2; ++ks) qf[h][ks] = *(const bf16x8*)(qrow + C_QI + h * 64 + ks * 32 + l4 * 8);
        const bf16* kbase = proj + (size_t)(b * SEQ + l15) * NINP + C_KI + l4 * 8;
        bf16x8 nk0 = *(const bf16x8*)(kbase + (size_t)kbeg * NINP), nk1 = *(const bf16x8*)(kbase + (size_t)kbeg * NINP + 32);
        for (int k0 = kbeg; k0 < kend; k0 += 16) {
            const bf16x8 ka0 = nk0, ka1 = nk1;
            { const int kn = (k0 + 16 < kend) ? k0 + 16 : k0; nk0 = *(const bf16x8*)(kbase + (size_t)kn * NINP); nk1 = *(const bf16x8*)(kbase + (size_t)kn * NINP + 32); }
            f32x4 tot = {0.f, 0.f, 0.f, 0.f};
#pragma unroll
            for (int h = 0; h < 16; ++h) { f32x4 s = {0.f, 0.f, 0.f, 0.f};
                s = __builtin_amdgcn_mfma_f32_16x16x32_bf16(ka0, qf[h][0], s, 0, 0, 0); s = __builtin_amdgcn_mfma_f32_16x16x32_bf16(ka1, qf[h][1], s, 0, 0, 0);
#pragma unroll
                for (int j = 0; j < 4; ++j) tot[j] += w[h] * fmaxf(s[j], 0.f); }
            *(f32x4*)(sc + (size_t)qtok * SEQ + k0 + 4 * l4) = tot;
        }
    }
}

DI void p4_select(Frame& F) {
    const float* sc = (const float*)(F.ws + WS_SC); unsigned* mask = (unsigned*)(F.ws + WS_MASK);
    const int gw = F.bid * 8 + F.wave, NGW = F.G * 8, lane = F.lane;
    for (int tok = gw; tok < MTOK; tok += NGW) {
        const int tpos = tok & (SEQ - 1), limit = ((tpos >> 6) + 1) * 64, nw = limit >> 5;
        unsigned mw = 0u;
        if (limit <= 256) { mw = lane < nw ? 0xffffffffu : 0u; }
        else {
            unsigned key[32];
            if (lane < nw) { const float* p = sc + (size_t)tok * SEQ + lane * 32;
#pragma unroll
                for (int q = 0; q < 8; ++q) { const f32x4 v = *(const f32x4*)(p + 4 * q);
#pragma unroll
                    for (int j = 0; j < 4; ++j) { const unsigned uu = __float_as_uint(v[j]); key[4 * q + j] = (uu & 0x80000000u) ? ~uu : (uu | 0x80000000u); } } }
            else {
#pragma unroll
                for (int j = 0; j < 32; ++j) key[j] = 0u; }
            unsigned T = 0u; bool exact = false;
            for (int bit = 31; bit >= 0; --bit) {
                const unsigned cand = T | (1u << bit); int cnt = 0;
#pragma unroll
                for (int j = 0; j < 32; ++j) cnt += __popcll(__ballot(key[j] >= cand));
                if (cnt >= 256) { T = cand; if (cnt == 256) { exact = true; break; } }
            }
            unsigned gtw = 0u, eqw = 0u;
#pragma unroll
            for (int j = 0; j < 32; ++j) { gtw |= (key[j] > T) ? (1u << j) : 0u; eqw |= (key[j] == T) ? (1u << j) : 0u; }
            if (exact) { mw = gtw | eqw; }
            else {
                int ngt = 0;
#pragma unroll
                for (int j = 0; j < 32; ++j) ngt += __popcll(__ballot(key[j] > T));
                const int need = 256 - ngt; const int el = __popc(eqw);
                int pre = el;
#pragma unroll
                for (int o = 1; o < 64; o <<= 1) { const int t = __shfl_up(pre, o); pre += (lane >= o) ? t : 0; }
                int take = need - (pre - el); take = take < 0 ? 0 : (take > el ? el : take);
                unsigned sel = 0u, rem = eqw;
                for (int t = 0; t < 32; ++t) { if (t < take) { const unsigned low = rem & (0u - rem); sel |= low; rem ^= low; } }
                mw = gtw | sel;
            }
        }
        mask[(size_t)tok * 64 + lane] = mw;
    }
}

DI void p4_lru_pass1(Frame& F) {
    const unsigned* AB = (const unsigned*)(F.ws + WS_A); float* CP = (float*)(F.ws + WS_CARRY); float* CH = CP + BATCH * 64 * DM;
    for (int u = F.bid; u < BATCH * 64; u += F.G) {
        const int j = u & 63, b = u >> 6, c = 4 * F.tid;
        const size_t base = ((size_t)b * SEQ + j * 32) * DM + c;
        u32x4 w[32];
#pragma unroll
        for (int t = 0; t < 32; ++t) w[t] = *(const u32x4*)(AB + base + (size_t)t * DM);
        f32x4 P = {1.f, 1.f, 1.f, 1.f}, H = {0.f, 0.f, 0.f, 0.f};
#pragma unroll
        for (int t = 0; t < 32; ++t) { const f32x4 a = {__expf(bflo(w[t].x)), __expf(bflo(w[t].y)), __expf(bflo(w[t].z)), __expf(bflo(w[t].w))}, bb = {bfhi(w[t].x), bfhi(w[t].y), bfhi(w[t].z), bfhi(w[t].w)};
            H = a * H + bb; P = P * a; }
        *(f32x4*)(CP + ((size_t)b * 64 + j) * DM + c) = P; *(f32x4*)(CH + ((size_t)b * 64 + j) * DM + c) = H;
    }
}
DI void p5_lru_pass2(Frame& F) {
    const unsigned* AB = (const unsigned*)(F.ws + WS_A); const float* CP = (const float*)(F.ws + WS_CARRY); const float* CH = CP + BATCH * 64 * DM;
    const bf16* proj = (const bf16*)(F.ws + WS_PROJ); bf16* mrg = (bf16*)(F.ws + WS_MRG);
    for (int u = F.bid; u < BATCH * 64; u += F.G) {
        const int j = u & 63, b = u >> 6, c = 4 * F.tid;
        f32x4 h = {0.f, 0.f, 0.f, 0.f};
#pragma unroll 8
        for (int jj = 0; jj < j; ++jj) { const f32x4 p = *(const f32x4*)(CP + ((size_t)b * 64 + jj) * DM + c), q = *(const f32x4*)(CH + ((size_t)b * 64 + jj) * DM + c); h = p * h + q; }
        const size_t tok0 = (size_t)b * SEQ + j * 32;
#pragma unroll 1
        for (int hs = 0; hs < 2; ++hs) {
            u32x4 w[16]; u32x2 gr[16], gg[16];
#pragma unroll
            for (int t = 0; t < 16; ++t) { const size_t tok = tok0 + hs * 16 + t; w[t] = *(const u32x4*)(AB + tok * DM + c); gr[t] = *(const u32x2*)(proj + tok * NINP + C_GR + c); gg[t] = *(const u32x2*)(proj + tok * NINP + C_G + 4096 + c); }
#pragma unroll
            for (int t = 0; t < 16; ++t) { const size_t tok = tok0 + hs * 16 + t;
                const f32x4 a = {__expf(bflo(w[t].x)), __expf(bflo(w[t].y)), __expf(bflo(w[t].z)), __expf(bflo(w[t].w))}, bb = {bfhi(w[t].x), bfhi(w[t].y), bfhi(w[t].z), bfhi(w[t].w)};
                h = a * h + bb;
                u32x2 o; o.x = pk2(h[0] * gelu_tanh_(bflo(gr[t].x)) * sigmoidf_(bflo(gg[t].x)), h[1] * gelu_tanh_(bfhi(gr[t].x)) * sigmoidf_(bfhi(gg[t].x)));
                o.y = pk2(h[2] * gelu_tanh_(bflo(gr[t].y)) * sigmoidf_(bflo(gg[t].y)), h[3] * gelu_tanh_(bfhi(gr[t].y)) * sigmoidf_(bfhi(gg[t].y)));
                *(u32x2*)(mrg + tok * MIXW + 4096 + c) = o; }
        }
    }
}

typedef short s16x4 __attribute__((ext_vector_type(4)));
constexpr int KS_STRIDE = 272, VS_STRIDE = 320, ATT_V = 64 * KS_STRIDE, ATT_BUF = 64 * KS_STRIDE + 64 * VS_STRIDE;
DI void p5_attention(Frame& F) {
    const bf16* proj = (const bf16*)(F.ws + WS_PROJ); const unsigned* mask = (const unsigned*)(F.ws + WS_MASK); bf16* mrg = (bf16*)(F.ws + WS_MRG);
    const int lane = F.lane, l31 = lane & 31, hf = lane >> 5, wave = F.wave, hh = wave >> 1, qh = wave & 1, tid = F.tid;
    const float sc2 = 0.08838834764831845f * 1.4426950408889634f;
    const int gi = lane >> 4, i16 = lane & 15;
    const int vbase = ATT_V + (4 * (gi >> 1) + (i16 >> 2)) * VS_STRIDE + (16 * (gi & 1) + 4 * (i16 & 3)) * 2;
    const int sr0 = tid >> 4, sch = tid & 15;
    for (int u = F.bid; u < BATCH * 16 * 4; u += F.G) {
        const int g = u & 3, cp = (u >> 2) & 15, b = u >> 6;
        for (int half = 0; half < 2; ++half) {
            const int c = half ? (31 - cp) : cp, nkt = c + 1, head = g * 4 + hh;
            const int qtok = b * SEQ + c * 64 + qh * 32 + l31;
            const bf16* qrow = proj + (size_t)qtok * NINP + C_Q + head * 128 + hf * 8;
            bf16x8 qf[8];
#pragma unroll
            for (int ks = 0; ks < 8; ++ks) qf[ks] = *(const bf16x8*)(qrow + ks * 16);
            f32x16 o[4];
#pragma unroll
            for (int db = 0; db < 4; ++db)
#pragma unroll
                for (int i = 0; i < 16; ++i) o[db][i] = 0.f;
            float mrun = -1e30f, lrun = 0.f;
            const bf16* kg = proj + (size_t)(b * SEQ + sr0) * NINP + C_K + g * 128 + sch * 8;
            const bf16* vg = proj + (size_t)(b * SEQ + sr0) * NINP + C_V + g * 128 + sch * 8;
            u32x4 kr0 = *(const u32x4*)kg, kr1 = *(const u32x4*)(kg + (size_t)32 * NINP), vr0 = *(const u32x4*)vg, vr1 = *(const u32x4*)(vg + (size_t)32 * NINP);
            const unsigned* mrow = mask + (size_t)qtok * 64;
            unsigned mw0 = mrow[0], mw1 = mrow[1];
            { LAS unsigned char* B0 = F.lds;
              *(LAS u32x4*)(B0 + sr0 * KS_STRIDE + sch * 16) = kr0; *(LAS u32x4*)(B0 + (sr0 + 32) * KS_STRIDE + sch * 16) = kr1;
              *(LAS u32x4*)(B0 + ATT_V + sr0 * VS_STRIDE + sch * 16) = vr0; *(LAS u32x4*)(B0 + ATT_V + (sr0 + 32) * VS_STRIDE + sch * 16) = vr1; }
            __syncthreads();
            for (int kt = 0; kt < nkt; ++kt) {
                LAS unsigned char* Bc = F.lds + (kt & 1) * ATT_BUF; LAS unsigned char* Bn = F.lds + ((kt + 1) & 1) * ATT_BUF;
                const unsigned cm0 = mw0, cm1 = mw1; const bool more = kt + 1 < nkt;
                if (more) { const size_t adv = (size_t)(kt + 1) * 64 * NINP;
                    kr0 = *(const u32x4*)(kg + adv); kr1 = *(const u32x4*)(kg + adv + (size_t)32 * NINP); vr0 = *(const u32x4*)(vg + adv); vr1 = *(const u32x4*)(vg + adv + (size_t)32 * NINP);
                    mw0 = mrow[2 * kt + 2]; mw1 = mrow[2 * kt + 3]; }
                f32x16 s0, s1;
#pragma unroll
                for (int i = 0; i < 16; ++i) { s0[i] = 0.f; s1[i] = 0.f; }
#pragma unroll
                for (int ks = 0; ks < 8; ++ks) {
                    const bf16x8 ka = *(const LAS bf16x8*)(Bc + l31 * KS_STRIDE + ks * 32 + hf * 16);
                    const bf16x8 kb = *(const LAS bf16x8*)(Bc + (32 + l31) * KS_STRIDE + ks * 32 + hf * 16);
                    s0 = __builtin_amdgcn_mfma_f32_32x32x16_bf16(ka, qf[ks], s0, 0, 0, 0);
                    s1 = __builtin_amdgcn_mfma_f32_32x32x16_bf16(kb, qf[ks], s1, 0, 0, 0);
                }
                const unsigned sm0 = cm0 >> (4 * hf), sm1 = cm1 >> (4 * hf);
                float tmax = -INFINITY;
#pragma unroll
                for (int i = 0; i < 16; ++i) { const unsigned bit = 1u << ((i & 3) + 8 * (i >> 2));
                    s0[i] = (sm0 & bit) ? s0[i] * sc2 : -INFINITY; s1[i] = (sm1 & bit) ? s1[i] * sc2 : -INFINITY; tmax = fmaxf(tmax, fmaxf(s0[i], s1[i])); }
                tmax = fmaxf(tmax, __shfl_xor(tmax, 32));
                const float mnew = fmaxf(mrun, tmax), alpha = __builtin_amdgcn_exp2f(mrun - mnew); mrun = mnew;
                float psum = 0.f;
#pragma unroll
                for (int i = 0; i < 16; ++i) { s0[i] = __builtin_amdgcn_exp2f(s0[i] - mnew); s1[i] = __builtin_amdgcn_exp2f(s1[i] - mnew); psum += s0[i] + s1[i]; }
                lrun = lrun * alpha + psum;
#pragma unroll
                for (int db = 0; db < 4; ++db)
#pragma unroll
                    for (int i = 0; i < 16; ++i) o[db][i] *= alpha;
#pragma unroll
                for (int kb = 0; kb < 2; ++kb)
#pragma unroll
                    for (int s = 0; s < 2; ++s) {
                        u32x4 pw;
                        if (kb == 0) { pw.x = pk2(s0[8 * s], s0[8 * s + 1]); pw.y = pk2(s0[8 * s + 2], s0[8 * s + 3]); pw.z = pk2(s0[8 * s + 4], s0[8 * s + 5]); pw.w = pk2(s0[8 * s + 6], s0[8 * s + 7]); }
                        else { pw.x = pk2(s1[8 * s], s1[8 * s + 1]); pw.y = pk2(s1[8 * s + 2], s1[8 * s + 3]); pw.z = pk2(s1[8 * s + 4], s1[8 * s + 5]); pw.w = pk2(s1[8 * s + 6], s1[8 * s + 7]); }
                        const bf16x8 pf = __builtin_bit_cast(bf16x8, pw);
#pragma unroll
                        for (int db = 0; db < 4; ++db) {
                            LAS unsigned char* vp = Bc + vbase + (kb * 32 + 16 * s) * VS_STRIDE + db * 64;
                            const s16x4 lo = __builtin_amdgcn_ds_read_tr16_b64_v4i16((LAS s16x4*)vp), hi = __builtin_amdgcn_ds_read_tr16_b64_v4i16((LAS s16x4*)(vp + 8 * VS_STRIDE));
                            const bf16x8 vf = __builtin_shufflevector(lo, hi, 0, 1, 2, 3, 4, 5, 6, 7);
                            o[db] = __builtin_amdgcn_mfma_f32_32x32x16_bf16(vf, pf, o[db], 0, 0, 0);
                        }
                    }
                if (more) {
                    *(LAS u32x4*)(Bn + sr0 * KS_STRIDE + sch * 16) = kr0; *(LAS u32x4*)(Bn + (sr0 + 32) * KS_STRIDE + sch * 16) = kr1;
                    *(LAS u32x4*)(Bn + ATT_V + sr0 * VS_STRIDE + sch * 16) = vr0; *(LAS u32x4*)(Bn + ATT_V + (sr0 + 32) * VS_STRIDE + sch * 16) = vr1; }
                __syncthreads();
            }
            const float ltot = lrun + __shfl_xor(lrun, 32), rl = 1.0f / ltot;
            const bf16* grow = proj + (size_t)qtok * NINP + C_G + head * 128; bf16* orow = mrg + (size_t)qtok * MIXW + head * 128;
#pragma unroll
            for (int db = 0; db < 4; ++db)
#pragma unroll
                for (int q4 = 0; q4 < 4; ++q4) { const int d0 = db * 32 + q4 * 8 + hf * 4; const u32x2 gv = *(const u32x2*)(grow + d0);
                    u32x2 w; w.x = pk2(o[db][4 * q4] * rl * sigmoidf_(bflo(gv.x)), o[db][4 * q4 + 1] * rl * sigmoidf_(bfhi(gv.x)));
                    w.y = pk2(o[db][4 * q4 + 2] * rl * sigmoidf_(bflo(gv.y)), o[db][4 * q4 + 3] * rl * sigmoidf_(bfhi(gv.y)));
                    *(u32x2*)(orow + d0) = w; }
        }
    }
    __syncthreads();
}

template <int MODE, bool ROUTE, bool WRITE_BF>
DI void p_layernorm(Frame& F, const Args& args, const float* src, const float* gam, const float* bet, float* outf, bf16* outb) {
    const int gw = F.bid * 8 + F.wave, NGW = F.G * 8, lane = F.lane;
    const unsigned* rt = (const unsigned*)(F.ws + WS_ROUTE); unsigned* rtw = (unsigned*)(F.ws + WS_ROUTE);
    LAS float* wr_l = (LAS float*)F.lds;
    LAS unsigned* cl = (LAS unsigned*)(F.lds + 65536);
    if (ROUTE) { for (int i = F.tid; i < DM * NEXP / 4; i += 512) *(LAS f32x4*)(wr_l + 4 * i) = *(const f32x4*)(INF(20) + 4 * i); if (F.tid < 8) cl[F.tid] = 0u; __syncthreads(); }
#define LN_COL(jj) (MODE == 1 ? (8 * lane + 512 * ((jj) >> 1) + 4 * ((jj) & 1)) : (4 * lane + 256 * (jj)))
    for (int row = gw; row < MTOK; row += NGW) {
        f32x4 v[8]; float s = 0.f;
        if (MODE == 0) {
#pragma unroll
            for (int j = 0; j < 8; ++j) v[j] = *(const f32x4*)(src + (size_t)row * DM + LN_COL(j));
        } else {
            const unsigned r0 = rt[RT_ROW + 2 * row], r1 = rt[RT_ROW + 2 * row + 1]; const float w0 = __uint_as_float(rt[RT_W + 2 * row]), w1 = __uint_as_float(rt[RT_W + 2 * row + 1]);
            const bf16* yb = (const bf16*)(F.ws + WS_YB);
            u32x4 pa[4][4], pb[4][4];
#pragma unroll
            for (int j = 0; j < 4; ++j)
#pragma unroll
                for (int ks = 0; ks < 4; ++ks) { pa[j][ks] = *(const u32x4*)(yb + ((size_t)ks * MOE_ROWS_MAX + r0) * DM + 8 * lane + 512 * j); pb[j][ks] = *(const u32x4*)(yb + ((size_t)ks * MOE_ROWS_MAX + r1) * DM + 8 * lane + 512 * j); }
#pragma unroll
            for (int j = 0; j < 4; ++j) { f32x4 a0 = {0.f, 0.f, 0.f, 0.f}, a1 = a0, b0 = a0, b1 = a0;
#pragma unroll
                for (int ks = 0; ks < 4; ++ks) { const u32x4 a = pa[j][ks], b = pb[j][ks];
                    a0 += (f32x4){bflo(a.x), bfhi(a.x), bflo(a.y), bfhi(a.y)}; a1 += (f32x4){bflo(a.z), bfhi(a.z), bflo(a.w), bfhi(a.w)};
                    b0 += (f32x4){bflo(b.x), bfhi(b.x), bflo(b.y), bfhi(b.y)}; b1 += (f32x4){bflo(b.z), bfhi(b.z), bflo(b.w), bfhi(b.w)}; }
                v[2 * j] = *(const f32x4*)(src + (size_t)row * DM + LN_COL(2 * j)) * ALPHA + a0 * w0 + b0 * w1;
                v[2 * j + 1] = *(const f32x4*)(src + (size_t)row * DM + LN_COL(2 * j + 1)) * ALPHA + a1 * w0 + b1 * w1; }
        }
#pragma unroll
        for (int j = 0; j < 8; ++j) s += (v[j][0] + v[j][1]) + (v[j][2] + v[j][3]);
        const float mean = wave_sum(s) * (1.f / DM); float s2 = 0.f;
#pragma unroll
        for (int j = 0; j < 8; ++j) { v[j] = v[j] - mean; s2 += (v[j][0] * v[j][0] + v[j][1] * v[j][1]) + (v[j][2] * v[j][2] + v[j][3] * v[j][3]); }
        const float rstd = 1.0f / sqrtf(wave_sum(s2) * (1.f / DM) + LN_EPS);
        float lg[8];
#pragma unroll
        for (int e = 0; e < 8; ++e) lg[e] = 0.f;
#pragma unroll
        for (int j = 0; j < 8; ++j) { const int cc = LN_COL(j); const f32x4 gv = *(const f32x4*)(gam + cc), bv = *(const f32x4*)(bet + cc);
            const f32x4 y = v[j] * rstd * gv + bv; *(f32x4*)(outf + (size_t)row * DM + cc) = y;
            if (WRITE_BF) { u32x2 w; w.x = pk2(y[0], y[1]); w.y = pk2(y[2], y[3]); *(u32x2*)(outb + (size_t)row * DM + cc) = w; }
            if (ROUTE) {
#pragma unroll
                for (int i = 0; i < 4; ++i) { const LAS float* wp = wr_l + (size_t)(cc + i) * 8; const f32x4 wa = *(const LAS f32x4*)wp, wb = *(const LAS f32x4*)(wp + 4); const float xv = y[i];
                    lg[0] += xv * wa[0]; lg[1] += xv * wa[1]; lg[2] += xv * wa[2]; lg[3] += xv * wa[3]; lg[4] += xv * wb[0]; lg[5] += xv * wb[1]; lg[6] += xv * wb[2]; lg[7] += xv * wb[3]; }
            }
            asm volatile("" ::: "memory"); }
        if (ROUTE) {
#pragma unroll
            for (int e = 0; e < 8; ++e) lg[e] = wave_sum(lg[e]);
            int e0 = 0; float l0 = lg[0];
#pragma unroll
            for (int e = 1; e < 8; ++e) if (lg[e] > l0) { l0 = lg[e]; e0 = e; }
            int e1 = 0; float l1 = -INFINITY;
#pragma unroll
            for (int e = 0; e < 8; ++e) if (e != e0 && lg[e] > l1) { l1 = lg[e]; e1 = e; }
            const float p1 = 1.0f / (1.0f + expf(l0 - l1)), p0 = 1.0f - p1;
            if (lane == 0) { const unsigned sl0 = __hip_atomic_fetch_add(cl + e0, 1u, __ATOMIC_RELAXED, __HIP_MEMORY_SCOPE_WORKGROUP), sl1 = __hip_atomic_fetch_add(cl + e1, 1u, __ATOMIC_RELAXED, __HIP_MEMORY_SCOPE_WORKGROUP);
                rtw[RT_E + 2 * row] = (unsigned)e0; rtw[RT_E + 2 * row + 1] = (unsigned)e1; rtw[RT_SLOT + 2 * row] = sl0; rtw[RT_SLOT + 2 * row + 1] = sl1;
                rtw[RT_W + 2 * row] = __float_as_uint(p0); rtw[RT_W + 2 * row + 1] = __float_as_uint(p1); }
        }
    }
#undef LN_COL
    if (ROUTE) { __syncthreads(); const int t2 = F.wave * 64 + lane_id_(); if (t2 < 8) rtw[RT_WGC + F.bid * 8 + t2] = cl[t2]; __syncthreads(); }
}

DI void p_moe_gather(Frame& F) {
    unsigned* rt = (unsigned*)(F.ws + WS_ROUTE);
    const bf16* x1b = (const bf16*)(F.ws + WS_X1B); bf16* am = (bf16*)(F.ws + WS_AMOE);
    LAS unsigned* pre = (LAS unsigned*)F.lds;
    LAS unsigned* tot = pre + 2048;
    const int lane = F.lane;
    __syncthreads();
    { const int e = F.wave; unsigned c[4]; unsigned s = 0u;
#pragma unroll
      for (int i = 0; i < 4; ++i) { const int b = 4 * lane + i; c[i] = b < F.G ? rt[RT_WGC + b * 8 + e] : 0u; s += c[i]; }
      unsigned inc = s;
#pragma unroll
      for (int o = 1; o < 64; o <<= 1) { const unsigned t = __shfl_up(inc, o); inc += (lane >= o) ? t : 0u; }
      unsigned ex = inc - s;
#pragma unroll
      for (int i = 0; i < 4; ++i) { pre[(4 * lane + i) * 8 + e] = ex; ex += c[i]; }
      if (lane == 63) tot[e] = inc; }
    __syncthreads();
    if (F.tid == 0) { unsigned t = 0u; for (int e = 0; e < 8; ++e) { tot[8 + e] = t; t += (tot[e] + 255u) >> 8; } }
    __syncthreads();
    if (F.bid == 0 && F.tid < 8) F.ctl[CW_CNT + F.tid] = tot[F.tid];
    const int gw = F.bid * 8 + F.wave, NGW = F.G * 8;
    for (int a = gw; a < MTOK * 2; a += NGW) {
        const int tok = a >> 1; const int e = (int)rt[RT_E + a], slot = (int)rt[RT_SLOT + a];
        const int bsrc = (tok % NGW) >> 3;
        const int row = (int)tot[8 + e] * 256 + (int)pre[bsrc * 8 + e] + slot;
        const u32x4* s = (const u32x4*)(x1b + (size_t)tok * DM); u32x4* d = (u32x4*)(am + (size_t)row * DM);
#pragma unroll
        for (int i = 0; i < 4; ++i) d[lane + 64 * i] = s[lane + 64 * i];
        if (lane == 0) rt[RT_ROW + a] = (unsigned)row;
    }
    for (int pr = gw; pr < 8 * 256; pr += NGW) { const int e = pr >> 8, i = pr & 255;
        const int row = (int)tot[8 + e] * 256 + (int)tot[e] + i, rend = ((int)tot[8 + e] + (((int)tot[e] + 255) >> 8)) * 256;
        if (row < rend) { u32x4* d = (u32x4*)(am + (size_t)row * DM);
#pragma unroll
            for (int q = 0; q < 4; ++q) d[lane + 64 * q] = (u32x4){0u, 0u, 0u, 0u}; } }
    __syncthreads();
}

constexpr int NPH_LAYER = 12;
constexpr int NPHASES = 1 + 2 * NPH_LAYER;
#define IN(k) (lo <= (k) && (k) < hi)
#define RELAUNDER() do { int l_ = lane_id_(); asm volatile("" : "+v"(l_)); F.lane = l_; F.tid = F.wave * 64 + l_; } while (0)
#define STAMP(k) do { if (STAMP_PROBE && F.bid == 0 && xb_t0(F.wave)) ((volatile LAS unsigned*)(F.lds + LDSCTL_OFF + 512))[k] = (unsigned)__builtin_amdgcn_s_memrealtime(); } while (0)
#define SEAM(k) do { if (IN(k) && IN((k) + 1)) { xcd_barrier(bar); STAMP((k) + 1); } } while (0)
template <int LAYER>
DI void run_layer(Frame& F, const Args& args, const XcdBarrier& bar, const int lo, const int hi) {
    constexpr int P = 1 + NPH_LAYER * LAYER;
    bf16* proj = (bf16*)(F.ws + WS_PROJ); bf16* xb = (bf16*)(F.ws + WS_XB); bf16* mrg = (bf16*)(F.ws + WS_MRG);
    float* x1 = (float*)(F.ws + WS_X1); bf16* x1b = (bf16*)(F.ws + WS_X1B); float* x2 = (float*)(F.ws + WS_X2); float* pre = (float*)(F.ws + WS_PRE);
    if (IN(P + 0)) {
        pg8::Gemm g{xb, (const bf16*)(F.ws + WS_WIN) + (size_t)LAYER * NINP * DM, DM, DM, DM};
        pg8::TileOrder S; S.init(MTOK / 256, NINP / 256, F.G, F.bid, (size_t)256 * DM * 2, (size_t)256 * DM * 2);
        pg8::EpiBf16 E{proj, NINP, 0};
        pg8::gemm_phase(F.lds, g, S, E, F.wave);
        RELAUNDER(); if (LAYER == 0) conv_range(F, args, CE_0, CE_3, 32); else conv_range(F, args, CE_5, CE_5 + MOE_EARLY, 32);
    }
    SEAM(P + 0);
    if (IN(P + 1)) { RELAUNDER(); p2_prep(F, args, LAYER); }
    SEAM(P + 1);
    if (IN(P + 2)) {
        { pg8::Gemm g{(const bf16*)(F.ws + WS_DIFF), (const bf16*)(F.ws + WS_WPOOL) + (size_t)LAYER * 2048 * 512, DM, 512, 512};
          pg8::TileOrder S; S.init(MTOK / 256, 8, F.G, F.bid, (size_t)256 * DM * 2, (size_t)256 * 512 * 2, 2, (size_t)512 * 2);
          pg8::EpiPool E{mrg, proj, INF(5) + (size_t)LAYER * DM};
          pg8::gemm_phase(F.lds, g, S, E, F.wave); }
        if (LAYER == 0) STAMP(25);
        { pg8::Gemm g{(const bf16*)(F.ws + WS_XC), (const bf16*)(F.ws + WS_WLRU) + (size_t)LAYER * 4096 * 256, DM, 256, 256};
          pg8::TileOrder S; S.init(MTOK / 256, 16, F.G, F.bid, (size_t)256 * DM * 2, (size_t)256 * 256 * 2, 2, (size_t)256 * 2);
          pg8::EpiLru E{(unsigned*)(F.ws + WS_A), (const bf16*)(F.ws + WS_XC), INF(9) + (size_t)LAYER * DM, INF(11) + (size_t)LAYER * DM, (const float*)(F.ws + WS_LRUC) + (size_t)LAYER * DM};
          pg8::gemm_phase(F.lds, g, S, E, F.wave); }
        if (LAYER == 0) STAMP(26);
        RELAUNDER(); p3_indexer(F);
        if (LAYER == 0) STAMP(29);
    }
    SEAM(P + 2);
    if (IN(P + 3)) { RELAUNDER(); p4_select(F); if (LAYER == 0) STAMP(27); RELAUNDER(); p4_lru_pass1(F); }
    SEAM(P + 3);
    if (IN(P + 4)) { RELAUNDER(); p5_attention(F); if (LAYER == 0) STAMP(28); RELAUNDER(); p5_lru_pass2(F); }
    SEAM(P + 4);
    if (IN(P + 5)) {
        pg8::Gemm g{mrg, (const bf16*)(F.ws + WS_WOUT) + (size_t)LAYER * DM * MIXW, MIXW, MIXW, MIXW};
        pg8::TileOrder S; S.init(MTOK / 256, DM / 256, F.G, F.bid, (size_t)256 * MIXW * 2, (size_t)256 * MIXW * 2);
        pg8::EpiRes E{pre, LAYER == 0 ? INF(0) : (const float*)x2, DM};
        pg8::gemm_phase(F.lds, g, S, E, F.wave);
    }
    SEAM(P + 5);
    if (IN(P + 6)) { RELAUNDER(); } if (IN(P + 6)) p_layernorm<0, LAYER == 1, true>(F, args, pre, INF(13) + LAYER * DM, INF(14) + LAYER * DM, x1, x1b);
    SEAM(P + 6);
    if constexpr (LAYER == 0) {
        if (IN(P + 7)) {
            pg8::Gemm g{x1b, (const bf16*)(F.ws + WS_WGU), DM, DM, DM};
            pg8::TileOrder S; S.init(MTOK / 256, 2 * DFF / 256, F.G, F.bid, (size_t)256 * DM * 2, (size_t)256 * DM * 2);
            pg8::EpiSwiglu E{(bf16*)(F.ws + WS_H), DFF};
            pg8::gemm_phase(F.lds, g, S, E, F.wave);
            RELAUNDER(); conv_range(F, args, CE_3, CE_5, 96);
        }
        SEAM(P + 7);
        if (IN(P + 8)) {
            pg8::Gemm g{(const bf16*)(F.ws + WS_H), (const bf16*)(F.ws + WS_WDN), DFF, DFF, DFF};
            pg8::TileOrder S; S.init(MTOK / 256, DM / 256, F.G, F.bid, (size_t)256 * DFF * 2, (size_t)256 * DFF * 2);
            pg8::EpiRes E{pre, x1, DM};
            pg8::gemm_phase(F.lds, g, S, E, F.wave);
        }
        SEAM(P + 8);
        if (IN(P + 9)) { RELAUNDER(); } if (IN(P + 9)) p_layernorm<0, false, true>(F, args, pre, INF(15), INF(16), x2, xb);
        if (IN(P + 9) && IN(P + 12)) { xcd_barrier(bar); STAMP(P + 10); STAMP(P + 11); STAMP(P + 12); }
    } else {
        if (IN(P + 7)) { RELAUNDER(); conv_range(F, args, CE_5 + MOE_EARLY, CE_7, 0); RELAUNDER(); p_moe_gather(F); }
        SEAM(P + 7);
        if (IN(P + 8)) {
            pg8::Gemm g{(const bf16*)(F.ws + WS_AMOE), (const bf16*)(F.ws + WS_MWGU), DM, DM, DM};
            pg8::MoeOrder S; S.init(F.ctl + CW_CNT, 2 * DEXP / 256, 1, F.G, F.bid, (size_t)256 * DM * 2, (size_t)2 * DEXP * DM * 2, (size_t)256 * DM * 2, 0);
            pg8::EpiSwiglu E{(bf16*)(F.ws + WS_HMOE), DEXP};
            pg8::gemm_phase(F.lds, g, S, E, F.wave);
        }
        SEAM(P + 8);
        if (IN(P + 9)) {
            pg8::Gemm g{(const bf16*)(F.ws + WS_HMOE), (const bf16*)(F.ws + WS_MWDN), DEXP, DEXP, DEXP / 4};
            pg8::MoeOrder S; S.init(F.ctl + CW_CNT, DM / 256, 4, F.G, F.bid, (size_t)256 * DEXP * 2, (size_t)DM * DEXP * 2, (size_t)256 * DEXP * 2, (size_t)(DEXP / 4) * 2);
            pg8::EpiBf16 E{(bf16*)(F.ws + WS_YB), DM, (size_t)MOE_ROWS_MAX * DM};
            pg8::gemm_phase(F.lds, g, S, E, F.wave);
        }
        SEAM(P + 9);
        if (IN(P + 10)) { RELAUNDER(); } if (IN(P + 10)) p_layernorm<1, false, false>(F, args, x1, INF(15) + DM, INF(16) + DM, args.out, nullptr);
    }
}
__global__ void __launch_bounds__(512, 2) fwd_kernel(Args args) {
    extern __shared__ __attribute__((aligned(16))) unsigned char lds_raw[];
    Frame F;
    F.lds = (LAS unsigned char*)lds_raw; F.ws = args.ws; F.ctl = (unsigned*)(args.ws + WS_CTL);
    F.wave = __builtin_amdgcn_readfirstlane((int)threadIdx.x >> 6); F.lane = lane_id_(); F.tid = F.wave * 64 + F.lane; F.G = gridDim.x; F.bid = blockIdx.x;
    volatile LAS unsigned* MISC = (volatile LAS unsigned*)(F.lds + LDSCTL_OFF);
    for (int u = F.tid; u < (LDS_BYTES - LDSCTL_OFF) / 4; u += 512) ((LAS unsigned*)(F.lds + LDSCTL_OFF))[u] = 0u;
    __syncthreads();
    const int lo = args.ph_lo, hi = args.ph_hi;
    XcdBarrier bar; bar.bar = F.ctl + CW_BAR; bar.x = 0; bar.st = nullptr; bar.wave = F.wave;
    if ((hi - lo) > 1) bar = xcd_barrier_post(F.ctl + CW_BAR, MISC + 8, F.wave);
    STAMP(0);
    if (IN(0)) { RELAUNDER(); p0_prologue(F, args); __syncthreads(); }
    SEAM(0);
    run_layer<0>(F, args, bar, lo, hi);
    run_layer<1>(F, args, bar, lo, hi);
#if STAMP_PROBE
    RELAUNDER();
    if (F.bid == 0) {
        asm volatile("s_waitcnt vmcnt(0)" ::: "memory"); __syncthreads();
        if (xb_t0(F.wave)) ((volatile LAS unsigned*)(F.lds + LDSCTL_OFF + 512))[NPHASES - 1] = (unsigned)__builtin_amdgcn_s_memrealtime();
        __syncthreads();
        volatile LAS unsigned* st = (volatile LAS unsigned*)(F.lds + LDSCTL_OFF + 512);
        const float ta = (float)(st[STAMP_A_HI] - st[STAMP_A_LO]) * 0.01f, tb = (float)(st[STAMP_B_HI] - st[STAMP_B_LO]) * 0.01f;
        const float da = __builtin_amdgcn_sqrtf(ta * 0.005f);
        for (int i = F.tid; i < DM; i += 512) args.out[i] += da;
        if (F.tid == 0) args.out[DM] += tb * 0.1f;
    }
#endif
}
#undef IN
#undef SEAM

extern "C" void kernel_launch(void* const* d_in, const int* in_sizes, int n_in, void* d_out, int out_size, void* d_ws, size_t ws_size, hipStream_t stream) {
    static int grid = 0;
    if (grid == 0) {
        if (n_in != 24 || out_size != MTOK * DM || ws_size < WS_END) { fprintf(stderr, "kernel_launch: unexpected problem (n_in %d, out %d, ws %zu, need %zu)\n", n_in, out_size, ws_size, (size_t)WS_END); grid = -1; return; }
        int dev = 0, cus = 0, per_cu = 0;
        if (hipGetDevice(&dev) != hipSuccess || hipDeviceGetAttribute(&cus, hipDeviceAttributeMultiprocessorCount, dev) != hipSuccess) { grid = -1; return; }
        if (hipFuncSetAttribute((const void*)fwd_kernel, hipFuncAttributeMaxDynamicSharedMemorySize, LDS_BYTES) != hipSuccess) { fprintf(stderr, "kernel_launch: hipFuncSetAttribute failed\n"); grid = -1; return; }
        if (hipOccupancyMaxActiveBlocksPerMultiprocessor(&per_cu, (const void*)fwd_kernel, 512, LDS_BYTES) != hipSuccess || per_cu < 1) fprintf(stderr, "kernel_launch: occupancy query reports %d\n", per_cu);
        (void)hipGetLastError();
        grid = cus;
    }
    if (grid < 0) return;
    (void)hipMemsetAsync((char*)d_ws + WS_CTL, 0, CTL_ZERO_BYTES, stream);
    Args a{};
    for (int i = 0; i < 24; ++i) a.in[i] = d_in[i];
    a.out = (float*)d_out; a.ws = (unsigned char*)d_ws;
#if MK_N_LAUNCHES == 1
    a.ph_lo = 0; a.ph_hi = NPHASES;
    hipLaunchKernelGGL(fwd_kernel, dim3(grid), dim3(512), LDS_BYTES, stream, a);
#else
    const int plist[] = {0, 1, 2, 3, 4, 5, 6, 7, 8, 9, 10, 13, 14, 15, 16, 17, 18, 19, 20, 21, 22, 23};
    for (int i = 0; i < (int)(sizeof(plist) / sizeof(int)); ++i) { a.ph_lo = plist[i]; a.ph_hi = plist[i] + 1; hipLaunchKernelGGL(fwd_kernel, dim3(grid), dim3(512), LDS_BYTES, stream, a); }
#endif
}
```

```cpp
#include <hip/hip_runtime.h>
#include <cstdio>
#include <cstdint>

#ifndef MK_N_LAUNCHES
#define MK_N_LAUNCHES 1
#endif

#ifndef STAMP_PROBE
#define STAMP_PROBE 0
#endif
#ifndef STAMP_A_LO
#define STAMP_A_LO 0
#define STAMP_A_HI 1
#define STAMP_B_LO 1
#define STAMP_B_HI 2
#endif
#define DI __device__ __forceinline__
#define LAS __attribute__((address_space(3)))
#define GAS __attribute__((address_space(1)))
typedef unsigned short bf16;
typedef short bf16x8 __attribute__((ext_vector_type(8)));
typedef float f32x2 __attribute__((ext_vector_type(2)));
typedef float f32x4 __attribute__((ext_vector_type(4)));
typedef float f32x16 __attribute__((ext_vector_type(16)));
typedef unsigned u32x2 __attribute__((ext_vector_type(2)));
typedef unsigned u32x4 __attribute__((ext_vector_type(4)));
typedef __bf16 bf16x2_t __attribute__((ext_vector_type(2)));

#define LDS_WAIT() asm volatile("s_waitcnt lgkmcnt(0)" ::: "memory")
#define VM_WAIT() asm volatile("s_waitcnt vmcnt(0)" ::: "memory")

DI unsigned pk2(float lo, float hi) { f32x2 v = {lo, hi}; return __builtin_bit_cast(unsigned, __builtin_convertvector(v, bf16x2_t)); }
DI float bflo(unsigned w) { return __uint_as_float(w << 16); }
DI float bfhi(unsigned w) { return __uint_as_float(w & 0xffff0000u); }
DI float bf2f(bf16 b) { return __uint_as_float(((unsigned)b) << 16); }
DI float rcp_(float x) { return __builtin_amdgcn_rcpf(x); }
DI float sigmoidf_(float x) { return rcp_(1.0f + __expf(-x)); }
DI float siluf_(float x) { return x * rcp_(1.0f + __expf(-x)); }
DI float gelu_tanh_(float x) { const float u = 0.7978845608028654f * (x + 0.044715f * x * x * x); const float t = 1.0f - 2.0f * rcp_(1.0f + __expf(2.0f * u)); return 0.5f * x * (1.0f + t); }
DI float one_minus_exp_(float x) {
    const float p = -x * (1.0f + x * 0.5f * (1.0f + x * (1.0f / 3.0f) * (1.0f + x * 0.25f * (1.0f + x * 0.2f * (1.0f + x * (1.0f / 6.0f) * (1.0f + x * (1.0f / 7.0f)))))));
    const float e = 1.0f - __expf(x);
    return x > -0.5f ? p : e;
}
DI int lane_id_() { int l; asm volatile("v_mbcnt_lo_u32_b32 %0, -1, 0\n\tv_mbcnt_hi_u32_b32 %0, -1, %0" : "=v"(l)); return l; }

constexpr int DM = 2048, BATCH = 4, SEQ = 2048, MTOK = BATCH * SEQ;
constexpr int NIN = 16464, NINP = 16640;
constexpr int C_Q = 0, C_K = 2048, C_V = 2560, C_QI = 3072, C_KI = 4096, C_WI = 4160, C_PADLO = 4176, C_P = 4352, C_XR = 6400, C_GR = 8448, C_G = 10496;
constexpr int MIXW = 6144, DFF = 5504, NEXP = 8, DEXP = 7168;
constexpr int MOE_ROWS_MAX = (MTOK * 2 / 256 + NEXP) * 256;
constexpr float ALPHA = 1.4142135623730951f, LN_EPS = 1e-5f;
constexpr int KSPLIT = 2;

constexpr size_t MiB = 1u << 20;
constexpr size_t WS_CTL = 0, CTL_ZERO_BYTES = 1 * MiB;
constexpr size_t WS_COSA = 1 * MiB, WS_SINA = 3 * MiB, WS_COSI = 5 * MiB, WS_SINI = 6 * MiB;
constexpr size_t WS_ROUTE = 9 * MiB;
constexpr size_t WS_MASK = 10 * MiB;
constexpr size_t WS_LRUC = 9 * MiB + 512 * 1024;
constexpr size_t WS_WIN = 12 * MiB;
constexpr size_t WS_WOUT = 142 * MiB;
constexpr size_t WS_WPOOL = 190 * MiB;
constexpr size_t WS_WLRU = 194 * MiB;
constexpr size_t WS_WGU = 198 * MiB;
constexpr size_t WS_WDN = 241 * MiB;
constexpr size_t WS_XB = 263 * MiB;
constexpr size_t WS_X1 = 295 * MiB;
constexpr size_t WS_X1B = 359 * MiB;
constexpr size_t WS_X2 = 391 * MiB;
constexpr size_t WS_PRE = 455 * MiB;
constexpr size_t WS_MWGU = 519 * MiB;
constexpr size_t WS_MWDN = 967 * MiB;
constexpr size_t WS_OV = 1191 * MiB;
constexpr size_t WS_PROJ = WS_OV;
constexpr size_t WS_DIFF = WS_OV + 260 * MiB;
constexpr size_t WS_XC = WS_OV + 292 * MiB;
constexpr size_t WS_A = WS_OV + 324 * MiB;
constexpr size_t WS_CARRY = WS_OV + 388 * MiB;
constexpr size_t WS_SC = WS_OV + 452 * MiB;
constexpr size_t WS_MRG = WS_OV + 516 * MiB;
constexpr size_t WS_H = WS_OV;
constexpr size_t WS_AMOE = WS_OV;
constexpr size_t WS_HMOE = WS_OV + 72 * MiB;
constexpr size_t WS_YB = WS_OV + 324 * MiB;
constexpr size_t WS_END = WS_OV + 612 * MiB;
constexpr int CW_BAR = 4096, CW_CNT = 16384;
constexpr int RT_E = 0, RT_SLOT = 2 * MTOK, RT_W = 4 * MTOK, RT_ROW = 6 * MTOK, RT_WGC = 8 * MTOK;

constexpr int RING_BYTES = 131072, LDSCTL_OFF = RING_BYTES, LDS_BYTES = 147456;

#define XB_TMO      128
#define XB_XCNT(j)  (256  + 64 * (j))
#define XB_XSUB(j)  (1280 + 64 * (j))
#define XB_XGEN(j)  (2304 + 64 * (j))
#define XB_TOP      3328
#define XB_TOPGEN   3392
#define XCD_BAR_WORDS 3456
#define XB_SPIN_CAP (1u << 18)
DI unsigned xb_ld(unsigned* p)              { return __hip_atomic_load(p, __ATOMIC_RELAXED, __HIP_MEMORY_SCOPE_AGENT); }
DI unsigned xb_add(unsigned* p, unsigned v) { return __hip_atomic_fetch_add(p, v, __ATOMIC_RELAXED, __HIP_MEMORY_SCOPE_AGENT); }
DI unsigned xb_xcc_id() { return (unsigned)__builtin_amdgcn_s_getreg((3 << 11) | 20) & 0xFu; }
#define XB_SPIN(cond, bar) do { unsigned _sp = 0; while (cond) { __builtin_amdgcn_s_sleep(1); \
    if ((++_sp & 255u) == 0u) { if (xb_ld(&(bar)[XB_TMO])) break; if (_sp > XB_SPIN_CAP) { atomicAdd(&(bar)[XB_TMO], 1u); break; } } } } while (0)
struct XcdBarrier { unsigned* bar; unsigned x; volatile LAS unsigned* st; int wave; };
DI bool xb_t0(int wave) { return wave == 0 && lane_id_() == 0; }
DI XcdBarrier xcd_barrier_post(unsigned* bar, volatile LAS unsigned* st, int wave) {
    XcdBarrier b; b.bar = bar; b.x = xb_xcc_id(); b.st = st; b.wave = wave;
    if (xb_t0(wave)) (void)xb_add(&bar[XB_XCNT(b.x)], 1u);
    return b;
}
DI void xcd_barrier_complete(unsigned* bar, unsigned x, unsigned& nloc, unsigned& nx) {
    const unsigned G = gridDim.x * gridDim.y * gridDim.z;
    unsigned sum, cnt, mine, sp = 0u;
    for (;;) {
        sum = 0u; cnt = 0u; mine = 0u;
#pragma unroll
        for (unsigned j = 0; j < 16; ++j) { const unsigned c = xb_ld(&bar[XB_XCNT(j)]); sum += c; cnt += (c > 0u) ? 1u : 0u; mine = (j == x) ? c : mine; }
        if (sum == G) break;
        __builtin_amdgcn_s_sleep(1);
        if ((++sp & 255u) == 0u) { if (xb_ld(&bar[XB_TMO])) break; if (sp > XB_SPIN_CAP) { atomicAdd(&bar[XB_TMO], 1u); break; } }
    }
    nloc = mine > 0u ? mine : 1u; nx = cnt > 0u ? cnt : 1u;
}
DI void xcd_barrier(const XcdBarrier& b) {
    asm volatile("s_waitcnt vmcnt(0)" ::: "memory");
    __syncthreads();
    if (xb_t0(b.wave)) {
        unsigned* bar = b.bar;
        __builtin_amdgcn_s_waitcnt(0);
        unsigned nloc = b.st[0], nx = b.st[1];
        if (nloc == 0u) { xcd_barrier_complete(bar, b.x, nloc, nx); b.st[0] = nloc; b.st[1] = nx; }
        const unsigned old = xb_add(&bar[XB_XSUB(b.x)], 1u);
        const unsigned gen = old / nloc;
        if (old + 1u == (gen + 1u) * nloc) {
            __builtin_amdgcn_fence(__ATOMIC_RELEASE, "agent");
            asm volatile("s_waitcnt vmcnt(0)" ::: "memory");
            const unsigned og = xb_add(&bar[XB_TOP], 1u);
            const unsigned tg = og / nx;
            if (og + 1u == (tg + 1u) * nx) xb_add(&bar[XB_TOPGEN], 1u);
            else XB_SPIN(xb_ld(&bar[XB_TOPGEN]) == tg, bar);
            __builtin_amdgcn_fence(__ATOMIC_ACQUIRE, "agent");
            xb_add(&bar[XB_XGEN(b.x)], 1u);
            asm volatile("s_waitcnt vmcnt(0)" ::: "memory");
        } else {
            XB_SPIN(xb_ld(&bar[XB_XGEN(b.x)]) == gen, bar);
            __builtin_amdgcn_fence(__ATOMIC_ACQUIRE, "agent");
            asm volatile("s_waitcnt vmcnt(0)" ::: "memory");
        }
    }
    __syncthreads();
}

namespace pg8 {
constexpr int BM = 256, BK = 64, HALF = 128, HTB = HALF * BK * 2, STAGE_BYTES = 8 * HTB, NXCD = 8, WGM = 8;
DI int lds_byte(int r, int c) { const int st = (r >> 4) * 2 + (c >> 5), rr = r & 15, cc = c & 31, ob = rr * 64 + cc * 2; return st * 1024 + (ob ^ (((ob >> 9) & 1) << 5)); }
DI void stage_rc(int b, int& R, int& C) { const int st = b / 1024, sb = b % 1024, swz = sb ^ (((sb >> 9) & 1) << 5); R = (st >> 1) * 16 + swz / 64; C = (st & 1) * 32 + (swz % 64) / 2; }
DI int perm32(int rho) { const int n = rho >> 4, i = rho & 15; return 8 * (i >> 2) + 4 * n + (i & 3); }

struct Unit { int pm, pn, e, ks; };
struct Gemm { const bf16* A; const bf16* Bt; int lda, ldb, K; };

struct TileOrder {
    int nM, nN, nwg, G, c, a_div; size_t a_pm, a_pn, b_pn;
    DI void init(int nM_, int nN_, int G_, int c_, size_t a_pm_, size_t b_pn_, int a_div_ = 1, size_t a_pn_ = 0) { nM = nM_; nN = nN_; nwg = nM * nN; G = G_; c = c_; a_pm = a_pm_; b_pn = b_pn_; a_div = a_div_; a_pn = a_pn_; }
    DI bool next(int i, Unit& u) const {
        const long L = (long)i * G + c; if (L >= nwg) return false;
        int wgid = (int)L; { const int q = nwg / NXCD, r = nwg % NXCD, xcd = wgid % NXCD, off = wgid / NXCD; wgid = (xcd < r ? xcd * (q + 1) : r * (q + 1) + (xcd - r) * q) + off; }
        const int nig = WGM * nN, gid = wgid / nig, fm = gid * WGM, gsz = (nM - fm) < WGM ? (nM - fm) : WGM;
        u.pm = fm + ((wgid % nig) % gsz); u.pn = (wgid % nig) / gsz; u.e = 0; u.ks = 0; return true;
    }
    DI size_t aoff(const Unit& u) const { return (size_t)u.pm * a_pm + (size_t)(u.pn / a_div) * a_pn; }
    DI size_t boff(const Unit& u) const { return (size_t)u.pn * b_pn; }
};
struct MoeOrder {
    int nN, nNk, nwg, G, c; int t1, t2, t3, t4, t5, t6, t7, t8; size_t a_pm, b_e, b_pn, ks_step;
    DI void init(const unsigned* cnt, int nN_, int ksplit, int G_, int c_, size_t a_pm_, size_t b_e_, size_t b_pn_, size_t ks_step_) {
        nN = nN_; nNk = nN_ * ksplit; G = G_; c = c_; a_pm = a_pm_; b_e = b_e_; b_pn = b_pn_; ks_step = ks_step_;
        int s = 0; s += ((int)cnt[0] + 255) >> 8; t1 = s; s += ((int)cnt[1] + 255) >> 8; t2 = s; s += ((int)cnt[2] + 255) >> 8; t3 = s; s += ((int)cnt[3] + 255) >> 8; t4 = s;
        s += ((int)cnt[4] + 255) >> 8; t5 = s; s += ((int)cnt[5] + 255) >> 8; t6 = s; s += ((int)cnt[6] + 255) >> 8; t7 = s; s += ((int)cnt[7] + 255) >> 8; t8 = s;
        nwg = t8 * nNk;
    }
    DI bool next(int i, Unit& u) const {
        const long L = (long)i * G + c; if (L >= nwg) return false;
        int wgid = (int)L; { const int q = nwg / NXCD, r = nwg % NXCD, xcd = wgid % NXCD, off = wgid / NXCD; wgid = (xcd < r ? xcd * (q + 1) : r * (q + 1) + (xcd - r) * q) + off; }
        int e = 0, ts = 0, nt = t1;
        if (wgid >= t1 * nNk) { e = 1; ts = t1; nt = t2 - t1; }
        if (wgid >= t2 * nNk) { e = 2; ts = t2; nt = t3 - t2; }
        if (wgid >= t3 * nNk) { e = 3; ts = t3; nt = t4 - t3; }
        if (wgid >= t4 * nNk) { e = 4; ts = t4; nt = t5 - t4; }
        if (wgid >= t5 * nNk) { e = 5; ts = t5; nt = t6 - t5; }
        if (wgid >= t6 * nNk) { e = 6; ts = t6; nt = t7 - t6; }
        if (wgid >= t7 * nNk) { e = 7; ts = t7; nt = t8 - t7; }
        const int loc = wgid - ts * nNk; nt = nt > 0 ? nt : 1;
        const int pn2 = loc / nt;
        u.pm = ts + loc % nt; u.pn = pn2 % nN; u.ks = pn2 / nN; u.e = e; return true;
    }
    DI size_t aoff(const Unit& u) const { return (size_t)u.pm * a_pm + (size_t)u.ks * ks_step; }
    DI size_t boff(const Unit& u) const { return (size_t)u.e * b_e + (size_t)u.pn * b_pn + (size_t)u.ks * ks_step; }
};

struct EpiBf16 {
    static constexpr bool PERM = true;
    bf16* O; int ldc; size_t ks_stride;
    DI void operator()(const f32x4 (&acc)[2][2][4][2], const Unit& u, int wr, int wc, int fr, int fq) const {
        const int row0 = u.pm * BM + wr * 64 + fr, col0 = u.pn * BM + wc * 32 + 8 * fq;
#pragma unroll
        for (int ai = 0; ai < 2; ++ai)
#pragma unroll
            for (int m = 0; m < 4; ++m) { bf16* rowp = O + (size_t)u.ks * ks_stride + (size_t)(row0 + ai * HALF + m * 16) * ldc + col0;
#pragma unroll
                for (int bj = 0; bj < 2; ++bj) { const f32x4 v0 = acc[ai][bj][m][0], v1 = acc[ai][bj][m][1];
                    u32x4 w; w.x = pk2(v0[0], v0[1]); w.y = pk2(v0[2], v0[3]); w.z = pk2(v1[0], v1[1]); w.w = pk2(v1[2], v1[3]);
                    *(u32x4*)(rowp + bj * HALF) = w; } }
    }
};
struct EpiF32 {
    static constexpr bool PERM = false;
    float* C; int ldc;
    DI void operator()(const f32x4 (&acc)[2][2][4][2], const Unit& u, int wr, int wc, int fr, int fq) const {
        const int row0 = u.pm * BM + wr * 64 + fr, col0 = u.pn * BM + wc * 32 + 4 * fq;
#pragma unroll
        for (int ai = 0; ai < 2; ++ai)
#pragma unroll
            for (int m = 0; m < 4; ++m) { float* rowp = C + (size_t)(row0 + ai * HALF + m * 16) * ldc + col0;
#pragma unroll
                for (int bj = 0; bj < 2; ++bj)
#pragma unroll
                    for (int n = 0; n < 2; ++n) *(f32x4*)(rowp + bj * HALF + n * 16) = acc[ai][bj][m][n]; }
    }
};
struct EpiRes {
    static constexpr bool PERM = false;
    float* C; const float* res; int ldc;
    DI void operator()(const f32x4 (&acc)[2][2][4][2], const Unit& u, int wr, int wc, int fr, int fq) const {
        const int row0 = u.pm * BM + wr * 64 + fr, col0 = u.pn * BM + wc * 32 + 4 * fq;
#pragma unroll
        for (int ai = 0; ai < 2; ++ai)
#pragma unroll
            for (int m = 0; m < 4; ++m) { const size_t off = (size_t)(row0 + ai * HALF + m * 16) * ldc + col0;
#pragma unroll
                for (int bj = 0; bj < 2; ++bj)
#pragma unroll
                    for (int n = 0; n < 2; ++n) { const f32x4 rv = *(const f32x4*)(res + off + bj * HALF + n * 16); *(f32x4*)(C + off + bj * HALF + n * 16) = acc[ai][bj][m][n] + rv * ALPHA; }
                asm volatile("" ::: "memory"); }
    }
};
struct EpiSwiglu {
    static constexpr bool PERM = true;
    bf16* H; int ldc;
    DI void operator()(const f32x4 (&acc)[2][2][4][2], const Unit& u, int wr, int wc, int fr, int fq) const {
        const int row0 = u.pm * BM + wr * 64 + fr, col0 = u.pn * HALF + wc * 32 + 8 * fq;
#pragma unroll
        for (int ai = 0; ai < 2; ++ai)
#pragma unroll
            for (int m = 0; m < 4; ++m) { bf16* rowp = H + (size_t)(row0 + ai * HALF + m * 16) * ldc + col0;
                const f32x4 g0 = acc[ai][0][m][0], g1 = acc[ai][0][m][1], u0 = acc[ai][1][m][0], u1 = acc[ai][1][m][1];
                u32x4 w; w.x = pk2(siluf_(g0[0]) * u0[0], siluf_(g0[1]) * u0[1]); w.y = pk2(siluf_(g0[2]) * u0[2], siluf_(g0[3]) * u0[3]);
                w.z = pk2(siluf_(g1[0]) * u1[0], siluf_(g1[1]) * u1[1]); w.w = pk2(siluf_(g1[2]) * u1[2], siluf_(g1[3]) * u1[3]);
                *(u32x4*)rowp = w; asm volatile("" ::: "memory"); }
    }
};
struct EpiPool {
    static constexpr bool PERM = true;
    bf16* mrg; const bf16* proj; const float* scale;
    DI void operator()(const f32x4 (&acc)[2][2][4][2], const Unit& u, int wr, int wc, int fr, int fq) const {
        const int row0 = u.pm * BM + wr * 64 + fr, col0 = u.pn * BM + wc * 32 + 8 * fq;
#pragma unroll
        for (int bj = 0; bj < 2; ++bj) { const int c = col0 + bj * HALF; const f32x4 s0 = *(const f32x4*)(scale + c), s1 = *(const f32x4*)(scale + c + 4);
#pragma unroll
            for (int ai = 0; ai < 2; ++ai)
#pragma unroll
                for (int m = 0; m < 4; ++m) { const size_t row = (size_t)(row0 + ai * HALF + m * 16);
                    const u32x4 gv = *(const u32x4*)(proj + row * NINP + C_G + 2048 + c);
                    const f32x4 v0 = acc[ai][bj][m][0] * s0, v1 = acc[ai][bj][m][1] * s1;
                    u32x4 w; w.x = pk2(v0[0] * sigmoidf_(bflo(gv.x)), v0[1] * sigmoidf_(bfhi(gv.x))); w.y = pk2(v0[2] * sigmoidf_(bflo(gv.y)), v0[3] * sigmoidf_(bfhi(gv.y)));
                    w.z = pk2(v1[0] * sigmoidf_(bflo(gv.z)), v1[1] * sigmoidf_(bfhi(gv.z))); w.w = pk2(v1[2] * sigmoidf_(bflo(gv.w)), v1[3] * sigmoidf_(bfhi(gv.w)));
                    *(u32x4*)(mrg + row * MIXW + 2048 + c) = w; asm volatile("" ::: "memory"); } }
    }
};
struct EpiLru {
    static constexpr bool PERM = false;
    unsigned* AB; const bf16* xc; const float* ba; const float* bx; const float* c8sp;
    DI void operator()(const f32x4 (&acc)[2][2][4][2], const Unit& u, int wr, int wc, int fr, int fq) const {
        const int row0 = u.pm * BM + wr * 64 + fr, ch0 = u.pn * HALF + wc * 32 + 4 * fq;
#pragma unroll
        for (int n = 0; n < 2; ++n) { const int ch = ch0 + n * 16; const f32x4 vba = *(const f32x4*)(ba + ch), vbx = *(const f32x4*)(bx + ch), vsp = *(const f32x4*)(c8sp + ch);
#pragma unroll
            for (int ai = 0; ai < 2; ++ai)
#pragma unroll
                for (int m = 0; m < 4; ++m) { const size_t off = (size_t)(row0 + ai * HALF + m * 16) * DM + ch;
                    const u32x2 xv = *(const u32x2*)(xc + off); const float xf[4] = {bflo(xv.x), bfhi(xv.x), bflo(xv.y), bfhi(xv.y)};
                    u32x4 w;
#pragma unroll
                    for (int j = 0; j < 4; ++j) { const float r = sigmoidf_(acc[ai][0][m][n][j] + vba[j]), ig = sigmoidf_(acc[ai][1][m][n][j] + vbx[j]);
                        const float la = -vsp[j] * r; w[j] = pk2(la, __builtin_amdgcn_sqrtf(fmaxf(one_minus_exp_(2.0f * la), 0.f)) * ig * xf[j]); }
                    *(u32x4*)(AB + off) = w; asm volatile("" ::: "memory"); } }
    }
};

#ifndef PG8_ALIGN
#define PG8_ALIGN true
#endif
#ifndef PG8_SP2
#define PG8_SP2 true
#endif
template <class Epi, class Sched, bool ALIGN_EPI = PG8_ALIGN, bool SP2 = PG8_SP2>
DI void gemm_phase(LAS unsigned char* lds, const Gemm g, const Sched& S, const Epi& E, const int wave_id) {
    int lane_ = lane_id_(); asm volatile("" : "+v"(lane_));
    const int wid = wave_id, lane = lane_, tid = wid * 64 + lane, wr = wid >> 2, wc = wid & 3, fr = lane & 15, fq = lane >> 4;
    const int nt = g.K / BK;
    unsigned voffA[2], voffB[2];
#pragma unroll
    for (int i = 0; i < 2; ++i) { int R, C; stage_rc(tid * 16 + i * 8192, R, C); const int Rb = Epi::PERM ? ((R & ~31) + perm32(R & 31)) : R;
        voffA[i] = (unsigned)(R * g.lda + C) * 2u; voffB[i] = (unsigned)(Rb * g.ldb + C) * 2u; }
    const size_t kstep = (size_t)(BK * 2);
    const size_t hstepA = (size_t)HALF * g.lda * 2, hstepB = (size_t)HALF * g.ldb * 2;
    const unsigned ldsw = (unsigned)wid * 1024u;
    const int aoff = lds_byte(wr * 64 + fr, fq * 8), boff = lds_byte(wc * 32 + fr, fq * 8);
#define PG8_SA(b, h) (((b) * 2 + (h)) * HTB)
#define PG8_SB(b, h) ((4 + (b) * 2 + (h)) * HTB)
#define PG8_STAGE(bufoff, gbase, voff) do { _Pragma("unroll") for (int _i = 0; _i < 2; ++_i) \
        __builtin_amdgcn_global_load_lds((const unsigned*)((const char*)(gbase) + (voff)[_i]), (LAS unsigned*)(lds + (bufoff) + ldsw + _i * 8192), 16, 0, 0); } while (0)
#define PG8_LDA(dst, b, h) do { _Pragma("unroll") for (int m = 0; m < 4; ++m) _Pragma("unroll") for (int k = 0; k < 2; ++k) dst[m][k] = *(const LAS bf16x8*)(lds + PG8_SA(b, h) + aoff + m * 2048 + k * 1024); } while (0)
#define PG8_LDB(dst, b, h) do { _Pragma("unroll") for (int n = 0; n < 2; ++n) _Pragma("unroll") for (int k = 0; k < 2; ++k) dst[n][k] = *(const LAS bf16x8*)(lds + PG8_SB(b, h) + boff + n * 2048 + k * 1024); } while (0)
#define PG8_MMA(ai, bj, At, Bt) do { __builtin_amdgcn_s_setprio(1); _Pragma("unroll") for (int m = 0; m < 4; ++m) _Pragma("unroll") for (int n = 0; n < 2; ++n) _Pragma("unroll") for (int k = 0; k < 2; ++k) \
        acc[ai][bj][m][n] = __builtin_amdgcn_mfma_f32_16x16x32_bf16(Bt[n][k], At[m][k], acc[ai][bj][m][n], 0, 0, 0); __builtin_amdgcn_s_setprio(0); } while (0)
#define PG8_WAIT_V(n) asm volatile("s_waitcnt vmcnt(" #n ")" ::: "memory")
#define PG8_WAIT_L(n) asm volatile("s_waitcnt lgkmcnt(" #n ")" ::: "memory")
#define PG8_BAR __builtin_amdgcn_s_barrier()
#define PG8_SCHED __builtin_amdgcn_sched_barrier(0)
    Unit cur, nxt; int ui = 0;
    if (!S.next(0, cur)) return;
    f32x4 acc[2][2][4][2];
#pragma unroll
    for (int a = 0; a < 2; ++a)
#pragma unroll
        for (int b = 0; b < 2; ++b)
#pragma unroll
            for (int m = 0; m < 4; ++m)
#pragma unroll
                for (int n = 0; n < 2; ++n) acc[a][b][m][n] = (f32x4){0.f, 0.f, 0.f, 0.f};
    bf16x8 At[4][2], B0[2][2], B1[2][2];
    const char* cA = (const char*)g.A + S.aoff(cur); const char* cB = (const char*)g.Bt + S.boff(cur);
    if constexpr (SP2) {
        PG8_STAGE(PG8_SB(0, 0), cB, voffB); PG8_STAGE(PG8_SB(0, 1), cB + hstepB, voffB); PG8_STAGE(PG8_SA(0, 0), cA, voffA); PG8_STAGE(PG8_SA(0, 1), cA + hstepA, voffA);
        if (wr == 1) PG8_BAR;
        PG8_WAIT_V(2); PG8_BAR;
        PG8_STAGE(PG8_SB(1, 0), cB + kstep, voffB); PG8_STAGE(PG8_SA(1, 0), cA + kstep, voffA); PG8_STAGE(PG8_SB(1, 1), cB + hstepB + kstep, voffB);
        PG8_WAIT_V(6); PG8_BAR;
    } else {
        PG8_STAGE(PG8_SB(0, 0), cB, voffB); PG8_STAGE(PG8_SA(0, 0), cA, voffA); PG8_STAGE(PG8_SB(0, 1), cB + hstepB, voffB); PG8_STAGE(PG8_SA(0, 1), cA + hstepA, voffA);
        if (wr == 1) PG8_BAR;
        PG8_WAIT_V(4); PG8_BAR;
        PG8_STAGE(PG8_SB(1, 0), cB + kstep, voffB); PG8_STAGE(PG8_SA(1, 0), cA + kstep, voffA); PG8_STAGE(PG8_SB(1, 1), cB + hstepB + kstep, voffB);
        PG8_WAIT_V(6); PG8_BAR;
    }
    for (;;) {
        const bool has_next = S.next(ui + 1, nxt);
        const char* nA = has_next ? (const char*)g.A + S.aoff(nxt) : cA; const char* nB = has_next ? (const char*)g.Bt + S.boff(nxt) : cB;
#pragma nounroll
        for (int t = 0; t < nt; t += 2) {
            const bool last = (t == nt - 2);
            const char* a1 = cA + (size_t)(t + 1) * kstep;
            const char* a2 = last ? nA : cA + (size_t)(t + 2) * kstep; const char* b2 = last ? nB : cB + (size_t)(t + 2) * kstep;
            const char* a3 = a2 + kstep; const char* b3 = b2 + kstep;
            if constexpr (SP2) {
            PG8_LDB(B0, 0, 0); PG8_LDB(B1, 0, 1); PG8_SCHED; PG8_LDA(At, 0, 0); PG8_STAGE(PG8_SA(1, 1), a1 + hstepA, voffA);
            PG8_WAIT_V(8); PG8_WAIT_L(0); PG8_BAR; PG8_MMA(0, 0, At, B0); PG8_MMA(0, 1, At, B1); PG8_BAR; PG8_SCHED;
            PG8_LDA(At, 0, 1); PG8_STAGE(PG8_SB(0, 0), b2, voffB); PG8_STAGE(PG8_SB(0, 1), b2 + hstepB, voffB); PG8_STAGE(PG8_SA(0, 0), a2, voffA);
            PG8_WAIT_V(8); PG8_WAIT_L(0); PG8_BAR; PG8_MMA(1, 0, At, B0); PG8_MMA(1, 1, At, B1); PG8_BAR; PG8_SCHED;
            PG8_LDB(B0, 1, 0); PG8_LDB(B1, 1, 1); PG8_SCHED; PG8_LDA(At, 1, 0); PG8_STAGE(PG8_SA(0, 1), a2 + hstepA, voffA);
            PG8_WAIT_V(8); PG8_WAIT_L(0); PG8_BAR; PG8_MMA(0, 0, At, B0); PG8_MMA(0, 1, At, B1); PG8_BAR; PG8_SCHED;
            PG8_LDA(At, 1, 1); PG8_STAGE(PG8_SB(1, 0), b3, voffB); PG8_STAGE(PG8_SB(1, 1), b3 + hstepB, voffB); PG8_STAGE(PG8_SA(1, 0), a3, voffA);
            PG8_WAIT_V(8); PG8_WAIT_L(0); PG8_BAR; PG8_MMA(1, 0, At, B0); PG8_MMA(1, 1, At, B1); PG8_BAR; PG8_SCHED;
            } else {
            PG8_LDB(B0, 0, 0); PG8_SCHED; PG8_LDA(At, 0, 0); PG8_STAGE(PG8_SA(1, 1), a1 + hstepA, voffA);
            PG8_WAIT_L(8); PG8_BAR; PG8_WAIT_L(0); PG8_MMA(0, 0, At, B0); PG8_BAR; PG8_SCHED;
            PG8_LDB(B1, 0, 1); PG8_STAGE(PG8_SB(0, 0), b2, voffB);
            PG8_BAR; PG8_WAIT_L(0); PG8_MMA(0, 1, At, B1); PG8_BAR;
            PG8_LDA(At, 0, 1); PG8_STAGE(PG8_SA(0, 0), a2, voffA);
            PG8_BAR; PG8_WAIT_L(0); PG8_MMA(1, 0, At, B0); PG8_BAR; PG8_SCHED;
            PG8_STAGE(PG8_SB(0, 1), b2 + hstepB, voffB);
            PG8_WAIT_V(6); PG8_BAR; PG8_MMA(1, 1, At, B1); PG8_BAR;
            PG8_LDB(B0, 1, 0); PG8_SCHED; PG8_LDA(At, 1, 0); PG8_STAGE(PG8_SA(0, 1), a2 + hstepA, voffA);
            PG8_WAIT_L(8); PG8_BAR; PG8_WAIT_L(0); PG8_MMA(0, 0, At, B0); PG8_BAR; PG8_SCHED;
            PG8_LDB(B1, 1, 1); PG8_STAGE(PG8_SB(1, 0), b3, voffB);
            PG8_BAR; PG8_WAIT_L(0); PG8_MMA(0, 1, At, B1); PG8_BAR;
            PG8_LDA(At, 1, 1); PG8_STAGE(PG8_SA(1, 0), a3, voffA);
            PG8_BAR; PG8_WAIT_L(0); PG8_MMA(1, 0, At, B0); PG8_BAR; PG8_SCHED;
            PG8_STAGE(PG8_SB(1, 1), b3 + hstepB, voffB);
            PG8_WAIT_V(6); PG8_BAR; PG8_MMA(1, 1, At, B1); PG8_BAR;
            }
        }
        if constexpr (ALIGN_EPI) { if (wr == 0) PG8_BAR; }
        E(acc, cur, wr, wc, fr, fq);
        if (!has_next) break;
#pragma unroll
        for (int a = 0; a < 2; ++a)
#pragma unroll
            for (int b = 0; b < 2; ++b)
#pragma unroll
                for (int m = 0; m < 4; ++m)
#pragma unroll
                    for (int n = 0; n < 2; ++n) acc[a][b][m][n] = (f32x4){0.f, 0.f, 0.f, 0.f};
        cur = nxt; cA = nA; cB = nB; ++ui;
        if constexpr (ALIGN_EPI) { if (wr == 1) PG8_BAR; }
    }
    PG8_WAIT_V(0);
    if constexpr (!ALIGN_EPI) { if (wr == 0) PG8_BAR; }
    PG8_BAR;
#undef PG8_SA
#undef PG8_SB
#undef PG8_STAGE
#undef PG8_LDA
#undef PG8_LDB
#undef PG8_MMA
#undef PG8_WAIT_V
#undef PG8_WAIT_L
#undef PG8_BAR
#undef PG8_SCHED
}
}

struct Args { const void* in[24]; float* out; unsigned char* ws; int ph_lo, ph_hi; };
struct Frame {
    LAS unsigned char* lds; unsigned* ctl; unsigned char* ws;
    int tid, lane, wave, G, bid;
};
#define INF(k) ((const float*)args.in[k])
DI float wave_sum(float v) {
#pragma unroll
    for (int o = 1; o < 64; o <<= 1) v += __shfl_xor(v, o);
    return v;
}

DI void tr_item(const float* W, int ldS, int Nvalid, bf16* WT, int ldD, int koff, int mode, int roff, LAS float* scr, int k0, int n0, int lane) {
    const int nl = n0 + (lane & 31);
    float tv[32]; const float* wp = W + (size_t)(k0 + (lane >> 5)) * ldS + nl; const bool ok = nl < Nvalid;
#pragma unroll
    for (int i = 0; i < 32; ++i) tv[i] = ok ? __builtin_nontemporal_load(wp + (size_t)(2 * i) * ldS) : 0.f;
#pragma unroll
    for (int i = 0; i < 32; ++i) scr[(2 * i + (lane >> 5)) * 33 + (lane & 31)] = tv[i];
    LDS_WAIT(); asm volatile("" ::: "memory");
    const int c = lane & 7;
#pragma unroll
    for (int j = 0; j < 4; ++j) { const int nn = (lane >> 3) + 8 * j, n = n0 + nn; const LAS float* s = scr + (8 * c) * 33 + nn;
        u32x4 o; o.x = pk2(s[0 * 33], s[1 * 33]); o.y = pk2(s[2 * 33], s[3 * 33]); o.z = pk2(s[4 * 33], s[5 * 33]); o.w = pk2(s[6 * 33], s[7 * 33]);
        const int row = mode == 0 ? roff + n : (mode == 1 ? (n < C_PADLO ? n : n + (C_P - C_PADLO)) : ((n >> 7) << 8) + roff + (n & 127));
        if (n < Nvalid) *(u32x4*)(WT + (size_t)row * ldD + koff + k0 + 8 * c) = o; }
    LDS_WAIT(); asm volatile("" ::: "memory");
}
constexpr int NB_IN = (NIN + 31) / 32;
constexpr int CI_IN = 32 * NB_IN, CI_OUT = 96 * 64, CI_POOL = 8 * 8 * 16, CI_LRU = 64 * 8, CI_GU = 2 * 32 * 172, CI_DN = 86 * 64, CI_MGU = 16 * 32 * 224, CI_MDN = 8 * 112 * 64;
constexpr int CE_0 = CI_IN + CI_POOL + CI_LRU;
constexpr int CE_1 = CE_0 + CI_OUT;
constexpr int CE_2 = CE_1 + CI_GU;
constexpr int CE_3 = CE_2 + CI_DN;
constexpr int CE_4 = CE_3 + CI_IN;
constexpr int CE_5 = CE_4 + CI_OUT;
constexpr int CE_6 = CE_5 + CI_MGU;
constexpr int CE_7 = CE_6 + CI_MDN;
constexpr int MOE_EARLY = 224 * 8 * 14;
constexpr int P2_ITEMS = 224 * 8 * 7;
DI void conv_item(unsigned char* ws, const Args& args, int idx, LAS float* scr, int lane) {
    const float* W; bf16* WT; int ldS, Nv, ldD, koff = 0, mode = 0, roff = 0, kb, nb; int r = idx;
    if (r < CI_IN) { kb = r / NB_IN; nb = r % NB_IN; W = INF(2); ldS = NIN; Nv = NIN; WT = (bf16*)(ws + WS_WIN); ldD = DM; mode = 1; }
    else if ((r -= CI_IN) < CI_POOL) { const int lg = r >> 7, q = r & 127; kb = q >> 4; nb = q & 15; W = INF(4) + (size_t)lg * 512 * 512; ldS = 512; Nv = 512; WT = (bf16*)(ws + WS_WPOOL) + (size_t)(lg >> 2) * 2048 * 512; ldD = 512; roff = (lg & 3) * 512; }
    else if ((r -= CI_POOL) < CI_LRU) { const int cmb = r >> 3, q = r & 7, l = cmb >> 5, which = (cmb >> 4) & 1, n = cmb & 15; kb = q >> 2; nb = q & 3;
        W = (which ? INF(10) : INF(8)) + ((size_t)l * 16 + n) * 128 * 128; ldS = 128; Nv = 128; WT = (bf16*)(ws + WS_WLRU) + (size_t)l * 4096 * 256; ldD = 256; koff = (n & 1) * 128; roff = n * 256 + which * 128; }
    else if ((r -= CI_LRU) < CI_OUT) { kb = r >> 6; nb = r & 63; W = INF(3); ldS = DM; Nv = DM; WT = (bf16*)(ws + WS_WOUT); ldD = MIXW; }
    else if ((r -= CI_OUT) < CI_GU) { const int which = r / (32 * 172), q = r % (32 * 172); kb = q / 172; nb = q % 172; W = which ? INF(18) : INF(17); ldS = DFF; Nv = DFF; WT = (bf16*)(ws + WS_WGU); ldD = DM; mode = 2; roff = which * 128; }
    else if ((r -= CI_GU) < CI_DN) { kb = r >> 6; nb = r & 63; W = INF(19); ldS = DM; Nv = DM; WT = (bf16*)(ws + WS_WDN); ldD = DFF; }
    else if ((r -= CI_DN) < CI_IN) { kb = r / NB_IN; nb = r % NB_IN; W = INF(2) + (size_t)DM * NIN; ldS = NIN; Nv = NIN; WT = (bf16*)(ws + WS_WIN) + (size_t)NINP * DM; ldD = DM; mode = 1; }
    else if ((r -= CI_IN) < CI_OUT) { kb = r >> 6; nb = r & 63; W = INF(3) + (size_t)MIXW * DM; ldS = DM; Nv = DM; WT = (bf16*)(ws + WS_WOUT) + (size_t)DM * MIXW; ldD = MIXW; }
    else if ((r -= CI_OUT) < CI_MGU) { const int ew = r / (32 * 224), q = r % (32 * 224), e = ew >> 1, which = ew & 1; kb = q / 224; nb = q % 224;
        W = (which ? INF(22) : INF(21)) + (size_t)e * DM * DEXP; ldS = DEXP; Nv = DEXP; WT = (bf16*)(ws + WS_MWGU) + (size_t)e * 2 * DEXP * DM; ldD = DM; mode = 2; roff = which * 128; }
    else { r -= CI_MGU; const int e = r / (112 * 64), q = r % (112 * 64); kb = q >> 6; nb = q & 63; W = INF(23) + (size_t)e * DEXP * DM; ldS = DM; Nv = DM; WT = (bf16*)(ws + WS_MWDN) + (size_t)e * DM * DEXP; ldD = DEXP; }
    tr_item(W, ldS, Nv, WT, ldD, koff, mode, roff, scr, 64 * kb, 32 * nb, lane);
}
DI void conv_range(Frame& F, const Args& args, int i0, int i1, int wg0) {
    if (F.bid < wg0) return;
    LAS float* scr = (LAS float*)(F.lds + F.wave * 16384);
    const int gw = (F.bid - wg0) * 8 + F.wave, NGW = (F.G - wg0) * 8;
    for (int it = i0 + gw; it < i1; it += NGW) conv_item(F.ws, args, it, scr, F.lane);
}
DI void p0_prologue(Frame& F, const Args& args) {
    conv_range(F, args, 0, CE_0, 0);
    bf16* Wlru = (bf16*)(F.ws + WS_WLRU);
    const int gt = F.bid * 512 + F.tid, NT = F.G * 512;
    for (int i = gt; i < 2 * 4096 * 16; i += NT) { const int row = i >> 4, ch = i & 15, n = (row & 4095) >> 8;
        *(u32x4*)(Wlru + (size_t)row * 256 + ((n + 1) & 1) * 128 + ch * 8) = (u32x4){0u, 0u, 0u, 0u}; }
    float* cosA = (float*)(F.ws + WS_COSA); float* sinA = (float*)(F.ws + WS_SINA); float* cosI = (float*)(F.ws + WS_COSI); float* sinI = (float*)(F.ws + WS_SINI);
    for (int i = gt; i < MTOK * 96; i += NT) {
        const int tok = i / 96, j = i % 96; const bool isA = j < 64; const int fi = isA ? j : j - 64; const double dim = isA ? 128.0 : 64.0;
        const float inv = (float)pow(10000.0, -(double)(2 * fi) / dim);
        const float ang = (float)((const int*)args.in[1])[tok] * inv; const double a = (double)ang; const double nrev = rint(a * 0.15915494309189535); const double rr = a - nrev * 6.283185307179586;
        const float cv = (float)cos(rr), sv = (float)sin(rr);
        if (isA) { cosA[tok * 64 + fi] = cv; sinA[tok * 64 + fi] = sv; } else { cosI[tok * 32 + fi] = cv; sinI[tok * 32 + fi] = sv; }
    }
    float* c8 = (float*)(F.ws + WS_LRUC);
    for (int i = gt; i < 2 * DM; i += NT) { const float lam = INF(12)[i]; c8[i] = 8.0f * log1pf(expf(-lam)); }
    bf16* xb = (bf16*)(F.ws + WS_XB);
    for (int i = gt; i < MTOK * DM / 8; i += NT) { const f32x4 a = *(const f32x4*)(INF(0) + (size_t)i * 8), b = *(const f32x4*)(INF(0) + (size_t)i * 8 + 4);
        u32x4 o; o.x = pk2(a[0], a[1]); o.y = pk2(a[2], a[3]); o.z = pk2(b[0], b[1]); o.w = pk2(b[2], b[3]); *(u32x4*)(xb + (size_t)i * 8) = o; }
}

DI void ld8(const bf16* p, float (&v)[8]) { const u32x4 w = *(const u32x4*)p; v[0] = bflo(w.x); v[1] = bfhi(w.x); v[2] = bflo(w.y); v[3] = bfhi(w.y); v[4] = bflo(w.z); v[5] = bfhi(w.z); v[6] = bflo(w.w); v[7] = bfhi(w.w); }
DI void st8(bf16* p, const float (&v)[8]) { u32x4 o; o.x = pk2(v[0], v[1]); o.y = pk2(v[2], v[3]); o.z = pk2(v[4], v[5]); o.w = pk2(v[6], v[7]); *(u32x4*)p = o; }

DI void acc8(float (&s)[8], const u32x4& r, float m) { s[0] += m * bflo(r.x); s[1] += m * bfhi(r.x); s[2] += m * bflo(r.y); s[3] += m * bfhi(r.y); s[4] += m * bflo(r.z); s[5] += m * bfhi(r.z); s[6] += m * bflo(r.w); s[7] += m * bfhi(r.w); }
template <int G>
DI void pool_range(const bf16* proj, bf16* diff, int tok0, int c) {
    constexpr int W = 2 << G, NR = W - 1 + 16;
    const int tpos0 = tok0 & (SEQ - 1);
    const bf16* pp = proj + (size_t)tok0 * NINP + C_P + c;
    u32x4 r[NR];
#pragma unroll
    for (int i = 0; i < NR; ++i) { const int back = (W - 1) - i; r[i] = *(const u32x4*)(pp - (ptrdiff_t)((back > 0 && tpos0 - back < 0) ? 0 : back) * NINP); }
    float s[8];
#pragma unroll
    for (int k = 0; k < 8; ++k) s[k] = 0.f;
#pragma unroll
    for (int i = 0; i < W - 1; ++i) acc8(s, r[i], (tpos0 - ((W - 1) - i) >= 0) ? 1.f : 0.f);
#pragma unroll
    for (int t = 0; t < 16; ++t) {
        acc8(s, r[W - 1 + t], 1.f);
        const int tpos = tpos0 + t, cnt = (tpos + 1) < W ? (tpos + 1) : W; const float rc = 1.0f / (float)cnt; const u32x4 cur = r[W - 1 + t];
        float v[8] = {s[0] * rc - bflo(cur.x), s[1] * rc - bfhi(cur.x), s[2] * rc - bflo(cur.y), s[3] * rc - bfhi(cur.y), s[4] * rc - bflo(cur.z), s[5] * rc - bfhi(cur.z), s[6] * rc - bflo(cur.w), s[7] * rc - bfhi(cur.w)};
        st8(diff + (size_t)(tok0 + t) * DM + c, v);
        acc8(s, r[t], (tpos - (W - 1) >= 0) ? -1.f : 0.f);
    }
}
DI void p2_prep(Frame& F, const Args& args, int layer) {
    bf16* proj = (bf16*)(F.ws + WS_PROJ); bf16* diff = (bf16*)(F.ws + WS_DIFF); bf16* xc = (bf16*)(F.ws + WS_XC);
    const float* cosA = (const float*)(F.ws + WS_COSA); const float* sinA = (const float*)(F.ws + WS_SINA); const float* cosI = (const float*)(F.ws + WS_COSI); const float* sinI = (const float*)(F.ws + WS_SINI);
    const int gt = F.bid * 512 + F.tid, NT = F.G * 512;
    for (int it0 = gt; it0 < MTOK * 256; it0 += 4 * NT) {
        u32x4 xa[4], xb_[4]; f32x4 c0[4], c1[4], s0[4], s1[4]; bf16* p1[4]; int hv[4]; bool act[4];
#pragma unroll
        for (int q = 0; q < 4; ++q) { const int it = it0 + q * NT, tok = it >> 8, j = it & 255; act[q] = j < 228;
            int col, half, d; const float *ct, *st;
            if (j < 128) { d = (j & 7) * 8; col = C_Q + (j >> 3) * 128 + d; half = 64; ct = cosA + tok * 64 + d; st = sinA + tok * 64 + d; }
            else if (j < 160) { const int jj = j - 128; d = (jj & 7) * 8; col = C_K + (jj >> 3) * 128 + d; half = 64; ct = cosA + tok * 64 + d; st = sinA + tok * 64 + d; }
            else if (j < 224) { const int jj = j - 160; d = (jj & 3) * 8; col = C_QI + (jj >> 2) * 64 + d; half = 32; ct = cosI + tok * 32 + d; st = sinI + tok * 32 + d; }
            else { const int jj = j < 228 ? j - 224 : 0; d = jj * 8; col = C_KI + d; half = 32; ct = cosI + tok * 32 + d; st = sinI + tok * 32 + d; }
            p1[q] = proj + (size_t)tok * NINP + col; hv[q] = half;
            xa[q] = *(const u32x4*)p1[q]; xb_[q] = *(const u32x4*)(p1[q] + half);
            c0[q] = *(const f32x4*)ct; c1[q] = *(const f32x4*)(ct + 4); s0[q] = *(const f32x4*)st; s1[q] = *(const f32x4*)(st + 4); }
#pragma unroll
        for (int q = 0; q < 4; ++q) { if (act[q]) {
            const float x1[8] = {bflo(xa[q].x), bfhi(xa[q].x), bflo(xa[q].y), bfhi(xa[q].y), bflo(xa[q].z), bfhi(xa[q].z), bflo(xa[q].w), bfhi(xa[q].w)};
            const float x2[8] = {bflo(xb_[q].x), bfhi(xb_[q].x), bflo(xb_[q].y), bfhi(xb_[q].y), bflo(xb_[q].z), bfhi(xb_[q].z), bflo(xb_[q].w), bfhi(xb_[q].w)};
            float y1[8], y2[8];
#pragma unroll
            for (int i = 0; i < 8; ++i) { const float c = i < 4 ? c0[q][i & 3] : c1[q][i & 3], s = i < 4 ? s0[q][i & 3] : s1[q][i & 3]; y1[i] = x1[i] * c - x2[i] * s; y2[i] = x2[i] * c + x1[i] * s; }
            st8(p1[q], y1); st8(p1[q] + hv[q], y2); } }
    }
    const float* cw = INF(6) + (size_t)layer * 4 * DM; const float* cb = INF(7) + (size_t)layer * DM;
    for (int it = gt; it < (MTOK / 16) * 256; it += NT) {
        const int cg = it & 255, c = cg * 8, tok0 = (it >> 8) * 16;
        const int g = cg >> 6;
        if (g == 0) pool_range<0>(proj, diff, tok0, c); else if (g == 1) pool_range<1>(proj, diff, tok0, c); else if (g == 2) pool_range<2>(proj, diff, tok0, c); else pool_range<3>(proj, diff, tok0, c);
    }
    for (int it = gt; it < (MTOK / 16) * 256; it += NT) {
        const int cg = it & 255, c = cg * 8, tok0 = (it >> 8) * 16, tpos0 = tok0 & (SEQ - 1);
        const bf16* px = proj + (size_t)tok0 * NINP + C_XR + c;
        u32x4 r[19];
#pragma unroll
        for (int i = 0; i < 19; ++i) { const int back = 3 - i; r[i] = *(const u32x4*)(px - (ptrdiff_t)((back > 0 && tpos0 - back < 0) ? 0 : back) * NINP); }
        f32x4 w0[4], w1[4]; const f32x4 b0 = *(const f32x4*)(cb + c), b1 = *(const f32x4*)(cb + c + 4);
#pragma unroll
        for (int jj = 0; jj < 4; ++jj) { w0[jj] = *(const f32x4*)(cw + jj * DM + c); w1[jj] = *(const f32x4*)(cw + jj * DM + c + 4); }
#pragma unroll
        for (int t = 0; t < 16; ++t) {
            float acc[8] = {b0[0], b0[1], b0[2], b0[3], b1[0], b1[1], b1[2], b1[3]};
#pragma unroll
            for (int jj = 0; jj < 4; ++jj) { const float m = (tpos0 + t - (3 - jj) >= 0) ? 1.f : 0.f; const u32x4 x = r[t + jj];
                acc[0] += m * bflo(x.x) * w0[jj][0]; acc[1] += m * bfhi(x.x) * w0[jj][1]; acc[2] += m * bflo(x.y) * w0[jj][2]; acc[3] += m * bfhi(x.y) * w0[jj][3];
                acc[4] += m * bflo(x.z) * w1[jj][0]; acc[5] += m * bfhi(x.z) * w1[jj][1]; acc[6] += m * bflo(x.w) * w1[jj][2]; acc[7] += m * bfhi(x.w) * w1[jj][3]; }
            st8(xc + (size_t)(tok0 + t) * DM + c, acc);
        }
    }
}

DI void p3_indexer(Frame& F) {
    const bf16* proj = (const bf16*)(F.ws + WS_PROJ); float* sc = (float*)(F.ws + WS_SC);
    const int gw = F.bid * 8 + F.wave, NGW = F.G * 8, l15 = F.lane & 15, l4 = F.lane >> 4;
    for (int u = gw; u < BATCH * 576; u += NGW) {
        const int b = u / 576, r = u % 576; int g8 = 0;
#pragma unroll
        for (int k = 1; k < 8; ++k) g8 = (r >= 8 * k * (k + 1)) ? k : g8;
        const int rr = r - 8 * g8 * (g8 + 1), sp = rr % (g8 + 1), qq = rr / (g8 + 1), qb16 = g8 * 16 + qq, c = qb16 >> 2;
        const int limit = (c + 1) * 64, kbeg = sp * 256, kend = (kbeg + 256) < limit ? (kbeg + 256) : limit;
        const int qtok = b * SEQ + qb16 * 16 + l15;
        const bf16* qrow = proj + (size_t)qtok * NINP;
        bf16x8 qf[16][2]; float w[16];
        { const u32x4 w0 = *(const u32x4*)(qrow + C_WI), w1 = *(const u32x4*)(qrow + C_WI + 8); const float s = 0.125f * 0.25f;
          w[0] = bflo(w0.x) * s; w[1] = bfhi(w0.x) * s; w[2] = bflo(w0.y) * s; w[3] = bfhi(w0.y) * s; w[4] = bflo(w0.z) * s; w[5] = bfhi(w0.z) * s; w[6] = bflo(w0.w) * s; w[7] = bfhi(w0.w) * s;
          w[8] = bflo(w1.x) * s; w[9] = bfhi(w1.x) * s; w[10] = bflo(w1.y) * s; w[11] = bfhi(w1.y) * s; w[12] = bflo(w1.z) * s; w[13] = bfhi(w1.z) * s; w[14] = bflo(w1.w) * s; w[15] = bfhi(w1.w) * s; }
#pragma unroll
        for (int h = 0; h < 16; ++h)
#pragma unroll
            for (int ks = 0; ks < 2; ++ks) qf[h][ks] = *(const bf16x8*)(qrow + C_QI + h * 64 + ks * 32 + l4 * 8);
        const bf16* kbase = proj + (size_t)(b * SEQ + l15) * NINP + C_KI + l4 * 8;
        bf16x8 nk0 = *(const bf16x8*)(kbase + (size_t)kbeg * NINP), nk1 = *(const bf16x8*)(kbase + (size_t)kbeg * NINP + 32);
        for (int k0 = kbeg; k0 < kend; k0 += 16) {
            const bf16x8 ka0 = nk0, ka1 = nk1;
            { const int kn = (k0 + 16 < kend) ? k0 + 16 : k0; nk0 = *(const bf16x8*)(kbase + (size_t)kn * NINP); nk1 = *(const bf16x8*)(kbase + (size_t)kn * NINP + 32); }
            f32x4 tot = {0.f, 0.f, 0.f, 0.f};
#pragma unroll
            for (int h = 0; h < 16; ++h) { f32x4 s = {0.f, 0.f, 0.f, 0.f};
                s = __builtin_amdgcn_mfma_f32_16x16x32_bf16(ka0, qf[h][0], s, 0, 0, 0); s = __builtin_amdgcn_mfma_f32_16x16x32_bf16(ka1, qf[h][1], s, 0, 0, 0);
#pragma unroll
                for (int j = 0; j < 4; ++j) tot[j] += w[h] * fmaxf(s[j], 0.f); }
            *(f32x4*)(sc + (size_t)qtok * SEQ + k0 + 4 * l4) = tot;
        }
    }
}

DI void p4_select(Frame& F) {
    const float* sc = (const float*)(F.ws + WS_SC); unsigned* mask = (unsigned*)(F.ws + WS_MASK);
    const int gw = F.bid * 8 + F.wave, NGW = F.G * 8, lane = F.lane;
    for (int tok = gw; tok < MTOK; tok += NGW) {
        const int tpos = tok & (SEQ - 1), limit = ((tpos >> 6) + 1) * 64, nw = limit >> 5;
        unsigned mw = 0u;
        if (limit <= 256) { mw = lane < nw ? 0xffffffffu : 0u; }
        else {
            unsigned key[32];
            if (lane < nw) { const float* p = sc + (size_t)tok * SEQ + lane * 32;
#pragma unroll
                for (int q = 0; q < 8; ++q) { const f32x4 v = *(const f32x4*)(p + 4 * q);
#pragma unroll
                    for (int j = 0; j < 4; ++j) { const unsigned uu = __float_as_uint(v[j]); key[4 * q + j] = (uu & 0x80000000u) ? ~uu : (uu | 0x80000000u); } } }
            else {
#pragma unroll
                for (int j = 0; j < 32; ++j) key[j] = 0u; }
            unsigned T = 0u; bool exact = false;
            for (int bit = 31; bit >= 0; --bit) {
                const unsigned cand = T | (1u << bit); int cnt = 0;
#pragma unroll
                for (int j = 0; j < 32; ++j) cnt += __popcll(__ballot(key[j] >= cand));
                if (cnt >= 256) { T = cand; if (cnt == 256) { exact = true; break; } }
            }
            unsigned gtw = 0u, eqw = 0u;
#pragma unroll
            for (int j = 0; j < 32; ++j) { gtw |= (key[j] > T) ? (1u << j) : 0u; eqw |= (key[j] == T) ? (1u << j) : 0u; }
            if (exact) { mw = gtw | eqw; }
            else {
                int ngt = 0;
#pragma unroll
                for (int j = 0; j < 32; ++j) ngt += __popcll(__ballot(key[j] > T));
                const int need = 256 - ngt; const int el = __popc(eqw);
                int pre = el;
#pragma unroll
                for (int o = 1; o < 64; o <<= 1) { const int t = __shfl_up(pre, o); pre += (lane >= o) ? t : 0; }
                int take = need - (pre - el); take = take < 0 ? 0 : (take > el ? el : take);
                unsigned sel = 0u, rem = eqw;
                for (int t = 0; t < 32; ++t) { if (t < take) { const unsigned low = rem & (0u - rem); sel |= low; rem ^= low; } }
                mw = gtw | sel;
            }
        }
        mask[(size_t)tok * 64 + lane] = mw;
    }
}

DI void p4_lru_pass1(Frame& F) {
    const unsigned* AB = (const unsigned*)(F.ws + WS_A); float* CP = (float*)(F.ws + WS_CARRY); float* CH = CP + BATCH * 64 * DM;
    for (int u = F.bid; u < BATCH * 64; u += F.G) {
        const int j = u & 63, b = u >> 6, c = 4 * F.tid;
        const size_t base = ((size_t)b * SEQ + j * 32) * DM + c;
        u32x4 w[32];
#pragma unroll
        for (int t = 0; t < 32; ++t) w[t] = *(const u32x4*)(AB + base + (size_t)t * DM);
        f32x4 P = {1.f, 1.f, 1.f, 1.f}, H = {0.f, 0.f, 0.f, 0.f};
#pragma unroll
        for (int t = 0; t < 32; ++t) { const f32x4 a = {__expf(bflo(w[t].x)), __expf(bflo(w[t].y)), __expf(bflo(w[t].z)), __expf(bflo(w[t].w))}, bb = {bfhi(w[t].x), bfhi(w[t].y), bfhi(w[t].z), bfhi(w[t].w)};
            H = a * H + bb; P = P * a; }
        *(f32x4*)(CP + ((size_t)b * 64 + j) * DM + c) = P; *(f32x4*)(CH + ((size_t)b * 64 + j) * DM + c) = H;
    }
}
DI void p5_lru_pass2(Frame& F) {
    const unsigned* AB = (const unsigned*)(F.ws + WS_A); const float* CP = (const float*)(F.ws + WS_CARRY); const float* CH = CP + BATCH * 64 * DM;
    const bf16* proj = (const bf16*)(F.ws + WS_PROJ); bf16* mrg = (bf16*)(F.ws + WS_MRG);
    for (int u = F.bid; u < BATCH * 64; u += F.G) {
        const int j = u & 63, b = u >> 6, c = 4 * F.tid;
        f32x4 h = {0.f, 0.f, 0.f, 0.f};
#pragma unroll 8
        for (int jj = 0; jj < j; ++jj) { const f32x4 p = *(const f32x4*)(CP + ((size_t)b * 64 + jj) * DM + c), q = *(const f32x4*)(CH + ((size_t)b * 64 + jj) * DM + c); h = p * h + q; }
        const size_t tok0 = (size_t)b * SEQ + j * 32;
#pragma unroll 1
        for (int hs = 0; hs < 2; ++hs) {
            u32x4 w[16]; u32x2 gr[16], gg[16];
#pragma unroll
            for (int t = 0; t < 16; ++t) { const size_t tok = tok0 + hs * 16 + t; w[t] = *(const u32x4*)(AB + tok * DM + c); gr[t] = *(const u32x2*)(proj + tok * NINP + C_GR + c); gg[t] = *(const u32x2*)(proj + tok * NINP + C_G + 4096 + c); }
#pragma unroll
            for (int t = 0; t < 16; ++t) { const size_t tok = tok0 + hs * 16 + t;
                const f32x4 a = {__expf(bflo(w[t].x)), __expf(bflo(w[t].y)), __expf(bflo(w[t].z)), __expf(bflo(w[t].w))}, bb = {bfhi(w[t].x), bfhi(w[t].y), bfhi(w[t].z), bfhi(w[t].w)};
                h = a * h + bb;
                u32x2 o; o.x = pk2(h[0] * gelu_tanh_(bflo(gr[t].x)) * sigmoidf_(bflo(gg[t].x)), h[1] * gelu_tanh_(bfhi(gr[t].x)) * sigmoidf_(bfhi(gg[t].x)));
                o.y = pk2(h[2] * gelu_tanh_(bflo(gr[t].y)) * sigmoidf_(bflo(gg[t].y)), h[3] * gelu_tanh_(bfhi(gr[t].y)) * sigmoidf_(bfhi(gg[t].y)));
                *(u32x2*)(mrg + tok * MIXW + 4096 + c) = o; }
        }
    }
}

typedef short s16x4 __attribute__((ext_vector_type(4)));
constexpr int KS_STRIDE = 272, VS_STRIDE = 320, ATT_V = 64 * KS_STRIDE, ATT_BUF = 64 * KS_STRIDE + 64 * VS_STRIDE;
DI void p5_attention(Frame& F) {
    const bf16* proj = (const bf16*)(F.ws + WS_PROJ); const unsigned* mask = (const unsigned*)(F.ws + WS_MASK); bf16* mrg = (bf16*)(F.ws + WS_MRG);
    const int lane = F.lane, l31 = lane & 31, hf = lane >> 5, wave = F.wave, hh = wave >> 1, qh = wave & 1, tid = F.tid;
    const float sc2 = 0.08838834764831845f * 1.4426950408889634f;
    const int gi = lane >> 4, i16 = lane & 15;
    const int vbase = ATT_V + (4 * (gi >> 1) + (i16 >> 2)) * VS_STRIDE + (16 * (gi & 1) + 4 * (i16 & 3)) * 2;
    const int sr0 = tid >> 4, sch = tid & 15;
    for (int u = F.bid; u < BATCH * 16 * 4; u += F.G) {
        const int g = u & 3, cp = (u >> 2) & 15, b = u >> 6;
        for (int half = 0; half < 2; ++half) {
            const int c = half ? (31 - cp) : cp, nkt = c + 1, head = g * 4 + hh;
            const int qtok = b * SEQ + c * 64 + qh * 32 + l31;
            const bf16* qrow = proj + (size_t)qtok * NINP + C_Q + head * 128 + hf * 8;
            bf16x8 qf[8];
#pragma unroll
            for (int ks = 0; ks < 8; ++ks) qf[ks] = *(const bf16x8*)(qrow + ks * 16);
            f32x16 o[4];
#pragma unroll
            for (int db = 0; db < 4; ++db)
#pragma unroll
                for (int i = 0; i < 16; ++i) o[db][i] = 0.f;
            float mrun = -1e30f, lrun = 0.f;
            const bf16* kg = proj + (size_t)(b * SEQ + sr0) * NINP + C_K + g * 128 + sch * 8;
            const bf16* vg = proj + (size_t)(b * SEQ + sr0) * NINP + C_V + g * 128 + sch * 8;
            u32x4 kr0 = *(const u32x4*)kg, kr1 = *(const u32x4*)(kg + (size_t)32 * NINP), vr0 = *(const u32x4*)vg, vr1 = *(const u32x4*)(vg + (size_t)32 * NINP);
            const unsigned* mrow = mask + (size_t)qtok * 64;
            unsigned mw0 = mrow[0], mw1 = mrow[1];
            { LAS unsigned char* B0 = F.lds;
              *(LAS u32x4*)(B0 + sr0 * KS_STRIDE + sch * 16) = kr0; *(LAS u32x4*)(B0 + (sr0 + 32) * KS_STRIDE + sch * 16) = kr1;
              *(LAS u32x4*)(B0 + ATT_V + sr0 * VS_STRIDE + sch * 16) = vr0; *(LAS u32x4*)(B0 + ATT_V + (sr0 + 32) * VS_STRIDE + sch * 16) = vr1; }
            __syncthreads();
            for (int kt = 0; kt < nkt; ++kt) {
                LAS unsigned char* Bc = F.lds + (kt & 1) * ATT_BUF; LAS unsigned char* Bn = F.lds + ((kt + 1) & 1) * ATT_BUF;
                const unsigned cm0 = mw0, cm1 = mw1; const bool more = kt + 1 < nkt;
                if (more) { const size_t adv = (size_t)(kt + 1) * 64 * NINP;
                    kr0 = *(const u32x4*)(kg + adv); kr1 = *(const u32x4*)(kg + adv + (size_t)32 * NINP); vr0 = *(const u32x4*)(vg + adv); vr1 = *(const u32x4*)(vg + adv + (size_t)32 * NINP);
                    mw0 = mrow[2 * kt + 2]; mw1 = mrow[2 * kt + 3]; }
                f32x16 s0, s1;
#pragma unroll
                for (int i = 0; i < 16; ++i) { s0[i] = 0.f; s1[i] = 0.f; }
#pragma unroll
                for (int ks = 0; ks < 8; ++ks) {
                    const bf16x8 ka = *(const LAS bf16x8*)(Bc + l31 * KS_STRIDE + ks * 32 + hf * 16);
                    const bf16x8 kb = *(const LAS bf16x8*)(Bc + (32 + l31) * KS_STRIDE + ks * 32 + hf * 16);
                    s0 = __builtin_amdgcn_mfma_f32_32x32x16_bf16(ka, qf[ks], s0, 0, 0, 0);
                    s1 = __builtin_amdgcn_mfma_f32_32x32x16_bf16(kb, qf[ks], s1, 0, 0, 0);
                }
                const unsigned sm0 = cm0 >> (4 * hf), sm1 = cm1 >> (4 * hf);
                float tmax = -INFINITY;
#pragma unroll
                for (int i = 0; i < 16; ++i) { const unsigned bit = 1u << ((i & 3) + 8 * (i >> 2));
                    s0[i] = (sm0 & bit) ? s0[i] * sc2 : -INFINITY; s1[i] = (sm1 & bit) ? s1[i] * sc2 : -INFINITY; tmax = fmaxf(tmax, fmaxf(s0[i], s1[i])); }
                tmax = fmaxf(tmax, __shfl_xor(tmax, 32));
                const float mnew = fmaxf(mrun, tmax), alpha = __builtin_amdgcn_exp2f(mrun - mnew); mrun = mnew;
                float psum = 0.f;
#pragma unroll
                for (int i = 0; i < 16; ++i) { s0[i] = __builtin_amdgcn_exp2f(s0[i] - mnew); s1[i] = __builtin_amdgcn_exp2f(s1[i] - mnew); psum += s0[i] + s1[i]; }
                lrun = lrun * alpha + psum;
#pragma unroll
                for (int db = 0; db < 4; ++db)
#pragma unroll
                    for (int i = 0; i < 16; ++i) o[db][i] *= alpha;
#pragma unroll
                for (int kb = 0; kb < 2; ++kb)
#pragma unroll
                    for (int s = 0; s < 2; ++s) {
                        u32x4 pw;
                        if (kb == 0) { pw.x = pk2(s0[8 * s], s0[8 * s + 1]); pw.y = pk2(s0[8 * s + 2], s0[8 * s + 3]); pw.z = pk2(s0[8 * s + 4], s0[8 * s + 5]); pw.w = pk2(s0[8 * s + 6], s0[8 * s + 7]); }
                        else { pw.x = pk2(s1[8 * s], s1[8 * s + 1]); pw.y = pk2(s1[8 * s + 2], s1[8 * s + 3]); pw.z = pk2(s1[8 * s + 4], s1[8 * s + 5]); pw.w = pk2(s1[8 * s + 6], s1[8 * s + 7]); }
                        const bf16x8 pf = __builtin_bit_cast(bf16x8, pw);
#pragma unroll
                        for (int db = 0; db < 4; ++db) {
                            LAS unsigned char* vp = Bc + vbase + (kb * 32 + 16 * s) * VS_STRIDE + db * 64;
                            const s16x4 lo = __builtin_amdgcn_ds_read_tr16_b64_v4i16((LAS s16x4*)vp), hi = __builtin_amdgcn_ds_read_tr16_b64_v4i16((LAS s16x4*)(vp + 8 * VS_STRIDE));
                            const bf16x8 vf = __builtin_shufflevector(lo, hi, 0, 1, 2, 3, 4, 5, 6, 7);
                            o[db] = __builtin_amdgcn_mfma_f32_32x32x16_bf16(vf, pf, o[db], 0, 0, 0);
                        }
                    }
                if (more) {
                    *(LAS u32x4*)(Bn + sr0 * KS_STRIDE + sch * 16) = kr0; *(LAS u32x4*)(Bn + (sr0 + 32) * KS_STRIDE + sch * 16) = kr1;
                    *(LAS u32x4*)(Bn + ATT_V + sr0 * VS_STRIDE + sch * 16) = vr0; *(LAS u32x4*)(Bn + ATT_V + (sr0 + 32) * VS_STRIDE + sch * 16) = vr1; }
                __syncthreads();
            }
            const float ltot = lrun + __shfl_xor(lrun, 32), rl = 1.0f / ltot;
            const bf16* grow = proj + (size_t)qtok * NINP + C_G + head * 128; bf16* orow = mrg + (size_t)qtok * MIXW + head * 128;
#pragma unroll
            for (int db = 0; db < 4; ++db)
#pragma unroll
                for (int q4 = 0; q4 < 4; ++q4) { const int d0 = db * 32 + q4 * 8 + hf * 4; const u32x2 gv = *(const u32x2*)(grow + d0);
                    u32x2 w; w.x = pk2(o[db][4 * q4] * rl * sigmoidf_(bflo(gv.x)), o[db][4 * q4 + 1] * rl * sigmoidf_(bfhi(gv.x)));
                    w.y = pk2(o[db][4 * q4 + 2] * rl * sigmoidf_(bflo(gv.y)), o[db][4 * q4 + 3] * rl * sigmoidf_(bfhi(gv.y)));
                    *(u32x2*)(orow + d0) = w; }
        }
    }
    __syncthreads();
}

template <int MODE, bool ROUTE, bool WRITE_BF>
DI void p_layernorm(Frame& F, const Args& args, const float* src, const float* gam, const float* bet, float* outf, bf16* outb) {
    const int gw = F.bid * 8 + F.wave, NGW = F.G * 8, lane = F.lane;
    const unsigned* rt = (const unsigned*)(F.ws + WS_ROUTE); unsigned* rtw = (unsigned*)(F.ws + WS_ROUTE);
    LAS float* wr_l = (LAS float*)F.lds;
    LAS unsigned* cl = (LAS unsigned*)(F.lds + 65536);
    if (ROUTE) { for (int i = F.tid; i < DM * NEXP / 4; i += 512) *(LAS f32x4*)(wr_l + 4 * i) = *(const f32x4*)(INF(20) + 4 * i); if (F.tid < 8) cl[F.tid] = 0u; __syncthreads(); }
#define LN_COL(jj) (MODE == 1 ? (8 * lane + 512 * ((jj) >> 1) + 4 * ((jj) & 1)) : (4 * lane + 256 * (jj)))
    for (int row = gw; row < MTOK; row += NGW) {
        f32x4 v[8]; float s = 0.f;
        if (MODE == 0) {
#pragma unroll
            for (int j = 0; j < 8; ++j) v[j] = *(const f32x4*)(src + (size_t)row * DM + LN_COL(j));
        } else {
            const unsigned r0 = rt[RT_ROW + 2 * row], r1 = rt[RT_ROW + 2 * row + 1]; const float w0 = __uint_as_float(rt[RT_W + 2 * row]), w1 = __uint_as_float(rt[RT_W + 2 * row + 1]);
            const bf16* yb = (const bf16*)(F.ws + WS_YB);
            u32x4 pa[4][KSPLIT], pb[4][KSPLIT];
#pragma unroll
            for (int j = 0; j < 4; ++j)
#pragma unroll
                for (int ks = 0; ks < KSPLIT; ++ks) { pa[j][ks] = *(const u32x4*)(yb + ((size_t)ks * MOE_ROWS_MAX + r0) * DM + 8 * lane + 512 * j); pb[j][ks] = *(const u32x4*)(yb + ((size_t)ks * MOE_ROWS_MAX + r1) * DM + 8 * lane + 512 * j); }
#pragma unroll
            for (int j = 0; j < 4; ++j) { f32x4 a0 = {0.f, 0.f, 0.f, 0.f}, a1 = a0, b0 = a0, b1 = a0;
#pragma unroll
                for (int ks = 0; ks < KSPLIT; ++ks) { const u32x4 a = pa[j][ks], b = pb[j][ks];
                    a0 += (f32x4){bflo(a.x), bfhi(a.x), bflo(a.y), bfhi(a.y)}; a1 += (f32x4){bflo(a.z), bfhi(a.z), bflo(a.w), bfhi(a.w)};
                    b0 += (f32x4){bflo(b.x), bfhi(b.x), bflo(b.y), bfhi(b.y)}; b1 += (f32x4){bflo(b.z), bfhi(b.z), bflo(b.w), bfhi(b.w)}; }
                v[2 * j] = *(const f32x4*)(src + (size_t)row * DM + LN_COL(2 * j)) * ALPHA + a0 * w0 + b0 * w1;
                v[2 * j + 1] = *(const f32x4*)(src + (size_t)row * DM + LN_COL(2 * j + 1)) * ALPHA + a1 * w0 + b1 * w1; }
        }
#pragma unroll
        for (int j = 0; j < 8; ++j) s += (v[j][0] + v[j][1]) + (v[j][2] + v[j][3]);
        const float mean = wave_sum(s) * (1.f / DM); float s2 = 0.f;
#pragma unroll
        for (int j = 0; j < 8; ++j) { v[j] = v[j] - mean; s2 += (v[j][0] * v[j][0] + v[j][1] * v[j][1]) + (v[j][2] * v[j][2] + v[j][3] * v[j][3]); }
        const float rstd = 1.0f / sqrtf(wave_sum(s2) * (1.f / DM) + LN_EPS);
        float lg[8];
#pragma unroll
        for (int e = 0; e < 8; ++e) lg[e] = 0.f;
#pragma unroll
        for (int j = 0; j < 8; ++j) { const int cc = LN_COL(j); const f32x4 gv = *(const f32x4*)(gam + cc), bv = *(const f32x4*)(bet + cc);
            const f32x4 y = v[j] * rstd * gv + bv; *(f32x4*)(outf + (size_t)row * DM + cc) = y;
            if (WRITE_BF) { u32x2 w; w.x = pk2(y[0], y[1]); w.y = pk2(y[2], y[3]); *(u32x2*)(outb + (size_t)row * DM + cc) = w; }
            if (ROUTE) {
#pragma unroll
                for (int i = 0; i < 4; ++i) { const LAS float* wp = wr_l + (size_t)(cc + i) * 8; const f32x4 wa = *(const LAS f32x4*)wp, wb = *(const LAS f32x4*)(wp + 4); const float xv = y[i];
                    lg[0] += xv * wa[0]; lg[1] += xv * wa[1]; lg[2] += xv * wa[2]; lg[3] += xv * wa[3]; lg[4] += xv * wb[0]; lg[5] += xv * wb[1]; lg[6] += xv * wb[2]; lg[7] += xv * wb[3]; }
            }
            asm volatile("" ::: "memory"); }
        if (ROUTE) {
#pragma unroll
            for (int e = 0; e < 8; ++e) lg[e] = wave_sum(lg[e]);
            int e0 = 0; float l0 = lg[0];
#pragma unroll
            for (int e = 1; e < 8; ++e) if (lg[e] > l0) { l0 = lg[e]; e0 = e; }
            int e1 = 0; float l1 = -INFINITY;
#pragma unroll
            for (int e = 0; e < 8; ++e) if (e != e0 && lg[e] > l1) { l1 = lg[e]; e1 = e; }
            const float p1 = 1.0f / (1.0f + expf(l0 - l1)), p0 = 1.0f - p1;
            if (lane == 0) { const unsigned sl0 = __hip_atomic_fetch_add(cl + e0, 1u, __ATOMIC_RELAXED, __HIP_MEMORY_SCOPE_WORKGROUP), sl1 = __hip_atomic_fetch_add(cl + e1, 1u, __ATOMIC_RELAXED, __HIP_MEMORY_SCOPE_WORKGROUP);
                rtw[RT_E + 2 * row] = (unsigned)e0; rtw[RT_E + 2 * row + 1] = (unsigned)e1; rtw[RT_SLOT + 2 * row] = sl0; rtw[RT_SLOT + 2 * row + 1] = sl1;
                rtw[RT_W + 2 * row] = __float_as_uint(p0); rtw[RT_W + 2 * row + 1] = __float_as_uint(p1); }
        }
    }
#undef LN_COL
    if (ROUTE) { __syncthreads(); const int t2 = F.wave * 64 + lane_id_(); if (t2 < 8) rtw[RT_WGC + F.bid * 8 + t2] = cl[t2]; __syncthreads(); }
}

DI void p_moe_gather(Frame& F) {
    unsigned* rt = (unsigned*)(F.ws + WS_ROUTE);
    const bf16* x1b = (const bf16*)(F.ws + WS_X1B); bf16* am = (bf16*)(F.ws + WS_AMOE);
    LAS unsigned* pre = (LAS unsigned*)F.lds;
    LAS unsigned* tot = pre + 2048;
    const int lane = F.lane;
    __syncthreads();
    { const int e = F.wave; unsigned c[4]; unsigned s = 0u;
#pragma unroll
      for (int i = 0; i < 4; ++i) { const int b = 4 * lane + i; c[i] = b < F.G ? rt[RT_WGC + b * 8 + e] : 0u; s += c[i]; }
      unsigned inc = s;
#pragma unroll
      for (int o = 1; o < 64; o <<= 1) { const unsigned t = __shfl_up(inc, o); inc += (lane >= o) ? t : 0u; }
      unsigned ex = inc - s;
#pragma unroll
      for (int i = 0; i < 4; ++i) { pre[(4 * lane + i) * 8 + e] = ex; ex += c[i]; }
      if (lane == 63) tot[e] = inc; }
    __syncthreads();
    if (F.tid == 0) { unsigned t = 0u; for (int e = 0; e < 8; ++e) { tot[8 + e] = t; t += (tot[e] + 255u) >> 8; } }
    __syncthreads();
    if (F.bid == 0 && F.tid < 8) F.ctl[CW_CNT + F.tid] = tot[F.tid];
    const int gw = F.bid * 8 + F.wave, NGW = F.G * 8;
    for (int a = gw; a < MTOK * 2; a += NGW) {
        const int tok = a >> 1; const int e = (int)rt[RT_E + a], slot = (int)rt[RT_SLOT + a];
        const int bsrc = (tok % NGW) >> 3;
        const int row = (int)tot[8 + e] * 256 + (int)pre[bsrc * 8 + e] + slot;
        const u32x4* s = (const u32x4*)(x1b + (size_t)tok * DM); u32x4* d = (u32x4*)(am + (size_t)row * DM);
#pragma unroll
        for (int i = 0; i < 4; ++i) d[lane + 64 * i] = s[lane + 64 * i];
        if (lane == 0) rt[RT_ROW + a] = (unsigned)row;
    }
    for (int pr = gw; pr < 8 * 256; pr += NGW) { const int e = pr >> 8, i = pr & 255;
        const int row = (int)tot[8 + e] * 256 + (int)tot[e] + i, rend = ((int)tot[8 + e] + (((int)tot[e] + 255) >> 8)) * 256;
        if (row < rend) { u32x4* d = (u32x4*)(am + (size_t)row * DM);
#pragma unroll
            for (int q = 0; q < 4; ++q) d[lane + 64 * q] = (u32x4){0u, 0u, 0u, 0u}; } }
    __syncthreads();
}

constexpr int NPH_LAYER = 12;
constexpr int NPHASES = 1 + 2 * NPH_LAYER;
#define IN(k) (lo <= (k) && (k) < hi)
#define RELAUNDER() do { int l_ = lane_id_(); asm volatile("" : "+v"(l_)); F.lane = l_; F.tid = F.wave * 64 + l_; } while (0)
#define STAMP(k) do { if (STAMP_PROBE && F.bid == 0 && xb_t0(F.wave)) ((volatile LAS unsigned*)(F.lds + LDSCTL_OFF + 512))[k] = (unsigned)__builtin_amdgcn_s_memrealtime(); } while (0)
#define SEAM(k) do { if (IN(k) && IN((k) + 1)) { xcd_barrier(bar); STAMP((k) + 1); } } while (0)
template <int LAYER>
DI void run_layer(Frame& F, const Args& args, const XcdBarrier& bar, const int lo, const int hi) {
    constexpr int P = 1 + NPH_LAYER * LAYER;
    bf16* proj = (bf16*)(F.ws + WS_PROJ); bf16* xb = (bf16*)(F.ws + WS_XB); bf16* mrg = (bf16*)(F.ws + WS_MRG);
    float* x1 = (float*)(F.ws + WS_X1); bf16* x1b = (bf16*)(F.ws + WS_X1B); float* x2 = (float*)(F.ws + WS_X2); float* pre = (float*)(F.ws + WS_PRE);
    if (IN(P + 0)) {
        pg8::Gemm g{xb, (const bf16*)(F.ws + WS_WIN) + (size_t)LAYER * NINP * DM, DM, DM, DM};
        pg8::TileOrder S; S.init(MTOK / 256, NINP / 256, F.G, F.bid, (size_t)256 * DM * 2, (size_t)256 * DM * 2);
        pg8::EpiBf16 E{proj, NINP, 0};
        pg8::gemm_phase(F.lds, g, S, E, F.wave);
        RELAUNDER(); if (LAYER == 0) conv_range(F, args, CE_0, CE_3, 32); else conv_range(F, args, CE_5, CE_5 + MOE_EARLY, 32);
    }
    SEAM(P + 0);
    if (IN(P + 1)) { RELAUNDER(); p2_prep(F, args, LAYER); }
    SEAM(P + 1);
    if (IN(P + 2)) {
        { pg8::Gemm g{(const bf16*)(F.ws + WS_DIFF), (const bf16*)(F.ws + WS_WPOOL) + (size_t)LAYER * 2048 * 512, DM, 512, 512};
          pg8::TileOrder S; S.init(MTOK / 256, 8, F.G, F.bid, (size_t)256 * DM * 2, (size_t)256 * 512 * 2, 2, (size_t)512 * 2);
          pg8::EpiPool E{mrg, proj, INF(5) + (size_t)LAYER * DM};
          pg8::gemm_phase(F.lds, g, S, E, F.wave); }
        if (LAYER == 0) STAMP(25);
        { pg8::Gemm g{(const bf16*)(F.ws + WS_XC), (const bf16*)(F.ws + WS_WLRU) + (size_t)LAYER * 4096 * 256, DM, 256, 256};
          pg8::TileOrder S; S.init(MTOK / 256, 16, F.G, F.bid, (size_t)256 * DM * 2, (size_t)256 * 256 * 2, 2, (size_t)256 * 2);
          pg8::EpiLru E{(unsigned*)(F.ws + WS_A), (const bf16*)(F.ws + WS_XC), INF(9) + (size_t)LAYER * DM, INF(11) + (size_t)LAYER * DM, (const float*)(F.ws + WS_LRUC) + (size_t)LAYER * DM};
          pg8::gemm_phase(F.lds, g, S, E, F.wave); }
        if (LAYER == 0) STAMP(26);
        RELAUNDER(); p3_indexer(F);
        if (LAYER == 0) STAMP(29);
        __syncthreads(); RELAUNDER(); if (LAYER == 0) conv_range(F, args, CE_3, CE_3 + P2_ITEMS, 32); else conv_range(F, args, CE_5 + MOE_EARLY, CE_5 + MOE_EARLY + P2_ITEMS, 32);
    }
    SEAM(P + 2);
    if (IN(P + 3)) { RELAUNDER(); p4_select(F); if (LAYER == 0) STAMP(27); RELAUNDER(); p4_lru_pass1(F); }
    SEAM(P + 3);
    if (IN(P + 4)) { RELAUNDER(); p5_attention(F); if (LAYER == 0) STAMP(28); RELAUNDER(); p5_lru_pass2(F); }
    SEAM(P + 4);
    if (IN(P + 5)) {
        pg8::Gemm g{mrg, (const bf16*)(F.ws + WS_WOUT) + (size_t)LAYER * DM * MIXW, MIXW, MIXW, MIXW};
        pg8::TileOrder S; S.init(MTOK / 256, DM / 256, F.G, F.bid, (size_t)256 * MIXW * 2, (size_t)256 * MIXW * 2);
        pg8::EpiRes E{pre, LAYER == 0 ? INF(0) : (const float*)x2, DM};
        pg8::gemm_phase(F.lds, g, S, E, F.wave);
    }
    SEAM(P + 5);
    if (IN(P + 6)) { RELAUNDER(); } if (IN(P + 6)) p_layernorm<0, LAYER == 1, true>(F, args, pre, INF(13) + LAYER * DM, INF(14) + LAYER * DM, x1, x1b);
    SEAM(P + 6);
    if constexpr (LAYER == 0) {
        if (IN(P + 7)) {
            pg8::Gemm g{x1b, (const bf16*)(F.ws + WS_WGU), DM, DM, DM};
            pg8::TileOrder S; S.init(MTOK / 256, 2 * DFF / 256, F.G, F.bid, (size_t)256 * DM * 2, (size_t)256 * DM * 2);
            pg8::EpiSwiglu E{(bf16*)(F.ws + WS_H), DFF};
            pg8::gemm_phase(F.lds, g, S, E, F.wave);
            RELAUNDER(); conv_range(F, args, CE_3 + P2_ITEMS, CE_5, 96);
        }
        SEAM(P + 7);
        if (IN(P + 8)) {
            pg8::Gemm g{(const bf16*)(F.ws + WS_H), (const bf16*)(F.ws + WS_WDN), DFF, DFF, DFF};
            pg8::TileOrder S; S.init(MTOK / 256, DM / 256, F.G, F.bid, (size_t)256 * DFF * 2, (size_t)256 * DFF * 2);
            pg8::EpiRes E{pre, x1, DM};
            pg8::gemm_phase(F.lds, g, S, E, F.wave);
        }
        SEAM(P + 8);
        if (IN(P + 9)) { RELAUNDER(); } if (IN(P + 9)) p_layernorm<0, false, true>(F, args, pre, INF(15), INF(16), x2, xb);
        if (IN(P + 9) && IN(P + 12)) { xcd_barrier(bar); STAMP(P + 10); STAMP(P + 11); STAMP(P + 12); }
    } else {
        if (IN(P + 7)) { RELAUNDER(); conv_range(F, args, CE_5 + MOE_EARLY + P2_ITEMS, CE_7, 0); RELAUNDER(); p_moe_gather(F); }
        SEAM(P + 7);
        if (IN(P + 8)) {
            pg8::Gemm g{(const bf16*)(F.ws + WS_AMOE), (const bf16*)(F.ws + WS_MWGU), DM, DM, DM};
            pg8::MoeOrder S; S.init(F.ctl + CW_CNT, 2 * DEXP / 256, 1, F.G, F.bid, (size_t)256 * DM * 2, (size_t)2 * DEXP * DM * 2, (size_t)256 * DM * 2, 0);
            pg8::EpiSwiglu E{(bf16*)(F.ws + WS_HMOE), DEXP};
            pg8::gemm_phase(F.lds, g, S, E, F.wave);
        }
        SEAM(P + 8);
        if (IN(P + 9)) {
            pg8::Gemm g{(const bf16*)(F.ws + WS_HMOE), (const bf16*)(F.ws + WS_MWDN), DEXP, DEXP, DEXP / KSPLIT};
            pg8::MoeOrder S; S.init(F.ctl + CW_CNT, DM / 256, KSPLIT, F.G, F.bid, (size_t)256 * DEXP * 2, (size_t)DM * DEXP * 2, (size_t)256 * DEXP * 2, (size_t)(DEXP / KSPLIT) * 2);
            pg8::EpiBf16 E{(bf16*)(F.ws + WS_YB), DM, (size_t)MOE_ROWS_MAX * DM};
            pg8::gemm_phase(F.lds, g, S, E, F.wave);
        }
        SEAM(P + 9);
        if (IN(P + 10)) { RELAUNDER(); } if (IN(P + 10)) p_layernorm<1, false, false>(F, args, x1, INF(15) + DM, INF(16) + DM, args.out, nullptr);
    }
}
__global__ void __launch_bounds__(512, 2) fwd_kernel(Args args) {
    extern __shared__ __attribute__((aligned(16))) unsigned char lds_raw[];
    Frame F;
    F.lds = (LAS unsigned char*)lds_raw; F.ws = args.ws; F.ctl = (unsigned*)(args.ws + WS_CTL);
    F.wave = __builtin_amdgcn_readfirstlane((int)threadIdx.x >> 6); F.lane = lane_id_(); F.tid = F.wave * 64 + F.lane; F.G = gridDim.x; F.bid = blockIdx.x;
    volatile LAS unsigned* MISC = (volatile LAS unsigned*)(F.lds + LDSCTL_OFF);
    for (int u = F.tid; u < (LDS_BYTES - LDSCTL_OFF) / 4; u += 512) ((LAS unsigned*)(F.lds + LDSCTL_OFF))[u] = 0u;
    __syncthreads();
    const int lo = args.ph_lo, hi = args.ph_hi;
    XcdBarrier bar; bar.bar = F.ctl + CW_BAR; bar.x = 0; bar.st = nullptr; bar.wave = F.wave;
    if ((hi - lo) > 1) bar = xcd_barrier_post(F.ctl + CW_BAR, MISC + 8, F.wave);
    STAMP(0);
    if (IN(0)) { RELAUNDER(); p0_prologue(F, args); __syncthreads(); }
    SEAM(0);
    run_layer<0>(F, args, bar, lo, hi);
    run_layer<1>(F, args, bar, lo, hi);
#if STAMP_PROBE
    RELAUNDER();
    if (F.bid == 0) {
        asm volatile("s_waitcnt vmcnt(0)" ::: "memory"); __syncthreads();
        if (xb_t0(F.wave)) ((volatile LAS unsigned*)(F.lds + LDSCTL_OFF + 512))[NPHASES - 1] = (unsigned)__builtin_amdgcn_s_memrealtime();
        __syncthreads();
        volatile LAS unsigned* st = (volatile LAS unsigned*)(F.lds + LDSCTL_OFF + 512);
        const float ta = (float)(st[STAMP_A_HI] - st[STAMP_A_LO]) * 0.01f, tb = (float)(st[STAMP_B_HI] - st[STAMP_B_LO]) * 0.01f;
        const float da = __builtin_amdgcn_sqrtf(ta * 0.005f);
        for (int i = F.tid; i < DM; i += 512) args.out[i] += da;
        if (F.tid == 0) args.out[DM] += tb * 0.1f;
    }
#endif
}
#undef IN
#undef SEAM

extern "C" void kernel_launch(void* const* d_in, const int* in_sizes, int n_in, void* d_out, int out_size, void* d_ws, size_t ws_size, hipStream_t stream) {
    static int grid = 0;
    if (grid == 0) {
        if (n_in != 24 || out_size != MTOK * DM || ws_size < WS_END) { fprintf(stderr, "kernel_launch: unexpected problem (n_in %d, out %d, ws %zu, need %zu)\n", n_in, out_size, ws_size, (size_t)WS_END); grid = -1; return; }
        int dev = 0, cus = 0, per_cu = 0;
        if (hipGetDevice(&dev) != hipSuccess || hipDeviceGetAttribute(&cus, hipDeviceAttributeMultiprocessorCount, dev) != hipSuccess) { grid = -1; return; }
        if (hipFuncSetAttribute((const void*)fwd_kernel, hipFuncAttributeMaxDynamicSharedMemorySize, LDS_BYTES) != hipSuccess) { fprintf(stderr, "kernel_launch: hipFuncSetAttribute failed\n"); grid = -1; return; }
        if (hipOccupancyMaxActiveBlocksPerMultiprocessor(&per_cu, (const void*)fwd_kernel, 512, LDS_BYTES) != hipSuccess || per_cu < 1) fprintf(stderr, "kernel_launch: occupancy query reports %d\n", per_cu);
        (void)hipGetLastError();
        grid = cus;
    }
    if (grid < 0) return;
    (void)hipMemsetAsync((char*)d_ws + WS_CTL, 0, CTL_ZERO_BYTES, stream);
    Args a{};
    for (int i = 0; i < 24; ++i) a.in[i] = d_in[i];
    a.out = (float*)d_out; a.ws = (unsigned char*)d_ws;
#if MK_N_LAUNCHES == 1
    a.ph_lo = 0; a.ph_hi = NPHASES;
    hipLaunchKernelGGL(fwd_kernel, dim3(grid), dim3(512), LDS_BYTES, stream, a);
#else
    const int plist[] = {0, 1, 2, 3, 4, 5, 6, 7, 8, 9, 10, 13, 14, 15, 16, 17, 18, 19, 20, 21, 22, 23};
    for (int i = 0; i < (int)(sizeof(plist) / sizeof(int)); ++i) { a.ph_lo = plist[i]; a.ph_hi = plist[i] + 1; hipLaunchKernelGGL(fwd_kernel, dim3(grid), dim3(512), LDS_BYTES, stream, a); }
#endif
}
```

```cpp
#include <hip/hip_runtime.h>
#include <cstdio>
#include <cstdint>

#ifndef MK_N_LAUNCHES
#define MK_N_LAUNCHES 1
#endif

#ifndef STAMP_PROBE
#define STAMP_PROBE 0
#endif
#ifndef STAMP_A_LO
#define STAMP_A_LO 0
#define STAMP_A_HI 1
#define STAMP_B_LO 1
#define STAMP_B_HI 2
#endif
#define DI __device__ __forceinline__
#define LAS __attribute__((address_space(3)))
#define GAS __attribute__((address_space(1)))
typedef unsigned short bf16;
typedef short bf16x8 __attribute__((ext_vector_type(8)));
typedef float f32x2 __attribute__((ext_vector_type(2)));
typedef float f32x4 __attribute__((ext_vector_type(4)));
typedef float f32x16 __attribute__((ext_vector_type(16)));
typedef unsigned u32x2 __attribute__((ext_vector_type(2)));
typedef unsigned u32x4 __attribute__((ext_vector_type(4)));
typedef __bf16 bf16x2_t __attribute__((ext_vector_type(2)));

#define LDS_WAIT() asm volatile("s_waitcnt lgkmcnt(0)" ::: "memory")
#define VM_WAIT() asm volatile("s_waitcnt vmcnt(0)" ::: "memory")

DI unsigned pk2(float lo, float hi) { f32x2 v = {lo, hi}; return __builtin_bit_cast(unsigned, __builtin_convertvector(v, bf16x2_t)); }
DI float bflo(unsigned w) { return __uint_as_float(w << 16); }
DI float bfhi(unsigned w) { return __uint_as_float(w & 0xffff0000u); }
DI float bf2f(bf16 b) { return __uint_as_float(((unsigned)b) << 16); }
DI float rcp_(float x) { return __builtin_amdgcn_rcpf(x); }
DI float sigmoidf_(float x) { return rcp_(1.0f + __expf(-x)); }
DI float siluf_(float x) { return x * rcp_(1.0f + __expf(-x)); }
DI float gelu_tanh_(float x) { const float u = 0.7978845608028654f * (x + 0.044715f * x * x * x); const float t = 1.0f - 2.0f * rcp_(1.0f + __expf(2.0f * u)); return 0.5f * x * (1.0f + t); }
DI float one_minus_exp_(float x) {
    const float p = -x * (1.0f + x * 0.5f * (1.0f + x * (1.0f / 3.0f) * (1.0f + x * 0.25f * (1.0f + x * 0.2f * (1.0f + x * (1.0f / 6.0f) * (1.0f + x * (1.0f / 7.0f)))))));
    const float e = 1.0f - __expf(x);
    return x > -0.5f ? p : e;
}
DI int lane_id_() { int l; asm volatile("v_mbcnt_lo_u32_b32 %0, -1, 0\n\tv_mbcnt_hi_u32_b32 %0, -1, %0" : "=v"(l)); return l; }

constexpr int DM = 2048, BATCH = 4, SEQ = 2048, MTOK = BATCH * SEQ;
constexpr int NIN = 16464, NINP = 16640;
constexpr int C_Q = 0, C_K = 2048, C_V = 2560, C_QI = 3072, C_KI = 4096, C_WI = 4160, C_PADLO = 4176, C_P = 4352, C_XR = 6400, C_GR = 8448, C_G = 10496;
constexpr int MIXW = 6144, DFF = 5504, NEXP = 8, DEXP = 7168;
constexpr int MOE_ROWS_MAX = (MTOK * 2 / 256 + NEXP) * 256;
constexpr float ALPHA = 1.4142135623730951f, LN_EPS = 1e-5f;
constexpr int KSPLIT = 2;

constexpr size_t MiB = 1u << 20;
constexpr size_t WS_CTL = 0, CTL_ZERO_BYTES = 1 * MiB;
constexpr size_t WS_COSA = 1 * MiB, WS_SINA = 3 * MiB, WS_COSI = 5 * MiB, WS_SINI = 6 * MiB;
constexpr size_t WS_ROUTE = 9 * MiB;
constexpr size_t WS_MASK = 10 * MiB;
constexpr size_t WS_LRUC = 9 * MiB + 512 * 1024;
constexpr size_t WS_WIN = 12 * MiB;
constexpr size_t WS_WOUT = 142 * MiB;
constexpr size_t WS_WPOOL = 190 * MiB;
constexpr size_t WS_WLRU = 194 * MiB;
constexpr size_t WS_WGU = 198 * MiB;
constexpr size_t WS_WDN = 241 * MiB;
constexpr size_t WS_XB = 263 * MiB;
constexpr size_t WS_X1 = 295 * MiB;
constexpr size_t WS_X1B = 359 * MiB;
constexpr size_t WS_X2 = 391 * MiB;
constexpr size_t WS_PRE = 455 * MiB;
constexpr size_t WS_MWGU = 519 * MiB;
constexpr size_t WS_MWDN = 967 * MiB;
constexpr size_t WS_OV = 1191 * MiB;
constexpr size_t WS_PROJ = WS_OV;
constexpr size_t WS_DIFF = WS_OV + 260 * MiB;
constexpr size_t WS_XC = WS_OV + 292 * MiB;
constexpr size_t WS_A = WS_OV + 324 * MiB;
constexpr size_t WS_CARRY = WS_OV + 388 * MiB;
constexpr size_t WS_SC = WS_OV + 452 * MiB;
constexpr size_t WS_MRG = WS_OV + 516 * MiB;
constexpr size_t WS_H = WS_OV;
constexpr size_t WS_AMOE = WS_OV;
constexpr size_t WS_HMOE = WS_OV + 72 * MiB;
constexpr size_t WS_YB = WS_OV + 324 * MiB;
constexpr size_t WS_END = WS_OV + 612 * MiB;
constexpr int CW_BAR = 4096, CW_CNT = 16384;
constexpr int RT_E = 0, RT_SLOT = 2 * MTOK, RT_W = 4 * MTOK, RT_ROW = 6 * MTOK, RT_WGC = 8 * MTOK;

constexpr int RING_BYTES = 131072, LDSCTL_OFF = RING_BYTES, LDS_BYTES = 147456;

#define XB_TMO      128
#define XB_XCNT(j)  (256  + 64 * (j))
#define XB_XSUB(j)  (1280 + 64 * (j))
#define XB_XGEN(j)  (2304 + 64 * (j))
#define XB_TOP      3328
#define XB_TOPGEN   3392
#define XCD_BAR_WORDS 3456
#define XB_SPIN_CAP (1u << 18)
DI unsigned xb_ld(unsigned* p)              { return __hip_atomic_load(p, __ATOMIC_RELAXED, __HIP_MEMORY_SCOPE_AGENT); }
DI unsigned xb_add(unsigned* p, unsigned v) { return __hip_atomic_fetch_add(p, v, __ATOMIC_RELAXED, __HIP_MEMORY_SCOPE_AGENT); }
DI unsigned xb_xcc_id() { return (unsigned)__builtin_amdgcn_s_getreg((3 << 11) | 20) & 0xFu; }
#define XB_SPIN(cond, bar) do { unsigned _sp = 0; while (cond) { __builtin_amdgcn_s_sleep(1); \
    if ((++_sp & 255u) == 0u) { if (xb_ld(&(bar)[XB_TMO])) break; if (_sp > XB_SPIN_CAP) { atomicAdd(&(bar)[XB_TMO], 1u); break; } } } } while (0)
struct XcdBarrier { unsigned* bar; unsigned x; volatile LAS unsigned* st; int wave; };
DI bool xb_t0(int wave) { return wave == 0 && lane_id_() == 0; }
DI XcdBarrier xcd_barrier_post(unsigned* bar, volatile LAS unsigned* st, int wave) {
    XcdBarrier b; b.bar = bar; b.x = xb_xcc_id(); b.st = st; b.wave = wave;
    if (xb_t0(wave)) (void)xb_add(&bar[XB_XCNT(b.x)], 1u);
    return b;
}
DI void xcd_barrier_complete(unsigned* bar, unsigned x, unsigned& nloc, unsigned& nx) {
    const unsigned G = gridDim.x * gridDim.y * gridDim.z;
    unsigned sum, cnt, mine, sp = 0u;
    for (;;) {
        sum = 0u; cnt = 0u; mine = 0u;
#pragma unroll
        for (unsigned j = 0; j < 16; ++j) { const unsigned c = xb_ld(&bar[XB_XCNT(j)]); sum += c; cnt += (c > 0u) ? 1u : 0u; mine = (j == x) ? c : mine; }
        if (sum == G) break;
        __builtin_amdgcn_s_sleep(1);
        if ((++sp & 255u) == 0u) { if (xb_ld(&bar[XB_TMO])) break; if (sp > XB_SPIN_CAP) { atomicAdd(&bar[XB_TMO], 1u); break; } }
    }
    nloc = mine > 0u ? mine : 1u; nx = cnt > 0u ? cnt : 1u;
}
DI void xcd_barrier(const XcdBarrier& b) {
    asm volatile("s_waitcnt vmcnt(0)" ::: "memory");
    __syncthreads();
    if (xb_t0(b.wave)) {
        unsigned* bar = b.bar;
        __builtin_amdgcn_s_waitcnt(0);
        unsigned nloc = b.st[0], nx = b.st[1];
        if (nloc == 0u) { xcd_barrier_complete(bar, b.x, nloc, nx); b.st[0] = nloc; b.st[1] = nx; }
        const unsigned old = xb_add(&bar[XB_XSUB(b.x)], 1u);
        const unsigned gen = old / nloc;
        if (old + 1u == (gen + 1u) * nloc) {
            __builtin_amdgcn_fence(__ATOMIC_RELEASE, "agent");
            asm volatile("s_waitcnt vmcnt(0)" ::: "memory");
            const unsigned og = xb_add(&bar[XB_TOP], 1u);
            const unsigned tg = og / nx;
            if (og + 1u == (tg + 1u) * nx) xb_add(&bar[XB_TOPGEN], 1u);
            else XB_SPIN(xb_ld(&bar[XB_TOPGEN]) == tg, bar);
            __builtin_amdgcn_fence(__ATOMIC_ACQUIRE, "agent");
            xb_add(&bar[XB_XGEN(b.x)], 1u);
            asm volatile("s_waitcnt vmcnt(0)" ::: "memory");
        } else {
            XB_SPIN(xb_ld(&bar[XB_XGEN(b.x)]) == gen, bar);
            __builtin_amdgcn_fence(__ATOMIC_ACQUIRE, "agent");
            asm volatile("s_waitcnt vmcnt(0)" ::: "memory");
        }
    }
    __syncthreads();
}

namespace pg8 {
constexpr int BM = 256, BK = 64, HALF = 128, HTB = HALF * BK * 2, STAGE_BYTES = 8 * HTB, NXCD = 8, WGM = 8;
DI int lds_byte(int r, int c) { const int st = (r >> 4) * 2 + (c >> 5), rr = r & 15, cc = c & 31, ob = rr * 64 + cc * 2; return st * 1024 + (ob ^ (((ob >> 9) & 1) << 5)); }
DI void stage_rc(int b, int& R, int& C) { const int st = b / 1024, sb = b % 1024, swz = sb ^ (((sb >> 9) & 1) << 5); R = (st >> 1) * 16 + swz / 64; C = (st & 1) * 32 + (swz % 64) / 2; }
DI int perm32(int rho) { const int n = rho >> 4, i = rho & 15; return 8 * (i >> 2) + 4 * n + (i & 3); }

struct Unit { int pm, pn, e, ks; };
struct Gemm { const bf16* A; const bf16* Bt; int lda, ldb, K; };

struct TileOrder {
    int nM, nN, nwg, G, c, a_div; size_t a_pm, a_pn, b_pn;
    DI void init(int nM_, int nN_, int G_, int c_, size_t a_pm_, size_t b_pn_, int a_div_ = 1, size_t a_pn_ = 0) { nM = nM_; nN = nN_; nwg = nM * nN; G = G_; c = c_; a_pm = a_pm_; b_pn = b_pn_; a_div = a_div_; a_pn = a_pn_; }
    DI bool next(int i, Unit& u) const {
        const long L = (long)i * G + c; if (L >= nwg) return false;
        int wgid = (int)L; { const int q = nwg / NXCD, r = nwg % NXCD, xcd = wgid % NXCD, off = wgid / NXCD; wgid = (xcd < r ? xcd * (q + 1) : r * (q + 1) + (xcd - r) * q) + off; }
        const int nig = WGM * nN, gid = wgid / nig, fm = gid * WGM, gsz = (nM - fm) < WGM ? (nM - fm) : WGM;
        u.pm = fm + ((wgid % nig) % gsz); u.pn = (wgid % nig) / gsz; u.e = 0; u.ks = 0; return true;
    }
    DI size_t aoff(const Unit& u) const { return (size_t)u.pm * a_pm + (size_t)(u.pn / a_div) * a_pn; }
    DI size_t boff(const Unit& u) const { return (size_t)u.pn * b_pn; }
};
struct MoeOrder {
    int nN, nNk, nwg, G, c; int t1, t2, t3, t4, t5, t6, t7, t8; size_t a_pm, b_e, b_pn, ks_step;
    DI void init(const unsigned* cnt, int nN_, int ksplit, int G_, int c_, size_t a_pm_, size_t b_e_, size_t b_pn_, size_t ks_step_) {
        nN = nN_; nNk = nN_ * ksplit; G = G_; c = c_; a_pm = a_pm_; b_e = b_e_; b_pn = b_pn_; ks_step = ks_step_;
        int s = 0; s += ((int)cnt[0] + 255) >> 8; t1 = s; s += ((int)cnt[1] + 255) >> 8; t2 = s; s += ((int)cnt[2] + 255) >> 8; t3 = s; s += ((int)cnt[3] + 255) >> 8; t4 = s;
        s += ((int)cnt[4] + 255) >> 8; t5 = s; s += ((int)cnt[5] + 255) >> 8; t6 = s; s += ((int)cnt[6] + 255) >> 8; t7 = s; s += ((int)cnt[7] + 255) >> 8; t8 = s;
        nwg = t8 * nNk;
    }
    DI bool next(int i, Unit& u) const {
        const long L = (long)i * G + c; if (L >= nwg) return false;
        int wgid = (int)L; { const int q = nwg / NXCD, r = nwg % NXCD, xcd = wgid % NXCD, off = wgid / NXCD; wgid = (xcd < r ? xcd * (q + 1) : r * (q + 1) + (xcd - r) * q) + off; }
        int e = 0, ts = 0, nt = t1;
        if (wgid >= t1 * nNk) { e = 1; ts = t1; nt = t2 - t1; }
        if (wgid >= t2 * nNk) { e = 2; ts = t2; nt = t3 - t2; }
        if (wgid >= t3 * nNk) { e = 3; ts = t3; nt = t4 - t3; }
        if (wgid >= t4 * nNk) { e = 4; ts = t4; nt = t5 - t4; }
        if (wgid >= t5 * nNk) { e = 5; ts = t5; nt = t6 - t5; }
        if (wgid >= t6 * nNk) { e = 6; ts = t6; nt = t7 - t6; }
        if (wgid >= t7 * nNk) { e = 7; ts = t7; nt = t8 - t7; }
        const int loc = wgid - ts * nNk; nt = nt > 0 ? nt : 1;
        const int pn2 = loc / nt;
        u.pm = ts + loc % nt; u.pn = pn2 % nN; u.ks = pn2 / nN; u.e = e; return true;
    }
    DI size_t aoff(const Unit& u) const { return (size_t)u.pm * a_pm + (size_t)u.ks * ks_step; }
    DI size_t boff(const Unit& u) const { return (size_t)u.e * b_e + (size_t)u.pn * b_pn + (size_t)u.ks * ks_step; }
};

struct EpiBf16 {
    static constexpr bool PERM = true;
    bf16* O; int ldc; size_t ks_stride;
    DI void operator()(const f32x4 (&acc)[2][2][4][2], const Unit& u, int wr, int wc, int fr, int fq) const {
        const int row0 = u.pm * BM + wr * 64 + fr, col0 = u.pn * BM + wc * 32 + 8 * fq;
#pragma unroll
        for (int ai = 0; ai < 2; ++ai)
#pragma unroll
            for (int m = 0; m < 4; ++m) { bf16* rowp = O + (size_t)u.ks * ks_stride + (size_t)(row0 + ai * HALF + m * 16) * ldc + col0;
#pragma unroll
                for (int bj = 0; bj < 2; ++bj) { const f32x4 v0 = acc[ai][bj][m][0], v1 = acc[ai][bj][m][1];
                    u32x4 w; w.x = pk2(v0[0], v0[1]); w.y = pk2(v0[2], v0[3]); w.z = pk2(v1[0], v1[1]); w.w = pk2(v1[2], v1[3]);
                    *(u32x4*)(rowp + bj * HALF) = w; } }
    }
};
struct EpiF32 {
    static constexpr bool PERM = false;
    float* C; int ldc;
    DI void operator()(const f32x4 (&acc)[2][2][4][2], const Unit& u, int wr, int wc, int fr, int fq) const {
        const int row0 = u.pm * BM + wr * 64 + fr, col0 = u.pn * BM + wc * 32 + 4 * fq;
#pragma unroll
        for (int ai = 0; ai < 2; ++ai)
#pragma unroll
            for (int m = 0; m < 4; ++m) { float* rowp = C + (size_t)(row0 + ai * HALF + m * 16) * ldc + col0;
#pragma unroll
                for (int bj = 0; bj < 2; ++bj)
#pragma unroll
                    for (int n = 0; n < 2; ++n) *(f32x4*)(rowp + bj * HALF + n * 16) = acc[ai][bj][m][n]; }
    }
};
template <bool RES_BF16>
struct EpiRes {
    static constexpr bool PERM = false;
    float* C; const void* res; int ldc;
    DI void operator()(const f32x4 (&acc)[2][2][4][2], const Unit& u, int wr, int wc, int fr, int fq) const {
        const int row0 = u.pm * BM + wr * 64 + fr, col0 = u.pn * BM + wc * 32 + 4 * fq;
#pragma unroll
        for (int ai = 0; ai < 2; ++ai)
#pragma unroll
            for (int m = 0; m < 4; ++m) { const size_t off = (size_t)(row0 + ai * HALF + m * 16) * ldc + col0;
#pragma unroll
                for (int bj = 0; bj < 2; ++bj)
#pragma unroll
                    for (int n = 0; n < 2; ++n) { f32x4 rv;
                        if (RES_BF16) { const u32x2 w = *(const u32x2*)((const bf16*)res + off + bj * HALF + n * 16); rv = (f32x4){bflo(w.x), bfhi(w.x), bflo(w.y), bfhi(w.y)}; }
                        else rv = *(const f32x4*)((const float*)res + off + bj * HALF + n * 16);
                        *(f32x4*)(C + off + bj * HALF + n * 16) = acc[ai][bj][m][n] + rv * ALPHA; }
                asm volatile("" ::: "memory"); }
    }
};
struct EpiSwiglu {
    static constexpr bool PERM = true;
    bf16* H; int ldc;
    DI void operator()(const f32x4 (&acc)[2][2][4][2], const Unit& u, int wr, int wc, int fr, int fq) const {
        const int row0 = u.pm * BM + wr * 64 + fr, col0 = u.pn * HALF + wc * 32 + 8 * fq;
#pragma unroll
        for (int ai = 0; ai < 2; ++ai)
#pragma unroll
            for (int m = 0; m < 4; ++m) { bf16* rowp = H + (size_t)(row0 + ai * HALF + m * 16) * ldc + col0;
                const f32x4 g0 = acc[ai][0][m][0], g1 = acc[ai][0][m][1], u0 = acc[ai][1][m][0], u1 = acc[ai][1][m][1];
                u32x4 w; w.x = pk2(siluf_(g0[0]) * u0[0], siluf_(g0[1]) * u0[1]); w.y = pk2(siluf_(g0[2]) * u0[2], siluf_(g0[3]) * u0[3]);
                w.z = pk2(siluf_(g1[0]) * u1[0], siluf_(g1[1]) * u1[1]); w.w = pk2(siluf_(g1[2]) * u1[2], siluf_(g1[3]) * u1[3]);
                *(u32x4*)rowp = w; asm volatile("" ::: "memory"); }
    }
};
struct EpiPool {
    static constexpr bool PERM = true;
    bf16* mrg; const bf16* proj; const float* scale;
    DI void operator()(const f32x4 (&acc)[2][2][4][2], const Unit& u, int wr, int wc, int fr, int fq) const {
        const int row0 = u.pm * BM + wr * 64 + fr, col0 = u.pn * BM + wc * 32 + 8 * fq;
#pragma unroll
        for (int bj = 0; bj < 2; ++bj) { const int c = col0 + bj * HALF; const f32x4 s0 = *(const f32x4*)(scale + c), s1 = *(const f32x4*)(scale + c + 4);
#pragma unroll
            for (int ai = 0; ai < 2; ++ai)
#pragma unroll
                for (int m = 0; m < 4; ++m) { const size_t row = (size_t)(row0 + ai * HALF + m * 16);
                    const u32x4 gv = *(const u32x4*)(proj + row * NINP + C_G + 2048 + c);
                    const f32x4 v0 = acc[ai][bj][m][0] * s0, v1 = acc[ai][bj][m][1] * s1;
                    u32x4 w; w.x = pk2(v0[0] * sigmoidf_(bflo(gv.x)), v0[1] * sigmoidf_(bfhi(gv.x))); w.y = pk2(v0[2] * sigmoidf_(bflo(gv.y)), v0[3] * sigmoidf_(bfhi(gv.y)));
                    w.z = pk2(v1[0] * sigmoidf_(bflo(gv.z)), v1[1] * sigmoidf_(bfhi(gv.z))); w.w = pk2(v1[2] * sigmoidf_(bflo(gv.w)), v1[3] * sigmoidf_(bfhi(gv.w)));
                    *(u32x4*)(mrg + row * MIXW + 2048 + c) = w; asm volatile("" ::: "memory"); } }
    }
};
struct EpiLru {
    static constexpr bool PERM = false;
    unsigned* AB; const bf16* xc; const float* ba; const float* bx; const float* c8sp;
    DI void operator()(const f32x4 (&acc)[2][2][4][2], const Unit& u, int wr, int wc, int fr, int fq) const {
        const int row0 = u.pm * BM + wr * 64 + fr, ch0 = u.pn * HALF + wc * 32 + 4 * fq;
#pragma unroll
        for (int n = 0; n < 2; ++n) { const int ch = ch0 + n * 16; const f32x4 vba = *(const f32x4*)(ba + ch), vbx = *(const f32x4*)(bx + ch), vsp = *(const f32x4*)(c8sp + ch);
#pragma unroll
            for (int ai = 0; ai < 2; ++ai)
#pragma unroll
                for (int m = 0; m < 4; ++m) { const size_t off = (size_t)(row0 + ai * HALF + m * 16) * DM + ch;
                    const u32x2 xv = *(const u32x2*)(xc + off); const float xf[4] = {bflo(xv.x), bfhi(xv.x), bflo(xv.y), bfhi(xv.y)};
                    u32x4 w;
#pragma unroll
                    for (int j = 0; j < 4; ++j) { const float r = sigmoidf_(acc[ai][0][m][n][j] + vba[j]), ig = sigmoidf_(acc[ai][1][m][n][j] + vbx[j]);
                        const float la = -vsp[j] * r; w[j] = pk2(la, __builtin_amdgcn_sqrtf(fmaxf(1.0f - __expf(2.0f * la), 0.f)) * ig * xf[j]); }
                    *(u32x4*)(AB + off) = w; asm volatile("" ::: "memory"); } }
    }
};

#ifndef PG8_ALIGN
#define PG8_ALIGN true
#endif
#ifndef PG8_SP2
#define PG8_SP2 true
#endif
template <class Epi, class Sched, bool ALIGN_EPI = PG8_ALIGN, bool SP2 = PG8_SP2>
DI void gemm_phase(LAS unsigned char* lds, const Gemm g, const Sched& S, const Epi& E, const int wave_id) {
    int lane_ = lane_id_(); asm volatile("" : "+v"(lane_));
    const int wid = wave_id, lane = lane_, tid = wid * 64 + lane, wr = wid >> 2, wc = wid & 3, fr = lane & 15, fq = lane >> 4;
    const int nt = g.K / BK;
    unsigned voffA[2], voffB[2];
#pragma unroll
    for (int i = 0; i < 2; ++i) { int R, C; stage_rc(tid * 16 + i * 8192, R, C); const int Rb = Epi::PERM ? ((R & ~31) + perm32(R & 31)) : R;
        voffA[i] = (unsigned)(R * g.lda + C) * 2u; voffB[i] = (unsigned)(Rb * g.ldb + C) * 2u; }
    const size_t kstep = (size_t)(BK * 2);
    const size_t hstepA = (size_t)HALF * g.lda * 2, hstepB = (size_t)HALF * g.ldb * 2;
    const unsigned ldsw = (unsigned)wid * 1024u;
    const int aoff = lds_byte(wr * 64 + fr, fq * 8), boff = lds_byte(wc * 32 + fr, fq * 8);
#define PG8_SA(b, h) (((b) * 2 + (h)) * HTB)
#define PG8_SB(b, h) ((4 + (b) * 2 + (h)) * HTB)
#define PG8_STAGE(bufoff, gbase, voff) do { _Pragma("unroll") for (int _i = 0; _i < 2; ++_i) \
        __builtin_amdgcn_global_load_lds((const unsigned*)((const char*)(gbase) + (voff)[_i]), (LAS unsigned*)(lds + (bufoff) + ldsw + _i * 8192), 16, 0, 0); } while (0)
#define PG8_LDA(dst, b, h) do { _Pragma("unroll") for (int m = 0; m < 4; ++m) _Pragma("unroll") for (int k = 0; k < 2; ++k) dst[m][k] = *(const LAS bf16x8*)(lds + PG8_SA(b, h) + aoff + m * 2048 + k * 1024); } while (0)
#define PG8_LDB(dst, b, h) do { _Pragma("unroll") for (int n = 0; n < 2; ++n) _Pragma("unroll") for (int k = 0; k < 2; ++k) dst[n][k] = *(const LAS bf16x8*)(lds + PG8_SB(b, h) + boff + n * 2048 + k * 1024); } while (0)
#define PG8_MMA(ai, bj, At, Bt) do { __builtin_amdgcn_s_setprio(1); _Pragma("unroll") for (int m = 0; m < 4; ++m) _Pragma("unroll") for (int n = 0; n < 2; ++n) _Pragma("unroll") for (int k = 0; k < 2; ++k) \
        acc[ai][bj][m][n] = __builtin_amdgcn_mfma_f32_16x16x32_bf16(Bt[n][k], At[m][k], acc[ai][bj][m][n], 0, 0, 0); __builtin_amdgcn_s_setprio(0); } while (0)
#define PG8_WAIT_V(n) asm volatile("s_waitcnt vmcnt(" #n ")" ::: "memory")
#define PG8_WAIT_L(n) asm volatile("s_waitcnt lgkmcnt(" #n ")" ::: "memory")
#define PG8_BAR __builtin_amdgcn_s_barrier()
#define PG8_SCHED __builtin_amdgcn_sched_barrier(0)
    Unit cur, nxt; int ui = 0;
    if (!S.next(0, cur)) return;
    f32x4 acc[2][2][4][2];
#pragma unroll
    for (int a = 0; a < 2; ++a)
#pragma unroll
        for (int b = 0; b < 2; ++b)
#pragma unroll
            for (int m = 0; m < 4; ++m)
#pragma unroll
                for (int n = 0; n < 2; ++n) acc[a][b][m][n] = (f32x4){0.f, 0.f, 0.f, 0.f};
    bf16x8 At[4][2], B0[2][2], B1[2][2];
    const char* cA = (const char*)g.A + S.aoff(cur); const char* cB = (const char*)g.Bt + S.boff(cur);
    if constexpr (SP2) {
        PG8_STAGE(PG8_SB(0, 0), cB, voffB); PG8_STAGE(PG8_SB(0, 1), cB + hstepB, voffB); PG8_STAGE(PG8_SA(0, 0), cA, voffA); PG8_STAGE(PG8_SA(0, 1), cA + hstepA, voffA);
        if (wr == 1) PG8_BAR;
        PG8_WAIT_V(2); PG8_BAR;
        PG8_STAGE(PG8_SB(1, 0), cB + kstep, voffB); PG8_STAGE(PG8_SA(1, 0), cA + kstep, voffA); PG8_STAGE(PG8_SB(1, 1), cB + hstepB + kstep, voffB);
        PG8_WAIT_V(6); PG8_BAR;
    } else {
        PG8_STAGE(PG8_SB(0, 0), cB, voffB); PG8_STAGE(PG8_SA(0, 0), cA, voffA); PG8_STAGE(PG8_SB(0, 1), cB + hstepB, voffB); PG8_STAGE(PG8_SA(0, 1), cA + hstepA, voffA);
        if (wr == 1) PG8_BAR;
        PG8_WAIT_V(4); PG8_BAR;
        PG8_STAGE(PG8_SB(1, 0), cB + kstep, voffB); PG8_STAGE(PG8_SA(1, 0), cA + kstep, voffA); PG8_STAGE(PG8_SB(1, 1), cB + hstepB + kstep, voffB);
        PG8_WAIT_V(6); PG8_BAR;
    }
    for (;;) {
        const bool has_next = S.next(ui + 1, nxt);
        const char* nA = has_next ? (const char*)g.A + S.aoff(nxt) : cA; const char* nB = has_next ? (const char*)g.Bt + S.boff(nxt) : cB;
#pragma nounroll
        for (int t = 0; t < nt; t += 2) {
            const bool last = (t == nt - 2);
            const char* a1 = cA + (size_t)(t + 1) * kstep;
            const char* a2 = last ? nA : cA + (size_t)(t + 2) * kstep; const char* b2 = last ? nB : cB + (size_t)(t + 2) * kstep;
            const char* a3 = a2 + kstep; const char* b3 = b2 + kstep;
            if constexpr (SP2) {
            PG8_LDB(B0, 0, 0); PG8_LDB(B1, 0, 1); PG8_SCHED; PG8_LDA(At, 0, 0); PG8_STAGE(PG8_SA(1, 1), a1 + hstepA, voffA);
            PG8_WAIT_V(8); PG8_WAIT_L(0); PG8_BAR; PG8_MMA(0, 0, At, B0); PG8_MMA(0, 1, At, B1); PG8_BAR; PG8_SCHED;
            PG8_LDA(At, 0, 1); PG8_STAGE(PG8_SB(0, 0), b2, voffB); PG8_STAGE(PG8_SB(0, 1), b2 + hstepB, voffB); PG8_STAGE(PG8_SA(0, 0), a2, voffA);
            PG8_WAIT_V(8); PG8_WAIT_L(0); PG8_BAR; PG8_MMA(1, 0, At, B0); PG8_MMA(1, 1, At, B1); PG8_BAR; PG8_SCHED;
            PG8_LDB(B0, 1, 0); PG8_LDB(B1, 1, 1); PG8_SCHED; PG8_LDA(At, 1, 0); PG8_STAGE(PG8_SA(0, 1), a2 + hstepA, voffA);
            PG8_WAIT_V(8); PG8_WAIT_L(0); PG8_BAR; PG8_MMA(0, 0, At, B0); PG8_MMA(0, 1, At, B1); PG8_BAR; PG8_SCHED;
            PG8_LDA(At, 1, 1); PG8_STAGE(PG8_SB(1, 0), b3, voffB); PG8_STAGE(PG8_SB(1, 1), b3 + hstepB, voffB); PG8_STAGE(PG8_SA(1, 0), a3, voffA);
            PG8_WAIT_V(8); PG8_WAIT_L(0); PG8_BAR; PG8_MMA(1, 0, At, B0); PG8_MMA(1, 1, At, B1); PG8_BAR; PG8_SCHED;
            } else {
            PG8_LDB(B0, 0, 0); PG8_SCHED; PG8_LDA(At, 0, 0); PG8_STAGE(PG8_SA(1, 1), a1 + hstepA, voffA);
            PG8_WAIT_L(8); PG8_BAR; PG8_WAIT_L(0); PG8_MMA(0, 0, At, B0); PG8_BAR; PG8_SCHED;
            PG8_LDB(B1, 0, 1); PG8_STAGE(PG8_SB(0, 0), b2, voffB);
            PG8_BAR; PG8_WAIT_L(0); PG8_MMA(0, 1, At, B1); PG8_BAR;
            PG8_LDA(At, 0, 1); PG8_STAGE(PG8_SA(0, 0), a2, voffA);
            PG8_BAR; PG8_WAIT_L(0); PG8_MMA(1, 0, At, B0); PG8_BAR; PG8_SCHED;
            PG8_STAGE(PG8_SB(0, 1), b2 + hstepB, voffB);
            PG8_WAIT_V(6); PG8_BAR; PG8_MMA(1, 1, At, B1); PG8_BAR;
            PG8_LDB(B0, 1, 0); PG8_SCHED; PG8_LDA(At, 1, 0); PG8_STAGE(PG8_SA(0, 1), a2 + hstepA, voffA);
            PG8_WAIT_L(8); PG8_BAR; PG8_WAIT_L(0); PG8_MMA(0, 0, At, B0); PG8_BAR; PG8_SCHED;
            PG8_LDB(B1, 1, 1); PG8_STAGE(PG8_SB(1, 0), b3, voffB);
            PG8_BAR; PG8_WAIT_L(0); PG8_MMA(0, 1, At, B1); PG8_BAR;
            PG8_LDA(At, 1, 1); PG8_STAGE(PG8_SA(1, 0), a3, voffA);
            PG8_BAR; PG8_WAIT_L(0); PG8_MMA(1, 0, At, B0); PG8_BAR; PG8_SCHED;
            PG8_STAGE(PG8_SB(1, 1), b3 + hstepB, voffB);
            PG8_WAIT_V(6); PG8_BAR; PG8_MMA(1, 1, At, B1); PG8_BAR;
            }
        }
        if constexpr (ALIGN_EPI) { if (wr == 0) PG8_BAR; }
        E(acc, cur, wr, wc, fr, fq);
        if (!has_next) break;
#pragma unroll
        for (int a = 0; a < 2; ++a)
#pragma unroll
            for (int b = 0; b < 2; ++b)
#pragma unroll
                for (int m = 0; m < 4; ++m)
#pragma unroll
                    for (int n = 0; n < 2; ++n) acc[a][b][m][n] = (f32x4){0.f, 0.f, 0.f, 0.f};
        cur = nxt; cA = nA; cB = nB; ++ui;
        if constexpr (ALIGN_EPI) { if (wr == 1) PG8_BAR; }
    }
    PG8_WAIT_V(0);
    if constexpr (!ALIGN_EPI) { if (wr == 0) PG8_BAR; }
    PG8_BAR;
#undef PG8_SA
#undef PG8_SB
#undef PG8_STAGE
#undef PG8_LDA
#undef PG8_LDB
#undef PG8_MMA
#undef PG8_WAIT_V
#undef PG8_WAIT_L
#undef PG8_BAR
#undef PG8_SCHED
}
}

struct Args { const void* in[24]; float* out; unsigned char* ws; int ph_lo, ph_hi; };
struct Frame {
    LAS unsigned char* lds; unsigned* ctl; unsigned char* ws;
    int tid, lane, wave, G, bid;
};
#define INF(k) ((const float*)args.in[k])
DI float wave_sum(float v) {
#pragma unroll
    for (int o = 1; o < 64; o <<= 1) v += __shfl_xor(v, o);
    return v;
}

DI void tr_item(const float* W, int ldS, int Nvalid, bf16* WT, int ldD, int koff, int mode, int roff, LAS float* scr, int k0, int n0, int lane) {
    const int nl = n0 + (lane & 31);
    float tv[32]; const float* wp = W + (size_t)(k0 + (lane >> 5)) * ldS + nl; const bool ok = nl < Nvalid;
#pragma unroll
    for (int i = 0; i < 32; ++i) tv[i] = ok ? __builtin_nontemporal_load(wp + (size_t)(2 * i) * ldS) : 0.f;
#pragma unroll
    for (int i = 0; i < 32; ++i) scr[(2 * i + (lane >> 5)) * 33 + (lane & 31)] = tv[i];
    LDS_WAIT(); asm volatile("" ::: "memory");
    const int c = lane & 7;
#pragma unroll
    for (int j = 0; j < 4; ++j) { const int nn = (lane >> 3) + 8 * j, n = n0 + nn; const LAS float* s = scr + (8 * c) * 33 + nn;
        u32x4 o; o.x = pk2(s[0 * 33], s[1 * 33]); o.y = pk2(s[2 * 33], s[3 * 33]); o.z = pk2(s[4 * 33], s[5 * 33]); o.w = pk2(s[6 * 33], s[7 * 33]);
        const int row = mode == 0 ? roff + n : (mode == 1 ? (n < C_PADLO ? n : n + (C_P - C_PADLO)) : ((n >> 7) << 8) + roff + (n & 127));
        if (n < Nvalid) *(u32x4*)(WT + (size_t)row * ldD + koff + k0 + 8 * c) = o; }
    LDS_WAIT(); asm volatile("" ::: "memory");
}
constexpr int NB_IN = (NIN + 31) / 32;
constexpr int CI_IN = 32 * NB_IN, CI_OUT = 96 * 64, CI_POOL = 8 * 8 * 16, CI_LRU = 64 * 8, CI_GU = 2 * 32 * 172, CI_DN = 86 * 64, CI_MGU = 16 * 32 * 224, CI_MDN = 8 * 112 * 64;
constexpr int CE_0 = CI_IN + CI_POOL + CI_LRU;
constexpr int CE_1 = CE_0 + CI_OUT;
constexpr int CE_2 = CE_1 + CI_GU;
constexpr int CE_3 = CE_2 + CI_DN;
constexpr int CE_4 = CE_3 + CI_IN;
constexpr int CE_5 = CE_4 + CI_OUT;
constexpr int CE_6 = CE_5 + CI_MGU;
constexpr int CE_7 = CE_6 + CI_MDN;
constexpr int MOE_EARLY = 224 * 8 * 14;
constexpr int P2_ITEMS = 224 * 8 * 4;
DI void conv_item(unsigned char* ws, const Args& args, int idx, LAS float* scr, int lane) {
    const float* W; bf16* WT; int ldS, Nv, ldD, koff = 0, mode = 0, roff = 0, kb, nb; int r = idx;
    if (r < CI_IN) { kb = r / NB_IN; nb = r % NB_IN; W = INF(2); ldS = NIN; Nv = NIN; WT = (bf16*)(ws + WS_WIN); ldD = DM; mode = 1; }
    else if ((r -= CI_IN) < CI_POOL) { const int lg = r >> 7, q = r & 127; kb = q >> 4; nb = q & 15; W = INF(4) + (size_t)lg * 512 * 512; ldS = 512; Nv = 512; WT = (bf16*)(ws + WS_WPOOL) + (size_t)(lg >> 2) * 2048 * 512; ldD = 512; roff = (lg & 3) * 512; }
    else if ((r -= CI_POOL) < CI_LRU) { const int cmb = r >> 3, q = r & 7, l = cmb >> 5, which = (cmb >> 4) & 1, n = cmb & 15; kb = q >> 2; nb = q & 3;
        W = (which ? INF(10) : INF(8)) + ((size_t)l * 16 + n) * 128 * 128; ldS = 128; Nv = 128; WT = (bf16*)(ws + WS_WLRU) + (size_t)l * 4096 * 256; ldD = 256; koff = (n & 1) * 128; roff = n * 256 + which * 128; }
    else if ((r -= CI_LRU) < CI_OUT) { kb = r >> 6; nb = r & 63; W = INF(3); ldS = DM; Nv = DM; WT = (bf16*)(ws + WS_WOUT); ldD = MIXW; }
    else if ((r -= CI_OUT) < CI_GU) { const int which = r / (32 * 172), q = r % (32 * 172); kb = q / 172; nb = q % 172; W = which ? INF(18) : INF(17); ldS = DFF; Nv = DFF; WT = (bf16*)(ws + WS_WGU); ldD = DM; mode = 2; roff = which * 128; }
    else if ((r -= CI_GU) < CI_DN) { kb = r >> 6; nb = r & 63; W = INF(19); ldS = DM; Nv = DM; WT = (bf16*)(ws + WS_WDN); ldD = DFF; }
    else if ((r -= CI_DN) < CI_IN) { kb = r / NB_IN; nb = r % NB_IN; W = INF(2) + (size_t)DM * NIN; ldS = NIN; Nv = NIN; WT = (bf16*)(ws + WS_WIN) + (size_t)NINP * DM; ldD = DM; mode = 1; }
    else if ((r -= CI_IN) < CI_OUT) { kb = r >> 6; nb = r & 63; W = INF(3) + (size_t)MIXW * DM; ldS = DM; Nv = DM; WT = (bf16*)(ws + WS_WOUT) + (size_t)DM * MIXW; ldD = MIXW; }
    else if ((r -= CI_OUT) < CI_MGU) { const int ew = r / (32 * 224), q = r % (32 * 224), e = ew >> 1, which = ew & 1; kb = q / 224; nb = q % 224;
        W = (which ? INF(22) : INF(21)) + (size_t)e * DM * DEXP; ldS = DEXP; Nv = DEXP; WT = (bf16*)(ws + WS_MWGU) + (size_t)e * 2 * DEXP * DM; ldD = DM; mode = 2; roff = which * 128; }
    else { r -= CI_MGU; const int e = r / (112 * 64), q = r % (112 * 64); kb = q >> 6; nb = q & 63; W = INF(23) + (size_t)e * DEXP * DM; ldS = DM; Nv = DM; WT = (bf16*)(ws + WS_MWDN) + (size_t)e * DM * DEXP; ldD = DEXP; }
    tr_item(W, ldS, Nv, WT, ldD, koff, mode, roff, scr, 64 * kb, 32 * nb, lane);
}
DI void conv_range(Frame& F, const Args& args, int i0, int i1, int wg0) {
    if (F.bid < wg0) return;
    LAS float* scr = (LAS float*)(F.lds + F.wave * 16384);
    const int gw = (F.bid - wg0) * 8 + F.wave, NGW = (F.G - wg0) * 8;
    for (int it = i0 + gw; it < i1; it += NGW) conv_item(F.ws, args, it, scr, F.lane);
}
DI void p0_prologue(Frame& F, const Args& args) {
    conv_range(F, args, 0, CE_0, 0);
    bf16* Wlru = (bf16*)(F.ws + WS_WLRU);
    const int gt = F.bid * 512 + F.tid, NT = F.G * 512;
    for (int i = gt; i < 2 * 4096 * 16; i += NT) { const int row = i >> 4, ch = i & 15, n = (row & 4095) >> 8;
        *(u32x4*)(Wlru + (size_t)row * 256 + ((n + 1) & 1) * 128 + ch * 8) = (u32x4){0u, 0u, 0u, 0u}; }
    float* cosA = (float*)(F.ws + WS_COSA); float* sinA = (float*)(F.ws + WS_SINA); float* cosI = (float*)(F.ws + WS_COSI); float* sinI = (float*)(F.ws + WS_SINI);
    for (int i = gt; i < MTOK * 96; i += NT) {
        const int tok = i / 96, j = i % 96; const bool isA = j < 64; const int fi = isA ? j : j - 64; const double dim = isA ? 128.0 : 64.0;
        const float inv = (float)pow(10000.0, -(double)(2 * fi) / dim);
        const float ang = (float)((const int*)args.in[1])[tok] * inv; const double a = (double)ang; const double nrev = rint(a * 0.15915494309189535); const double rr = a - nrev * 6.283185307179586;
        const float cv = (float)cos(rr), sv = (float)sin(rr);
        if (isA) { cosA[tok * 64 + fi] = cv; sinA[tok * 64 + fi] = sv; } else { cosI[tok * 32 + fi] = cv; sinI[tok * 32 + fi] = sv; }
    }
    float* c8 = (float*)(F.ws + WS_LRUC);
    for (int i = gt; i < 2 * DM; i += NT) { const float lam = INF(12)[i]; c8[i] = 8.0f * log1pf(expf(-lam)); }
    bf16* xb = (bf16*)(F.ws + WS_XB);
    for (int i = gt; i < MTOK * DM / 8; i += NT) { const f32x4 a = *(const f32x4*)(INF(0) + (size_t)i * 8), b = *(const f32x4*)(INF(0) + (size_t)i * 8 + 4);
        u32x4 o; o.x = pk2(a[0], a[1]); o.y = pk2(a[2], a[3]); o.z = pk2(b[0], b[1]); o.w = pk2(b[2], b[3]); *(u32x4*)(xb + (size_t)i * 8) = o; }
}

DI void ld8(const bf16* p, float (&v)[8]) { const u32x4 w = *(const u32x4*)p; v[0] = bflo(w.x); v[1] = bfhi(w.x); v[2] = bflo(w.y); v[3] = bfhi(w.y); v[4] = bflo(w.z); v[5] = bfhi(w.z); v[6] = bflo(w.w); v[7] = bfhi(w.w); }
DI void st8(bf16* p, const float (&v)[8]) { u32x4 o; o.x = pk2(v[0], v[1]); o.y = pk2(v[2], v[3]); o.z = pk2(v[4], v[5]); o.w = pk2(v[6], v[7]); *(u32x4*)p = o; }

DI void acc8(float (&s)[8], const u32x4& r, float m) { s[0] += m * bflo(r.x); s[1] += m * bfhi(r.x); s[2] += m * bflo(r.y); s[3] += m * bfhi(r.y); s[4] += m * bflo(r.z); s[5] += m * bfhi(r.z); s[6] += m * bflo(r.w); s[7] += m * bfhi(r.w); }
template <int G>
DI void pool_range(const bf16* proj, bf16* diff, int tok0, int c) {
    constexpr int W = 2 << G, NR = W - 1 + 16;
    const int tpos0 = tok0 & (SEQ - 1);
    const bf16* pp = proj + (size_t)tok0 * NINP + C_P + c;
    u32x4 r[NR];
#pragma unroll
    for (int i = 0; i < NR; ++i) { const int back = (W - 1) - i; r[i] = *(const u32x4*)(pp - (ptrdiff_t)((back > 0 && tpos0 - back < 0) ? 0 : back) * NINP); }
    float s[8];
#pragma unroll
    for (int k = 0; k < 8; ++k) s[k] = 0.f;
#pragma unroll
    for (int i = 0; i < W - 1; ++i) acc8(s, r[i], (tpos0 - ((W - 1) - i) >= 0) ? 1.f : 0.f);
#pragma unroll
    for (int t = 0; t < 16; ++t) {
        acc8(s, r[W - 1 + t], 1.f);
        const int tpos = tpos0 + t, cnt = (tpos + 1) < W ? (tpos + 1) : W; const float rc = 1.0f / (float)cnt; const u32x4 cur = r[W - 1 + t];
        float v[8] = {s[0] * rc - bflo(cur.x), s[1] * rc - bfhi(cur.x), s[2] * rc - bflo(cur.y), s[3] * rc - bfhi(cur.y), s[4] * rc - bflo(cur.z), s[5] * rc - bfhi(cur.z), s[6] * rc - bflo(cur.w), s[7] * rc - bfhi(cur.w)};
        st8(diff + (size_t)(tok0 + t) * DM + c, v);
        acc8(s, r[t], (tpos - (W - 1) >= 0) ? -1.f : 0.f);
    }
}
DI void p2_prep(Frame& F, const Args& args, int layer) {
    bf16* proj = (bf16*)(F.ws + WS_PROJ); bf16* diff = (bf16*)(F.ws + WS_DIFF); bf16* xc = (bf16*)(F.ws + WS_XC);
    const float* cosA = (const float*)(F.ws + WS_COSA); const float* sinA = (const float*)(F.ws + WS_SINA); const float* cosI = (const float*)(F.ws + WS_COSI); const float* sinI = (const float*)(F.ws + WS_SINI);
    const int gt = F.bid * 512 + F.tid, NT = F.G * 512;
    for (int it = gt; it < MTOK * 32; it += NT) {
        const int tok = it >> 5, dch = it & 7, hq = (it >> 3) & 3, d = dch * 8;
        const float* ct = cosA + tok * 64 + d; const float* st = sinA + tok * 64 + d;
        const f32x4 c0 = *(const f32x4*)ct, c1 = *(const f32x4*)(ct + 4), s0 = *(const f32x4*)st, s1 = *(const f32x4*)(st + 4);
        bf16* base = proj + (size_t)tok * NINP;
        u32x4 xa[5], xb_[5];
#pragma unroll
        for (int q = 0; q < 5; ++q) { bf16* p1 = base + (q < 4 ? C_Q + (hq * 4 + q) * 128 : C_K + hq * 128) + d; xa[q] = *(const u32x4*)p1; xb_[q] = *(const u32x4*)(p1 + 64); }
#pragma unroll
        for (int q = 0; q < 5; ++q) { bf16* p1 = base + (q < 4 ? C_Q + (hq * 4 + q) * 128 : C_K + hq * 128) + d;
            const float x1[8] = {bflo(xa[q].x), bfhi(xa[q].x), bflo(xa[q].y), bfhi(xa[q].y), bflo(xa[q].z), bfhi(xa[q].z), bflo(xa[q].w), bfhi(xa[q].w)};
            const float x2[8] = {bflo(xb_[q].x), bfhi(xb_[q].x), bflo(xb_[q].y), bfhi(xb_[q].y), bflo(xb_[q].z), bfhi(xb_[q].z), bflo(xb_[q].w), bfhi(xb_[q].w)};
            float y1[8], y2[8];
#pragma unroll
            for (int i = 0; i < 8; ++i) { const float c = i < 4 ? c0[i & 3] : c1[i & 3], s = i < 4 ? s0[i & 3] : s1[i & 3]; y1[i] = x1[i] * c - x2[i] * s; y2[i] = x2[i] * c + x1[i] * s; }
            st8(p1, y1); st8(p1 + 64, y2); }
    }
    for (int it = gt; it < MTOK * 16; it += NT) {
        const int tok = it >> 4, dch = it & 3, hq = (it >> 2) & 3, d = dch * 8;
        const float* ct = cosI + tok * 32 + d; const float* st = sinI + tok * 32 + d;
        const f32x4 c0 = *(const f32x4*)ct, c1 = *(const f32x4*)(ct + 4), s0 = *(const f32x4*)st, s1 = *(const f32x4*)(st + 4);
        bf16* base = proj + (size_t)tok * NINP;
        u32x4 xa[5], xb_[5];
#pragma unroll
        for (int q = 0; q < 5; ++q) { bf16* p1 = base + (q < 4 ? C_QI + (hq * 4 + q) * 64 : C_KI) + d; xa[q] = *(const u32x4*)p1; xb_[q] = *(const u32x4*)(p1 + 32); }
#pragma unroll
        for (int q = 0; q < 5; ++q) { if (q < 4 || hq == 0) { bf16* p1 = base + (q < 4 ? C_QI + (hq * 4 + q) * 64 : C_KI) + d;
            const float x1[8] = {bflo(xa[q].x), bfhi(xa[q].x), bflo(xa[q].y), bfhi(xa[q].y), bflo(xa[q].z), bfhi(xa[q].z), bflo(xa[q].w), bfhi(xa[q].w)};
            const float x2[8] = {bflo(xb_[q].x), bfhi(xb_[q].x), bflo(xb_[q].y), bfhi(xb_[q].y), bflo(xb_[q].z), bfhi(xb_[q].z), bflo(xb_[q].w), bfhi(xb_[q].w)};
            float y1[8], y2[8];
#pragma unroll
            for (int i = 0; i < 8; ++i) { const float c = i < 4 ? c0[i & 3] : c1[i & 3], s = i < 4 ? s0[i & 3] : s1[i & 3]; y1[i] = x1[i] * c - x2[i] * s; y2[i] = x2[i] * c + x1[i] * s; }
            st8(p1, y1); st8(p1 + 32, y2); } }
    }
    const float* cw = INF(6) + (size_t)layer * 4 * DM; const float* cb = INF(7) + (size_t)layer * DM;
    for (int it = gt; it < (MTOK / 16) * 256; it += NT) {
        const int cg = it & 255, c = cg * 8, tok0 = (it >> 8) * 16;
        const int g = cg >> 6;
        if (g == 0) pool_range<0>(proj, diff, tok0, c); else if (g == 1) pool_range<1>(proj, diff, tok0, c); else if (g == 2) pool_range<2>(proj, diff, tok0, c); else pool_range<3>(proj, diff, tok0, c);
    }
    for (int it = gt; it < (MTOK / 16) * 256; it += NT) {
        const int cg = it & 255, c = cg * 8, tok0 = (it >> 8) * 16, tpos0 = tok0 & (SEQ - 1);
        const bf16* px = proj + (size_t)tok0 * NINP + C_XR + c;
        u32x4 r[19];
#pragma unroll
        for (int i = 0; i < 19; ++i) { const int back = 3 - i; r[i] = *(const u32x4*)(px - (ptrdiff_t)((back > 0 && tpos0 - back < 0) ? 0 : back) * NINP); }
        f32x4 w0[4], w1[4]; const f32x4 b0 = *(const f32x4*)(cb + c), b1 = *(const f32x4*)(cb + c + 4);
#pragma unroll
        for (int jj = 0; jj < 4; ++jj) { w0[jj] = *(const f32x4*)(cw + jj * DM + c); w1[jj] = *(const f32x4*)(cw + jj * DM + c + 4); }
#pragma unroll
        for (int t = 0; t < 16; ++t) {
            float acc[8] = {b0[0], b0[1], b0[2], b0[3], b1[0], b1[1], b1[2], b1[3]};
#pragma unroll
            for (int jj = 0; jj < 4; ++jj) { const float m = (tpos0 + t - (3 - jj) >= 0) ? 1.f : 0.f; const u32x4 x = r[t + jj];
                acc[0] += m * bflo(x.x) * w0[jj][0]; acc[1] += m * bfhi(x.x) * w0[jj][1]; acc[2] += m * bflo(x.y) * w0[jj][2]; acc[3] += m * bfhi(x.y) * w0[jj][3];
                acc[4] += m * bflo(x.z) * w1[jj][0]; acc[5] += m * bfhi(x.z) * w1[jj][1]; acc[6] += m * bflo(x.w) * w1[jj][2]; acc[7] += m * bfhi(x.w) * w1[jj][3]; }
            st8(xc + (size_t)(tok0 + t) * DM + c, acc);
        }
    }
}

DI void p3_indexer(Frame& F) {
    const bf16* proj = (const bf16*)(F.ws + WS_PROJ); float* sc = (float*)(F.ws + WS_SC);
    const int gw = F.bid * 8 + F.wave, NGW = F.G * 8, l15 = F.lane & 15, l4 = F.lane >> 4;
    for (int u = gw; u < BATCH * 576; u += NGW) {
        const int b = u / 576, r = u % 576; int g8 = 0;
#pragma unroll
        for (int k = 1; k < 8; ++k) g8 = (r >= 8 * k * (k + 1)) ? k : g8;
        const int rr = r - 8 * g8 * (g8 + 1), sp = rr % (g8 + 1), qq = rr / (g8 + 1), qb16 = g8 * 16 + qq, c = qb16 >> 2;
        const int limit = (c + 1) * 64, kbeg = sp * 256, kend = (kbeg + 256) < limit ? (kbeg + 256) : limit;
        const int qtok = b * SEQ + qb16 * 16 + l15;
        const bf16* qrow = proj + (size_t)qtok * NINP;
        bf16x8 qf[16][2]; float w[16];
        { const u32x4 w0 = *(const u32x4*)(qrow + C_WI), w1 = *(const u32x4*)(qrow + C_WI + 8); const float s = 0.125f * 0.25f;
          w[0] = bflo(w0.x) * s; w[1] = bfhi(w0.x) * s; w[2] = bflo(w0.y) * s; w[3] = bfhi(w0.y) * s; w[4] = bflo(w0.z) * s; w[5] = bfhi(w0.z) * s; w[6] = bflo(w0.w) * s; w[7] = bfhi(w0.w) * s;
          w[8] = bflo(w1.x) * s; w[9] = bfhi(w1.x) * s; w[10] = bflo(w1.y) * s; w[11] = bfhi(w1.y) * s; w[12] = bflo(w1.z) * s; w[13] = bfhi(w1.z) * s; w[14] = bflo(w1.w) * s; w[15] = bfhi(w1.w) * s; }
#pragma unroll
        for (int h = 0; h < 16; ++h)
#pragma unroll
            for (int ks = 0; ks < 2; ++ks) qf[h][ks] = *(const bf16x8*)(qrow + C_QI + h * 64 + ks * 32 + l4 * 8);
        const bf16* kbase = proj + (size_t)(b * SEQ + l15) * NINP + C_KI + l4 * 8;
        bf16x8 nk0 = *(const bf16x8*)(kbase + (size_t)kbeg * NINP), nk1 = *(const bf16x8*)(kbase + (size_t)kbeg * NINP + 32);
        for (int k0 = kbeg; k0 < kend; k0 += 16) {
            const bf16x8 ka0 = nk0, ka1 = nk1;
            { const int kn = (k0 + 16 < kend) ? k0 + 16 : k0; nk0 = *(const bf16x8*)(kbase + (size_t)kn * NINP); nk1 = *(const bf16x8*)(kbase + (size_t)kn * NINP + 32); }
            f32x4 tot = {0.f, 0.f, 0.f, 0.f};
#pragma unroll
            for (int h = 0; h < 16; ++h) { f32x4 s = {0.f, 0.f, 0.f, 0.f};
                s = __builtin_amdgcn_mfma_f32_16x16x32_bf16(ka0, qf[h][0], s, 0, 0, 0); s = __builtin_amdgcn_mfma_f32_16x16x32_bf16(ka1, qf[h][1], s, 0, 0, 0);
#pragma unroll
                for (int j = 0; j < 4; ++j) tot[j] += w[h] * fmaxf(s[j], 0.f); }
            *(f32x4*)(sc + (size_t)qtok * SEQ + k0 + 4 * l4) = tot;
        }
    }
}

DI void p4_select(Frame& F) {
    const float* sc = (const float*)(F.ws + WS_SC); unsigned* mask = (unsigned*)(F.ws + WS_MASK);
    const int gw = F.bid * 8 + F.wave, NGW = F.G * 8, lane = F.lane;
    for (int tok = gw; tok < MTOK; tok += NGW) {
        const int tpos = tok & (SEQ - 1), limit = ((tpos >> 6) + 1) * 64, nw = limit >> 5;
        unsigned mw = 0u;
        if (limit <= 256) { mw = lane < nw ? 0xffffffffu : 0u; }
        else {
            unsigned key[32];
            if (lane < nw) { const float* p = sc + (size_t)tok * SEQ + lane * 32;
#pragma unroll
                for (int q = 0; q < 8; ++q) { const f32x4 v = *(const f32x4*)(p + 4 * q);
#pragma unroll
                    for (int j = 0; j < 4; ++j) { const unsigned uu = __float_as_uint(v[j]); key[4 * q + j] = (uu & 0x80000000u) ? ~uu : (uu | 0x80000000u); } } }
            else {
#pragma unroll
                for (int j = 0; j < 32; ++j) key[j] = 0u; }
            unsigned T = 0u; bool exact = false;
            for (int bit = 31; bit >= 0; --bit) {
                const unsigned cand = T | (1u << bit); int cnt = 0;
#pragma unroll
                for (int j = 0; j < 32; ++j) cnt += __popcll(__ballot(key[j] >= cand));
                if (cnt >= 256) { T = cand; if (cnt == 256) { exact = true; break; } }
            }
            unsigned gtw = 0u, eqw = 0u;
#pragma unroll
            for (int j = 0; j < 32; ++j) { gtw |= (key[j] > T) ? (1u << j) : 0u; eqw |= (key[j] == T) ? (1u << j) : 0u; }
            if (exact) { mw = gtw | eqw; }
            else {
                int ngt = 0;
#pragma unroll
                for (int j = 0; j < 32; ++j) ngt += __popcll(__ballot(key[j] > T));
                const int need = 256 - ngt; const int el = __popc(eqw);
                int pre = el;
#pragma unroll
                for (int o = 1; o < 64; o <<= 1) { const int t = __shfl_up(pre, o); pre += (lane >= o) ? t : 0; }
                int take = need - (pre - el); take = take < 0 ? 0 : (take > el ? el : take);
                unsigned sel = 0u, rem = eqw;
                for (int t = 0; t < 32; ++t) { if (t < take) { const unsigned low = rem & (0u - rem); sel |= low; rem ^= low; } }
                mw = gtw | sel;
            }
        }
        mask[(size_t)tok * 64 + lane] = mw;
    }
}

DI void p4_lru_pass1(Frame& F) {
    const unsigned* AB = (const unsigned*)(F.ws + WS_A); float* CP = (float*)(F.ws + WS_CARRY); float* CH = CP + BATCH * 64 * DM;
    for (int u = F.bid; u < BATCH * 64; u += F.G) {
        const int j = u & 63, b = u >> 6, c = 4 * F.tid;
        const size_t base = ((size_t)b * SEQ + j * 32) * DM + c;
        u32x4 w[32];
#pragma unroll
        for (int t = 0; t < 32; ++t) w[t] = *(const u32x4*)(AB + base + (size_t)t * DM);
        f32x4 P = {1.f, 1.f, 1.f, 1.f}, H = {0.f, 0.f, 0.f, 0.f};
#pragma unroll
        for (int t = 0; t < 32; ++t) { const f32x4 a = {__expf(bflo(w[t].x)), __expf(bflo(w[t].y)), __expf(bflo(w[t].z)), __expf(bflo(w[t].w))}, bb = {bfhi(w[t].x), bfhi(w[t].y), bfhi(w[t].z), bfhi(w[t].w)};
            H = a * H + bb; P = P * a; }
        *(f32x4*)(CP + ((size_t)b * 64 + j) * DM + c) = P; *(f32x4*)(CH + ((size_t)b * 64 + j) * DM + c) = H;
    }
}
DI void p5_lru_pass2(Frame& F) {
    const unsigned* AB = (const unsigned*)(F.ws + WS_A); const float* CP = (const float*)(F.ws + WS_CARRY); const float* CH = CP + BATCH * 64 * DM;
    const bf16* proj = (const bf16*)(F.ws + WS_PROJ); bf16* mrg = (bf16*)(F.ws + WS_MRG);
    for (int u = F.bid; u < BATCH * 64; u += F.G) {
        const int j = u & 63, b = u >> 6, c = 4 * F.tid;
        f32x4 h = {0.f, 0.f, 0.f, 0.f};
#pragma unroll 8
        for (int jj = 0; jj < j; ++jj) { const f32x4 p = *(const f32x4*)(CP + ((size_t)b * 64 + jj) * DM + c), q = *(const f32x4*)(CH + ((size_t)b * 64 + jj) * DM + c); h = p * h + q; }
        const size_t tok0 = (size_t)b * SEQ + j * 32;
#pragma unroll 1
        for (int hs = 0; hs < 2; ++hs) {
            u32x4 w[16]; u32x2 gr[16], gg[16];
#pragma unroll
            for (int t = 0; t < 16; ++t) { const size_t tok = tok0 + hs * 16 + t; w[t] = *(const u32x4*)(AB + tok * DM + c); gr[t] = *(const u32x2*)(proj + tok * NINP + C_GR + c); gg[t] = *(const u32x2*)(proj + tok * NINP + C_G + 4096 + c); }
#pragma unroll
            for (int t = 0; t < 16; ++t) { const size_t tok = tok0 + hs * 16 + t;
                const f32x4 a = {__expf(bflo(w[t].x)), __expf(bflo(w[t].y)), __expf(bflo(w[t].z)), __expf(bflo(w[t].w))}, bb = {bfhi(w[t].x), bfhi(w[t].y), bfhi(w[t].z), bfhi(w[t].w)};
                h = a * h + bb;
                u32x2 o; o.x = pk2(h[0] * gelu_tanh_(bflo(gr[t].x)) * sigmoidf_(bflo(gg[t].x)), h[1] * gelu_tanh_(bfhi(gr[t].x)) * sigmoidf_(bfhi(gg[t].x)));
                o.y = pk2(h[2] * gelu_tanh_(bflo(gr[t].y)) * sigmoidf_(bflo(gg[t].y)), h[3] * gelu_tanh_(bfhi(gr[t].y)) * sigmoidf_(bfhi(gg[t].y)));
                *(u32x2*)(mrg + tok * MIXW + 4096 + c) = o; }
        }
    }
}

typedef short s16x4 __attribute__((ext_vector_type(4)));
constexpr int KS_STRIDE = 272, VS_STRIDE = 320, ATT_V = 64 * KS_STRIDE, ATT_BUF = 64 * KS_STRIDE + 64 * VS_STRIDE;
DI void p5_attention(Frame& F) {
    const bf16* proj = (const bf16*)(F.ws + WS_PROJ); const unsigned* mask = (const unsigned*)(F.ws + WS_MASK); bf16* mrg = (bf16*)(F.ws + WS_MRG);
    const int lane = F.lane, l31 = lane & 31, hf = lane >> 5, wave = F.wave, hh = wave >> 1, qh = wave & 1, tid = F.tid;
    const float sc2 = 0.08838834764831845f * 1.4426950408889634f;
    const int gi = lane >> 4, i16 = lane & 15;
    const int vbase = ATT_V + (4 * (gi >> 1) + (i16 >> 2)) * VS_STRIDE + (16 * (gi & 1) + 4 * (i16 & 3)) * 2;
    const int sr0 = tid >> 4, sch = tid & 15;
    for (int u = F.bid; u < BATCH * 16 * 4; u += F.G) {
        const int g = u & 3, cp = (u >> 2) & 15, b = u >> 6;
        for (int half = 0; half < 2; ++half) {
            const int c = half ? (31 - cp) : cp, nkt = c + 1, head = g * 4 + hh;
            const int qtok = b * SEQ + c * 64 + qh * 32 + l31;
            const bf16* qrow = proj + (size_t)qtok * NINP + C_Q + head * 128 + hf * 8;
            bf16x8 qf[8];
#pragma unroll
            for (int ks = 0; ks < 8; ++ks) qf[ks] = *(const bf16x8*)(qrow + ks * 16);
            f32x16 o[4];
#pragma unroll
            for (int db = 0; db < 4; ++db)
#pragma unroll
                for (int i = 0; i < 16; ++i) o[db][i] = 0.f;
            float mrun = -1e30f, lrun = 0.f;
            const bf16* kg = proj + (size_t)(b * SEQ + sr0) * NINP + C_K + g * 128 + sch * 8;
            const bf16* vg = proj + (size_t)(b * SEQ + sr0) * NINP + C_V + g * 128 + sch * 8;
            u32x4 kr0 = *(const u32x4*)kg, kr1 = *(const u32x4*)(kg + (size_t)32 * NINP), vr0 = *(const u32x4*)vg, vr1 = *(const u32x4*)(vg + (size_t)32 * NINP);
            const unsigned* mrow = mask + (size_t)qtok * 64;
            unsigned mw0 = mrow[0], mw1 = mrow[1];
            { LAS unsigned char* B0 = F.lds;
              *(LAS u32x4*)(B0 + sr0 * KS_STRIDE + sch * 16) = kr0; *(LAS u32x4*)(B0 + (sr0 + 32) * KS_STRIDE + sch * 16) = kr1;
              *(LAS u32x4*)(B0 + ATT_V + sr0 * VS_STRIDE + sch * 16) = vr0; *(LAS u32x4*)(B0 + ATT_V + (sr0 + 32) * VS_STRIDE + sch * 16) = vr1; }
            __syncthreads();
            for (int kt = 0; kt < nkt; ++kt) {
                LAS unsigned char* Bc = F.lds + (kt & 1) * ATT_BUF; LAS unsigned char* Bn = F.lds + ((kt + 1) & 1) * ATT_BUF;
                const unsigned cm0 = mw0, cm1 = mw1; const bool more = kt + 1 < nkt;
                if (more) { const size_t adv = (size_t)(kt + 1) * 64 * NINP;
                    kr0 = *(const u32x4*)(kg + adv); kr1 = *(const u32x4*)(kg + adv + (size_t)32 * NINP); vr0 = *(const u32x4*)(vg + adv); vr1 = *(const u32x4*)(vg + adv + (size_t)32 * NINP);
                    mw0 = mrow[2 * kt + 2]; mw1 = mrow[2 * kt + 3]; }
                f32x16 s0, s1;
#pragma unroll
                for (int i = 0; i < 16; ++i) { s0[i] = 0.f; s1[i] = 0.f; }
#pragma unroll
                for (int ks = 0; ks < 8; ++ks) {
                    const bf16x8 ka = *(const LAS bf16x8*)(Bc + l31 * KS_STRIDE + ks * 32 + hf * 16);
                    const bf16x8 kb = *(const LAS bf16x8*)(Bc + (32 + l31) * KS_STRIDE + ks * 32 + hf * 16);
                    s0 = __builtin_amdgcn_mfma_f32_32x32x16_bf16(ka, qf[ks], s0, 0, 0, 0);
                    s1 = __builtin_amdgcn_mfma_f32_32x32x16_bf16(kb, qf[ks], s1, 0, 0, 0);
                }
                const unsigned sm0 = cm0 >> (4 * hf), sm1 = cm1 >> (4 * hf);
                float tmax = -INFINITY;
#pragma unroll
                for (int i = 0; i < 16; ++i) { const unsigned bit = 1u << ((i & 3) + 8 * (i >> 2));
                    s0[i] = (sm0 & bit) ? s0[i] * sc2 : -INFINITY; s1[i] = (sm1 & bit) ? s1[i] * sc2 : -INFINITY; tmax = fmaxf(tmax, fmaxf(s0[i], s1[i])); }
                tmax = fmaxf(tmax, __shfl_xor(tmax, 32));
                const float mnew = fmaxf(mrun, tmax), alpha = __builtin_amdgcn_exp2f(mrun - mnew); mrun = mnew;
                float psum = 0.f;
#pragma unroll
                for (int i = 0; i < 16; ++i) { s0[i] = __builtin_amdgcn_exp2f(s0[i] - mnew); s1[i] = __builtin_amdgcn_exp2f(s1[i] - mnew); psum += s0[i] + s1[i]; }
                lrun = lrun * alpha + psum;
                if (!__all(alpha == 1.0f)) {
#pragma unroll
                    for (int db = 0; db < 4; ++db)
#pragma unroll
                        for (int i = 0; i < 16; ++i) o[db][i] *= alpha; }
#pragma unroll
                for (int kb = 0; kb < 2; ++kb)
#pragma unroll
                    for (int s = 0; s < 2; ++s) {
                        u32x4 pw;
                        if (kb == 0) { pw.x = pk2(s0[8 * s], s0[8 * s + 1]); pw.y = pk2(s0[8 * s + 2], s0[8 * s + 3]); pw.z = pk2(s0[8 * s + 4], s0[8 * s + 5]); pw.w = pk2(s0[8 * s + 6], s0[8 * s + 7]); }
                        else { pw.x = pk2(s1[8 * s], s1[8 * s + 1]); pw.y = pk2(s1[8 * s + 2], s1[8 * s + 3]); pw.z = pk2(s1[8 * s + 4], s1[8 * s + 5]); pw.w = pk2(s1[8 * s + 6], s1[8 * s + 7]); }
                        const bf16x8 pf = __builtin_bit_cast(bf16x8, pw);
#pragma unroll
                        for (int db = 0; db < 4; ++db) {
                            LAS unsigned char* vp = Bc + vbase + (kb * 32 + 16 * s) * VS_STRIDE + db * 64;
                            const s16x4 lo = __builtin_amdgcn_ds_read_tr16_b64_v4i16((LAS s16x4*)vp), hi = __builtin_amdgcn_ds_read_tr16_b64_v4i16((LAS s16x4*)(vp + 8 * VS_STRIDE));
                            const bf16x8 vf = __builtin_shufflevector(lo, hi, 0, 1, 2, 3, 4, 5, 6, 7);
                            o[db] = __builtin_amdgcn_mfma_f32_32x32x16_bf16(vf, pf, o[db], 0, 0, 0);
                        }
                    }
                if (more) {
                    *(LAS u32x4*)(Bn + sr0 * KS_STRIDE + sch * 16) = kr0; *(LAS u32x4*)(Bn + (sr0 + 32) * KS_STRIDE + sch * 16) = kr1;
                    *(LAS u32x4*)(Bn + ATT_V + sr0 * VS_STRIDE + sch * 16) = vr0; *(LAS u32x4*)(Bn + ATT_V + (sr0 + 32) * VS_STRIDE + sch * 16) = vr1; }
                __syncthreads();
            }
            const float ltot = lrun + __shfl_xor(lrun, 32), rl = 1.0f / ltot;
            const bf16* grow = proj + (size_t)qtok * NINP + C_G + head * 128; bf16* orow = mrg + (size_t)qtok * MIXW + head * 128;
#pragma unroll
            for (int db = 0; db < 4; ++db)
#pragma unroll
                for (int q4 = 0; q4 < 4; ++q4) { const int d0 = db * 32 + q4 * 8 + hf * 4; const u32x2 gv = *(const u32x2*)(grow + d0);
                    u32x2 w; w.x = pk2(o[db][4 * q4] * rl * sigmoidf_(bflo(gv.x)), o[db][4 * q4 + 1] * rl * sigmoidf_(bfhi(gv.x)));
                    w.y = pk2(o[db][4 * q4 + 2] * rl * sigmoidf_(bflo(gv.y)), o[db][4 * q4 + 3] * rl * sigmoidf_(bfhi(gv.y)));
                    *(u32x2*)(orow + d0) = w; }
        }
    }
    __syncthreads();
}

template <int MODE, bool ROUTE, bool WRITE_BF, bool WRITE_F32>
DI void p_layernorm(Frame& F, const Args& args, const float* src, const float* gam, const float* bet, float* outf, bf16* outb) {
    const int gw = F.bid * 8 + F.wave, NGW = F.G * 8, lane = F.lane;
    const unsigned* rt = (const unsigned*)(F.ws + WS_ROUTE); unsigned* rtw = (unsigned*)(F.ws + WS_ROUTE);
    LAS float* wr_l = (LAS float*)F.lds;
    LAS unsigned* cl = (LAS unsigned*)(F.lds + 65536);
    if (ROUTE) { for (int i = F.tid; i < DM * NEXP / 4; i += 512) *(LAS f32x4*)(wr_l + 4 * i) = *(const f32x4*)(INF(20) + 4 * i); if (F.tid < 8) cl[F.tid] = 0u; __syncthreads(); }
#define LN_COL(jj) (MODE == 1 ? (8 * lane + 512 * ((jj) >> 1) + 4 * ((jj) & 1)) : (4 * lane + 256 * (jj)))
    for (int row = gw; row < MTOK; row += NGW) {
        f32x4 v[8]; float s = 0.f;
        if (MODE == 0) {
#pragma unroll
            for (int j = 0; j < 8; ++j) v[j] = *(const f32x4*)(src + (size_t)row * DM + LN_COL(j));
        } else {
            const unsigned r0 = rt[RT_ROW + 2 * row], r1 = rt[RT_ROW + 2 * row + 1]; const float w0 = __uint_as_float(rt[RT_W + 2 * row]), w1 = __uint_as_float(rt[RT_W + 2 * row + 1]);
            const bf16* yb = (const bf16*)(F.ws + WS_YB);
            u32x4 pa[4][KSPLIT], pb[4][KSPLIT];
#pragma unroll
            for (int j = 0; j < 4; ++j)
#pragma unroll
                for (int ks = 0; ks < KSPLIT; ++ks) { pa[j][ks] = *(const u32x4*)(yb + ((size_t)ks * MOE_ROWS_MAX + r0) * DM + 8 * lane + 512 * j); pb[j][ks] = *(const u32x4*)(yb + ((size_t)ks * MOE_ROWS_MAX + r1) * DM + 8 * lane + 512 * j); }
#pragma unroll
            for (int j = 0; j < 4; ++j) { f32x4 a0 = {0.f, 0.f, 0.f, 0.f}, a1 = a0, b0 = a0, b1 = a0;
#pragma unroll
                for (int ks = 0; ks < KSPLIT; ++ks) { const u32x4 a = pa[j][ks], b = pb[j][ks];
                    a0 += (f32x4){bflo(a.x), bfhi(a.x), bflo(a.y), bfhi(a.y)}; a1 += (f32x4){bflo(a.z), bfhi(a.z), bflo(a.w), bfhi(a.w)};
                    b0 += (f32x4){bflo(b.x), bfhi(b.x), bflo(b.y), bfhi(b.y)}; b1 += (f32x4){bflo(b.z), bfhi(b.z), bflo(b.w), bfhi(b.w)}; }
                const u32x4 xr = *(const u32x4*)((const bf16*)src + (size_t)row * DM + 8 * lane + 512 * j);
                v[2 * j] = (f32x4){bflo(xr.x), bfhi(xr.x), bflo(xr.y), bfhi(xr.y)} * ALPHA + a0 * w0 + b0 * w1;
                v[2 * j + 1] = (f32x4){bflo(xr.z), bfhi(xr.z), bflo(xr.w), bfhi(xr.w)} * ALPHA + a1 * w0 + b1 * w1; }
        }
#pragma unroll
        for (int j = 0; j < 8; ++j) s += (v[j][0] + v[j][1]) + (v[j][2] + v[j][3]);
        const float mean = wave_sum(s) * (1.f / DM); float s2 = 0.f;
#pragma unroll
        for (int j = 0; j < 8; ++j) { v[j] = v[j] - mean; s2 += (v[j][0] * v[j][0] + v[j][1] * v[j][1]) + (v[j][2] * v[j][2] + v[j][3] * v[j][3]); }
        const float rstd = 1.0f / sqrtf(wave_sum(s2) * (1.f / DM) + LN_EPS);
        float lg[8];
#pragma unroll
        for (int e = 0; e < 8; ++e) lg[e] = 0.f;
#pragma unroll
        for (int j = 0; j < 8; ++j) { const int cc = LN_COL(j); const f32x4 gv = *(const f32x4*)(gam + cc), bv = *(const f32x4*)(bet + cc);
            const f32x4 y = v[j] * rstd * gv + bv; if (WRITE_F32) *(f32x4*)(outf + (size_t)row * DM + cc) = y;
            if (WRITE_BF) { u32x2 w; w.x = pk2(y[0], y[1]); w.y = pk2(y[2], y[3]); *(u32x2*)(outb + (size_t)row * DM + cc) = w; }
            if (ROUTE) {
#pragma unroll
                for (int i = 0; i < 4; ++i) { const LAS float* wp = wr_l + (size_t)(cc + i) * 8; const f32x4 wa = *(const LAS f32x4*)wp, wb = *(const LAS f32x4*)(wp + 4); const float xv = y[i];
                    lg[0] += xv * wa[0]; lg[1] += xv * wa[1]; lg[2] += xv * wa[2]; lg[3] += xv * wa[3]; lg[4] += xv * wb[0]; lg[5] += xv * wb[1]; lg[6] += xv * wb[2]; lg[7] += xv * wb[3]; }
            }
            asm volatile("" ::: "memory"); }
        if (ROUTE) {
#pragma unroll
            for (int e = 0; e < 8; ++e) lg[e] = wave_sum(lg[e]);
            int e0 = 0; float l0 = lg[0];
#pragma unroll
            for (int e = 1; e < 8; ++e) if (lg[e] > l0) { l0 = lg[e]; e0 = e; }
            int e1 = 0; float l1 = -INFINITY;
#pragma unroll
            for (int e = 0; e < 8; ++e) if (e != e0 && lg[e] > l1) { l1 = lg[e]; e1 = e; }
            const float p1 = 1.0f / (1.0f + expf(l0 - l1)), p0 = 1.0f - p1;
            if (lane == 0) { const unsigned sl0 = __hip_atomic_fetch_add(cl + e0, 1u, __ATOMIC_RELAXED, __HIP_MEMORY_SCOPE_WORKGROUP), sl1 = __hip_atomic_fetch_add(cl + e1, 1u, __ATOMIC_RELAXED, __HIP_MEMORY_SCOPE_WORKGROUP);
                rtw[RT_E + 2 * row] = (unsigned)e0; rtw[RT_E + 2 * row + 1] = (unsigned)e1; rtw[RT_SLOT + 2 * row] = sl0; rtw[RT_SLOT + 2 * row + 1] = sl1;
                rtw[RT_W + 2 * row] = __float_as_uint(p0); rtw[RT_W + 2 * row + 1] = __float_as_uint(p1); }
        }
    }
#undef LN_COL
    if (ROUTE) { __syncthreads(); const int t2 = F.wave * 64 + lane_id_(); if (t2 < 8) rtw[RT_WGC + F.bid * 8 + t2] = cl[t2]; __syncthreads(); }
}

DI void p_moe_gather(Frame& F) {
    unsigned* rt = (unsigned*)(F.ws + WS_ROUTE);
    const bf16* x1b = (const bf16*)(F.ws + WS_X1B); bf16* am = (bf16*)(F.ws + WS_AMOE);
    LAS unsigned* pre = (LAS unsigned*)F.lds;
    LAS unsigned* tot = pre + 2048;
    const int lane = F.lane;
    __syncthreads();
    { const int e = F.wave; unsigned c[4]; unsigned s = 0u;
#pragma unroll
      for (int i = 0; i < 4; ++i) { const int b = 4 * lane + i; c[i] = b < F.G ? rt[RT_WGC + b * 8 + e] : 0u; s += c[i]; }
      unsigned inc = s;
#pragma unroll
      for (int o = 1; o < 64; o <<= 1) { const unsigned t = __shfl_up(inc, o); inc += (lane >= o) ? t : 0u; }
      unsigned ex = inc - s;
#pragma unroll
      for (int i = 0; i < 4; ++i) { pre[(4 * lane + i) * 8 + e] = ex; ex += c[i]; }
      if (lane == 63) tot[e] = inc; }
    __syncthreads();
    if (F.tid == 0) { unsigned t = 0u; for (int e = 0; e < 8; ++e) { tot[8 + e] = t; t += (tot[e] + 255u) >> 8; } }
    __syncthreads();
    if (F.bid == 0 && F.tid < 8) F.ctl[CW_CNT + F.tid] = tot[F.tid];
    const int gw = F.bid * 8 + F.wave, NGW = F.G * 8;
    for (int a = gw; a < MTOK * 2; a += NGW) {
        const int tok = a >> 1; const int e = (int)rt[RT_E + a], slot = (int)rt[RT_SLOT + a];
        const int bsrc = (tok % NGW) >> 3;
        const int row = (int)tot[8 + e] * 256 + (int)pre[bsrc * 8 + e] + slot;
        const u32x4* s = (const u32x4*)(x1b + (size_t)tok * DM); u32x4* d = (u32x4*)(am + (size_t)row * DM);
#pragma unroll
        for (int i = 0; i < 4; ++i) d[lane + 64 * i] = s[lane + 64 * i];
        if (lane == 0) rt[RT_ROW + a] = (unsigned)row;
    }
    for (int pr = gw; pr < 8 * 256; pr += NGW) { const int e = pr >> 8, i = pr & 255;
        const int row = (int)tot[8 + e] * 256 + (int)tot[e] + i, rend = ((int)tot[8 + e] + (((int)tot[e] + 255) >> 8)) * 256;
        if (row < rend) { u32x4* d = (u32x4*)(am + (size_t)row * DM);
#pragma unroll
            for (int q = 0; q < 4; ++q) d[lane + 64 * q] = (u32x4){0u, 0u, 0u, 0u}; } }
    __syncthreads();
}

constexpr int NPH_LAYER = 12;
constexpr int NPHASES = 1 + 2 * NPH_LAYER;
#define IN(k) (lo <= (k) && (k) < hi)
#define RELAUNDER() do { int l_ = lane_id_(); asm volatile("" : "+v"(l_)); F.lane = l_; F.tid = F.wave * 64 + l_; } while (0)
#define STAMP(k) do { if (STAMP_PROBE && F.bid == 0 && xb_t0(F.wave)) ((volatile LAS unsigned*)(F.lds + LDSCTL_OFF + 512))[k] = (unsigned)__builtin_amdgcn_s_memrealtime(); } while (0)
#define SEAM(k) do { if (IN(k) && IN((k) + 1)) { xcd_barrier(bar); STAMP((k) + 1); } } while (0)
template <int LAYER>
DI void run_layer(Frame& F, const Args& args, const XcdBarrier& bar, const int lo, const int hi) {
    constexpr int P = 1 + NPH_LAYER * LAYER;
    bf16* proj = (bf16*)(F.ws + WS_PROJ); bf16* xb = (bf16*)(F.ws + WS_XB); bf16* mrg = (bf16*)(F.ws + WS_MRG);
    float* x1 = (float*)(F.ws + WS_X1); bf16* x1b = (bf16*)(F.ws + WS_X1B); float* x2 = (float*)(F.ws + WS_X2); float* pre = (float*)(F.ws + WS_PRE);
    if (IN(P + 0)) {
        pg8::Gemm g{xb, (const bf16*)(F.ws + WS_WIN) + (size_t)LAYER * NINP * DM, DM, DM, DM};
        pg8::TileOrder S; S.init(MTOK / 256, NINP / 256, F.G, F.bid, (size_t)256 * DM * 2, (size_t)256 * DM * 2);
        pg8::EpiBf16 E{proj, NINP, 0};
        pg8::gemm_phase(F.lds, g, S, E, F.wave);
        RELAUNDER(); if (LAYER == 0) conv_range(F, args, CE_0, CE_3, 32); else conv_range(F, args, CE_5, CE_5 + MOE_EARLY, 32);
    }
    SEAM(P + 0);
    if (IN(P + 1)) { RELAUNDER(); p2_prep(F, args, LAYER); }
    SEAM(P + 1);
    if (IN(P + 2)) {
        { pg8::Gemm g{(const bf16*)(F.ws + WS_DIFF), (const bf16*)(F.ws + WS_WPOOL) + (size_t)LAYER * 2048 * 512, DM, 512, 512};
          pg8::TileOrder S; S.init(MTOK / 256, 8, F.G, F.bid, (size_t)256 * DM * 2, (size_t)256 * 512 * 2, 2, (size_t)512 * 2);
          pg8::EpiPool E{mrg, proj, INF(5) + (size_t)LAYER * DM};
          pg8::gemm_phase(F.lds, g, S, E, F.wave); }
        if (LAYER == 0) STAMP(25);
        { pg8::Gemm g{(const bf16*)(F.ws + WS_XC), (const bf16*)(F.ws + WS_WLRU) + (size_t)LAYER * 4096 * 256, DM, 256, 256};
          pg8::TileOrder S; S.init(MTOK / 256, 16, F.G, F.bid, (size_t)256 * DM * 2, (size_t)256 * 256 * 2, 2, (size_t)256 * 2);
          pg8::EpiLru E{(unsigned*)(F.ws + WS_A), (const bf16*)(F.ws + WS_XC), INF(9) + (size_t)LAYER * DM, INF(11) + (size_t)LAYER * DM, (const float*)(F.ws + WS_LRUC) + (size_t)LAYER * DM};
          pg8::gemm_phase(F.lds, g, S, E, F.wave); }
        if (LAYER == 0) STAMP(26);
        RELAUNDER(); p3_indexer(F);
        if (LAYER == 0) STAMP(29);
        __syncthreads(); RELAUNDER(); if (LAYER == 0) conv_range(F, args, CE_3, CE_3 + P2_ITEMS, 32); else conv_range(F, args, CE_5 + MOE_EARLY, CE_5 + MOE_EARLY + P2_ITEMS, 32);
    }
    SEAM(P + 2);
    if (IN(P + 3)) { RELAUNDER(); p4_select(F); if (LAYER == 0) STAMP(27); RELAUNDER(); p4_lru_pass1(F); }
    SEAM(P + 3);
    if (IN(P + 4)) { RELAUNDER(); p5_attention(F); if (LAYER == 0) STAMP(28); RELAUNDER(); p5_lru_pass2(F); }
    SEAM(P + 4);
    if (IN(P + 5)) {
        pg8::Gemm g{mrg, (const bf16*)(F.ws + WS_WOUT) + (size_t)LAYER * DM * MIXW, MIXW, MIXW, MIXW};
        pg8::TileOrder S; S.init(MTOK / 256, DM / 256, F.G, F.bid, (size_t)256 * MIXW * 2, (size_t)256 * MIXW * 2);
        pg8::EpiRes<LAYER == 1> E{pre, LAYER == 0 ? (const void*)INF(0) : (const void*)xb, DM};
        pg8::gemm_phase(F.lds, g, S, E, F.wave);
    }
    SEAM(P + 5);
    if (IN(P + 6)) { RELAUNDER(); } if (IN(P + 6)) p_layernorm<0, LAYER == 1, true, false>(F, args, pre, INF(13) + LAYER * DM, INF(14) + LAYER * DM, nullptr, x1b);
    SEAM(P + 6);
    if constexpr (LAYER == 0) {
        if (IN(P + 7)) {
            pg8::Gemm g{x1b, (const bf16*)(F.ws + WS_WGU), DM, DM, DM};
            pg8::TileOrder S; S.init(MTOK / 256, 2 * DFF / 256, F.G, F.bid, (size_t)256 * DM * 2, (size_t)256 * DM * 2);
            pg8::EpiSwiglu E{(bf16*)(F.ws + WS_H), DFF};
            pg8::gemm_phase(F.lds, g, S, E, F.wave);
            RELAUNDER(); conv_range(F, args, CE_3 + P2_ITEMS, CE_5, 96);
        }
        SEAM(P + 7);
        if (IN(P + 8)) {
            pg8::Gemm g{(const bf16*)(F.ws + WS_H), (const bf16*)(F.ws + WS_WDN), DFF, DFF, DFF};
            pg8::TileOrder S; S.init(MTOK / 256, DM / 256, F.G, F.bid, (size_t)256 * DFF * 2, (size_t)256 * DFF * 2);
            pg8::EpiRes<true> E{pre, x1b, DM};
            pg8::gemm_phase(F.lds, g, S, E, F.wave);
        }
        SEAM(P + 8);
        if (IN(P + 9)) { RELAUNDER(); } if (IN(P + 9)) p_layernorm<0, false, true, false>(F, args, pre, INF(15), INF(16), nullptr, xb);
        if (IN(P + 9) && IN(P + 12)) { xcd_barrier(bar); STAMP(P + 10); STAMP(P + 11); STAMP(P + 12); }
    } else {
        if (IN(P + 7)) { RELAUNDER(); conv_range(F, args, CE_5 + MOE_EARLY + P2_ITEMS, CE_7, 0); RELAUNDER(); p_moe_gather(F); }
        SEAM(P + 7);
        if (IN(P + 8)) {
            pg8::Gemm g{(const bf16*)(F.ws + WS_AMOE), (const bf16*)(F.ws + WS_MWGU), DM, DM, DM};
            pg8::MoeOrder S; S.init(F.ctl + CW_CNT, 2 * DEXP / 256, 1, F.G, F.bid, (size_t)256 * DM * 2, (size_t)2 * DEXP * DM * 2, (size_t)256 * DM * 2, 0);
            pg8::EpiSwiglu E{(bf16*)(F.ws + WS_HMOE), DEXP};
            pg8::gemm_phase(F.lds, g, S, E, F.wave);
        }
        SEAM(P + 8);
        if (IN(P + 9)) {
            pg8::Gemm g{(const bf16*)(F.ws + WS_HMOE), (const bf16*)(F.ws + WS_MWDN), DEXP, DEXP, DEXP / KSPLIT};
            pg8::MoeOrder S; S.init(F.ctl + CW_CNT, DM / 256, KSPLIT, F.G, F.bid, (size_t)256 * DEXP * 2, (size_t)DM * DEXP * 2, (size_t)256 * DEXP * 2, (size_t)(DEXP / KSPLIT) * 2);
            pg8::EpiBf16 E{(bf16*)(F.ws + WS_YB), DM, (size_t)MOE_ROWS_MAX * DM};
            pg8::gemm_phase(F.lds, g, S, E, F.wave);
        }
        SEAM(P + 9);
        if (IN(P + 10)) { RELAUNDER(); } if (IN(P + 10)) p_layernorm<1, false, false, true>(F, args, (const float*)x1b, INF(15) + DM, INF(16) + DM, args.out, nullptr);
    }
}
__global__ void __launch_bounds__(512, 2) fwd_kernel(Args args) {
    extern __shared__ __attribute__((aligned(16))) unsigned char lds_raw[];
    Frame F;
    F.lds = (LAS unsigned char*)lds_raw; F.ws = args.ws; F.ctl = (unsigned*)(args.ws + WS_CTL);
    F.wave = __builtin_amdgcn_readfirstlane((int)threadIdx.x >> 6); F.lane = lane_id_(); F.tid = F.wave * 64 + F.lane; F.G = gridDim.x; F.bid = blockIdx.x;
    volatile LAS unsigned* MISC = (volatile LAS unsigned*)(F.lds + LDSCTL_OFF);
    for (int u = F.tid; u < (LDS_BYTES - LDSCTL_OFF) / 4; u += 512) ((LAS unsigned*)(F.lds + LDSCTL_OFF))[u] = 0u;
    __syncthreads();
    const int lo = args.ph_lo, hi = args.ph_hi;
    XcdBarrier bar; bar.bar = F.ctl + CW_BAR; bar.x = 0; bar.st = nullptr; bar.wave = F.wave;
    if ((hi - lo) > 1) bar = xcd_barrier_post(F.ctl + CW_BAR, MISC + 8, F.wave);
    STAMP(0);
    if (IN(0)) { RELAUNDER(); p0_prologue(F, args); __syncthreads(); }
    SEAM(0);
    run_layer<0>(F, args, bar, lo, hi);
    run_layer<1>(F, args, bar, lo, hi);
#if STAMP_PROBE
    RELAUNDER();
    if (F.bid == 0) {
        asm volatile("s_waitcnt vmcnt(0)" ::: "memory"); __syncthreads();
        if (xb_t0(F.wave)) ((volatile LAS unsigned*)(F.lds + LDSCTL_OFF + 512))[NPHASES - 1] = (unsigned)__builtin_amdgcn_s_memrealtime();
        __syncthreads();
        volatile LAS unsigned* st = (volatile LAS unsigned*)(F.lds + LDSCTL_OFF + 512);
        const float ta = (float)(st[STAMP_A_HI] - st[STAMP_A_LO]) * 0.01f, tb = (float)(st[STAMP_B_HI] - st[STAMP_B_LO]) * 0.01f;
        const float da = __builtin_amdgcn_sqrtf(ta * 0.005f);
        for (int i = F.tid; i < DM; i += 512) args.out[i] += da;
        if (F.tid == 0) args.out[DM] += tb * 0.1f;
    }
#endif
}
#undef IN
#undef SEAM

extern "C" void kernel_launch(void* const* d_in, const int* in_sizes, int n_in, void* d_out, int out_size, void* d_ws, size_t ws_size, hipStream_t stream) {
    static int grid = 0;
    if (grid == 0) {
        if (n_in != 24 || out_size != MTOK * DM || ws_size < WS_END) { fprintf(stderr, "kernel_launch: unexpected problem (n_in %d, out %d, ws %zu, need %zu)\n", n_in, out_size, ws_size, (size_t)WS_END); grid = -1; return; }
        int dev = 0, cus = 0, per_cu = 0;
        if (hipGetDevice(&dev) != hipSuccess || hipDeviceGetAttribute(&cus, hipDeviceAttributeMultiprocessorCount, dev) != hipSuccess) { grid = -1; return; }
        if (hipFuncSetAttribute((const void*)fwd_kernel, hipFuncAttributeMaxDynamicSharedMemorySize, LDS_BYTES) != hipSuccess) { fprintf(stderr, "kernel_launch: hipFuncSetAttribute failed\n"); grid = -1; return; }
        if (hipOccupancyMaxActiveBlocksPerMultiprocessor(&per_cu, (const void*)fwd_kernel, 512, LDS_BYTES) != hipSuccess || per_cu < 1) fprintf(stderr, "kernel_launch: occupancy query reports %d\n", per_cu);
        (void)hipGetLastError();
        grid = cus;
    }
    if (grid < 0) return;
    (void)hipMemsetAsync((char*)d_ws + WS_CTL, 0, CTL_ZERO_BYTES, stream);
    Args a{};
    for (int i = 0; i < 24; ++i) a.in[i] = d_in[i];
    a.out = (float*)d_out; a.ws = (unsigned char*)d_ws;
#if MK_N_LAUNCHES == 1
    a.ph_lo = 0; a.ph_hi = NPHASES;
    hipLaunchKernelGGL(fwd_kernel, dim3(grid), dim3(512), LDS_BYTES, stream, a);
#else
    const int plist[] = {0, 1, 2, 3, 4, 5, 6, 7, 8, 9, 10, 13, 14, 15, 16, 17, 18, 19, 20, 21, 22, 23};
    for (int i = 0; i < (int)(sizeof(plist) / sizeof(int)); ++i) { a.ph_lo = plist[i]; a.ph_hi = plist[i] + 1; hipLaunchKernelGGL(fwd_kernel, dim3(grid), dim3(512), LDS_BYTES, stream, a); }
#endif
}
```

```cpp
#include <hip/hip_runtime.h>
#include <cstdio>
#include <cstdint>

#ifndef MK_N_LAUNCHES
#define MK_N_LAUNCHES 1
#endif

#ifndef STAMP_PROBE
#define STAMP_PROBE 0
#endif
#ifndef STAMP_A_LO
#define STAMP_A_LO 0
#define STAMP_A_HI 1
#define STAMP_B_LO 1
#define STAMP_B_HI 2
#endif
#define DI __device__ __forceinline__
#define LAS __attribute__((address_space(3)))
#define GAS __attribute__((address_space(1)))
typedef unsigned short bf16;
typedef short bf16x8 __attribute__((ext_vector_type(8)));
typedef float f32x2 __attribute__((ext_vector_type(2)));
typedef float f32x4 __attribute__((ext_vector_type(4)));
typedef float f32x16 __attribute__((ext_vector_type(16)));
typedef unsigned u32x2 __attribute__((ext_vector_type(2)));
typedef unsigned u32x4 __attribute__((ext_vector_type(4)));
typedef __bf16 bf16x2_t __attribute__((ext_vector_type(2)));
typedef int i32x8 __attribute__((ext_vector_type(8)));
typedef int i32x4 __attribute__((ext_vector_type(4)));

#define LDS_WAIT() asm volatile("s_waitcnt lgkmcnt(0)" ::: "memory")
#define VM_WAIT() asm volatile("s_waitcnt vmcnt(0)" ::: "memory")

DI unsigned pk2(float lo, float hi) { f32x2 v = {lo, hi}; return __builtin_bit_cast(unsigned, __builtin_convertvector(v, bf16x2_t)); }
DI unsigned pk4_fp8(float a, float b, float c, float d) { int w = 0; w = __builtin_amdgcn_cvt_pk_fp8_f32(a, b, w, false); w = __builtin_amdgcn_cvt_pk_fp8_f32(c, d, w, true); return (unsigned)w; }
DI float bflo(unsigned w) { return __uint_as_float(w << 16); }
DI float bfhi(unsigned w) { return __uint_as_float(w & 0xffff0000u); }
DI float bf2f(bf16 b) { return __uint_as_float(((unsigned)b) << 16); }
DI float rcp_(float x) { return __builtin_amdgcn_rcpf(x); }
DI float sigmoidf_(float x) { return rcp_(1.0f + __expf(-x)); }
DI float siluf_(float x) { return x * rcp_(1.0f + __expf(-x)); }
DI float gelu_tanh_(float x) { const float u = 0.7978845608028654f * (x + 0.044715f * x * x * x); const float t = 1.0f - 2.0f * rcp_(1.0f + __expf(2.0f * u)); return 0.5f * x * (1.0f + t); }
DI float one_minus_exp_(float x) {
    const float p = -x * (1.0f + x * 0.5f * (1.0f + x * (1.0f / 3.0f) * (1.0f + x * 0.25f * (1.0f + x * 0.2f * (1.0f + x * (1.0f / 6.0f) * (1.0f + x * (1.0f / 7.0f)))))));
    const float e = 1.0f - __expf(x);
    return x > -0.5f ? p : e;
}
DI int lane_id_() { int l; asm volatile("v_mbcnt_lo_u32_b32 %0, -1, 0\n\tv_mbcnt_hi_u32_b32 %0, -1, %0" : "=v"(l)); return l; }

constexpr int DM = 2048, BATCH = 4, SEQ = 2048, MTOK = BATCH * SEQ;
constexpr int NIN = 16464, NINP = 16640;
constexpr int C_Q = 0, C_K = 2048, C_V = 2560, C_QI = 3072, C_KI = 4096, C_WI = 4160, C_PADLO = 4176, C_P = 4352, C_XR = 6400, C_GR = 8448, C_G = 10496;
constexpr int MIXW = 6144, DFF = 5504, NEXP = 8, DEXP = 7168;
constexpr int MOE_ROWS_MAX = (MTOK * 2 / 256 + NEXP) * 256;
constexpr float ALPHA = 1.4142135623730951f, LN_EPS = 1e-5f;
constexpr int KSPLIT = 2;

constexpr size_t MiB = 1u << 20;
constexpr size_t WS_CTL = 0, CTL_ZERO_BYTES = 1 * MiB;
constexpr size_t WS_COSA = 1 * MiB, WS_SINA = 3 * MiB, WS_COSI = 5 * MiB, WS_SINI = 6 * MiB;
constexpr size_t WS_ROUTE = 9 * MiB;
constexpr size_t WS_MASK = 10 * MiB;
constexpr size_t WS_LRUC = 9 * MiB + 512 * 1024;
constexpr size_t WS_WIN = 12 * MiB;
constexpr size_t WS_WOUT = 142 * MiB;
constexpr size_t WS_WPOOL = 190 * MiB;
constexpr size_t WS_WLRU = 194 * MiB;
constexpr size_t WS_WGU = 198 * MiB;
constexpr size_t WS_WDN = 241 * MiB;
constexpr size_t WS_XB = 263 * MiB;
constexpr size_t WS_X1 = 295 * MiB;
constexpr size_t WS_X1B = 359 * MiB;
constexpr size_t WS_X2 = 391 * MiB;
constexpr size_t WS_PRE = 455 * MiB;
constexpr size_t WS_MWGU = 519 * MiB;
constexpr size_t WS_MWDN = 967 * MiB;
constexpr size_t WS_OV = 1191 * MiB;
constexpr size_t WS_PROJ = WS_OV;
constexpr size_t WS_DIFF = WS_OV + 260 * MiB;
constexpr size_t WS_XC = WS_OV + 292 * MiB;
constexpr size_t WS_A = WS_OV + 324 * MiB;
constexpr size_t WS_CARRY = WS_OV + 388 * MiB;
constexpr size_t WS_SC = WS_OV + 452 * MiB;
constexpr size_t WS_MRG = WS_OV + 516 * MiB;
constexpr size_t WS_H = WS_OV;
constexpr size_t WS_AMOE = WS_OV;
constexpr size_t WS_HMOE = WS_OV + 72 * MiB;
constexpr size_t WS_YB = WS_OV + 324 * MiB;
constexpr size_t WS_END = WS_OV + 612 * MiB;
constexpr int CW_BAR = 4096, CW_CNT = 16384;
constexpr int RT_E = 0, RT_SLOT = 2 * MTOK, RT_W = 4 * MTOK, RT_ROW = 6 * MTOK, RT_WGC = 8 * MTOK;

constexpr int RING_BYTES = 131072, LDSCTL_OFF = RING_BYTES, LDS_BYTES = 147456;

#define XB_TMO      128
#define XB_XCNT(j)  (256  + 64 * (j))
#define XB_XSUB(j)  (1280 + 64 * (j))
#define XB_XGEN(j)  (2304 + 64 * (j))
#define XB_TOP      3328
#define XB_TOPGEN   3392
#define XCD_BAR_WORDS 3456
#define XB_SPIN_CAP (1u << 18)
DI unsigned xb_ld(unsigned* p)              { return __hip_atomic_load(p, __ATOMIC_RELAXED, __HIP_MEMORY_SCOPE_AGENT); }
DI unsigned xb_add(unsigned* p, unsigned v) { return __hip_atomic_fetch_add(p, v, __ATOMIC_RELAXED, __HIP_MEMORY_SCOPE_AGENT); }
DI unsigned xb_xcc_id() { return (unsigned)__builtin_amdgcn_s_getreg((3 << 11) | 20) & 0xFu; }
#define XB_SPIN(cond, bar) do { unsigned _sp = 0; while (cond) { __builtin_amdgcn_s_sleep(1); \
    if ((++_sp & 255u) == 0u) { if (xb_ld(&(bar)[XB_TMO])) break; if (_sp > XB_SPIN_CAP) { atomicAdd(&(bar)[XB_TMO], 1u); break; } } } } while (0)
struct XcdBarrier { unsigned* bar; unsigned x; volatile LAS unsigned* st; int wave; };
DI bool xb_t0(int wave) { return wave == 0 && lane_id_() == 0; }
DI XcdBarrier xcd_barrier_post(unsigned* bar, volatile LAS unsigned* st, int wave) {
    XcdBarrier b; b.bar = bar; b.x = xb_xcc_id(); b.st = st; b.wave = wave;
    if (xb_t0(wave)) (void)xb_add(&bar[XB_XCNT(b.x)], 1u);
    return b;
}
DI void xcd_barrier_complete(unsigned* bar, unsigned x, unsigned& nloc, unsigned& nx) {
    const unsigned G = gridDim.x * gridDim.y * gridDim.z;
    unsigned sum, cnt, mine, sp = 0u;
    for (;;) {
        sum = 0u; cnt = 0u; mine = 0u;
#pragma unroll
        for (unsigned j = 0; j < 16; ++j) { const unsigned c = xb_ld(&bar[XB_XCNT(j)]); sum += c; cnt += (c > 0u) ? 1u : 0u; mine = (j == x) ? c : mine; }
        if (sum == G) break;
        __builtin_amdgcn_s_sleep(1);
        if ((++sp & 255u) == 0u) { if (xb_ld(&bar[XB_TMO])) break; if (sp > XB_SPIN_CAP) { atomicAdd(&bar[XB_TMO], 1u); break; } }
    }
    nloc = mine > 0u ? mine : 1u; nx = cnt > 0u ? cnt : 1u;
}
DI void xcd_barrier(const XcdBarrier& b) {
    asm volatile("s_waitcnt vmcnt(0)" ::: "memory");
    __syncthreads();
    if (xb_t0(b.wave)) {
        unsigned* bar = b.bar;
        __builtin_amdgcn_s_waitcnt(0);
        unsigned nloc = b.st[0], nx = b.st[1];
        if (nloc == 0u) { xcd_barrier_complete(bar, b.x, nloc, nx); b.st[0] = nloc; b.st[1] = nx; }
        const unsigned old = xb_add(&bar[XB_XSUB(b.x)], 1u);
        const unsigned gen = old / nloc;
        if (old + 1u == (gen + 1u) * nloc) {
            __builtin_amdgcn_fence(__ATOMIC_RELEASE, "agent");
            asm volatile("s_waitcnt vmcnt(0)" ::: "memory");
            const unsigned og = xb_add(&bar[XB_TOP], 1u);
            const unsigned tg = og / nx;
            if (og + 1u == (tg + 1u) * nx) xb_add(&bar[XB_TOPGEN], 1u);
            else XB_SPIN(xb_ld(&bar[XB_TOPGEN]) == tg, bar);
            __builtin_amdgcn_fence(__ATOMIC_ACQUIRE, "agent");
            xb_add(&bar[XB_XGEN(b.x)], 1u);
            asm volatile("s_waitcnt vmcnt(0)" ::: "memory");
        } else {
            XB_SPIN(xb_ld(&bar[XB_XGEN(b.x)]) == gen, bar);
            __builtin_amdgcn_fence(__ATOMIC_ACQUIRE, "agent");
            asm volatile("s_waitcnt vmcnt(0)" ::: "memory");
        }
    }
    __syncthreads();
}

namespace pg8 {
constexpr int BM = 256, BK = 64, HALF = 128, HTB = HALF * BK * 2, STAGE_BYTES = 8 * HTB, NXCD = 8, WGM = 8;
DI int lds_byte(int r, int c) { const int st = (r >> 4) * 2 + (c >> 5), rr = r & 15, cc = c & 31, ob = rr * 64 + cc * 2; return st * 1024 + (ob ^ (((ob >> 9) & 1) << 5)); }
DI void stage_rc(int b, int& R, int& C) { const int st = b / 1024, sb = b % 1024, swz = sb ^ (((sb >> 9) & 1) << 5); R = (st >> 1) * 16 + swz / 64; C = (st & 1) * 32 + (swz % 64) / 2; }
DI int perm32(int rho) { const int n = rho >> 4, i = rho & 15; return 8 * (i >> 2) + 4 * n + (i & 3); }

struct Unit { int pm, pn, e, ks; };
struct Gemm { const bf16* A; const bf16* Bt; int lda, ldb, K; };

struct TileOrder {
    int nM, nN, nwg, G, c, a_div; size_t a_pm, a_pn, b_pn;
    DI void init(int nM_, int nN_, int G_, int c_, size_t a_pm_, size_t b_pn_, int a_div_ = 1, size_t a_pn_ = 0) { nM = nM_; nN = nN_; nwg = nM * nN; G = G_; c = c_; a_pm = a_pm_; b_pn = b_pn_; a_div = a_div_; a_pn = a_pn_; }
    DI bool next(int i, Unit& u) const {
        const long L = (long)i * G + c; if (L >= nwg) return false;
        int wgid = (int)L; { const int q = nwg / NXCD, r = nwg % NXCD, xcd = wgid % NXCD, off = wgid / NXCD; wgid = (xcd < r ? xcd * (q + 1) : r * (q + 1) + (xcd - r) * q) + off; }
        const int nig = WGM * nN, gid = wgid / nig, fm = gid * WGM, gsz = (nM - fm) < WGM ? (nM - fm) : WGM;
        u.pm = fm + ((wgid % nig) % gsz); u.pn = (wgid % nig) / gsz; u.e = 0; u.ks = 0; return true;
    }
    DI size_t aoff(const Unit& u) const { return (size_t)u.pm * a_pm + (size_t)(u.pn / a_div) * a_pn; }
    DI size_t boff(const Unit& u) const { return (size_t)u.pn * b_pn; }
};
struct MoeOrder {
    int nN, nNk, nwg, G, c; int t1, t2, t3, t4, t5, t6, t7, t8; size_t a_pm, b_e, b_pn, ks_step;
    DI void init(const unsigned* cnt, int nN_, int ksplit, int G_, int c_, size_t a_pm_, size_t b_e_, size_t b_pn_, size_t ks_step_) {
        nN = nN_; nNk = nN_ * ksplit; G = G_; c = c_; a_pm = a_pm_; b_e = b_e_; b_pn = b_pn_; ks_step = ks_step_;
        int s = 0; s += ((int)cnt[0] + 255) >> 8; t1 = s; s += ((int)cnt[1] + 255) >> 8; t2 = s; s += ((int)cnt[2] + 255) >> 8; t3 = s; s += ((int)cnt[3] + 255) >> 8; t4 = s;
        s += ((int)cnt[4] + 255) >> 8; t5 = s; s += ((int)cnt[5] + 255) >> 8; t6 = s; s += ((int)cnt[6] + 255) >> 8; t7 = s; s += ((int)cnt[7] + 255) >> 8; t8 = s;
        nwg = t8 * nNk;
    }
    DI bool next(int i, Unit& u) const {
        const long L = (long)i * G + c; if (L >= nwg) return false;
        int wgid = (int)L; { const int q = nwg / NXCD, r = nwg % NXCD, xcd = wgid % NXCD, off = wgid / NXCD; wgid = (xcd < r ? xcd * (q + 1) : r * (q + 1) + (xcd - r) * q) + off; }
        int e = 0, ts = 0, nt = t1;
        if (wgid >= t1 * nNk) { e = 1; ts = t1; nt = t2 - t1; }
        if (wgid >= t2 * nNk) { e = 2; ts = t2; nt = t3 - t2; }
        if (wgid >= t3 * nNk) { e = 3; ts = t3; nt = t4 - t3; }
        if (wgid >= t4 * nNk) { e = 4; ts = t4; nt = t5 - t4; }
        if (wgid >= t5 * nNk) { e = 5; ts = t5; nt = t6 - t5; }
        if (wgid >= t6 * nNk) { e = 6; ts = t6; nt = t7 - t6; }
        if (wgid >= t7 * nNk) { e = 7; ts = t7; nt = t8 - t7; }
        const int loc = wgid - ts * nNk; nt = nt > 0 ? nt : 1;
        const int pn2 = loc / nt;
        u.pm = ts + loc % nt; u.pn = pn2 % nN; u.ks = pn2 / nN; u.e = e; return true;
    }
    DI size_t aoff(const Unit& u) const { return (size_t)u.pm * a_pm + (size_t)u.ks * ks_step; }
    DI size_t boff(const Unit& u) const { return (size_t)u.e * b_e + (size_t)u.pn * b_pn + (size_t)u.ks * ks_step; }
};

struct EpiBf16 {
    static constexpr bool PERM = true;
    bf16* O; int ldc; size_t ks_stride; float scale;
    DI void operator()(const f32x4 (&acc)[2][2][4][2], const Unit& u, int wr, int wc, int fr, int fq) const {
        const int row0 = u.pm * BM + wr * 64 + fr, col0 = u.pn * BM + wc * 32 + 8 * fq;
#pragma unroll
        for (int ai = 0; ai < 2; ++ai)
#pragma unroll
            for (int m = 0; m < 4; ++m) { bf16* rowp = O + (size_t)u.ks * ks_stride + (size_t)(row0 + ai * HALF + m * 16) * ldc + col0;
#pragma unroll
                for (int bj = 0; bj < 2; ++bj) { const f32x4 v0 = acc[ai][bj][m][0] * scale, v1 = acc[ai][bj][m][1] * scale;
                    u32x4 w; w.x = pk2(v0[0], v0[1]); w.y = pk2(v0[2], v0[3]); w.z = pk2(v1[0], v1[1]); w.w = pk2(v1[2], v1[3]);
                    *(u32x4*)(rowp + bj * HALF) = w; } }
    }
};
struct EpiF32 {
    static constexpr bool PERM = false;
    float* C; int ldc;
    DI void operator()(const f32x4 (&acc)[2][2][4][2], const Unit& u, int wr, int wc, int fr, int fq) const {
        const int row0 = u.pm * BM + wr * 64 + fr, col0 = u.pn * BM + wc * 32 + 4 * fq;
#pragma unroll
        for (int ai = 0; ai < 2; ++ai)
#pragma unroll
            for (int m = 0; m < 4; ++m) { float* rowp = C + (size_t)(row0 + ai * HALF + m * 16) * ldc + col0;
#pragma unroll
                for (int bj = 0; bj < 2; ++bj)
#pragma unroll
                    for (int n = 0; n < 2; ++n) *(f32x4*)(rowp + bj * HALF + n * 16) = acc[ai][bj][m][n]; }
    }
};
template <bool RES_BF16>
struct EpiRes {
    static constexpr bool PERM = false;
    float* C; const void* res; int ldc;
    DI void operator()(const f32x4 (&acc)[2][2][4][2], const Unit& u, int wr, int wc, int fr, int fq) const {
        const int row0 = u.pm * BM + wr * 64 + fr, col0 = u.pn * BM + wc * 32 + 4 * fq;
#pragma unroll
        for (int ai = 0; ai < 2; ++ai)
#pragma unroll
            for (int m = 0; m < 4; ++m) { const size_t off = (size_t)(row0 + ai * HALF + m * 16) * ldc + col0;
#pragma unroll
                for (int bj = 0; bj < 2; ++bj)
#pragma unroll
                    for (int n = 0; n < 2; ++n) { f32x4 rv;
                        if (RES_BF16) { const u32x2 w = *(const u32x2*)((const bf16*)res + off + bj * HALF + n * 16); rv = (f32x4){bflo(w.x), bfhi(w.x), bflo(w.y), bfhi(w.y)}; }
                        else rv = *(const f32x4*)((const float*)res + off + bj * HALF + n * 16);
                        *(f32x4*)(C + off + bj * HALF + n * 16) = acc[ai][bj][m][n] + rv * ALPHA; }
                asm volatile("" ::: "memory"); }
    }
};
struct EpiSwiglu {
    static constexpr bool PERM = true;
    bf16* H; int ldc;
    DI void operator()(const f32x4 (&acc)[2][2][4][2], const Unit& u, int wr, int wc, int fr, int fq) const {
        const int row0 = u.pm * BM + wr * 64 + fr, col0 = u.pn * HALF + wc * 32 + 8 * fq;
#pragma unroll
        for (int ai = 0; ai < 2; ++ai)
#pragma unroll
            for (int m = 0; m < 4; ++m) { bf16* rowp = H + (size_t)(row0 + ai * HALF + m * 16) * ldc + col0;
                const f32x4 g0 = acc[ai][0][m][0], g1 = acc[ai][0][m][1], u0 = acc[ai][1][m][0], u1 = acc[ai][1][m][1];
                u32x4 w; w.x = pk2(siluf_(g0[0]) * u0[0], siluf_(g0[1]) * u0[1]); w.y = pk2(siluf_(g0[2]) * u0[2], siluf_(g0[3]) * u0[3]);
                w.z = pk2(siluf_(g1[0]) * u1[0], siluf_(g1[1]) * u1[1]); w.w = pk2(siluf_(g1[2]) * u1[2], siluf_(g1[3]) * u1[3]);
                *(u32x4*)rowp = w; asm volatile("" ::: "memory"); }
    }
};
struct EpiSwigluF8 {
    static constexpr bool PERM = true;
    unsigned char* H; int ldc; float scale;
    DI void operator()(const f32x4 (&acc)[2][2][4][2], const Unit& u, int wr, int wc, int fr, int fq) const {
        const int row0 = u.pm * BM + wr * 64 + fr, col0 = u.pn * HALF + wc * 32 + 8 * fq;
#pragma unroll
        for (int ai = 0; ai < 2; ++ai)
#pragma unroll
            for (int m = 0; m < 4; ++m) { unsigned char* rowp = H + (size_t)(row0 + ai * HALF + m * 16) * ldc + col0;
                const f32x4 g0 = acc[ai][0][m][0] * scale, g1 = acc[ai][0][m][1] * scale, u0 = acc[ai][1][m][0] * scale, u1 = acc[ai][1][m][1] * scale;
                u32x2 w; w.x = pk4_fp8(siluf_(g0[0]) * u0[0], siluf_(g0[1]) * u0[1], siluf_(g0[2]) * u0[2], siluf_(g0[3]) * u0[3]);
                w.y = pk4_fp8(siluf_(g1[0]) * u1[0], siluf_(g1[1]) * u1[1], siluf_(g1[2]) * u1[2], siluf_(g1[3]) * u1[3]);
                *(u32x2*)rowp = w; asm volatile("" ::: "memory"); }
    }
};
struct EpiPool {
    static constexpr bool PERM = true;
    bf16* mrg; const bf16* proj; const float* scale;
    DI void operator()(const f32x4 (&acc)[2][2][4][2], const Unit& u, int wr, int wc, int fr, int fq) const {
        const int row0 = u.pm * BM + wr * 64 + fr, col0 = u.pn * BM + wc * 32 + 8 * fq;
#pragma unroll
        for (int bj = 0; bj < 2; ++bj) { const int c = col0 + bj * HALF; const f32x4 s0 = *(const f32x4*)(scale + c), s1 = *(const f32x4*)(scale + c + 4);
#pragma unroll
            for (int ai = 0; ai < 2; ++ai)
#pragma unroll
                for (int m = 0; m < 4; ++m) { const size_t row = (size_t)(row0 + ai * HALF + m * 16);
                    const u32x4 gv = *(const u32x4*)(proj + row * NINP + C_G + 2048 + c);
                    const f32x4 v0 = acc[ai][bj][m][0] * s0, v1 = acc[ai][bj][m][1] * s1;
                    u32x4 w; w.x = pk2(v0[0] * sigmoidf_(bflo(gv.x)), v0[1] * sigmoidf_(bfhi(gv.x))); w.y = pk2(v0[2] * sigmoidf_(bflo(gv.y)), v0[3] * sigmoidf_(bfhi(gv.y)));
                    w.z = pk2(v1[0] * sigmoidf_(bflo(gv.z)), v1[1] * sigmoidf_(bfhi(gv.z))); w.w = pk2(v1[2] * sigmoidf_(bflo(gv.w)), v1[3] * sigmoidf_(bfhi(gv.w)));
                    *(u32x4*)(mrg + row * MIXW + 2048 + c) = w; asm volatile("" ::: "memory"); } }
    }
};
struct EpiLru {
    static constexpr bool PERM = false;
    unsigned* AB; const bf16* xc; const float* ba; const float* bx; const float* c8sp;
    DI void operator()(const f32x4 (&acc)[2][2][4][2], const Unit& u, int wr, int wc, int fr, int fq) const {
        const int row0 = u.pm * BM + wr * 64 + fr, ch0 = u.pn * HALF + wc * 32 + 4 * fq;
#pragma unroll
        for (int n = 0; n < 2; ++n) { const int ch = ch0 + n * 16; const f32x4 vba = *(const f32x4*)(ba + ch), vbx = *(const f32x4*)(bx + ch), vsp = *(const f32x4*)(c8sp + ch);
#pragma unroll
            for (int ai = 0; ai < 2; ++ai)
#pragma unroll
                for (int m = 0; m < 4; ++m) { const size_t off = (size_t)(row0 + ai * HALF + m * 16) * DM + ch;
                    const u32x2 xv = *(const u32x2*)(xc + off); const float xf[4] = {bflo(xv.x), bfhi(xv.x), bflo(xv.y), bfhi(xv.y)};
                    u32x4 w;
#pragma unroll
                    for (int j = 0; j < 4; ++j) { const float r = sigmoidf_(acc[ai][0][m][n][j] + vba[j]), ig = sigmoidf_(acc[ai][1][m][n][j] + vbx[j]);
                        const float la = -vsp[j] * r; w[j] = pk2(la, __builtin_amdgcn_sqrtf(fmaxf(1.0f - __expf(2.0f * la), 0.f)) * ig * xf[j]); }
                    *(u32x4*)(AB + off) = w; asm volatile("" ::: "memory"); } }
    }
};

#ifndef PG8_ALIGN
#define PG8_ALIGN true
#endif
#ifndef PG8_SP2
#define PG8_SP2 true
#endif
template <class Epi, class Sched, bool F8 = false, bool ALIGN_EPI = PG8_ALIGN, bool SP2 = PG8_SP2>
DI void gemm_phase(LAS unsigned char* lds, const Gemm g, const Sched& S, const Epi& E, const int wave_id) {
    int lane_ = lane_id_(); asm volatile("" : "+v"(lane_));
    const int wid = wave_id, lane = lane_, tid = wid * 64 + lane, wr = wid >> 2, wc = wid & 3, fr = lane & 15, fq = lane >> 4;
    const int nt = g.K / BK;
    unsigned voffA[2], voffB[2];
#pragma unroll
    for (int i = 0; i < 2; ++i) { int R, C; stage_rc(tid * 16 + i * 8192, R, C); const int Rb = Epi::PERM ? ((R & ~31) + perm32(R & 31)) : R;
        voffA[i] = (unsigned)(R * g.lda + C) * 2u; voffB[i] = (unsigned)(Rb * g.ldb + C) * 2u; }
    const size_t kstep = (size_t)(BK * 2);
    const size_t hstepA = (size_t)HALF * g.lda * 2, hstepB = (size_t)HALF * g.ldb * 2;
    const unsigned ldsw = (unsigned)wid * 1024u;
    const int aoff = lds_byte(wr * 64 + fr, fq * 8), boff = lds_byte(wc * 32 + fr, fq * 8);
#define PG8_SA(b, h) (((b) * 2 + (h)) * HTB)
#define PG8_SB(b, h) ((4 + (b) * 2 + (h)) * HTB)
#define PG8_STAGE(bufoff, gbase, voff) do { _Pragma("unroll") for (int _i = 0; _i < 2; ++_i) \
        __builtin_amdgcn_global_load_lds((const unsigned*)((const char*)(gbase) + (voff)[_i]), (LAS unsigned*)(lds + (bufoff) + ldsw + _i * 8192), 16, 0, 0); } while (0)
#define PG8_LDA(dst, b, h) do { _Pragma("unroll") for (int m = 0; m < 4; ++m) _Pragma("unroll") for (int k = 0; k < 2; ++k) dst[m][k] = *(const LAS bf16x8*)(lds + PG8_SA(b, h) + aoff + m * 2048 + k * 1024); } while (0)
#define PG8_LDB(dst, b, h) do { _Pragma("unroll") for (int n = 0; n < 2; ++n) _Pragma("unroll") for (int k = 0; k < 2; ++k) dst[n][k] = *(const LAS bf16x8*)(lds + PG8_SB(b, h) + boff + n * 2048 + k * 1024); } while (0)
#define PG8_F8CAT(x) __builtin_shufflevector(__builtin_bit_cast(i32x4, (x)[0]), __builtin_bit_cast(i32x4, (x)[1]), 0, 1, 2, 3, 4, 5, 6, 7)
#define PG8_MMA(ai, bj, At, Bt) do { __builtin_amdgcn_s_setprio(1); _Pragma("unroll") for (int m = 0; m < 4; ++m) _Pragma("unroll") for (int n = 0; n < 2; ++n) { \
        if constexpr (F8) { const i32x8 fa_ = PG8_F8CAT(Bt[n]), fb_ = PG8_F8CAT(At[m]); asm volatile("v_mfma_scale_f32_16x16x128_f8f6f4 %0, %1, %2, %0, %3, %3 op_sel_hi:[0,0,0]" : "+v"(acc[ai][bj][m][n]) : "v"(fa_), "v"(fb_), "v"(f8one)); } \
        else { _Pragma("unroll") for (int k = 0; k < 2; ++k) acc[ai][bj][m][n] = __builtin_amdgcn_mfma_f32_16x16x32_bf16(Bt[n][k], At[m][k], acc[ai][bj][m][n], 0, 0, 0); } } \
        __builtin_amdgcn_s_setprio(0); } while (0)
#define PG8_WAIT_V(n) asm volatile("s_waitcnt vmcnt(" #n ")" ::: "memory")
#define PG8_WAIT_L(n) asm volatile("s_waitcnt lgkmcnt(" #n ")" ::: "memory")
#define PG8_BAR __builtin_amdgcn_s_barrier()
#define PG8_SCHED __builtin_amdgcn_sched_barrier(0)
    int f8one = 0x7f7f7f7f; asm volatile("" : "+v"(f8one));
    Unit cur, nxt; int ui = 0;
    if (!S.next(0, cur)) return;
    f32x4 acc[2][2][4][2];
#pragma unroll
    for (int a = 0; a < 2; ++a)
#pragma unroll
        for (int b = 0; b < 2; ++b)
#pragma unroll
            for (int m = 0; m < 4; ++m)
#pragma unroll
                for (int n = 0; n < 2; ++n) acc[a][b][m][n] = (f32x4){0.f, 0.f, 0.f, 0.f};
    bf16x8 At[4][2], B0[2][2], B1[2][2];
    const char* cA = (const char*)g.A + S.aoff(cur); const char* cB = (const char*)g.Bt + S.boff(cur);
    if constexpr (SP2) {
        PG8_STAGE(PG8_SB(0, 0), cB, voffB); PG8_STAGE(PG8_SB(0, 1), cB + hstepB, voffB); PG8_STAGE(PG8_SA(0, 0), cA, voffA); PG8_STAGE(PG8_SA(0, 1), cA + hstepA, voffA);
        if (wr == 1) PG8_BAR;
        PG8_WAIT_V(2); PG8_BAR;
        PG8_STAGE(PG8_SB(1, 0), cB + kstep, voffB); PG8_STAGE(PG8_SA(1, 0), cA + kstep, voffA); PG8_STAGE(PG8_SB(1, 1), cB + hstepB + kstep, voffB);
        PG8_WAIT_V(6); PG8_BAR;
    } else {
        PG8_STAGE(PG8_SB(0, 0), cB, voffB); PG8_STAGE(PG8_SA(0, 0), cA, voffA); PG8_STAGE(PG8_SB(0, 1), cB + hstepB, voffB); PG8_STAGE(PG8_SA(0, 1), cA + hstepA, voffA);
        if (wr == 1) PG8_BAR;
        PG8_WAIT_V(4); PG8_BAR;
        PG8_STAGE(PG8_SB(1, 0), cB + kstep, voffB); PG8_STAGE(PG8_SA(1, 0), cA + kstep, voffA); PG8_STAGE(PG8_SB(1, 1), cB + hstepB + kstep, voffB);
        PG8_WAIT_V(6); PG8_BAR;
    }
    for (;;) {
        const bool has_next = S.next(ui + 1, nxt);
        const char* nA = has_next ? (const char*)g.A + S.aoff(nxt) : cA; const char* nB = has_next ? (const char*)g.Bt + S.boff(nxt) : cB;
#pragma nounroll
        for (int t = 0; t < nt; t += 2) {
            const bool last = (t == nt - 2);
            const char* a1 = cA + (size_t)(t + 1) * kstep;
            const char* a2 = last ? nA : cA + (size_t)(t + 2) * kstep; const char* b2 = last ? nB : cB + (size_t)(t + 2) * kstep;
            const char* a3 = a2 + kstep; const char* b3 = b2 + kstep;
            if constexpr (SP2) {
            PG8_LDB(B0, 0, 0); PG8_LDB(B1, 0, 1); PG8_SCHED; PG8_LDA(At, 0, 0); PG8_STAGE(PG8_SA(1, 1), a1 + hstepA, voffA);
            PG8_WAIT_V(8); PG8_WAIT_L(0); PG8_BAR; PG8_MMA(0, 0, At, B0); PG8_MMA(0, 1, At, B1); PG8_BAR; PG8_SCHED;
            PG8_LDA(At, 0, 1); PG8_STAGE(PG8_SB(0, 0), b2, voffB); PG8_STAGE(PG8_SB(0, 1), b2 + hstepB, voffB); PG8_STAGE(PG8_SA(0, 0), a2, voffA);
            PG8_WAIT_V(8); PG8_WAIT_L(0); PG8_BAR; PG8_MMA(1, 0, At, B0); PG8_MMA(1, 1, At, B1); PG8_BAR; PG8_SCHED;
            PG8_LDB(B0, 1, 0); PG8_LDB(B1, 1, 1); PG8_SCHED; PG8_LDA(At, 1, 0); PG8_STAGE(PG8_SA(0, 1), a2 + hstepA, voffA);
            PG8_WAIT_V(8); PG8_WAIT_L(0); PG8_BAR; PG8_MMA(0, 0, At, B0); PG8_MMA(0, 1, At, B1); PG8_BAR; PG8_SCHED;
            PG8_LDA(At, 1, 1); PG8_STAGE(PG8_SB(1, 0), b3, voffB); PG8_STAGE(PG8_SB(1, 1), b3 + hstepB, voffB); PG8_STAGE(PG8_SA(1, 0), a3, voffA);
            PG8_WAIT_V(8); PG8_WAIT_L(0); PG8_BAR; PG8_MMA(1, 0, At, B0); PG8_MMA(1, 1, At, B1); PG8_BAR; PG8_SCHED;
            } else {
            PG8_LDB(B0, 0, 0); PG8_SCHED; PG8_LDA(At, 0, 0); PG8_STAGE(PG8_SA(1, 1), a1 + hstepA, voffA);
            PG8_WAIT_L(8); PG8_BAR; PG8_WAIT_L(0); PG8_MMA(0, 0, At, B0); PG8_BAR; PG8_SCHED;
            PG8_LDB(B1, 0, 1); PG8_STAGE(PG8_SB(0, 0), b2, voffB);
            PG8_BAR; PG8_WAIT_L(0); PG8_MMA(0, 1, At, B1); PG8_BAR;
            PG8_LDA(At, 0, 1); PG8_STAGE(PG8_SA(0, 0), a2, voffA);
            PG8_BAR; PG8_WAIT_L(0); PG8_MMA(1, 0, At, B0); PG8_BAR; PG8_SCHED;
            PG8_STAGE(PG8_SB(0, 1), b2 + hstepB, voffB);
            PG8_WAIT_V(6); PG8_BAR; PG8_MMA(1, 1, At, B1); PG8_BAR;
            PG8_LDB(B0, 1, 0); PG8_SCHED; PG8_LDA(At, 1, 0); PG8_STAGE(PG8_SA(0, 1), a2 + hstepA, voffA);
            PG8_WAIT_L(8); PG8_BAR; PG8_WAIT_L(0); PG8_MMA(0, 0, At, B0); PG8_BAR; PG8_SCHED;
            PG8_LDB(B1, 1, 1); PG8_STAGE(PG8_SB(1, 0), b3, voffB);
            PG8_BAR; PG8_WAIT_L(0); PG8_MMA(0, 1, At, B1); PG8_BAR;
            PG8_LDA(At, 1, 1); PG8_STAGE(PG8_SA(1, 0), a3, voffA);
            PG8_BAR; PG8_WAIT_L(0); PG8_MMA(1, 0, At, B0); PG8_BAR; PG8_SCHED;
            PG8_STAGE(PG8_SB(1, 1), b3 + hstepB, voffB);
            PG8_WAIT_V(6); PG8_BAR; PG8_MMA(1, 1, At, B1); PG8_BAR;
            }
        }
        if constexpr (ALIGN_EPI) { if (wr == 0) PG8_BAR; }
        if constexpr (F8) asm volatile("s_nop 15\n\ts_nop 15" ::: "memory");
        E(acc, cur, wr, wc, fr, fq);
        if (!has_next) break;
#pragma unroll
        for (int a = 0; a < 2; ++a)
#pragma unroll
            for (int b = 0; b < 2; ++b)
#pragma unroll
                for (int m = 0; m < 4; ++m)
#pragma unroll
                    for (int n = 0; n < 2; ++n) acc[a][b][m][n] = (f32x4){0.f, 0.f, 0.f, 0.f};
        cur = nxt; cA = nA; cB = nB; ++ui;
        if constexpr (ALIGN_EPI) { if (wr == 1) PG8_BAR; }
    }
    PG8_WAIT_V(0);
    if constexpr (!ALIGN_EPI) { if (wr == 0) PG8_BAR; }
    PG8_BAR;
#undef PG8_SA
#undef PG8_SB
#undef PG8_STAGE
#undef PG8_LDA
#undef PG8_LDB
#undef PG8_MMA
#undef PG8_F8CAT
#undef PG8_WAIT_V
#undef PG8_WAIT_L
#undef PG8_BAR
#undef PG8_SCHED
}
}

struct Args { const void* in[24]; float* out; unsigned char* ws; int ph_lo, ph_hi; };
struct Frame {
    LAS unsigned char* lds; unsigned* ctl; unsigned char* ws;
    int tid, lane, wave, G, bid;
};
#define INF(k) ((const float*)args.in[k])
DI float wave_sum(float v) {
#pragma unroll
    for (int o = 1; o < 64; o <<= 1) v += __shfl_xor(v, o);
    return v;
}

constexpr float F8_WSCALE = 64.0f;
DI void tr_item(const float* W, int ldS, int Nvalid, bf16* WT, int ldD, int koff, int mode, int roff, LAS float* scr, int k0, int n0, int lane, bool f8 = false) {
    const int nl = n0 + (lane & 31);
    float tv[32]; const float* wp = W + (size_t)(k0 + (lane >> 5)) * ldS + nl; const bool ok = nl < Nvalid;
#pragma unroll
    for (int i = 0; i < 32; ++i) tv[i] = ok ? __builtin_nontemporal_load(wp + (size_t)(2 * i) * ldS) : 0.f;
#pragma unroll
    for (int i = 0; i < 32; ++i) scr[(2 * i + (lane >> 5)) * 33 + (lane & 31)] = tv[i];
    LDS_WAIT(); asm volatile("" ::: "memory");
    const int c = lane & 7;
#pragma unroll
    for (int j = 0; j < 4; ++j) { const int nn = (lane >> 3) + 8 * j, n = n0 + nn; const LAS float* s = scr + (8 * c) * 33 + nn;
        u32x4 o; o.x = pk2(s[0 * 33], s[1 * 33]); o.y = pk2(s[2 * 33], s[3 * 33]); o.z = pk2(s[4 * 33], s[5 * 33]); o.w = pk2(s[6 * 33], s[7 * 33]);
        const int row = mode == 0 ? roff + n : (mode == 1 ? (n < C_PADLO ? n : n + (C_P - C_PADLO)) : ((n >> 7) << 8) + roff + (n & 127));
        if (n < Nvalid) { if (f8) { u32x2 o8; o8.x = pk4_fp8(s[0 * 33] * F8_WSCALE, s[1 * 33] * F8_WSCALE, s[2 * 33] * F8_WSCALE, s[3 * 33] * F8_WSCALE); o8.y = pk4_fp8(s[4 * 33] * F8_WSCALE, s[5 * 33] * F8_WSCALE, s[6 * 33] * F8_WSCALE, s[7 * 33] * F8_WSCALE);
                *(u32x2*)((unsigned char*)WT + (size_t)row * ldD + koff + k0 + 8 * c) = o8; }
            else *(u32x4*)(WT + (size_t)row * ldD + koff + k0 + 8 * c) = o; } }
    LDS_WAIT(); asm volatile("" ::: "memory");
}
constexpr int NB_IN = (NIN + 31) / 32;
constexpr int CI_IN = 32 * NB_IN, CI_OUT = 96 * 64, CI_POOL = 8 * 8 * 16, CI_LRU = 64 * 8, CI_GU = 2 * 32 * 172, CI_DN = 86 * 64, CI_MGU = 16 * 32 * 224, CI_MDN = 8 * 112 * 64;
constexpr int CE_0 = CI_IN + CI_POOL + CI_LRU;
constexpr int CE_1 = CE_0 + CI_OUT;
constexpr int CE_2 = CE_1 + CI_GU;
constexpr int CE_3 = CE_2 + CI_DN;
constexpr int CE_4 = CE_3 + CI_IN;
constexpr int CE_5 = CE_4 + CI_OUT;
constexpr int CE_6 = CE_5 + CI_MGU;
constexpr int CE_7 = CE_6 + CI_MDN;
constexpr int MOE_EARLY = 224 * 8 * 14;
constexpr int P2_ITEMS = 224 * 8 * 4;
DI void conv_item(unsigned char* ws, const Args& args, int idx, LAS float* scr, int lane) {
    const float* W; bf16* WT; int ldS, Nv, ldD, koff = 0, mode = 0, roff = 0, kb, nb; int r = idx; bool f8 = false;
    if (r < CI_IN) { kb = r / NB_IN; nb = r % NB_IN; W = INF(2); ldS = NIN; Nv = NIN; WT = (bf16*)(ws + WS_WIN); ldD = DM; mode = 1; }
    else if ((r -= CI_IN) < CI_POOL) { const int lg = r >> 7, q = r & 127; kb = q >> 4; nb = q & 15; W = INF(4) + (size_t)lg * 512 * 512; ldS = 512; Nv = 512; WT = (bf16*)(ws + WS_WPOOL) + (size_t)(lg >> 2) * 2048 * 512; ldD = 512; roff = (lg & 3) * 512; }
    else if ((r -= CI_POOL) < CI_LRU) { const int cmb = r >> 3, q = r & 7, l = cmb >> 5, which = (cmb >> 4) & 1, n = cmb & 15; kb = q >> 2; nb = q & 3;
        W = (which ? INF(10) : INF(8)) + ((size_t)l * 16 + n) * 128 * 128; ldS = 128; Nv = 128; WT = (bf16*)(ws + WS_WLRU) + (size_t)l * 4096 * 256; ldD = 256; koff = (n & 1) * 128; roff = n * 256 + which * 128; }
    else if ((r -= CI_LRU) < CI_OUT) { kb = r >> 6; nb = r & 63; W = INF(3); ldS = DM; Nv = DM; WT = (bf16*)(ws + WS_WOUT); ldD = MIXW; }
    else if ((r -= CI_OUT) < CI_GU) { const int which = r / (32 * 172), q = r % (32 * 172); kb = q / 172; nb = q % 172; W = which ? INF(18) : INF(17); ldS = DFF; Nv = DFF; WT = (bf16*)(ws + WS_WGU); ldD = DM; mode = 2; roff = which * 128; }
    else if ((r -= CI_GU) < CI_DN) { kb = r >> 6; nb = r & 63; W = INF(19); ldS = DM; Nv = DM; WT = (bf16*)(ws + WS_WDN); ldD = DFF; }
    else if ((r -= CI_DN) < CI_IN) { kb = r / NB_IN; nb = r % NB_IN; W = INF(2) + (size_t)DM * NIN; ldS = NIN; Nv = NIN; WT = (bf16*)(ws + WS_WIN) + (size_t)NINP * DM; ldD = DM; mode = 1; }
    else if ((r -= CI_IN) < CI_OUT) { kb = r >> 6; nb = r & 63; W = INF(3) + (size_t)MIXW * DM; ldS = DM; Nv = DM; WT = (bf16*)(ws + WS_WOUT) + (size_t)DM * MIXW; ldD = MIXW; }
    else if ((r -= CI_OUT) < CI_MGU) { const int ew = r / (32 * 224), q = r % (32 * 224), e = ew >> 1, which = ew & 1; kb = q / 224; nb = q % 224;
        W = (which ? INF(22) : INF(21)) + (size_t)e * DM * DEXP; ldS = DEXP; Nv = DEXP; WT = (bf16*)(ws + WS_MWGU + (size_t)e * 2 * DEXP * DM); ldD = DM; mode = 2; roff = which * 128; f8 = true; }
    else { r -= CI_MGU; const int e = r / (112 * 64), q = r % (112 * 64); kb = q >> 6; nb = q & 63; W = INF(23) + (size_t)e * DEXP * DM; ldS = DM; Nv = DM; WT = (bf16*)(ws + WS_MWDN + (size_t)e * DM * DEXP); ldD = DEXP; f8 = true; }
    tr_item(W, ldS, Nv, WT, ldD, koff, mode, roff, scr, 64 * kb, 32 * nb, lane, f8);
}
DI void conv_range(Frame& F, const Args& args, int i0, int i1, int wg0) {
    if (F.bid < wg0) return;
    LAS float* scr = (LAS float*)(F.lds + F.wave * 16384);
    const int gw = (F.bid - wg0) * 8 + F.wave, NGW = (F.G - wg0) * 8;
    for (int it = i0 + gw; it < i1; it += NGW) conv_item(F.ws, args, it, scr, F.lane);
}
DI void p0_prologue(Frame& F, const Args& args) {
    conv_range(F, args, 0, CE_0, 0);
    bf16* Wlru = (bf16*)(F.ws + WS_WLRU);
    const int gt = F.bid * 512 + F.tid, NT = F.G * 512;
    for (int i = gt; i < 2 * 4096 * 16; i += NT) { const int row = i >> 4, ch = i & 15, n = (row & 4095) >> 8;
        *(u32x4*)(Wlru + (size_t)row * 256 + ((n + 1) & 1) * 128 + ch * 8) = (u32x4){0u, 0u, 0u, 0u}; }
    float* cosA = (float*)(F.ws + WS_COSA); float* sinA = (float*)(F.ws + WS_SINA); float* cosI = (float*)(F.ws + WS_COSI); float* sinI = (float*)(F.ws + WS_SINI);
    for (int i = gt; i < MTOK * 96; i += NT) {
        const int tok = i / 96, j = i % 96; const bool isA = j < 64; const int fi = isA ? j : j - 64; const double dim = isA ? 128.0 : 64.0;
        const float inv = (float)pow(10000.0, -(double)(2 * fi) / dim);
        const float ang = (float)((const int*)args.in[1])[tok] * inv; const double a = (double)ang; const double nrev = rint(a * 0.15915494309189535); const double rr = a - nrev * 6.283185307179586;
        const float cv = (float)cos(rr), sv = (float)sin(rr);
        if (isA) { cosA[tok * 64 + fi] = cv; sinA[tok * 64 + fi] = sv; } else { cosI[tok * 32 + fi] = cv; sinI[tok * 32 + fi] = sv; }
    }
    float* c8 = (float*)(F.ws + WS_LRUC);
    for (int i = gt; i < 2 * DM; i += NT) { const float lam = INF(12)[i]; c8[i] = 8.0f * log1pf(expf(-lam)); }
    bf16* xb = (bf16*)(F.ws + WS_XB);
    for (int i = gt; i < MTOK * DM / 8; i += NT) { const f32x4 a = *(const f32x4*)(INF(0) + (size_t)i * 8), b = *(const f32x4*)(INF(0) + (size_t)i * 8 + 4);
        u32x4 o; o.x = pk2(a[0], a[1]); o.y = pk2(a[2], a[3]); o.z = pk2(b[0], b[1]); o.w = pk2(b[2], b[3]); *(u32x4*)(xb + (size_t)i * 8) = o; }
}

DI void ld8(const bf16* p, float (&v)[8]) { const u32x4 w = *(const u32x4*)p; v[0] = bflo(w.x); v[1] = bfhi(w.x); v[2] = bflo(w.y); v[3] = bfhi(w.y); v[4] = bflo(w.z); v[5] = bfhi(w.z); v[6] = bflo(w.w); v[7] = bfhi(w.w); }
DI void st8(bf16* p, const float (&v)[8]) { u32x4 o; o.x = pk2(v[0], v[1]); o.y = pk2(v[2], v[3]); o.z = pk2(v[4], v[5]); o.w = pk2(v[6], v[7]); *(u32x4*)p = o; }

DI void acc8(float (&s)[8], const u32x4& r, float m) { s[0] += m * bflo(r.x); s[1] += m * bfhi(r.x); s[2] += m * bflo(r.y); s[3] += m * bfhi(r.y); s[4] += m * bflo(r.z); s[5] += m * bfhi(r.z); s[6] += m * bflo(r.w); s[7] += m * bfhi(r.w); }
template <int G>
DI void pool_range(const bf16* proj, bf16* diff, int tok0, int c) {
    constexpr int W = 2 << G, NR = W - 1 + 16;
    const int tpos0 = tok0 & (SEQ - 1);
    const bf16* pp = proj + (size_t)tok0 * NINP + C_P + c;
    u32x4 r[NR];
#pragma unroll
    for (int i = 0; i < NR; ++i) { const int back = (W - 1) - i; r[i] = *(const u32x4*)(pp - (ptrdiff_t)((back > 0 && tpos0 - back < 0) ? 0 : back) * NINP); }
    float s[8];
#pragma unroll
    for (int k = 0; k < 8; ++k) s[k] = 0.f;
#pragma unroll
    for (int i = 0; i < W - 1; ++i) acc8(s, r[i], (tpos0 - ((W - 1) - i) >= 0) ? 1.f : 0.f);
#pragma unroll
    for (int t = 0; t < 16; ++t) {
        acc8(s, r[W - 1 + t], 1.f);
        const int tpos = tpos0 + t, cnt = (tpos + 1) < W ? (tpos + 1) : W; const float rc = 1.0f / (float)cnt; const u32x4 cur = r[W - 1 + t];
        float v[8] = {s[0] * rc - bflo(cur.x), s[1] * rc - bfhi(cur.x), s[2] * rc - bflo(cur.y), s[3] * rc - bfhi(cur.y), s[4] * rc - bflo(cur.z), s[5] * rc - bfhi(cur.z), s[6] * rc - bflo(cur.w), s[7] * rc - bfhi(cur.w)};
        st8(diff + (size_t)(tok0 + t) * DM + c, v);
        acc8(s, r[t], (tpos - (W - 1) >= 0) ? -1.f : 0.f);
    }
}
DI void p2_prep(Frame& F, const Args& args, int layer) {
    bf16* proj = (bf16*)(F.ws + WS_PROJ); bf16* diff = (bf16*)(F.ws + WS_DIFF); bf16* xc = (bf16*)(F.ws + WS_XC);
    const float* cosA = (const float*)(F.ws + WS_COSA); const float* sinA = (const float*)(F.ws + WS_SINA); const float* cosI = (const float*)(F.ws + WS_COSI); const float* sinI = (const float*)(F.ws + WS_SINI);
    const int gt = F.bid * 512 + F.tid, NT = F.G * 512;
    for (int it = gt; it < MTOK * 32; it += NT) {
        const int tok = it >> 5, dch = it & 7, hq = (it >> 3) & 3, d = dch * 8;
        const float* ct = cosA + tok * 64 + d; const float* st = sinA + tok * 64 + d;
        const f32x4 c0 = *(const f32x4*)ct, c1 = *(const f32x4*)(ct + 4), s0 = *(const f32x4*)st, s1 = *(const f32x4*)(st + 4);
        bf16* base = proj + (size_t)tok * NINP;
        u32x4 xa[5], xb_[5];
#pragma unroll
        for (int q = 0; q < 5; ++q) { bf16* p1 = base + (q < 4 ? C_Q + (hq * 4 + q) * 128 : C_K + hq * 128) + d; xa[q] = *(const u32x4*)p1; xb_[q] = *(const u32x4*)(p1 + 64); }
#pragma unroll
        for (int q = 0; q < 5; ++q) { bf16* p1 = base + (q < 4 ? C_Q + (hq * 4 + q) * 128 : C_K + hq * 128) + d;
            const float x1[8] = {bflo(xa[q].x), bfhi(xa[q].x), bflo(xa[q].y), bfhi(xa[q].y), bflo(xa[q].z), bfhi(xa[q].z), bflo(xa[q].w), bfhi(xa[q].w)};
            const float x2[8] = {bflo(xb_[q].x), bfhi(xb_[q].x), bflo(xb_[q].y), bfhi(xb_[q].y), bflo(xb_[q].z), bfhi(xb_[q].z), bflo(xb_[q].w), bfhi(xb_[q].w)};
            float y1[8], y2[8];
#pragma unroll
            for (int i = 0; i < 8; ++i) { const float c = i < 4 ? c0[i & 3] : c1[i & 3], s = i < 4 ? s0[i & 3] : s1[i & 3]; y1[i] = x1[i] * c - x2[i] * s; y2[i] = x2[i] * c + x1[i] * s; }
            st8(p1, y1); st8(p1 + 64, y2); }
    }
    for (int it = gt; it < MTOK * 16; it += NT) {
        const int tok = it >> 4, dch = it & 3, hq = (it >> 2) & 3, d = dch * 8;
        const float* ct = cosI + tok * 32 + d; const float* st = sinI + tok * 32 + d;
        const f32x4 c0 = *(const f32x4*)ct, c1 = *(const f32x4*)(ct + 4), s0 = *(const f32x4*)st, s1 = *(const f32x4*)(st + 4);
        bf16* base = proj + (size_t)tok * NINP;
        u32x4 xa[5], xb_[5];
#pragma unroll
        for (int q = 0; q < 5; ++q) { bf16* p1 = base + (q < 4 ? C_QI + (hq * 4 + q) * 64 : C_KI) + d; xa[q] = *(const u32x4*)p1; xb_[q] = *(const u32x4*)(p1 + 32); }
#pragma unroll
        for (int q = 0; q < 5; ++q) { if (q < 4 || hq == 0) { bf16* p1 = base + (q < 4 ? C_QI + (hq * 4 + q) * 64 : C_KI) + d;
            const float x1[8] = {bflo(xa[q].x), bfhi(xa[q].x), bflo(xa[q].y), bfhi(xa[q].y), bflo(xa[q].z), bfhi(xa[q].z), bflo(xa[q].w), bfhi(xa[q].w)};
            const float x2[8] = {bflo(xb_[q].x), bfhi(xb_[q].x), bflo(xb_[q].y), bfhi(xb_[q].y), bflo(xb_[q].z), bfhi(xb_[q].z), bflo(xb_[q].w), bfhi(xb_[q].w)};
            float y1[8], y2[8];
#pragma unroll
            for (int i = 0; i < 8; ++i) { const float c = i < 4 ? c0[i & 3] : c1[i & 3], s = i < 4 ? s0[i & 3] : s1[i & 3]; y1[i] = x1[i] * c - x2[i] * s; y2[i] = x2[i] * c + x1[i] * s; }
            st8(p1, y1); st8(p1 + 32, y2); } }
    }
    const float* cw = INF(6) + (size_t)layer * 4 * DM; const float* cb = INF(7) + (size_t)layer * DM;
    for (int it = gt; it < (MTOK / 16) * 256; it += NT) {
        const int cg = it & 255, c = cg * 8, tok0 = (it >> 8) * 16;
        const int g = cg >> 6;
        if (g == 0) pool_range<0>(proj, diff, tok0, c); else if (g == 1) pool_range<1>(proj, diff, tok0, c); else if (g == 2) pool_range<2>(proj, diff, tok0, c); else pool_range<3>(proj, diff, tok0, c);
    }
    for (int it = gt; it < (MTOK / 16) * 256; it += NT) {
        const int cg = it & 255, c = cg * 8, tok0 = (it >> 8) * 16, tpos0 = tok0 & (SEQ - 1);
        const bf16* px = proj + (size_t)tok0 * NINP + C_XR + c;
        u32x4 r[19];
#pragma unroll
        for (int i = 0; i < 19; ++i) { const int back = 3 - i; r[i] = *(const u32x4*)(px - (ptrdiff_t)((back > 0 && tpos0 - back < 0) ? 0 : back) * NINP); }
        f32x4 w0[4], w1[4]; const f32x4 b0 = *(const f32x4*)(cb + c), b1 = *(const f32x4*)(cb + c + 4);
#pragma unroll
        for (int jj = 0; jj < 4; ++jj) { w0[jj] = *(const f32x4*)(cw + jj * DM + c); w1[jj] = *(const f32x4*)(cw + jj * DM + c + 4); }
#pragma unroll
        for (int t = 0; t < 16; ++t) {
            float acc[8] = {b0[0], b0[1], b0[2], b0[3], b1[0], b1[1], b1[2], b1[3]};
#pragma unroll
            for (int jj = 0; jj < 4; ++jj) { const float m = (tpos0 + t - (3 - jj) >= 0) ? 1.f : 0.f; const u32x4 x = r[t + jj];
                acc[0] += m * bflo(x.x) * w0[jj][0]; acc[1] += m * bfhi(x.x) * w0[jj][1]; acc[2] += m * bflo(x.y) * w0[jj][2]; acc[3] += m * bfhi(x.y) * w0[jj][3];
                acc[4] += m * bflo(x.z) * w1[jj][0]; acc[5] += m * bfhi(x.z) * w1[jj][1]; acc[6] += m * bflo(x.w) * w1[jj][2]; acc[7] += m * bfhi(x.w) * w1[jj][3]; }
            st8(xc + (size_t)(tok0 + t) * DM + c, acc);
        }
    }
}

DI void p3_indexer(Frame& F) {
    const bf16* proj = (const bf16*)(F.ws + WS_PROJ); float* sc = (float*)(F.ws + WS_SC);
    const int gw = F.bid * 8 + F.wave, NGW = F.G * 8, l15 = F.lane & 15, l4 = F.lane >> 4;
    for (int u = gw; u < BATCH * 576; u += NGW) {
        const int b = u / 576, r = u % 576; int g8 = 0;
#pragma unroll
        for (int k = 1; k < 8; ++k) g8 = (r >= 8 * k * (k + 1)) ? k : g8;
        const int rr = r - 8 * g8 * (g8 + 1), sp = rr % (g8 + 1), qq = rr / (g8 + 1), qb16 = g8 * 16 + qq, c = qb16 >> 2;
        const int limit = (c + 1) * 64, kbeg = sp * 256, kend = (kbeg + 256) < limit ? (kbeg + 256) : limit;
        const int qtok = b * SEQ + qb16 * 16 + l15;
        const bf16* qrow = proj + (size_t)qtok * NINP;
        bf16x8 qf[16][2]; float w[16];
        { const u32x4 w0 = *(const u32x4*)(qrow + C_WI), w1 = *(const u32x4*)(qrow + C_WI + 8); const float s = 0.125f * 0.25f;
          w[0] = bflo(w0.x) * s; w[1] = bfhi(w0.x) * s; w[2] = bflo(w0.y) * s; w[3] = bfhi(w0.y) * s; w[4] = bflo(w0.z) * s; w[5] = bfhi(w0.z) * s; w[6] = bflo(w0.w) * s; w[7] = bfhi(w0.w) * s;
          w[8] = bflo(w1.x) * s; w[9] = bfhi(w1.x) * s; w[10] = bflo(w1.y) * s; w[11] = bfhi(w1.y) * s; w[12] = bflo(w1.z) * s; w[13] = bfhi(w1.z) * s; w[14] = bflo(w1.w) * s; w[15] = bfhi(w1.w) * s; }
#pragma unroll
        for (int h = 0; h < 16; ++h)
#pragma unroll
            for (int ks = 0; ks < 2; ++ks) qf[h][ks] = *(const bf16x8*)(qrow + C_QI + h * 64 + ks * 32 + l4 * 8);
        const bf16* kbase = proj + (size_t)(b * SEQ + l15) * NINP + C_KI + l4 * 8;
        bf16x8 nk0 = *(const bf16x8*)(kbase + (size_t)kbeg * NINP), nk1 = *(const bf16x8*)(kbase + (size_t)kbeg * NINP + 32);
        for (int k0 = kbeg; k0 < kend; k0 += 16) {
            const bf16x8 ka0 = nk0, ka1 = nk1;
            { const int kn = (k0 + 16 < kend) ? k0 + 16 : k0; nk0 = *(const bf16x8*)(kbase + (size_t)kn * NINP); nk1 = *(const bf16x8*)(kbase + (size_t)kn * NINP + 32); }
            f32x4 tot = {0.f, 0.f, 0.f, 0.f};
#pragma unroll
            for (int h = 0; h < 16; ++h) { f32x4 s = {0.f, 0.f, 0.f, 0.f};
                s = __builtin_amdgcn_mfma_f32_16x16x32_bf16(ka0, qf[h][0], s, 0, 0, 0); s = __builtin_amdgcn_mfma_f32_16x16x32_bf16(ka1, qf[h][1], s, 0, 0, 0);
#pragma unroll
                for (int j = 0; j < 4; ++j) tot[j] += w[h] * fmaxf(s[j], 0.f); }
            *(f32x4*)(sc + (size_t)qtok * SEQ + k0 + 4 * l4) = tot;
        }
    }
}

DI void p4_select(Frame& F) {
    const float* sc = (const float*)(F.ws + WS_SC); unsigned* mask = (unsigned*)(F.ws + WS_MASK);
    const int gw = F.bid * 8 + F.wave, NGW = F.G * 8, lane = F.lane;
    for (int tok = gw; tok < MTOK; tok += NGW) {
        const int tpos = tok & (SEQ - 1), limit = ((tpos >> 6) + 1) * 64, nw = limit >> 5;
        unsigned mw = 0u;
        if (limit <= 256) { mw = lane < nw ? 0xffffffffu : 0u; }
        else {
            unsigned key[32];
            if (lane < nw) { const float* p = sc + (size_t)tok * SEQ + lane * 32;
#pragma unroll
                for (int q = 0; q < 8; ++q) { const f32x4 v = *(const f32x4*)(p + 4 * q);
#pragma unroll
                    for (int j = 0; j < 4; ++j) { const unsigned uu = __float_as_uint(v[j]); key[4 * q + j] = (uu & 0x80000000u) ? ~uu : (uu | 0x80000000u); } } }
            else {
#pragma unroll
                for (int j = 0; j < 32; ++j) key[j] = 0u; }
            unsigned T = 0u; bool exact = false;
            for (int bit = 31; bit >= 0; --bit) {
                const unsigned cand = T | (1u << bit); int cnt = 0;
#pragma unroll
                for (int j = 0; j < 32; ++j) cnt += __popcll(__ballot(key[j] >= cand));
                if (cnt >= 256) { T = cand; if (cnt == 256) { exact = true; break; } }
            }
            unsigned gtw = 0u, eqw = 0u;
#pragma unroll
            for (int j = 0; j < 32; ++j) { gtw |= (key[j] > T) ? (1u << j) : 0u; eqw |= (key[j] == T) ? (1u << j) : 0u; }
            if (exact) { mw = gtw | eqw; }
            else {
                int ngt = 0;
#pragma unroll
                for (int j = 0; j < 32; ++j) ngt += __popcll(__ballot(key[j] > T));
                const int need = 256 - ngt; const int el = __popc(eqw);
                int pre = el;
#pragma unroll
                for (int o = 1; o < 64; o <<= 1) { const int t = __shfl_up(pre, o); pre += (lane >= o) ? t : 0; }
                int take = need - (pre - el); take = take < 0 ? 0 : (take > el ? el : take);
                unsigned sel = 0u, rem = eqw;
                for (int t = 0; t < 32; ++t) { if (t < take) { const unsigned low = rem & (0u - rem); sel |= low; rem ^= low; } }
                mw = gtw | sel;
            }
        }
        mask[(size_t)tok * 64 + lane] = mw;
    }
}

DI void p4_lru_pass1(Frame& F) {
    const unsigned* AB = (const unsigned*)(F.ws + WS_A); float* CP = (float*)(F.ws + WS_CARRY); float* CH = CP + BATCH * 64 * DM;
    for (int u = F.bid; u < BATCH * 64; u += F.G) {
        const int j = u & 63, b = u >> 6, c = 4 * F.tid;
        const size_t base = ((size_t)b * SEQ + j * 32) * DM + c;
        u32x4 w[32];
#pragma unroll
        for (int t = 0; t < 32; ++t) w[t] = *(const u32x4*)(AB + base + (size_t)t * DM);
        f32x4 P = {1.f, 1.f, 1.f, 1.f}, H = {0.f, 0.f, 0.f, 0.f};
#pragma unroll
        for (int t = 0; t < 32; ++t) { const f32x4 a = {__expf(bflo(w[t].x)), __expf(bflo(w[t].y)), __expf(bflo(w[t].z)), __expf(bflo(w[t].w))}, bb = {bfhi(w[t].x), bfhi(w[t].y), bfhi(w[t].z), bfhi(w[t].w)};
            H = a * H + bb; P = P * a; }
        *(f32x4*)(CP + ((size_t)b * 64 + j) * DM + c) = P; *(f32x4*)(CH + ((size_t)b * 64 + j) * DM + c) = H;
    }
}
DI void p5_lru_pass2(Frame& F) {
    const unsigned* AB = (const unsigned*)(F.ws + WS_A); const float* CP = (const float*)(F.ws + WS_CARRY); const float* CH = CP + BATCH * 64 * DM;
    const bf16* proj = (const bf16*)(F.ws + WS_PROJ); bf16* mrg = (bf16*)(F.ws + WS_MRG);
    for (int u = F.bid; u < BATCH * 64; u += F.G) {
        const int j = u & 63, b = u >> 6, c = 4 * F.tid;
        f32x4 h = {0.f, 0.f, 0.f, 0.f};
#pragma unroll 8
        for (int jj = 0; jj < j; ++jj) { const f32x4 p = *(const f32x4*)(CP + ((size_t)b * 64 + jj) * DM + c), q = *(const f32x4*)(CH + ((size_t)b * 64 + jj) * DM + c); h = p * h + q; }
        const size_t tok0 = (size_t)b * SEQ + j * 32;
#pragma unroll 1
        for (int hs = 0; hs < 2; ++hs) {
            u32x4 w[16]; u32x2 gr[16], gg[16];
#pragma unroll
            for (int t = 0; t < 16; ++t) { const size_t tok = tok0 + hs * 16 + t; w[t] = *(const u32x4*)(AB + tok * DM + c); gr[t] = *(const u32x2*)(proj + tok * NINP + C_GR + c); gg[t] = *(const u32x2*)(proj + tok * NINP + C_G + 4096 + c); }
#pragma unroll
            for (int t = 0; t < 16; ++t) { const size_t tok = tok0 + hs * 16 + t;
                const f32x4 a = {__expf(bflo(w[t].x)), __expf(bflo(w[t].y)), __expf(bflo(w[t].z)), __expf(bflo(w[t].w))}, bb = {bfhi(w[t].x), bfhi(w[t].y), bfhi(w[t].z), bfhi(w[t].w)};
                h = a * h + bb;
                u32x2 o; o.x = pk2(h[0] * gelu_tanh_(bflo(gr[t].x)) * sigmoidf_(bflo(gg[t].x)), h[1] * gelu_tanh_(bfhi(gr[t].x)) * sigmoidf_(bfhi(gg[t].x)));
                o.y = pk2(h[2] * gelu_tanh_(bflo(gr[t].y)) * sigmoidf_(bflo(gg[t].y)), h[3] * gelu_tanh_(bfhi(gr[t].y)) * sigmoidf_(bfhi(gg[t].y)));
                *(u32x2*)(mrg + tok * MIXW + 4096 + c) = o; }
        }
    }
}

typedef short s16x4 __attribute__((ext_vector_type(4)));
constexpr int KS_STRIDE = 272, VS_STRIDE = 320, ATT_V = 64 * KS_STRIDE, ATT_BUF = 64 * KS_STRIDE + 64 * VS_STRIDE;
DI void p5_attention(Frame& F) {
    const bf16* proj = (const bf16*)(F.ws + WS_PROJ); const unsigned* mask = (const unsigned*)(F.ws + WS_MASK); bf16* mrg = (bf16*)(F.ws + WS_MRG);
    const int lane = F.lane, l31 = lane & 31, hf = lane >> 5, wave = F.wave, hh = wave >> 1, qh = wave & 1, tid = F.tid;
    const float sc2 = 0.08838834764831845f * 1.4426950408889634f;
    const int gi = lane >> 4, i16 = lane & 15;
    const int vbase = ATT_V + (4 * (gi >> 1) + (i16 >> 2)) * VS_STRIDE + (16 * (gi & 1) + 4 * (i16 & 3)) * 2;
    const int sr0 = tid >> 4, sch = tid & 15;
    for (int u = F.bid; u < BATCH * 16 * 4; u += F.G) {
        const int g = u & 3, cp = (u >> 2) & 15, b = u >> 6;
        for (int half = 0; half < 2; ++half) {
            const int c = half ? (31 - cp) : cp, nkt = c + 1, head = g * 4 + hh;
            const int qtok = b * SEQ + c * 64 + qh * 32 + l31;
            const bf16* qrow = proj + (size_t)qtok * NINP + C_Q + head * 128 + hf * 8;
            bf16x8 qf[8];
#pragma unroll
            for (int ks = 0; ks < 8; ++ks) qf[ks] = *(const bf16x8*)(qrow + ks * 16);
            f32x16 o[4];
#pragma unroll
            for (int db = 0; db < 4; ++db)
#pragma unroll
                for (int i = 0; i < 16; ++i) o[db][i] = 0.f;
            float mrun = -1e30f, lrun = 0.f;
            const bf16* kg = proj + (size_t)(b * SEQ + sr0) * NINP + C_K + g * 128 + sch * 8;
            const bf16* vg = proj + (size_t)(b * SEQ + sr0) * NINP + C_V + g * 128 + sch * 8;
            u32x4 kr0 = *(const u32x4*)kg, kr1 = *(const u32x4*)(kg + (size_t)32 * NINP), vr0 = *(const u32x4*)vg, vr1 = *(const u32x4*)(vg + (size_t)32 * NINP);
            const unsigned* mrow = mask + (size_t)qtok * 64;
            unsigned mw0 = mrow[0], mw1 = mrow[1];
            { LAS unsigned char* B0 = F.lds;
              *(LAS u32x4*)(B0 + sr0 * KS_STRIDE + sch * 16) = kr0; *(LAS u32x4*)(B0 + (sr0 + 32) * KS_STRIDE + sch * 16) = kr1;
              *(LAS u32x4*)(B0 + ATT_V + sr0 * VS_STRIDE + sch * 16) = vr0; *(LAS u32x4*)(B0 + ATT_V + (sr0 + 32) * VS_STRIDE + sch * 16) = vr1; }
            __syncthreads();
            for (int kt = 0; kt < nkt; ++kt) {
                LAS unsigned char* Bc = F.lds + (kt & 1) * ATT_BUF; LAS unsigned char* Bn = F.lds + ((kt + 1) & 1) * ATT_BUF;
                const unsigned cm0 = mw0, cm1 = mw1; const bool more = kt + 1 < nkt;
                if (more) { const size_t adv = (size_t)(kt + 1) * 64 * NINP;
                    kr0 = *(const u32x4*)(kg + adv); kr1 = *(const u32x4*)(kg + adv + (size_t)32 * NINP); vr0 = *(const u32x4*)(vg + adv); vr1 = *(const u32x4*)(vg + adv + (size_t)32 * NINP);
                    mw0 = mrow[2 * kt + 2]; mw1 = mrow[2 * kt + 3]; }
                f32x16 s0, s1;
#pragma unroll
                for (int i = 0; i < 16; ++i) { s0[i] = 0.f; s1[i] = 0.f; }
#pragma unroll
                for (int ks = 0; ks < 8; ++ks) {
                    const bf16x8 ka = *(const LAS bf16x8*)(Bc + l31 * KS_STRIDE + ks * 32 + hf * 16);
                    const bf16x8 kb = *(const LAS bf16x8*)(Bc + (32 + l31) * KS_STRIDE + ks * 32 + hf * 16);
                    s0 = __builtin_amdgcn_mfma_f32_32x32x16_bf16(ka, qf[ks], s0, 0, 0, 0);
                    s1 = __builtin_amdgcn_mfma_f32_32x32x16_bf16(kb, qf[ks], s1, 0, 0, 0);
                }
                const unsigned sm0 = cm0 >> (4 * hf), sm1 = cm1 >> (4 * hf);
                float tmax = -INFINITY;
#pragma unroll
                for (int i = 0; i < 16; ++i) { const unsigned bit = 1u << ((i & 3) + 8 * (i >> 2));
                    s0[i] = (sm0 & bit) ? s0[i] * sc2 : -INFINITY; s1[i] = (sm1 & bit) ? s1[i] * sc2 : -INFINITY; tmax = fmaxf(tmax, fmaxf(s0[i], s1[i])); }
                tmax = fmaxf(tmax, __shfl_xor(tmax, 32));
                const float mnew = fmaxf(mrun, tmax), alpha = __builtin_amdgcn_exp2f(mrun - mnew); mrun = mnew;
                float psum = 0.f;
#pragma unroll
                for (int i = 0; i < 16; ++i) { s0[i] = __builtin_amdgcn_exp2f(s0[i] - mnew); s1[i] = __builtin_amdgcn_exp2f(s1[i] - mnew); psum += s0[i] + s1[i]; }
                lrun = lrun * alpha + psum;
                if (!__all(alpha == 1.0f)) {
#pragma unroll
                    for (int db = 0; db < 4; ++db)
#pragma unroll
                        for (int i = 0; i < 16; ++i) o[db][i] *= alpha; }
#pragma unroll
                for (int kb = 0; kb < 2; ++kb)
#pragma unroll
                    for (int s = 0; s < 2; ++s) {
                        u32x4 pw;
                        if (kb == 0) { pw.x = pk2(s0[8 * s], s0[8 * s + 1]); pw.y = pk2(s0[8 * s + 2], s0[8 * s + 3]); pw.z = pk2(s0[8 * s + 4], s0[8 * s + 5]); pw.w = pk2(s0[8 * s + 6], s0[8 * s + 7]); }
                        else { pw.x = pk2(s1[8 * s], s1[8 * s + 1]); pw.y = pk2(s1[8 * s + 2], s1[8 * s + 3]); pw.z = pk2(s1[8 * s + 4], s1[8 * s + 5]); pw.w = pk2(s1[8 * s + 6], s1[8 * s + 7]); }
                        const bf16x8 pf = __builtin_bit_cast(bf16x8, pw);
#pragma unroll
                        for (int db = 0; db < 4; ++db) {
                            LAS unsigned char* vp = Bc + vbase + (kb * 32 + 16 * s) * VS_STRIDE + db * 64;
                            const s16x4 lo = __builtin_amdgcn_ds_read_tr16_b64_v4i16((LAS s16x4*)vp), hi = __builtin_amdgcn_ds_read_tr16_b64_v4i16((LAS s16x4*)(vp + 8 * VS_STRIDE));
                            const bf16x8 vf = __builtin_shufflevector(lo, hi, 0, 1, 2, 3, 4, 5, 6, 7);
                            o[db] = __builtin_amdgcn_mfma_f32_32x32x16_bf16(vf, pf, o[db], 0, 0, 0);
                        }
                    }
                if (more) {
                    *(LAS u32x4*)(Bn + sr0 * KS_STRIDE + sch * 16) = kr0; *(LAS u32x4*)(Bn + (sr0 + 32) * KS_STRIDE + sch * 16) = kr1;
                    *(LAS u32x4*)(Bn + ATT_V + sr0 * VS_STRIDE + sch * 16) = vr0; *(LAS u32x4*)(Bn + ATT_V + (sr0 + 32) * VS_STRIDE + sch * 16) = vr1; }
                __syncthreads();
            }
            const float ltot = lrun + __shfl_xor(lrun, 32), rl = 1.0f / ltot;
            const bf16* grow = proj + (size_t)qtok * NINP + C_G + head * 128; bf16* orow = mrg + (size_t)qtok * MIXW + head * 128;
#pragma unroll
            for (int db = 0; db < 4; ++db)
#pragma unroll
                for (int q4 = 0; q4 < 4; ++q4) { const int d0 = db * 32 + q4 * 8 + hf * 4; const u32x2 gv = *(const u32x2*)(grow + d0);
                    u32x2 w; w.x = pk2(o[db][4 * q4] * rl * sigmoidf_(bflo(gv.x)), o[db][4 * q4 + 1] * rl * sigmoidf_(bfhi(gv.x)));
                    w.y = pk2(o[db][4 * q4 + 2] * rl * sigmoidf_(bflo(gv.y)), o[db][4 * q4 + 3] * rl * sigmoidf_(bfhi(gv.y)));
                    *(u32x2*)(orow + d0) = w; }
        }
    }
    __syncthreads();
}

template <int MODE, bool ROUTE, bool WRITE_BF, bool WRITE_F32>
DI void p_layernorm(Frame& F, const Args& args, const float* src, const float* gam, const float* bet, float* outf, bf16* outb) {
    const int gw = F.bid * 8 + F.wave, NGW = F.G * 8, lane = F.lane;
    const unsigned* rt = (const unsigned*)(F.ws + WS_ROUTE); unsigned* rtw = (unsigned*)(F.ws + WS_ROUTE);
    LAS float* wr_l = (LAS float*)F.lds;
    LAS unsigned* cl = (LAS unsigned*)(F.lds + 65536);
    if (ROUTE) { for (int i = F.tid; i < DM * NEXP / 4; i += 512) *(LAS f32x4*)(wr_l + 4 * i) = *(const f32x4*)(INF(20) + 4 * i); if (F.tid < 8) cl[F.tid] = 0u; __syncthreads(); }
#define LN_COL(jj) (MODE == 1 ? (8 * lane + 512 * ((jj) >> 1) + 4 * ((jj) & 1)) : (4 * lane + 256 * (jj)))
    for (int row = gw; row < MTOK; row += NGW) {
        f32x4 v[8]; float s = 0.f;
        if (MODE == 0) {
#pragma unroll
            for (int j = 0; j < 8; ++j) v[j] = *(const f32x4*)(src + (size_t)row * DM + LN_COL(j));
        } else {
            const unsigned r0 = rt[RT_ROW + 2 * row], r1 = rt[RT_ROW + 2 * row + 1]; const float w0 = __uint_as_float(rt[RT_W + 2 * row]), w1 = __uint_as_float(rt[RT_W + 2 * row + 1]);
            const bf16* yb = (const bf16*)(F.ws + WS_YB);
            u32x4 pa[4][KSPLIT], pb[4][KSPLIT];
#pragma unroll
            for (int j = 0; j < 4; ++j)
#pragma unroll
                for (int ks = 0; ks < KSPLIT; ++ks) { pa[j][ks] = *(const u32x4*)(yb + ((size_t)ks * MOE_ROWS_MAX + r0) * DM + 8 * lane + 512 * j); pb[j][ks] = *(const u32x4*)(yb + ((size_t)ks * MOE_ROWS_MAX + r1) * DM + 8 * lane + 512 * j); }
#pragma unroll
            for (int j = 0; j < 4; ++j) { f32x4 a0 = {0.f, 0.f, 0.f, 0.f}, a1 = a0, b0 = a0, b1 = a0;
#pragma unroll
                for (int ks = 0; ks < KSPLIT; ++ks) { const u32x4 a = pa[j][ks], b = pb[j][ks];
                    a0 += (f32x4){bflo(a.x), bfhi(a.x), bflo(a.y), bfhi(a.y)}; a1 += (f32x4){bflo(a.z), bfhi(a.z), bflo(a.w), bfhi(a.w)};
                    b0 += (f32x4){bflo(b.x), bfhi(b.x), bflo(b.y), bfhi(b.y)}; b1 += (f32x4){bflo(b.z), bfhi(b.z), bflo(b.w), bfhi(b.w)}; }
                const u32x4 xr = *(const u32x4*)((const bf16*)src + (size_t)row * DM + 8 * lane + 512 * j);
                v[2 * j] = (f32x4){bflo(xr.x), bfhi(xr.x), bflo(xr.y), bfhi(xr.y)} * ALPHA + a0 * w0 + b0 * w1;
                v[2 * j + 1] = (f32x4){bflo(xr.z), bfhi(xr.z), bflo(xr.w), bfhi(xr.w)} * ALPHA + a1 * w0 + b1 * w1; }
        }
#pragma unroll
        for (int j = 0; j < 8; ++j) s += (v[j][0] + v[j][1]) + (v[j][2] + v[j][3]);
        const float mean = wave_sum(s) * (1.f / DM); float s2 = 0.f;
#pragma unroll
        for (int j = 0; j < 8; ++j) { v[j] = v[j] - mean; s2 += (v[j][0] * v[j][0] + v[j][1] * v[j][1]) + (v[j][2] * v[j][2] + v[j][3] * v[j][3]); }
        const float rstd = 1.0f / sqrtf(wave_sum(s2) * (1.f / DM) + LN_EPS);
        float lg[8];
#pragma unroll
        for (int e = 0; e < 8; ++e) lg[e] = 0.f;
#pragma unroll
        for (int j = 0; j < 8; ++j) { const int cc = LN_COL(j); const f32x4 gv = *(const f32x4*)(gam + cc), bv = *(const f32x4*)(bet + cc);
            const f32x4 y = v[j] * rstd * gv + bv; if (WRITE_F32) *(f32x4*)(outf + (size_t)row * DM + cc) = y;
            if (WRITE_BF) { u32x2 w; w.x = pk2(y[0], y[1]); w.y = pk2(y[2], y[3]); *(u32x2*)(outb + (size_t)row * DM + cc) = w; }
            if (ROUTE) {
#pragma unroll
                for (int i = 0; i < 4; ++i) { const LAS float* wp = wr_l + (size_t)(cc + i) * 8; const f32x4 wa = *(const LAS f32x4*)wp, wb = *(const LAS f32x4*)(wp + 4); const float xv = y[i];
                    lg[0] += xv * wa[0]; lg[1] += xv * wa[1]; lg[2] += xv * wa[2]; lg[3] += xv * wa[3]; lg[4] += xv * wb[0]; lg[5] += xv * wb[1]; lg[6] += xv * wb[2]; lg[7] += xv * wb[3]; }
            }
            asm volatile("" ::: "memory"); }
        if (ROUTE) {
#pragma unroll
            for (int e = 0; e < 8; ++e) lg[e] = wave_sum(lg[e]);
            int e0 = 0; float l0 = lg[0];
#pragma unroll
            for (int e = 1; e < 8; ++e) if (lg[e] > l0) { l0 = lg[e]; e0 = e; }
            int e1 = 0; float l1 = -INFINITY;
#pragma unroll
            for (int e = 0; e < 8; ++e) if (e != e0 && lg[e] > l1) { l1 = lg[e]; e1 = e; }
            const float p1 = 1.0f / (1.0f + expf(l0 - l1)), p0 = 1.0f - p1;
            if (lane == 0) { const unsigned sl0 = __hip_atomic_fetch_add(cl + e0, 1u, __ATOMIC_RELAXED, __HIP_MEMORY_SCOPE_WORKGROUP), sl1 = __hip_atomic_fetch_add(cl + e1, 1u, __ATOMIC_RELAXED, __HIP_MEMORY_SCOPE_WORKGROUP);
                rtw[RT_E + 2 * row] = (unsigned)e0; rtw[RT_E + 2 * row + 1] = (unsigned)e1; rtw[RT_SLOT + 2 * row] = sl0; rtw[RT_SLOT + 2 * row + 1] = sl1;
                rtw[RT_W + 2 * row] = __float_as_uint(p0); rtw[RT_W + 2 * row + 1] = __float_as_uint(p1); }
        }
    }
#undef LN_COL
    if (ROUTE) { __syncthreads(); const int t2 = F.wave * 64 + lane_id_(); if (t2 < 8) rtw[RT_WGC + F.bid * 8 + t2] = cl[t2]; __syncthreads(); }
}

DI void p_moe_gather(Frame& F) {
    unsigned* rt = (unsigned*)(F.ws + WS_ROUTE);
    const bf16* x1b = (const bf16*)(F.ws + WS_X1B); bf16* am = (bf16*)(F.ws + WS_AMOE);
    LAS unsigned* pre = (LAS unsigned*)F.lds;
    LAS unsigned* tot = pre + 2048;
    const int lane = F.lane;
    __syncthreads();
    { const int e = F.wave; unsigned c[4]; unsigned s = 0u;
#pragma unroll
      for (int i = 0; i < 4; ++i) { const int b = 4 * lane + i; c[i] = b < F.G ? rt[RT_WGC + b * 8 + e] : 0u; s += c[i]; }
      unsigned inc = s;
#pragma unroll
      for (int o = 1; o < 64; o <<= 1) { const unsigned t = __shfl_up(inc, o); inc += (lane >= o) ? t : 0u; }
      unsigned ex = inc - s;
#pragma unroll
      for (int i = 0; i < 4; ++i) { pre[(4 * lane + i) * 8 + e] = ex; ex += c[i]; }
      if (lane == 63) tot[e] = inc; }
    __syncthreads();
    if (F.tid == 0) { unsigned t = 0u; for (int e = 0; e < 8; ++e) { tot[8 + e] = t; t += (tot[e] + 255u) >> 8; } }
    __syncthreads();
    if (F.bid == 0 && F.tid < 8) F.ctl[CW_CNT + F.tid] = tot[F.tid];
    const int gw = F.bid * 8 + F.wave, NGW = F.G * 8;
    for (int a = gw; a < MTOK * 2; a += NGW) {
        const int tok = a >> 1; const int e = (int)rt[RT_E + a], slot = (int)rt[RT_SLOT + a];
        const int bsrc = (tok % NGW) >> 3;
        const int row = (int)tot[8 + e] * 256 + (int)pre[bsrc * 8 + e] + slot;
        const u32x4* s = (const u32x4*)(x1b + (size_t)tok * DM) + 4 * lane; u32x4* d = (u32x4*)((unsigned char*)am + (size_t)row * DM) + 2 * lane;
        const u32x4 i0 = s[0], i1 = s[1], i2 = s[2], i3 = s[3];
        u32x4 o0, o1;
        o0.x = pk4_fp8(bflo(i0.x), bfhi(i0.x), bflo(i0.y), bfhi(i0.y)); o0.y = pk4_fp8(bflo(i0.z), bfhi(i0.z), bflo(i0.w), bfhi(i0.w)); o0.z = pk4_fp8(bflo(i1.x), bfhi(i1.x), bflo(i1.y), bfhi(i1.y)); o0.w = pk4_fp8(bflo(i1.z), bfhi(i1.z), bflo(i1.w), bfhi(i1.w));
        o1.x = pk4_fp8(bflo(i2.x), bfhi(i2.x), bflo(i2.y), bfhi(i2.y)); o1.y = pk4_fp8(bflo(i2.z), bfhi(i2.z), bflo(i2.w), bfhi(i2.w)); o1.z = pk4_fp8(bflo(i3.x), bfhi(i3.x), bflo(i3.y), bfhi(i3.y)); o1.w = pk4_fp8(bflo(i3.z), bfhi(i3.z), bflo(i3.w), bfhi(i3.w));
        d[0] = o0; d[1] = o1;
        if (lane == 0) rt[RT_ROW + a] = (unsigned)row;
    }
    for (int pr = gw; pr < 8 * 256; pr += NGW) { const int e = pr >> 8, i = pr & 255;
        const int row = (int)tot[8 + e] * 256 + (int)tot[e] + i, rend = ((int)tot[8 + e] + (((int)tot[e] + 255) >> 8)) * 256;
        if (row < rend) { u32x4* d = (u32x4*)((unsigned char*)am + (size_t)row * DM);
#pragma unroll
            for (int q = 0; q < 2; ++q) d[lane + 64 * q] = (u32x4){0u, 0u, 0u, 0u}; } }
    __syncthreads();
}

constexpr int NPH_LAYER = 12;
constexpr int NPHASES = 1 + 2 * NPH_LAYER;
#define IN(k) (lo <= (k) && (k) < hi)
#define RELAUNDER() do { int l_ = lane_id_(); asm volatile("" : "+v"(l_)); F.lane = l_; F.tid = F.wave * 64 + l_; } while (0)
#define STAMP(k) do { if (STAMP_PROBE && F.bid == 0 && xb_t0(F.wave)) ((volatile LAS unsigned*)(F.lds + LDSCTL_OFF + 512))[k] = (unsigned)__builtin_amdgcn_s_memrealtime(); } while (0)
#define SEAM(k) do { if (IN(k) && IN((k) + 1)) { xcd_barrier(bar); STAMP((k) + 1); } } while (0)
template <int LAYER>
DI void run_layer(Frame& F, const Args& args, const XcdBarrier& bar, const int lo, const int hi) {
    constexpr int P = 1 + NPH_LAYER * LAYER;
    bf16* proj = (bf16*)(F.ws + WS_PROJ); bf16* xb = (bf16*)(F.ws + WS_XB); bf16* mrg = (bf16*)(F.ws + WS_MRG);
    float* x1 = (float*)(F.ws + WS_X1); bf16* x1b = (bf16*)(F.ws + WS_X1B); float* x2 = (float*)(F.ws + WS_X2); float* pre = (float*)(F.ws + WS_PRE);
    if (IN(P + 0)) {
        pg8::Gemm g{xb, (const bf16*)(F.ws + WS_WIN) + (size_t)LAYER * NINP * DM, DM, DM, DM};
        pg8::TileOrder S; S.init(MTOK / 256, NINP / 256, F.G, F.bid, (size_t)256 * DM * 2, (size_t)256 * DM * 2);
        pg8::EpiBf16 E{proj, NINP, 0, 1.0f};
        pg8::gemm_phase(F.lds, g, S, E, F.wave);
        RELAUNDER(); if (LAYER == 0) conv_range(F, args, CE_0, CE_3, 32); else conv_range(F, args, CE_5, CE_5 + MOE_EARLY, 32);
    }
    SEAM(P + 0);
    if (IN(P + 1)) { RELAUNDER(); p2_prep(F, args, LAYER); }
    SEAM(P + 1);
    if (IN(P + 2)) {
        { pg8::Gemm g{(const bf16*)(F.ws + WS_DIFF), (const bf16*)(F.ws + WS_WPOOL) + (size_t)LAYER * 2048 * 512, DM, 512, 512};
          pg8::TileOrder S; S.init(MTOK / 256, 8, F.G, F.bid, (size_t)256 * DM * 2, (size_t)256 * 512 * 2, 2, (size_t)512 * 2);
          pg8::EpiPool E{mrg, proj, INF(5) + (size_t)LAYER * DM};
          pg8::gemm_phase(F.lds, g, S, E, F.wave); }
        if (LAYER == 0) STAMP(25);
        { pg8::Gemm g{(const bf16*)(F.ws + WS_XC), (const bf16*)(F.ws + WS_WLRU) + (size_t)LAYER * 4096 * 256, DM, 256, 256};
          pg8::TileOrder S; S.init(MTOK / 256, 16, F.G, F.bid, (size_t)256 * DM * 2, (size_t)256 * 256 * 2, 2, (size_t)256 * 2);
          pg8::EpiLru E{(unsigned*)(F.ws + WS_A), (const bf16*)(F.ws + WS_XC), INF(9) + (size_t)LAYER * DM, INF(11) + (size_t)LAYER * DM, (const float*)(F.ws + WS_LRUC) + (size_t)LAYER * DM};
          pg8::gemm_phase(F.lds, g, S, E, F.wave); }
        if (LAYER == 0) STAMP(26);
        RELAUNDER(); p3_indexer(F);
        if (LAYER == 0) STAMP(29);
        __syncthreads(); RELAUNDER(); if (LAYER == 0) conv_range(F, args, CE_3, CE_3 + P2_ITEMS, 32); else conv_range(F, args, CE_5 + MOE_EARLY, CE_5 + MOE_EARLY + P2_ITEMS, 32);
    }
    SEAM(P + 2);
    if (IN(P + 3)) { RELAUNDER(); p4_select(F); if (LAYER == 0) STAMP(27); RELAUNDER(); p4_lru_pass1(F); }
    SEAM(P + 3);
    if (IN(P + 4)) { RELAUNDER(); p5_attention(F); if (LAYER == 0) STAMP(28); RELAUNDER(); p5_lru_pass2(F); }
    SEAM(P + 4);
    if (IN(P + 5)) {
        pg8::Gemm g{mrg, (const bf16*)(F.ws + WS_WOUT) + (size_t)LAYER * DM * MIXW, MIXW, MIXW, MIXW};
        pg8::TileOrder S; S.init(MTOK / 256, DM / 256, F.G, F.bid, (size_t)256 * MIXW * 2, (size_t)256 * MIXW * 2);
        pg8::EpiRes<LAYER == 1> E{pre, LAYER == 0 ? (const void*)INF(0) : (const void*)xb, DM};
        pg8::gemm_phase(F.lds, g, S, E, F.wave);
    }
    SEAM(P + 5);
    if (IN(P + 6)) { RELAUNDER(); } if (IN(P + 6)) p_layernorm<0, LAYER == 1, true, false>(F, args, pre, INF(13) + LAYER * DM, INF(14) + LAYER * DM, nullptr, x1b);
    SEAM(P + 6);
    if constexpr (LAYER == 0) {
        if (IN(P + 7)) {
            pg8::Gemm g{x1b, (const bf16*)(F.ws + WS_WGU), DM, DM, DM};
            pg8::TileOrder S; S.init(MTOK / 256, 2 * DFF / 256, F.G, F.bid, (size_t)256 * DM * 2, (size_t)256 * DM * 2);
            pg8::EpiSwiglu E{(bf16*)(F.ws + WS_H), DFF};
            pg8::gemm_phase(F.lds, g, S, E, F.wave);
            RELAUNDER(); conv_range(F, args, CE_3 + P2_ITEMS, CE_5, 96);
        }
        SEAM(P + 7);
        if (IN(P + 8)) {
            pg8::Gemm g{(const bf16*)(F.ws + WS_H), (const bf16*)(F.ws + WS_WDN), DFF, DFF, DFF};
            pg8::TileOrder S; S.init(MTOK / 256, DM / 256, F.G, F.bid, (size_t)256 * DFF * 2, (size_t)256 * DFF * 2);
            pg8::EpiRes<true> E{pre, x1b, DM};
            pg8::gemm_phase(F.lds, g, S, E, F.wave);
        }
        SEAM(P + 8);
        if (IN(P + 9)) { RELAUNDER(); } if (IN(P + 9)) p_layernorm<0, false, true, false>(F, args, pre, INF(15), INF(16), nullptr, xb);
        if (IN(P + 9) && IN(P + 12)) { xcd_barrier(bar); STAMP(P + 10); STAMP(P + 11); STAMP(P + 12); }
    } else {
        if (IN(P + 7)) { RELAUNDER(); conv_range(F, args, CE_5 + MOE_EARLY + P2_ITEMS, CE_7, 0); RELAUNDER(); p_moe_gather(F); }
        SEAM(P + 7);
        if (IN(P + 8)) {
            pg8::Gemm g{(const bf16*)(F.ws + WS_AMOE), (const bf16*)(F.ws + WS_MWGU), DM / 2, DM / 2, DM / 2};
            pg8::MoeOrder S; S.init(F.ctl + CW_CNT, 2 * DEXP / 256, 1, F.G, F.bid, (size_t)256 * DM, (size_t)2 * DEXP * DM, (size_t)256 * DM, 0);
            pg8::EpiSwigluF8 E{F.ws + WS_HMOE, DEXP, 1.0f / F8_WSCALE};
            pg8::gemm_phase<pg8::EpiSwigluF8, pg8::MoeOrder, true>(F.lds, g, S, E, F.wave);
        }
        SEAM(P + 8);
        if (IN(P + 9)) {
            pg8::Gemm g{(const bf16*)(F.ws + WS_HMOE), (const bf16*)(F.ws + WS_MWDN), DEXP / 2, DEXP / 2, DEXP / 2 / KSPLIT};
            pg8::MoeOrder S; S.init(F.ctl + CW_CNT, DM / 256, KSPLIT, F.G, F.bid, (size_t)256 * DEXP, (size_t)DM * DEXP, (size_t)256 * DEXP, (size_t)(DEXP / KSPLIT));
            pg8::EpiBf16 E{(bf16*)(F.ws + WS_YB), DM, (size_t)MOE_ROWS_MAX * DM, 1.0f / F8_WSCALE};
            pg8::gemm_phase<pg8::EpiBf16, pg8::MoeOrder, true>(F.lds, g, S, E, F.wave);
        }
        SEAM(P + 9);
        if (IN(P + 10)) { RELAUNDER(); } if (IN(P + 10)) p_layernorm<1, false, false, true>(F, args, (const float*)x1b, INF(15) + DM, INF(16) + DM, args.out, nullptr);
    }
}
__global__ void __launch_bounds__(512, 2) fwd_kernel(Args args) {
    extern __shared__ __attribute__((aligned(16))) unsigned char lds_raw[];
    Frame F;
    F.lds = (LAS unsigned char*)lds_raw; F.ws = args.ws; F.ctl = (unsigned*)(args.ws + WS_CTL);
    F.wave = __builtin_amdgcn_readfirstlane((int)threadIdx.x >> 6); F.lane = lane_id_(); F.tid = F.wave * 64 + F.lane; F.G = gridDim.x; F.bid = blockIdx.x;
    volatile LAS unsigned* MISC = (volatile LAS unsigned*)(F.lds + LDSCTL_OFF);
    for (int u = F.tid; u < (LDS_BYTES - LDSCTL_OFF) / 4; u += 512) ((LAS unsigned*)(F.lds + LDSCTL_OFF))[u] = 0u;
    __syncthreads();
    const int lo = args.ph_lo, hi = args.ph_hi;
    XcdBarrier bar; bar.bar = F.ctl + CW_BAR; bar.x = 0; bar.st = nullptr; bar.wave = F.wave;
    if ((hi - lo) > 1) bar = xcd_barrier_post(F.ctl + CW_BAR, MISC + 8, F.wave);
    STAMP(0);
    if (IN(0)) { RELAUNDER(); p0_prologue(F, args); __syncthreads(); }
    SEAM(0);
    run_layer<0>(F, args, bar, lo, hi);
    run_layer<1>(F, args, bar, lo, hi);
#if STAMP_PROBE
    RELAUNDER();
    if (F.bid == 0) {
        asm volatile("s_waitcnt vmcnt(0)" ::: "memory"); __syncthreads();
        if (xb_t0(F.wave)) ((volatile LAS unsigned*)(F.lds + LDSCTL_OFF + 512))[NPHASES - 1] = (unsigned)__builtin_amdgcn_s_memrealtime();
        __syncthreads();
        volatile LAS unsigned* st = (volatile LAS unsigned*)(F.lds + LDSCTL_OFF + 512);
        const float ta = (float)(st[STAMP_A_HI] - st[STAMP_A_LO]) * 0.01f, tb = (float)(st[STAMP_B_HI] - st[STAMP_B_LO]) * 0.01f;
        const float da = __builtin_amdgcn_sqrtf(ta * 0.005f);
        for (int i = F.tid; i < DM; i += 512) args.out[i] += da;
        if (F.tid == 0) args.out[DM] += tb * 0.1f;
    }
#endif
}
#undef IN
#undef SEAM

extern "C" void kernel_launch(void* const* d_in, const int* in_sizes, int n_in, void* d_out, int out_size, void* d_ws, size_t ws_size, hipStream_t stream) {
    static int grid = 0;
    if (grid == 0) {
        if (n_in != 24 || out_size != MTOK * DM || ws_size < WS_END) { fprintf(stderr, "kernel_launch: unexpected problem (n_in %d, out %d, ws %zu, need %zu)\n", n_in, out_size, ws_size, (size_t)WS_END); grid = -1; return; }
        int dev = 0, cus = 0, per_cu = 0;
        if (hipGetDevice(&dev) != hipSuccess || hipDeviceGetAttribute(&cus, hipDeviceAttributeMultiprocessorCount, dev) != hipSuccess) { grid = -1; return; }
        if (hipFuncSetAttribute((const void*)fwd_kernel, hipFuncAttributeMaxDynamicSharedMemorySize, LDS_BYTES) != hipSuccess) { fprintf(stderr, "kernel_launch: hipFuncSetAttribute failed\n"); grid = -1; return; }
        if (hipOccupancyMaxActiveBlocksPerMultiprocessor(&per_cu, (const void*)fwd_kernel, 512, LDS_BYTES) != hipSuccess || per_cu < 1) fprintf(stderr, "kernel_launch: occupancy query reports %d\n", per_cu);
        (void)hipGetLastError();
        grid = cus;
    }
    if (grid < 0) return;
    (void)hipMemsetAsync((char*)d_ws + WS_CTL, 0, CTL_ZERO_BYTES, stream);
    Args a{};
    for (int i = 0; i < 24; ++i) a.in[i] = d_in[i];
    a.out = (float*)d_out; a.ws = (unsigned char*)d_ws;
#if MK_N_LAUNCHES == 1
    a.ph_lo = 0; a.ph_hi = NPHASES;
    hipLaunchKernelGGL(fwd_kernel, dim3(grid), dim3(512), LDS_BYTES, stream, a);
#else
    const int plist[] = {0, 1, 2, 3, 4, 5, 6, 7, 8, 9, 10, 13, 14, 15, 16, 17, 18, 19, 20, 21, 22, 23};
    for (int i = 0; i < (int)(sizeof(plist) / sizeof(int)); ++i) { a.ph_lo = plist[i]; a.ph_hi = plist[i] + 1; hipLaunchKernelGGL(fwd_kernel, dim3(grid), dim3(512), LDS_BYTES, stream, a); }
#endif
}
```

```cpp
#include <hip/hip_runtime.h>
#include <cstdio>
#include <cstdint>

#ifndef MK_N_LAUNCHES
#define MK_N_LAUNCHES 1
#endif

#ifndef STAMP_PROBE
#define STAMP_PROBE 0
#endif
#ifndef STAMP_A_LO
#define STAMP_A_LO 0
#define STAMP_A_HI 1
#define STAMP_B_LO 1
#define STAMP_B_HI 2
#endif
#define DI __device__ __forceinline__
#define LAS __attribute__((address_space(3)))
#define GAS __attribute__((address_space(1)))
typedef unsigned short bf16;
typedef short bf16x8 __attribute__((ext_vector_type(8)));
typedef float f32x2 __attribute__((ext_vector_type(2)));
typedef float f32x4 __attribute__((ext_vector_type(4)));
typedef float f32x16 __attribute__((ext_vector_type(16)));
typedef unsigned u32x2 __attribute__((ext_vector_type(2)));
typedef unsigned u32x4 __attribute__((ext_vector_type(4)));
typedef __bf16 bf16x2_t __attribute__((ext_vector_type(2)));
typedef int i32x8 __attribute__((ext_vector_type(8)));
typedef int i32x4 __attribute__((ext_vector_type(4)));

#define LDS_WAIT() asm volatile("s_waitcnt lgkmcnt(0)" ::: "memory")
#define VM_WAIT() asm volatile("s_waitcnt vmcnt(0)" ::: "memory")

DI unsigned pk2(float lo, float hi) { f32x2 v = {lo, hi}; return __builtin_bit_cast(unsigned, __builtin_convertvector(v, bf16x2_t)); }
DI unsigned pk4_fp8(float a, float b, float c, float d) { int w = 0; w = __builtin_amdgcn_cvt_pk_fp8_f32(a, b, w, false); w = __builtin_amdgcn_cvt_pk_fp8_f32(c, d, w, true); return (unsigned)w; }
DI float bflo(unsigned w) { return __uint_as_float(w << 16); }
DI float bfhi(unsigned w) { return __uint_as_float(w & 0xffff0000u); }
DI float bf2f(bf16 b) { return __uint_as_float(((unsigned)b) << 16); }
DI float rcp_(float x) { return __builtin_amdgcn_rcpf(x); }
DI float sigmoidf_(float x) { return rcp_(1.0f + __expf(-x)); }
DI float siluf_(float x) { return x * rcp_(1.0f + __expf(-x)); }
DI float gelu_tanh_(float x) { const float u = 0.7978845608028654f * (x + 0.044715f * x * x * x); const float t = 1.0f - 2.0f * rcp_(1.0f + __expf(2.0f * u)); return 0.5f * x * (1.0f + t); }
DI float one_minus_exp_(float x) {
    const float p = -x * (1.0f + x * 0.5f * (1.0f + x * (1.0f / 3.0f) * (1.0f + x * 0.25f * (1.0f + x * 0.2f * (1.0f + x * (1.0f / 6.0f) * (1.0f + x * (1.0f / 7.0f)))))));
    const float e = 1.0f - __expf(x);
    return x > -0.5f ? p : e;
}
DI int lane_id_() { int l; asm volatile("v_mbcnt_lo_u32_b32 %0, -1, 0\n\tv_mbcnt_hi_u32_b32 %0, -1, %0" : "=v"(l)); return l; }

constexpr int DM = 2048, BATCH = 4, SEQ = 2048, MTOK = BATCH * SEQ;
constexpr int NIN = 16464, NINP = 16640;
constexpr int C_Q = 0, C_K = 2048, C_V = 2560, C_QI = 3072, C_KI = 4096, C_WI = 4160, C_PADLO = 4176, C_P = 4352, C_XR = 6400, C_GR = 8448, C_G = 10496;
constexpr int MIXW = 6144, DFF = 5504, NEXP = 8, DEXP = 7168;
constexpr int MOE_ROWS_MAX = (MTOK * 2 / 256 + NEXP) * 256;
constexpr float ALPHA = 1.4142135623730951f, LN_EPS = 1e-5f;
constexpr int DFFP = 5632;
constexpr int KSPLIT = 2;

constexpr size_t MiB = 1u << 20;
constexpr size_t WS_CTL = 0, CTL_ZERO_BYTES = 1 * MiB;
constexpr size_t WS_COSA = 1 * MiB, WS_SINA = 3 * MiB, WS_COSI = 5 * MiB, WS_SINI = 6 * MiB;
constexpr size_t WS_ROUTE = 9 * MiB;
constexpr size_t WS_MASK = 10 * MiB;
constexpr size_t WS_LRUC = 9 * MiB + 512 * 1024;
constexpr size_t WS_WIN = 12 * MiB;
constexpr size_t WS_WOUT = 142 * MiB;
constexpr size_t WS_WPOOL = 190 * MiB;
constexpr size_t WS_WLRU = 194 * MiB;
constexpr size_t WS_WGU = 198 * MiB;
constexpr size_t WS_WDN = 241 * MiB;
constexpr size_t WS_XB = 263 * MiB;
constexpr size_t WS_X1 = 295 * MiB;
constexpr size_t WS_X1B = 359 * MiB;
constexpr size_t WS_X2 = 391 * MiB;
constexpr size_t WS_PRE = 455 * MiB;
constexpr size_t WS_MWGU = 519 * MiB;
constexpr size_t WS_MWDN = 967 * MiB;
constexpr size_t WS_OV = 1191 * MiB;
constexpr size_t WS_PROJ = WS_OV;
constexpr size_t WS_DIFF = WS_OV + 260 * MiB;
constexpr size_t WS_XC = WS_OV + 292 * MiB;
constexpr size_t WS_A = WS_OV + 324 * MiB;
constexpr size_t WS_CARRY = WS_OV + 388 * MiB;
constexpr size_t WS_SC = WS_OV + 452 * MiB;
constexpr size_t WS_MRG = WS_OV + 516 * MiB;
constexpr size_t WS_H = WS_OV;
constexpr size_t WS_AMOE = WS_OV;
constexpr size_t WS_HMOE = WS_OV + 72 * MiB;
constexpr size_t WS_YB = WS_OV + 324 * MiB;
constexpr size_t WS_END = WS_OV + 612 * MiB;
constexpr int CW_BAR = 4096, CW_CNT = 16384;
constexpr int RT_E = 0, RT_SLOT = 2 * MTOK, RT_W = 4 * MTOK, RT_ROW = 6 * MTOK, RT_WGC = 8 * MTOK;

constexpr int RING_BYTES = 131072, LDSCTL_OFF = RING_BYTES, LDS_BYTES = 147456;

#define XB_TMO      128
#define XB_XCNT(j)  (256  + 64 * (j))
#define XB_XSUB(j)  (1280 + 64 * (j))
#define XB_XGEN(j)  (2304 + 64 * (j))
#define XB_TOP      3328
#define XB_TOPGEN   3392
#define XCD_BAR_WORDS 3456
#define XB_SPIN_CAP (1u << 18)
DI unsigned xb_ld(unsigned* p)              { return __hip_atomic_load(p, __ATOMIC_RELAXED, __HIP_MEMORY_SCOPE_AGENT); }
DI unsigned xb_add(unsigned* p, unsigned v) { return __hip_atomic_fetch_add(p, v, __ATOMIC_RELAXED, __HIP_MEMORY_SCOPE_AGENT); }
DI unsigned xb_xcc_id() { return (unsigned)__builtin_amdgcn_s_getreg((3 << 11) | 20) & 0xFu; }
#define XB_SPIN(cond, bar) do { unsigned _sp = 0; while (cond) { __builtin_amdgcn_s_sleep(1); \
    if ((++_sp & 255u) == 0u) { if (xb_ld(&(bar)[XB_TMO])) break; if (_sp > XB_SPIN_CAP) { atomicAdd(&(bar)[XB_TMO], 1u); break; } } } } while (0)
struct XcdBarrier { unsigned* bar; unsigned x; volatile LAS unsigned* st; int wave; };
DI bool xb_t0(int wave) { return wave == 0 && lane_id_() == 0; }
DI XcdBarrier xcd_barrier_post(unsigned* bar, volatile LAS unsigned* st, int wave) {
    XcdBarrier b; b.bar = bar; b.x = xb_xcc_id(); b.st = st; b.wave = wave;
    if (xb_t0(wave)) (void)xb_add(&bar[XB_XCNT(b.x)], 1u);
    return b;
}
DI void xcd_barrier_complete(unsigned* bar, unsigned x, unsigned& nloc, unsigned& nx) {
    const unsigned G = gridDim.x * gridDim.y * gridDim.z;
    unsigned sum, cnt, mine, sp = 0u;
    for (;;) {
        sum = 0u; cnt = 0u; mine = 0u;
#pragma unroll
        for (unsigned j = 0; j < 16; ++j) { const unsigned c = xb_ld(&bar[XB_XCNT(j)]); sum += c; cnt += (c > 0u) ? 1u : 0u; mine = (j == x) ? c : mine; }
        if (sum == G) break;
        __builtin_amdgcn_s_sleep(1);
        if ((++sp & 255u) == 0u) { if (xb_ld(&bar[XB_TMO])) break; if (sp > XB_SPIN_CAP) { atomicAdd(&bar[XB_TMO], 1u); break; } }
    }
    nloc = mine > 0u ? mine : 1u; nx = cnt > 0u ? cnt : 1u;
}
DI void xcd_barrier(const XcdBarrier& b) {
    asm volatile("s_waitcnt vmcnt(0)" ::: "memory");
    __syncthreads();
    if (xb_t0(b.wave)) {
        unsigned* bar = b.bar;
        __builtin_amdgcn_s_waitcnt(0);
        unsigned nloc = b.st[0], nx = b.st[1];
        if (nloc == 0u) { xcd_barrier_complete(bar, b.x, nloc, nx); b.st[0] = nloc; b.st[1] = nx; }
        const unsigned old = xb_add(&bar[XB_XSUB(b.x)], 1u);
        const unsigned gen = old / nloc;
        if (old + 1u == (gen + 1u) * nloc) {
            __builtin_amdgcn_fence(__ATOMIC_RELEASE, "agent");
            asm volatile("s_waitcnt vmcnt(0)" ::: "memory");
            const unsigned og = xb_add(&bar[XB_TOP], 1u);
            const unsigned tg = og / nx;
            if (og + 1u == (tg + 1u) * nx) xb_add(&bar[XB_TOPGEN], 1u);
            else XB_SPIN(xb_ld(&bar[XB_TOPGEN]) == tg, bar);
            __builtin_amdgcn_fence(__ATOMIC_ACQUIRE, "agent");
            xb_add(&bar[XB_XGEN(b.x)], 1u);
            asm volatile("s_waitcnt vmcnt(0)" ::: "memory");
        } else {
            XB_SPIN(xb_ld(&bar[XB_XGEN(b.x)]) == gen, bar);
            __builtin_amdgcn_fence(__ATOMIC_ACQUIRE, "agent");
            asm volatile("s_waitcnt vmcnt(0)" ::: "memory");
        }
    }
    __syncthreads();
}

namespace pg8 {
constexpr int BM = 256, BK = 64, HALF = 128, HTB = HALF * BK * 2, STAGE_BYTES = 8 * HTB, NXCD = 8, WGM = 8;
DI int lds_byte(int r, int c) { const int st = (r >> 4) * 2 + (c >> 5), rr = r & 15, cc = c & 31, ob = rr * 64 + cc * 2; return st * 1024 + (ob ^ (((ob >> 9) & 1) << 5)); }
DI void stage_rc(int b, int& R, int& C) { const int st = b / 1024, sb = b % 1024, swz = sb ^ (((sb >> 9) & 1) << 5); R = (st >> 1) * 16 + swz / 64; C = (st & 1) * 32 + (swz % 64) / 2; }
DI int perm32(int rho) { const int n = rho >> 4, i = rho & 15; return 8 * (i >> 2) + 4 * n + (i & 3); }

struct Unit { int pm, pn, e, ks; };
struct Gemm { const bf16* A; const bf16* Bt; int lda, ldb, K; };

struct TileOrder {
    int nM, nN, nwg, G, c, a_div; size_t a_pm, a_pn, b_pn;
    DI void init(int nM_, int nN_, int G_, int c_, size_t a_pm_, size_t b_pn_, int a_div_ = 1, size_t a_pn_ = 0) { nM = nM_; nN = nN_; nwg = nM * nN; G = G_; c = c_; a_pm = a_pm_; b_pn = b_pn_; a_div = a_div_; a_pn = a_pn_; }
    DI bool next(int i, Unit& u) const {
        const long L = (long)i * G + c; if (L >= nwg) return false;
        int wgid = (int)L; { const int q = nwg / NXCD, r = nwg % NXCD, xcd = wgid % NXCD, off = wgid / NXCD; wgid = (xcd < r ? xcd * (q + 1) : r * (q + 1) + (xcd - r) * q) + off; }
        const int nig = WGM * nN, gid = wgid / nig, fm = gid * WGM, gsz = (nM - fm) < WGM ? (nM - fm) : WGM;
        u.pm = fm + ((wgid % nig) % gsz); u.pn = (wgid % nig) / gsz; u.e = 0; u.ks = 0; return true;
    }
    DI size_t aoff(const Unit& u) const { return (size_t)u.pm * a_pm + (size_t)(u.pn / a_div) * a_pn; }
    DI size_t boff(const Unit& u) const { return (size_t)u.pn * b_pn; }
};
struct MoeOrder {
    int nN, nNk, nwg, G, c; int t1, t2, t3, t4, t5, t6, t7, t8; size_t a_pm, b_e, b_pn, ks_step;
    DI void init(const unsigned* cnt, int nN_, int ksplit, int G_, int c_, size_t a_pm_, size_t b_e_, size_t b_pn_, size_t ks_step_) {
        nN = nN_; nNk = nN_ * ksplit; G = G_; c = c_; a_pm = a_pm_; b_e = b_e_; b_pn = b_pn_; ks_step = ks_step_;
        int s = 0; s += ((int)cnt[0] + 255) >> 8; t1 = s; s += ((int)cnt[1] + 255) >> 8; t2 = s; s += ((int)cnt[2] + 255) >> 8; t3 = s; s += ((int)cnt[3] + 255) >> 8; t4 = s;
        s += ((int)cnt[4] + 255) >> 8; t5 = s; s += ((int)cnt[5] + 255) >> 8; t6 = s; s += ((int)cnt[6] + 255) >> 8; t7 = s; s += ((int)cnt[7] + 255) >> 8; t8 = s;
        nwg = t8 * nNk;
    }
    DI bool next(int i, Unit& u) const {
        const long L = (long)i * G + c; if (L >= nwg) return false;
        int wgid = (int)L; { const int q = nwg / NXCD, r = nwg % NXCD, xcd = wgid % NXCD, off = wgid / NXCD; wgid = (xcd < r ? xcd * (q + 1) : r * (q + 1) + (xcd - r) * q) + off; }
        int e = 0, ts = 0, nt = t1;
        if (wgid >= t1 * nNk) { e = 1; ts = t1; nt = t2 - t1; }
        if (wgid >= t2 * nNk) { e = 2; ts = t2; nt = t3 - t2; }
        if (wgid >= t3 * nNk) { e = 3; ts = t3; nt = t4 - t3; }
        if (wgid >= t4 * nNk) { e = 4; ts = t4; nt = t5 - t4; }
        if (wgid >= t5 * nNk) { e = 5; ts = t5; nt = t6 - t5; }
        if (wgid >= t6 * nNk) { e = 6; ts = t6; nt = t7 - t6; }
        if (wgid >= t7 * nNk) { e = 7; ts = t7; nt = t8 - t7; }
        const int loc = wgid - ts * nNk; nt = nt > 0 ? nt : 1;
        const int pn2 = loc / nt;
        u.pm = ts + loc % nt; u.pn = pn2 % nN; u.ks = pn2 / nN; u.e = e; return true;
    }
    DI size_t aoff(const Unit& u) const { return (size_t)u.pm * a_pm + (size_t)u.ks * ks_step; }
    DI size_t boff(const Unit& u) const { return (size_t)u.e * b_e + (size_t)u.pn * b_pn + (size_t)u.ks * ks_step; }
};

struct EpiBf16 {
    static constexpr bool PERM = true;
    bf16* O; int ldc; size_t ks_stride; float scale;
    DI void operator()(const f32x4 (&acc)[2][2][4][2], const Unit& u, int wr, int wc, int fr, int fq) const {
        const int row0 = u.pm * BM + wr * 64 + fr, col0 = u.pn * BM + wc * 32 + 8 * fq;
#pragma unroll
        for (int ai = 0; ai < 2; ++ai)
#pragma unroll
            for (int m = 0; m < 4; ++m) { bf16* rowp = O + (size_t)u.ks * ks_stride + (size_t)(row0 + ai * HALF + m * 16) * ldc + col0;
#pragma unroll
                for (int bj = 0; bj < 2; ++bj) { const f32x4 v0 = acc[ai][bj][m][0] * scale, v1 = acc[ai][bj][m][1] * scale;
                    u32x4 w; w.x = pk2(v0[0], v0[1]); w.y = pk2(v0[2], v0[3]); w.z = pk2(v1[0], v1[1]); w.w = pk2(v1[2], v1[3]);
                    *(u32x4*)(rowp + bj * HALF) = w; } }
    }
};
struct EpiF32 {
    static constexpr bool PERM = false;
    float* C; int ldc;
    DI void operator()(const f32x4 (&acc)[2][2][4][2], const Unit& u, int wr, int wc, int fr, int fq) const {
        const int row0 = u.pm * BM + wr * 64 + fr, col0 = u.pn * BM + wc * 32 + 4 * fq;
#pragma unroll
        for (int ai = 0; ai < 2; ++ai)
#pragma unroll
            for (int m = 0; m < 4; ++m) { float* rowp = C + (size_t)(row0 + ai * HALF + m * 16) * ldc + col0;
#pragma unroll
                for (int bj = 0; bj < 2; ++bj)
#pragma unroll
                    for (int n = 0; n < 2; ++n) *(f32x4*)(rowp + bj * HALF + n * 16) = acc[ai][bj][m][n]; }
    }
};
template <bool RES_BF16>
struct EpiRes {
    static constexpr bool PERM = false;
    float* C; const void* res; int ldc; float scale;
    DI void operator()(const f32x4 (&acc)[2][2][4][2], const Unit& u, int wr, int wc, int fr, int fq) const {
        const int row0 = u.pm * BM + wr * 64 + fr, col0 = u.pn * BM + wc * 32 + 4 * fq;
#pragma unroll
        for (int ai = 0; ai < 2; ++ai)
#pragma unroll
            for (int m = 0; m < 4; ++m) { const size_t off = (size_t)(row0 + ai * HALF + m * 16) * ldc + col0;
#pragma unroll
                for (int bj = 0; bj < 2; ++bj)
#pragma unroll
                    for (int n = 0; n < 2; ++n) { f32x4 rv;
                        if (RES_BF16) { const u32x2 w = *(const u32x2*)((const bf16*)res + off + bj * HALF + n * 16); rv = (f32x4){bflo(w.x), bfhi(w.x), bflo(w.y), bfhi(w.y)}; }
                        else rv = *(const f32x4*)((const float*)res + off + bj * HALF + n * 16);
                        *(f32x4*)(C + off + bj * HALF + n * 16) = acc[ai][bj][m][n] * scale + rv * ALPHA; }
                asm volatile("" ::: "memory"); }
    }
};
struct EpiSwiglu {
    static constexpr bool PERM = true;
    bf16* H; int ldc;
    DI void operator()(const f32x4 (&acc)[2][2][4][2], const Unit& u, int wr, int wc, int fr, int fq) const {
        const int row0 = u.pm * BM + wr * 64 + fr, col0 = u.pn * HALF + wc * 32 + 8 * fq;
#pragma unroll
        for (int ai = 0; ai < 2; ++ai)
#pragma unroll
            for (int m = 0; m < 4; ++m) { bf16* rowp = H + (size_t)(row0 + ai * HALF + m * 16) * ldc + col0;
                const f32x4 g0 = acc[ai][0][m][0], g1 = acc[ai][0][m][1], u0 = acc[ai][1][m][0], u1 = acc[ai][1][m][1];
                u32x4 w; w.x = pk2(siluf_(g0[0]) * u0[0], siluf_(g0[1]) * u0[1]); w.y = pk2(siluf_(g0[2]) * u0[2], siluf_(g0[3]) * u0[3]);
                w.z = pk2(siluf_(g1[0]) * u1[0], siluf_(g1[1]) * u1[1]); w.w = pk2(siluf_(g1[2]) * u1[2], siluf_(g1[3]) * u1[3]);
                *(u32x4*)rowp = w; asm volatile("" ::: "memory"); }
    }
};
struct EpiSwigluF8 {
    static constexpr bool PERM = true;
    unsigned char* H; int ldc; float scale;
    DI void operator()(const f32x4 (&acc)[2][2][4][2], const Unit& u, int wr, int wc, int fr, int fq) const {
        const int row0 = u.pm * BM + wr * 64 + fr, col0 = u.pn * HALF + wc * 32 + 8 * fq;
#pragma unroll
        for (int ai = 0; ai < 2; ++ai)
#pragma unroll
            for (int m = 0; m < 4; ++m) { unsigned char* rowp = H + (size_t)(row0 + ai * HALF + m * 16) * ldc + col0;
                const f32x4 g0 = acc[ai][0][m][0] * scale, g1 = acc[ai][0][m][1] * scale, u0 = acc[ai][1][m][0] * scale, u1 = acc[ai][1][m][1] * scale;
                u32x2 w; w.x = pk4_fp8(siluf_(g0[0]) * u0[0], siluf_(g0[1]) * u0[1], siluf_(g0[2]) * u0[2], siluf_(g0[3]) * u0[3]);
                w.y = pk4_fp8(siluf_(g1[0]) * u1[0], siluf_(g1[1]) * u1[1], siluf_(g1[2]) * u1[2], siluf_(g1[3]) * u1[3]);
                *(u32x2*)rowp = w; asm volatile("" ::: "memory"); }
    }
};
struct EpiPool {
    static constexpr bool PERM = true;
    unsigned char* mrg; const bf16* proj; const float* scale;
    DI void operator()(const f32x4 (&acc)[2][2][4][2], const Unit& u, int wr, int wc, int fr, int fq) const {
        const int row0 = u.pm * BM + wr * 64 + fr, col0 = u.pn * BM + wc * 32 + 8 * fq;
#pragma unroll
        for (int bj = 0; bj < 2; ++bj) { const int c = col0 + bj * HALF; const f32x4 s0 = *(const f32x4*)(scale + c), s1 = *(const f32x4*)(scale + c + 4);
#pragma unroll
            for (int ai = 0; ai < 2; ++ai)
#pragma unroll
                for (int m = 0; m < 4; ++m) { const size_t row = (size_t)(row0 + ai * HALF + m * 16);
                    const u32x4 gv = *(const u32x4*)(proj + row * NINP + C_G + 2048 + c);
                    const f32x4 v0 = acc[ai][bj][m][0] * s0, v1 = acc[ai][bj][m][1] * s1;
                    u32x2 w; w.x = pk4_fp8(v0[0] * sigmoidf_(bflo(gv.x)), v0[1] * sigmoidf_(bfhi(gv.x)), v0[2] * sigmoidf_(bflo(gv.y)), v0[3] * sigmoidf_(bfhi(gv.y)));
                    w.y = pk4_fp8(v1[0] * sigmoidf_(bflo(gv.z)), v1[1] * sigmoidf_(bfhi(gv.z)), v1[2] * sigmoidf_(bflo(gv.w)), v1[3] * sigmoidf_(bfhi(gv.w)));
                    *(u32x2*)(mrg + row * MIXW + 2048 + c) = w; asm volatile("" ::: "memory"); } }
    }
};
struct EpiLru {
    static constexpr bool PERM = false;
    unsigned* AB; const bf16* xc; const float* ba; const float* bx; const float* c8sp;
    DI void operator()(const f32x4 (&acc)[2][2][4][2], const Unit& u, int wr, int wc, int fr, int fq) const {
        const int row0 = u.pm * BM + wr * 64 + fr, ch0 = u.pn * HALF + wc * 32 + 4 * fq;
#pragma unroll
        for (int n = 0; n < 2; ++n) { const int ch = ch0 + n * 16; const f32x4 vba = *(const f32x4*)(ba + ch), vbx = *(const f32x4*)(bx + ch), vsp = *(const f32x4*)(c8sp + ch);
#pragma unroll
            for (int ai = 0; ai < 2; ++ai)
#pragma unroll
                for (int m = 0; m < 4; ++m) { const size_t off = (size_t)(row0 + ai * HALF + m * 16) * DM + ch;
                    const u32x2 xv = *(const u32x2*)(xc + off); const float xf[4] = {bflo(xv.x), bfhi(xv.x), bflo(xv.y), bfhi(xv.y)};
                    u32x4 w;
#pragma unroll
                    for (int j = 0; j < 4; ++j) { const float r = sigmoidf_(acc[ai][0][m][n][j] + vba[j]), ig = sigmoidf_(acc[ai][1][m][n][j] + vbx[j]);
                        const float la = -vsp[j] * r; w[j] = pk2(la, __builtin_amdgcn_sqrtf(fmaxf(1.0f - __expf(2.0f * la), 0.f)) * ig * xf[j]); }
                    *(u32x4*)(AB + off) = w; asm volatile("" ::: "memory"); } }
    }
};

#ifndef PG8_ALIGN
#define PG8_ALIGN true
#endif
#ifndef PG8_SP2
#define PG8_SP2 true
#endif
template <class Epi, class Sched, bool F8 = false, bool ALIGN_EPI = PG8_ALIGN, bool SP2 = PG8_SP2>
DI void gemm_phase(LAS unsigned char* lds, const Gemm g, const Sched& S, const Epi& E, const int wave_id) {
    int lane_ = lane_id_(); asm volatile("" : "+v"(lane_));
    const int wid = wave_id, lane = lane_, tid = wid * 64 + lane, wr = wid >> 2, wc = wid & 3, fr = lane & 15, fq = lane >> 4;
    const int nt = g.K / BK;
    unsigned voffA[2], voffB[2];
#pragma unroll
    for (int i = 0; i < 2; ++i) { int R, C; stage_rc(tid * 16 + i * 8192, R, C); const int Rb = Epi::PERM ? ((R & ~31) + perm32(R & 31)) : R;
        voffA[i] = (unsigned)(R * g.lda + C) * 2u; voffB[i] = (unsigned)(Rb * g.ldb + C) * 2u; }
    const size_t kstep = (size_t)(BK * 2);
    const size_t hstepA = (size_t)HALF * g.lda * 2, hstepB = (size_t)HALF * g.ldb * 2;
    const unsigned ldsw = (unsigned)wid * 1024u;
    const int aoff = lds_byte(wr * 64 + fr, fq * 8), boff = lds_byte(wc * 32 + fr, fq * 8);
#define PG8_SA(b, h) (((b) * 2 + (h)) * HTB)
#define PG8_SB(b, h) ((4 + (b) * 2 + (h)) * HTB)
#define PG8_STAGE(bufoff, gbase, voff) do { _Pragma("unroll") for (int _i = 0; _i < 2; ++_i) \
        __builtin_amdgcn_global_load_lds((const unsigned*)((const char*)(gbase) + (voff)[_i]), (LAS unsigned*)(lds + (bufoff) + ldsw + _i * 8192), 16, 0, 0); } while (0)
#define PG8_LDA(dst, b, h) do { _Pragma("unroll") for (int m = 0; m < 4; ++m) _Pragma("unroll") for (int k = 0; k < 2; ++k) dst[m][k] = *(const LAS bf16x8*)(lds + PG8_SA(b, h) + aoff + m * 2048 + k * 1024); } while (0)
#define PG8_LDB(dst, b, h) do { _Pragma("unroll") for (int n = 0; n < 2; ++n) _Pragma("unroll") for (int k = 0; k < 2; ++k) dst[n][k] = *(const LAS bf16x8*)(lds + PG8_SB(b, h) + boff + n * 2048 + k * 1024); } while (0)
#define PG8_F8CAT(x) __builtin_shufflevector(__builtin_bit_cast(i32x4, (x)[0]), __builtin_bit_cast(i32x4, (x)[1]), 0, 1, 2, 3, 4, 5, 6, 7)
#define PG8_MMA(ai, bj, At, Bt) do { __builtin_amdgcn_s_setprio(1); _Pragma("unroll") for (int m = 0; m < 4; ++m) _Pragma("unroll") for (int n = 0; n < 2; ++n) { \
        if constexpr (F8) { const i32x8 fa_ = PG8_F8CAT(Bt[n]), fb_ = PG8_F8CAT(At[m]); asm volatile("v_mfma_scale_f32_16x16x128_f8f6f4 %0, %1, %2, %0, %3, %3 op_sel_hi:[0,0,0]" : "+v"(acc[ai][bj][m][n]) : "v"(fa_), "v"(fb_), "v"(f8one)); } \
        else { _Pragma("unroll") for (int k = 0; k < 2; ++k) acc[ai][bj][m][n] = __builtin_amdgcn_mfma_f32_16x16x32_bf16(Bt[n][k], At[m][k], acc[ai][bj][m][n], 0, 0, 0); } } \
        __builtin_amdgcn_s_setprio(0); } while (0)
#define PG8_WAIT_V(n) asm volatile("s_waitcnt vmcnt(" #n ")" ::: "memory")
#define PG8_WAIT_L(n) asm volatile("s_waitcnt lgkmcnt(" #n ")" ::: "memory")
#define PG8_BAR __builtin_amdgcn_s_barrier()
#define PG8_SCHED __builtin_amdgcn_sched_barrier(0)
    int f8one = 0x7f7f7f7f; asm volatile("" : "+v"(f8one));
    Unit cur, nxt; int ui = 0;
    if (!S.next(0, cur)) return;
    f32x4 acc[2][2][4][2];
#pragma unroll
    for (int a = 0; a < 2; ++a)
#pragma unroll
        for (int b = 0; b < 2; ++b)
#pragma unroll
            for (int m = 0; m < 4; ++m)
#pragma unroll
                for (int n = 0; n < 2; ++n) acc[a][b][m][n] = (f32x4){0.f, 0.f, 0.f, 0.f};
    bf16x8 At[4][2], B0[2][2], B1[2][2];
    const char* cA = (const char*)g.A + S.aoff(cur); const char* cB = (const char*)g.Bt + S.boff(cur);
    if constexpr (SP2) {
        PG8_STAGE(PG8_SB(0, 0), cB, voffB); PG8_STAGE(PG8_SB(0, 1), cB + hstepB, voffB); PG8_STAGE(PG8_SA(0, 0), cA, voffA); PG8_STAGE(PG8_SA(0, 1), cA + hstepA, voffA);
        if (wr == 1) PG8_BAR;
        PG8_WAIT_V(2); PG8_BAR;
        PG8_STAGE(PG8_SB(1, 0), cB + kstep, voffB); PG8_STAGE(PG8_SA(1, 0), cA + kstep, voffA); PG8_STAGE(PG8_SB(1, 1), cB + hstepB + kstep, voffB);
        PG8_WAIT_V(6); PG8_BAR;
    } else {
        PG8_STAGE(PG8_SB(0, 0), cB, voffB); PG8_STAGE(PG8_SA(0, 0), cA, voffA); PG8_STAGE(PG8_SB(0, 1), cB + hstepB, voffB); PG8_STAGE(PG8_SA(0, 1), cA + hstepA, voffA);
        if (wr == 1) PG8_BAR;
        PG8_WAIT_V(4); PG8_BAR;
        PG8_STAGE(PG8_SB(1, 0), cB + kstep, voffB); PG8_STAGE(PG8_SA(1, 0), cA + kstep, voffA); PG8_STAGE(PG8_SB(1, 1), cB + hstepB + kstep, voffB);
        PG8_WAIT_V(6); PG8_BAR;
    }
    for (;;) {
        const bool has_next = S.next(ui + 1, nxt);
        const char* nA = has_next ? (const char*)g.A + S.aoff(nxt) : cA; const char* nB = has_next ? (const char*)g.Bt + S.boff(nxt) : cB;
#pragma nounroll
        for (int t = 0; t < nt; t += 2) {
            const bool last = (t == nt - 2);
            const char* a1 = cA + (size_t)(t + 1) * kstep;
            const char* a2 = last ? nA : cA + (size_t)(t + 2) * kstep; const char* b2 = last ? nB : cB + (size_t)(t + 2) * kstep;
            const char* a3 = a2 + kstep; const char* b3 = b2 + kstep;
            if constexpr (SP2) {
            PG8_LDB(B0, 0, 0); PG8_LDB(B1, 0, 1); PG8_SCHED; PG8_LDA(At, 0, 0); PG8_STAGE(PG8_SA(1, 1), a1 + hstepA, voffA);
            PG8_WAIT_V(8); PG8_WAIT_L(0); PG8_BAR; PG8_MMA(0, 0, At, B0); PG8_MMA(0, 1, At, B1); PG8_BAR; PG8_SCHED;
            PG8_LDA(At, 0, 1); PG8_STAGE(PG8_SB(0, 0), b2, voffB); PG8_STAGE(PG8_SB(0, 1), b2 + hstepB, voffB); PG8_STAGE(PG8_SA(0, 0), a2, voffA);
            PG8_WAIT_V(8); PG8_WAIT_L(0); PG8_BAR; PG8_MMA(1, 0, At, B0); PG8_MMA(1, 1, At, B1); PG8_BAR; PG8_SCHED;
            PG8_LDB(B0, 1, 0); PG8_LDB(B1, 1, 1); PG8_SCHED; PG8_LDA(At, 1, 0); PG8_STAGE(PG8_SA(0, 1), a2 + hstepA, voffA);
            PG8_WAIT_V(8); PG8_WAIT_L(0); PG8_BAR; PG8_MMA(0, 0, At, B0); PG8_MMA(0, 1, At, B1); PG8_BAR; PG8_SCHED;
            PG8_LDA(At, 1, 1); PG8_STAGE(PG8_SB(1, 0), b3, voffB); PG8_STAGE(PG8_SB(1, 1), b3 + hstepB, voffB); PG8_STAGE(PG8_SA(1, 0), a3, voffA);
            PG8_WAIT_V(8); PG8_WAIT_L(0); PG8_BAR; PG8_MMA(1, 0, At, B0); PG8_MMA(1, 1, At, B1); PG8_BAR; PG8_SCHED;
            } else {
            PG8_LDB(B0, 0, 0); PG8_SCHED; PG8_LDA(At, 0, 0); PG8_STAGE(PG8_SA(1, 1), a1 + hstepA, voffA);
            PG8_WAIT_L(8); PG8_BAR; PG8_WAIT_L(0); PG8_MMA(0, 0, At, B0); PG8_BAR; PG8_SCHED;
            PG8_LDB(B1, 0, 1); PG8_STAGE(PG8_SB(0, 0), b2, voffB);
            PG8_BAR; PG8_WAIT_L(0); PG8_MMA(0, 1, At, B1); PG8_BAR;
            PG8_LDA(At, 0, 1); PG8_STAGE(PG8_SA(0, 0), a2, voffA);
            PG8_BAR; PG8_WAIT_L(0); PG8_MMA(1, 0, At, B0); PG8_BAR; PG8_SCHED;
            PG8_STAGE(PG8_SB(0, 1), b2 + hstepB, voffB);
            PG8_WAIT_V(6); PG8_BAR; PG8_MMA(1, 1, At, B1); PG8_BAR;
            PG8_LDB(B0, 1, 0); PG8_SCHED; PG8_LDA(At, 1, 0); PG8_STAGE(PG8_SA(0, 1), a2 + hstepA, voffA);
            PG8_WAIT_L(8); PG8_BAR; PG8_WAIT_L(0); PG8_MMA(0, 0, At, B0); PG8_BAR; PG8_SCHED;
            PG8_LDB(B1, 1, 1); PG8_STAGE(PG8_SB(1, 0), b3, voffB);
            PG8_BAR; PG8_WAIT_L(0); PG8_MMA(0, 1, At, B1); PG8_BAR;
            PG8_LDA(At, 1, 1); PG8_STAGE(PG8_SA(1, 0), a3, voffA);
            PG8_BAR; PG8_WAIT_L(0); PG8_MMA(1, 0, At, B0); PG8_BAR; PG8_SCHED;
            PG8_STAGE(PG8_SB(1, 1), b3 + hstepB, voffB);
            PG8_WAIT_V(6); PG8_BAR; PG8_MMA(1, 1, At, B1); PG8_BAR;
            }
        }
        if constexpr (ALIGN_EPI) { if (wr == 0) PG8_BAR; }
        if constexpr (F8) asm volatile("s_nop 15\n\ts_nop 15" ::: "memory");
        E(acc, cur, wr, wc, fr, fq);
        if (!has_next) break;
#pragma unroll
        for (int a = 0; a < 2; ++a)
#pragma unroll
            for (int b = 0; b < 2; ++b)
#pragma unroll
                for (int m = 0; m < 4; ++m)
#pragma unroll
                    for (int n = 0; n < 2; ++n) acc[a][b][m][n] = (f32x4){0.f, 0.f, 0.f, 0.f};
        cur = nxt; cA = nA; cB = nB; ++ui;
        if constexpr (ALIGN_EPI) { if (wr == 1) PG8_BAR; }
    }
    PG8_WAIT_V(0);
    if constexpr (!ALIGN_EPI) { if (wr == 0) PG8_BAR; }
    PG8_BAR;
#undef PG8_SA
#undef PG8_SB
#undef PG8_STAGE
#undef PG8_LDA
#undef PG8_LDB
#undef PG8_MMA
#undef PG8_F8CAT
#undef PG8_WAIT_V
#undef PG8_WAIT_L
#undef PG8_BAR
#undef PG8_SCHED
}
}

struct Args { const void* in[24]; float* out; unsigned char* ws; int ph_lo, ph_hi; };
struct Frame {
    LAS unsigned char* lds; unsigned* ctl; unsigned char* ws;
    int tid, lane, wave, G, bid;
};
#define INF(k) ((const float*)args.in[k])
DI float wave_sum(float v) {
#pragma unroll
    for (int o = 1; o < 64; o <<= 1) v += __shfl_xor(v, o);
    return v;
}

constexpr float F8_WSCALE = 64.0f;
DI void tr_item(const float* W, int ldS, int Nvalid, bf16* WT, int ldD, int koff, int mode, int roff, LAS float* scr, int k0, int n0, int lane, bool f8 = false) {
    const int nl = n0 + (lane & 31);
    float tv[32]; const float* wp = W + (size_t)(k0 + (lane >> 5)) * ldS + nl; const bool ok = nl < Nvalid;
#pragma unroll
    for (int i = 0; i < 32; ++i) tv[i] = ok ? __builtin_nontemporal_load(wp + (size_t)(2 * i) * ldS) : 0.f;
#pragma unroll
    for (int i = 0; i < 32; ++i) scr[(2 * i + (lane >> 5)) * 33 + (lane & 31)] = tv[i];
    LDS_WAIT(); asm volatile("" ::: "memory");
    const int c = lane & 7;
#pragma unroll
    for (int j = 0; j < 4; ++j) { const int nn = (lane >> 3) + 8 * j, n = n0 + nn; const LAS float* s = scr + (8 * c) * 33 + nn;
        u32x4 o; o.x = pk2(s[0 * 33], s[1 * 33]); o.y = pk2(s[2 * 33], s[3 * 33]); o.z = pk2(s[4 * 33], s[5 * 33]); o.w = pk2(s[6 * 33], s[7 * 33]);
        const int row = mode == 0 ? roff + n : (mode == 1 ? (n < C_PADLO ? n : n + (C_P - C_PADLO)) : ((n >> 7) << 8) + roff + (n & 127));
        if (n < Nvalid) { if (f8) { u32x2 o8; o8.x = pk4_fp8(s[0 * 33] * F8_WSCALE, s[1 * 33] * F8_WSCALE, s[2 * 33] * F8_WSCALE, s[3 * 33] * F8_WSCALE); o8.y = pk4_fp8(s[4 * 33] * F8_WSCALE, s[5 * 33] * F8_WSCALE, s[6 * 33] * F8_WSCALE, s[7 * 33] * F8_WSCALE);
                *(u32x2*)((unsigned char*)WT + (size_t)row * ldD + koff + k0 + 8 * c) = o8; }
            else *(u32x4*)(WT + (size_t)row * ldD + koff + k0 + 8 * c) = o; } }
    LDS_WAIT(); asm volatile("" ::: "memory");
}
constexpr int NB_IN = (NIN + 31) / 32;
constexpr int CI_IN = 32 * NB_IN, CI_OUT = 96 * 64, CI_POOL = 8 * 8 * 16, CI_LRU = 64 * 8, CI_GU = 2 * 32 * 172, CI_DN = 86 * 64, CI_MGU = 16 * 32 * 224, CI_MDN = 8 * 112 * 64;
constexpr int CE_0 = CI_IN + CI_POOL + CI_LRU;
constexpr int CE_1 = CE_0 + CI_OUT;
constexpr int CE_2 = CE_1 + CI_GU;
constexpr int CE_3 = CE_2 + CI_DN;
constexpr int CE_4 = CE_3 + CI_IN;
constexpr int CE_5 = CE_4 + CI_OUT;
constexpr int CE_6 = CE_5 + CI_MGU;
constexpr int CE_7 = CE_6 + CI_MDN;
constexpr int MOE_EARLY = 224 * 8 * 14;
constexpr int P2_ITEMS = 224 * 8 * 4;
DI void conv_item(unsigned char* ws, const Args& args, int idx, LAS float* scr, int lane) {
    const float* W; bf16* WT; int ldS, Nv, ldD, koff = 0, mode = 0, roff = 0, kb, nb; int r = idx; bool f8 = false;
    if (r < CI_IN) { kb = r / NB_IN; nb = r % NB_IN; W = INF(2); ldS = NIN; Nv = NIN; WT = (bf16*)(ws + WS_WIN); ldD = DM; mode = 1; }
    else if ((r -= CI_IN) < CI_POOL) { const int lg = r >> 7, q = r & 127; kb = q >> 4; nb = q & 15; W = INF(4) + (size_t)lg * 512 * 512; ldS = 512; Nv = 512; WT = (bf16*)(ws + WS_WPOOL) + (size_t)(lg >> 2) * 2048 * 512; ldD = 512; roff = (lg & 3) * 512; }
    else if ((r -= CI_POOL) < CI_LRU) { const int cmb = r >> 3, q = r & 7, l = cmb >> 5, which = (cmb >> 4) & 1, n = cmb & 15; kb = q >> 2; nb = q & 3;
        W = (which ? INF(10) : INF(8)) + ((size_t)l * 16 + n) * 128 * 128; ldS = 128; Nv = 128; WT = (bf16*)(ws + WS_WLRU) + (size_t)l * 4096 * 256; ldD = 256; koff = (n & 1) * 128; roff = n * 256 + which * 128; }
    else if ((r -= CI_LRU) < CI_OUT) { kb = r >> 6; nb = r & 63; W = INF(3); ldS = DM; Nv = DM; WT = (bf16*)(ws + WS_WOUT); ldD = MIXW; f8 = true; }
    else if ((r -= CI_OUT) < CI_GU) { const int which = r / (32 * 172), q = r % (32 * 172); kb = q / 172; nb = q % 172; W = which ? INF(18) : INF(17); ldS = DFF; Nv = DFF; WT = (bf16*)(ws + WS_WGU); ldD = DM; mode = 2; roff = which * 128; }
    else if ((r -= CI_GU) < CI_DN) { kb = r >> 6; nb = r & 63; W = INF(19); ldS = DM; Nv = DM; WT = (bf16*)(ws + WS_WDN); ldD = DFF; }
    else if ((r -= CI_DN) < CI_IN) { kb = r / NB_IN; nb = r % NB_IN; W = INF(2) + (size_t)DM * NIN; ldS = NIN; Nv = NIN; WT = (bf16*)(ws + WS_WIN) + (size_t)NINP * DM; ldD = DM; mode = 1; }
    else if ((r -= CI_IN) < CI_OUT) { kb = r >> 6; nb = r & 63; W = INF(3) + (size_t)MIXW * DM; ldS = DM; Nv = DM; WT = (bf16*)(ws + WS_WOUT + (size_t)DM * MIXW); ldD = MIXW; f8 = true; }
    else if ((r -= CI_OUT) < CI_MGU) { const int ew = r / (32 * 224), q = r % (32 * 224), e = ew >> 1, which = ew & 1; kb = q / 224; nb = q % 224;
        W = (which ? INF(22) : INF(21)) + (size_t)e * DM * DEXP; ldS = DEXP; Nv = DEXP; WT = (bf16*)(ws + WS_MWGU + (size_t)e * 2 * DEXP * DM); ldD = DM; mode = 2; roff = which * 128; f8 = true; }
    else { r -= CI_MGU; const int e = r / (112 * 64), q = r % (112 * 64); kb = q >> 6; nb = q & 63; W = INF(23) + (size_t)e * DEXP * DM; ldS = DM; Nv = DM; WT = (bf16*)(ws + WS_MWDN + (size_t)e * DM * DEXP); ldD = DEXP; f8 = true; }
    tr_item(W, ldS, Nv, WT, ldD, koff, mode, roff, scr, 64 * kb, 32 * nb, lane, f8);
}
DI void conv_range(Frame& F, const Args& args, int i0, int i1, int wg0) {
    if (F.bid < wg0) return;
    LAS float* scr = (LAS float*)(F.lds + F.wave * 16384);
    const int gw = (F.bid - wg0) * 8 + F.wave, NGW = (F.G - wg0) * 8;
    for (int it = i0 + gw; it < i1; it += NGW) conv_item(F.ws, args, it, scr, F.lane);
}
DI void p0_prologue(Frame& F, const Args& args) {
    conv_range(F, args, 0, CE_0, 0);
    bf16* Wlru = (bf16*)(F.ws + WS_WLRU);
    const int gt = F.bid * 512 + F.tid, NT = F.G * 512;
    for (int i = gt; i < 2 * 4096 * 16; i += NT) { const int row = i >> 4, ch = i & 15, n = (row & 4095) >> 8;
        *(u32x4*)(Wlru + (size_t)row * 256 + ((n + 1) & 1) * 128 + ch * 8) = (u32x4){0u, 0u, 0u, 0u}; }
    float* cosA = (float*)(F.ws + WS_COSA); float* sinA = (float*)(F.ws + WS_SINA); float* cosI = (float*)(F.ws + WS_COSI); float* sinI = (float*)(F.ws + WS_SINI);
    for (int i = gt; i < MTOK * 96; i += NT) {
        const int tok = i / 96, j = i % 96; const bool isA = j < 64; const int fi = isA ? j : j - 64; const double dim = isA ? 128.0 : 64.0;
        const float inv = (float)pow(10000.0, -(double)(2 * fi) / dim);
        const float ang = (float)((const int*)args.in[1])[tok] * inv; const double a = (double)ang; const double nrev = rint(a * 0.15915494309189535); const double rr = a - nrev * 6.283185307179586;
        const float cv = (float)cos(rr), sv = (float)sin(rr);
        if (isA) { cosA[tok * 64 + fi] = cv; sinA[tok * 64 + fi] = sv; } else { cosI[tok * 32 + fi] = cv; sinI[tok * 32 + fi] = sv; }
    }
    float* c8 = (float*)(F.ws + WS_LRUC);
    for (int i = gt; i < 2 * DM; i += NT) { const float lam = INF(12)[i]; c8[i] = 8.0f * log1pf(expf(-lam)); }
    bf16* xb = (bf16*)(F.ws + WS_XB);
    for (int i = gt; i < MTOK * DM / 8; i += NT) { const f32x4 a = *(const f32x4*)(INF(0) + (size_t)i * 8), b = *(const f32x4*)(INF(0) + (size_t)i * 8 + 4);
        u32x4 o; o.x = pk2(a[0], a[1]); o.y = pk2(a[2], a[3]); o.z = pk2(b[0], b[1]); o.w = pk2(b[2], b[3]); *(u32x4*)(xb + (size_t)i * 8) = o; }
}

DI void ld8(const bf16* p, float (&v)[8]) { const u32x4 w = *(const u32x4*)p; v[0] = bflo(w.x); v[1] = bfhi(w.x); v[2] = bflo(w.y); v[3] = bfhi(w.y); v[4] = bflo(w.z); v[5] = bfhi(w.z); v[6] = bflo(w.w); v[7] = bfhi(w.w); }
DI void st8(bf16* p, const float (&v)[8]) { u32x4 o; o.x = pk2(v[0], v[1]); o.y = pk2(v[2], v[3]); o.z = pk2(v[4], v[5]); o.w = pk2(v[6], v[7]); *(u32x4*)p = o; }

DI void acc8(float (&s)[8], const u32x4& r, float m) { s[0] += m * bflo(r.x); s[1] += m * bfhi(r.x); s[2] += m * bflo(r.y); s[3] += m * bfhi(r.y); s[4] += m * bflo(r.z); s[5] += m * bfhi(r.z); s[6] += m * bflo(r.w); s[7] += m * bfhi(r.w); }
template <int G>
DI void pool_range(const bf16* proj, bf16* diff, int tok0, int c) {
    constexpr int W = 2 << G, NR = W - 1 + 16;
    const int tpos0 = tok0 & (SEQ - 1);
    const bf16* pp = proj + (size_t)tok0 * NINP + C_P + c;
    u32x4 r[NR];
#pragma unroll
    for (int i = 0; i < NR; ++i) { const int back = (W - 1) - i; r[i] = *(const u32x4*)(pp - (ptrdiff_t)((back > 0 && tpos0 - back < 0) ? 0 : back) * NINP); }
    float s[8];
#pragma unroll
    for (int k = 0; k < 8; ++k) s[k] = 0.f;
#pragma unroll
    for (int i = 0; i < W - 1; ++i) acc8(s, r[i], (tpos0 - ((W - 1) - i) >= 0) ? 1.f : 0.f);
#pragma unroll
    for (int t = 0; t < 16; ++t) {
        acc8(s, r[W - 1 + t], 1.f);
        const int tpos = tpos0 + t, cnt = (tpos + 1) < W ? (tpos + 1) : W; const float rc = 1.0f / (float)cnt; const u32x4 cur = r[W - 1 + t];
        float v[8] = {s[0] * rc - bflo(cur.x), s[1] * rc - bfhi(cur.x), s[2] * rc - bflo(cur.y), s[3] * rc - bfhi(cur.y), s[4] * rc - bflo(cur.z), s[5] * rc - bfhi(cur.z), s[6] * rc - bflo(cur.w), s[7] * rc - bfhi(cur.w)};
        st8(diff + (size_t)(tok0 + t) * DM + c, v);
        acc8(s, r[t], (tpos - (W - 1) >= 0) ? -1.f : 0.f);
    }
}
DI void p2_prep(Frame& F, const Args& args, int layer) {
    bf16* proj = (bf16*)(F.ws + WS_PROJ); bf16* diff = (bf16*)(F.ws + WS_DIFF); bf16* xc = (bf16*)(F.ws + WS_XC);
    const float* cosA = (const float*)(F.ws + WS_COSA); const float* sinA = (const float*)(F.ws + WS_SINA); const float* cosI = (const float*)(F.ws + WS_COSI); const float* sinI = (const float*)(F.ws + WS_SINI);
    const int gt = F.bid * 512 + F.tid, NT = F.G * 512;
    for (int it = gt; it < MTOK * 32; it += NT) {
        const int tok = it >> 5, dch = it & 7, hq = (it >> 3) & 3, d = dch * 8;
        const float* ct = cosA + tok * 64 + d; const float* st = sinA + tok * 64 + d;
        const f32x4 c0 = *(const f32x4*)ct, c1 = *(const f32x4*)(ct + 4), s0 = *(const f32x4*)st, s1 = *(const f32x4*)(st + 4);
        bf16* base = proj + (size_t)tok * NINP;
        u32x4 xa[5], xb_[5];
#pragma unroll
        for (int q = 0; q < 5; ++q) { bf16* p1 = base + (q < 4 ? C_Q + (hq * 4 + q) * 128 : C_K + hq * 128) + d; xa[q] = *(const u32x4*)p1; xb_[q] = *(const u32x4*)(p1 + 64); }
#pragma unroll
        for (int q = 0; q < 5; ++q) { bf16* p1 = base + (q < 4 ? C_Q + (hq * 4 + q) * 128 : C_K + hq * 128) + d;
            const float x1[8] = {bflo(xa[q].x), bfhi(xa[q].x), bflo(xa[q].y), bfhi(xa[q].y), bflo(xa[q].z), bfhi(xa[q].z), bflo(xa[q].w), bfhi(xa[q].w)};
            const float x2[8] = {bflo(xb_[q].x), bfhi(xb_[q].x), bflo(xb_[q].y), bfhi(xb_[q].y), bflo(xb_[q].z), bfhi(xb_[q].z), bflo(xb_[q].w), bfhi(xb_[q].w)};
            float y1[8], y2[8];
#pragma unroll
            for (int i = 0; i < 8; ++i) { const float c = i < 4 ? c0[i & 3] : c1[i & 3], s = i < 4 ? s0[i & 3] : s1[i & 3]; y1[i] = x1[i] * c - x2[i] * s; y2[i] = x2[i] * c + x1[i] * s; }
            st8(p1, y1); st8(p1 + 64, y2); }
    }
    for (int it = gt; it < MTOK * 16; it += NT) {
        const int tok = it >> 4, dch = it & 3, hq = (it >> 2) & 3, d = dch * 8;
        const float* ct = cosI + tok * 32 + d; const float* st = sinI + tok * 32 + d;
        const f32x4 c0 = *(const f32x4*)ct, c1 = *(const f32x4*)(ct + 4), s0 = *(const f32x4*)st, s1 = *(const f32x4*)(st + 4);
        bf16* base = proj + (size_t)tok * NINP;
        u32x4 xa[5], xb_[5];
#pragma unroll
        for (int q = 0; q < 5; ++q) { bf16* p1 = base + (q < 4 ? C_QI + (hq * 4 + q) * 64 : C_KI) + d; xa[q] = *(const u32x4*)p1; xb_[q] = *(const u32x4*)(p1 + 32); }
#pragma unroll
        for (int q = 0; q < 5; ++q) { if (q < 4 || hq == 0) { bf16* p1 = base + (q < 4 ? C_QI + (hq * 4 + q) * 64 : C_KI) + d;
            const float x1[8] = {bflo(xa[q].x), bfhi(xa[q].x), bflo(xa[q].y), bfhi(xa[q].y), bflo(xa[q].z), bfhi(xa[q].z), bflo(xa[q].w), bfhi(xa[q].w)};
            const float x2[8] = {bflo(xb_[q].x), bfhi(xb_[q].x), bflo(xb_[q].y), bfhi(xb_[q].y), bflo(xb_[q].z), bfhi(xb_[q].z), bflo(xb_[q].w), bfhi(xb_[q].w)};
            float y1[8], y2[8];
#pragma unroll
            for (int i = 0; i < 8; ++i) { const float c = i < 4 ? c0[i & 3] : c1[i & 3], s = i < 4 ? s0[i & 3] : s1[i & 3]; y1[i] = x1[i] * c - x2[i] * s; y2[i] = x2[i] * c + x1[i] * s; }
            st8(p1, y1); st8(p1 + 32, y2); } }
    }
    const float* cw = INF(6) + (size_t)layer * 4 * DM; const float* cb = INF(7) + (size_t)layer * DM;
    for (int it = gt; it < (MTOK / 16) * 256; it += NT) {
        const int cg = it & 255, c = cg * 8, tok0 = (it >> 8) * 16;
        const int g = cg >> 6;
        if (g == 0) pool_range<0>(proj, diff, tok0, c); else if (g == 1) pool_range<1>(proj, diff, tok0, c); else if (g == 2) pool_range<2>(proj, diff, tok0, c); else pool_range<3>(proj, diff, tok0, c);
    }
    for (int it = gt; it < (MTOK / 16) * 256; it += NT) {
        const int cg = it & 255, c = cg * 8, tok0 = (it >> 8) * 16, tpos0 = tok0 & (SEQ - 1);
        const bf16* px = proj + (size_t)tok0 * NINP + C_XR + c;
        u32x4 r[19];
#pragma unroll
        for (int i = 0; i < 19; ++i) { const int back = 3 - i; r[i] = *(const u32x4*)(px - (ptrdiff_t)((back > 0 && tpos0 - back < 0) ? 0 : back) * NINP); }
        f32x4 w0[4], w1[4]; const f32x4 b0 = *(const f32x4*)(cb + c), b1 = *(const f32x4*)(cb + c + 4);
#pragma unroll
        for (int jj = 0; jj < 4; ++jj) { w0[jj] = *(const f32x4*)(cw + jj * DM + c); w1[jj] = *(const f32x4*)(cw + jj * DM + c + 4); }
#pragma unroll
        for (int t = 0; t < 16; ++t) {
            float acc[8] = {b0[0], b0[1], b0[2], b0[3], b1[0], b1[1], b1[2], b1[3]};
#pragma unroll
            for (int jj = 0; jj < 4; ++jj) { const float m = (tpos0 + t - (3 - jj) >= 0) ? 1.f : 0.f; const u32x4 x = r[t + jj];
                acc[0] += m * bflo(x.x) * w0[jj][0]; acc[1] += m * bfhi(x.x) * w0[jj][1]; acc[2] += m * bflo(x.y) * w0[jj][2]; acc[3] += m * bfhi(x.y) * w0[jj][3];
                acc[4] += m * bflo(x.z) * w1[jj][0]; acc[5] += m * bfhi(x.z) * w1[jj][1]; acc[6] += m * bflo(x.w) * w1[jj][2]; acc[7] += m * bfhi(x.w) * w1[jj][3]; }
            st8(xc + (size_t)(tok0 + t) * DM + c, acc);
        }
    }
}

DI void p3_indexer(Frame& F) {
    const bf16* proj = (const bf16*)(F.ws + WS_PROJ); float* sc = (float*)(F.ws + WS_SC);
    const int gw = F.bid * 8 + F.wave, NGW = F.G * 8, l15 = F.lane & 15, l4 = F.lane >> 4;
    for (int u = gw; u < BATCH * 576; u += NGW) {
        const int b = u / 576, r = u % 576; int g8 = 0;
#pragma unroll
        for (int k = 1; k < 8; ++k) g8 = (r >= 8 * k * (k + 1)) ? k : g8;
        const int rr = r - 8 * g8 * (g8 + 1), sp = rr % (g8 + 1), qq = rr / (g8 + 1), qb16 = g8 * 16 + qq, c = qb16 >> 2;
        const int limit = (c + 1) * 64, kbeg = sp * 256, kend = (kbeg + 256) < limit ? (kbeg + 256) : limit;
        const int qtok = b * SEQ + qb16 * 16 + l15;
        const bf16* qrow = proj + (size_t)qtok * NINP;
        bf16x8 qf[16][2]; float w[16];
        { const u32x4 w0 = *(const u32x4*)(qrow + C_WI), w1 = *(const u32x4*)(qrow + C_WI + 8); const float s = 0.125f * 0.25f;
          w[0] = bflo(w0.x) * s; w[1] = bfhi(w0.x) * s; w[2] = bflo(w0.y) * s; w[3] = bfhi(w0.y) * s; w[4] = bflo(w0.z) * s; w[5] = bfhi(w0.z) * s; w[6] = bflo(w0.w) * s; w[7] = bfhi(w0.w) * s;
          w[8] = bflo(w1.x) * s; w[9] = bfhi(w1.x) * s; w[10] = bflo(w1.y) * s; w[11] = bfhi(w1.y) * s; w[12] = bflo(w1.z) * s; w[13] = bfhi(w1.z) * s; w[14] = bflo(w1.w) * s; w[15] = bfhi(w1.w) * s; }
#pragma unroll
        for (int h = 0; h < 16; ++h)
#pragma unroll
            for (int ks = 0; ks < 2; ++ks) qf[h][ks] = *(const bf16x8*)(qrow + C_QI + h * 64 + ks * 32 + l4 * 8);
        const bf16* kbase = proj + (size_t)(b * SEQ + l15) * NINP + C_KI + l4 * 8;
        bf16x8 nk0 = *(const bf16x8*)(kbase + (size_t)kbeg * NINP), nk1 = *(const bf16x8*)(kbase + (size_t)kbeg * NINP + 32);
        for (int k0 = kbeg; k0 < kend; k0 += 16) {
            const bf16x8 ka0 = nk0, ka1 = nk1;
            { const int kn = (k0 + 16 < kend) ? k0 + 16 : k0; nk0 = *(const bf16x8*)(kbase + (size_t)kn * NINP); nk1 = *(const bf16x8*)(kbase + (size_t)kn * NINP + 32); }
            f32x4 tot = {0.f, 0.f, 0.f, 0.f};
#pragma unroll
            for (int h = 0; h < 16; ++h) { f32x4 s = {0.f, 0.f, 0.f, 0.f};
                s = __builtin_amdgcn_mfma_f32_16x16x32_bf16(ka0, qf[h][0], s, 0, 0, 0); s = __builtin_amdgcn_mfma_f32_16x16x32_bf16(ka1, qf[h][1], s, 0, 0, 0);
#pragma unroll
                for (int j = 0; j < 4; ++j) tot[j] += w[h] * fmaxf(s[j], 0.f); }
            *(f32x4*)(sc + (size_t)qtok * SEQ + k0 + 4 * l4) = tot;
        }
    }
}

DI void p4_select(Frame& F) {
    const float* sc = (const float*)(F.ws + WS_SC); unsigned* mask = (unsigned*)(F.ws + WS_MASK);
    const int gw = F.bid * 8 + F.wave, NGW = F.G * 8, lane = F.lane;
    for (int tok = gw; tok < MTOK; tok += NGW) {
        const int tpos = tok & (SEQ - 1), limit = ((tpos >> 6) + 1) * 64, nw = limit >> 5;
        unsigned mw = 0u;
        if (limit <= 256) { mw = lane < nw ? 0xffffffffu : 0u; }
        else {
            unsigned key[32];
            if (lane < nw) { const float* p = sc + (size_t)tok * SEQ + lane * 32;
#pragma unroll
                for (int q = 0; q < 8; ++q) { const f32x4 v = *(const f32x4*)(p + 4 * q);
#pragma unroll
                    for (int j = 0; j < 4; ++j) { const unsigned uu = __float_as_uint(v[j]); key[4 * q + j] = (uu & 0x80000000u) ? ~uu : (uu | 0x80000000u); } } }
            else {
#pragma unroll
                for (int j = 0; j < 32; ++j) key[j] = 0u; }
            unsigned T = 0u; bool exact = false;
            for (int bit = 31; bit >= 0; --bit) {
                const unsigned cand = T | (1u << bit); int cnt = 0;
#pragma unroll
                for (int j = 0; j < 32; ++j) cnt += __popcll(__ballot(key[j] >= cand));
                if (cnt >= 256) { T = cand; if (cnt == 256) { exact = true; break; } }
            }
            unsigned gtw = 0u, eqw = 0u;
#pragma unroll
            for (int j = 0; j < 32; ++j) { gtw |= (key[j] > T) ? (1u << j) : 0u; eqw |= (key[j] == T) ? (1u << j) : 0u; }
            if (exact) { mw = gtw | eqw; }
            else {
                int ngt = 0;
#pragma unroll
                for (int j = 0; j < 32; ++j) ngt += __popcll(__ballot(key[j] > T));
                const int need = 256 - ngt; const int el = __popc(eqw);
                int pre = el;
#pragma unroll
                for (int o = 1; o < 64; o <<= 1) { const int t = __shfl_up(pre, o); pre += (lane >= o) ? t : 0; }
                int take = need - (pre - el); take = take < 0 ? 0 : (take > el ? el : take);
                unsigned sel = 0u, rem = eqw;
                for (int t = 0; t < 32; ++t) { if (t < take) { const unsigned low = rem & (0u - rem); sel |= low; rem ^= low; } }
                mw = gtw | sel;
            }
        }
        mask[(size_t)tok * 64 + lane] = mw;
    }
}

DI void p4_lru_pass1(Frame& F) {
    const unsigned* AB = (const unsigned*)(F.ws + WS_A); float* CP = (float*)(F.ws + WS_CARRY); float* CH = CP + BATCH * 64 * DM;
    for (int u = F.bid; u < BATCH * 64; u += F.G) {
        const int j = u & 63, b = u >> 6, c = 4 * F.tid;
        const size_t base = ((size_t)b * SEQ + j * 32) * DM + c;
        u32x4 w[32];
#pragma unroll
        for (int t = 0; t < 32; ++t) w[t] = *(const u32x4*)(AB + base + (size_t)t * DM);
        f32x4 P = {1.f, 1.f, 1.f, 1.f}, H = {0.f, 0.f, 0.f, 0.f};
#pragma unroll
        for (int t = 0; t < 32; ++t) { const f32x4 a = {__expf(bflo(w[t].x)), __expf(bflo(w[t].y)), __expf(bflo(w[t].z)), __expf(bflo(w[t].w))}, bb = {bfhi(w[t].x), bfhi(w[t].y), bfhi(w[t].z), bfhi(w[t].w)};
            H = a * H + bb; P = P * a; }
        *(f32x4*)(CP + ((size_t)b * 64 + j) * DM + c) = P; *(f32x4*)(CH + ((size_t)b * 64 + j) * DM + c) = H;
    }
}
DI void p5_lru_pass2(Frame& F) {
    const unsigned* AB = (const unsigned*)(F.ws + WS_A); const float* CP = (const float*)(F.ws + WS_CARRY); const float* CH = CP + BATCH * 64 * DM;
    const bf16* proj = (const bf16*)(F.ws + WS_PROJ); unsigned char* mrg = F.ws + WS_MRG;
    for (int u = F.bid; u < BATCH * 64; u += F.G) {
        const int j = u & 63, b = u >> 6, c = 4 * F.tid;
        f32x4 h = {0.f, 0.f, 0.f, 0.f};
#pragma unroll 8
        for (int jj = 0; jj < j; ++jj) { const f32x4 p = *(const f32x4*)(CP + ((size_t)b * 64 + jj) * DM + c), q = *(const f32x4*)(CH + ((size_t)b * 64 + jj) * DM + c); h = p * h + q; }
        const size_t tok0 = (size_t)b * SEQ + j * 32;
#pragma unroll 1
        for (int hs = 0; hs < 2; ++hs) {
            u32x4 w[16]; u32x2 gr[16], gg[16];
#pragma unroll
            for (int t = 0; t < 16; ++t) { const size_t tok = tok0 + hs * 16 + t; w[t] = *(const u32x4*)(AB + tok * DM + c); gr[t] = *(const u32x2*)(proj + tok * NINP + C_GR + c); gg[t] = *(const u32x2*)(proj + tok * NINP + C_G + 4096 + c); }
#pragma unroll
            for (int t = 0; t < 16; ++t) { const size_t tok = tok0 + hs * 16 + t;
                const f32x4 a = {__expf(bflo(w[t].x)), __expf(bflo(w[t].y)), __expf(bflo(w[t].z)), __expf(bflo(w[t].w))}, bb = {bfhi(w[t].x), bfhi(w[t].y), bfhi(w[t].z), bfhi(w[t].w)};
                h = a * h + bb;
                const unsigned o = pk4_fp8(h[0] * gelu_tanh_(bflo(gr[t].x)) * sigmoidf_(bflo(gg[t].x)), h[1] * gelu_tanh_(bfhi(gr[t].x)) * sigmoidf_(bfhi(gg[t].x)),
                                           h[2] * gelu_tanh_(bflo(gr[t].y)) * sigmoidf_(bflo(gg[t].y)), h[3] * gelu_tanh_(bfhi(gr[t].y)) * sigmoidf_(bfhi(gg[t].y)));
                *(unsigned*)(mrg + tok * MIXW + 4096 + c) = o; }
        }
    }
}

typedef short s16x4 __attribute__((ext_vector_type(4)));
constexpr int KS_STRIDE = 272, VS_STRIDE = 320, ATT_V = 64 * KS_STRIDE, ATT_BUF = 64 * KS_STRIDE + 64 * VS_STRIDE;
DI void p5_attention(Frame& F) {
    const bf16* proj = (const bf16*)(F.ws + WS_PROJ); const unsigned* mask = (const unsigned*)(F.ws + WS_MASK); unsigned char* mrg = F.ws + WS_MRG;
    const int lane = F.lane, l31 = lane & 31, hf = lane >> 5, wave = F.wave, hh = wave >> 1, qh = wave & 1, tid = F.tid;
    const float sc2 = 0.08838834764831845f * 1.4426950408889634f;
    const int gi = lane >> 4, i16 = lane & 15;
    const int vbase = ATT_V + (4 * (gi >> 1) + (i16 >> 2)) * VS_STRIDE + (16 * (gi & 1) + 4 * (i16 & 3)) * 2;
    const int sr0 = tid >> 4, sch = tid & 15;
    for (int u = F.bid; u < BATCH * 16 * 4; u += F.G) {
        const int g = u & 3, cp = (u >> 2) & 15, b = u >> 6;
        for (int half = 0; half < 2; ++half) {
            const int c = half ? (31 - cp) : cp, nkt = c + 1, head = g * 4 + hh;
            const int qtok = b * SEQ + c * 64 + qh * 32 + l31;
            const bf16* qrow = proj + (size_t)qtok * NINP + C_Q + head * 128 + hf * 8;
            bf16x8 qf[8];
#pragma unroll
            for (int ks = 0; ks < 8; ++ks) qf[ks] = *(const bf16x8*)(qrow + ks * 16);
            f32x16 o[4];
#pragma unroll
            for (int db = 0; db < 4; ++db)
#pragma unroll
                for (int i = 0; i < 16; ++i) o[db][i] = 0.f;
            float mrun = -1e30f, lrun = 0.f;
            const bf16* kg = proj + (size_t)(b * SEQ + sr0) * NINP + C_K + g * 128 + sch * 8;
            const bf16* vg = proj + (size_t)(b * SEQ + sr0) * NINP + C_V + g * 128 + sch * 8;
            u32x4 kr0 = *(const u32x4*)kg, kr1 = *(const u32x4*)(kg + (size_t)32 * NINP), vr0 = *(const u32x4*)vg, vr1 = *(const u32x4*)(vg + (size_t)32 * NINP);
            const unsigned* mrow = mask + (size_t)qtok * 64;
            unsigned mw0 = mrow[0], mw1 = mrow[1];
            { LAS unsigned char* B0 = F.lds;
              *(LAS u32x4*)(B0 + sr0 * KS_STRIDE + sch * 16) = kr0; *(LAS u32x4*)(B0 + (sr0 + 32) * KS_STRIDE + sch * 16) = kr1;
              *(LAS u32x4*)(B0 + ATT_V + sr0 * VS_STRIDE + sch * 16) = vr0; *(LAS u32x4*)(B0 + ATT_V + (sr0 + 32) * VS_STRIDE + sch * 16) = vr1; }
            __syncthreads();
            for (int kt = 0; kt < nkt; ++kt) {
                LAS unsigned char* Bc = F.lds + (kt & 1) * ATT_BUF; LAS unsigned char* Bn = F.lds + ((kt + 1) & 1) * ATT_BUF;
                const unsigned cm0 = mw0, cm1 = mw1; const bool more = kt + 1 < nkt;
                if (more) { const size_t adv = (size_t)(kt + 1) * 64 * NINP;
                    kr0 = *(const u32x4*)(kg + adv); kr1 = *(const u32x4*)(kg + adv + (size_t)32 * NINP); vr0 = *(const u32x4*)(vg + adv); vr1 = *(const u32x4*)(vg + adv + (size_t)32 * NINP);
                    mw0 = mrow[2 * kt + 2]; mw1 = mrow[2 * kt + 3]; }
                f32x16 s0, s1;
#pragma unroll
                for (int i = 0; i < 16; ++i) { s0[i] = 0.f; s1[i] = 0.f; }
#pragma unroll
                for (int ks = 0; ks < 8; ++ks) {
                    const bf16x8 ka = *(const LAS bf16x8*)(Bc + l31 * KS_STRIDE + ks * 32 + hf * 16);
                    const bf16x8 kb = *(const LAS bf16x8*)(Bc + (32 + l31) * KS_STRIDE + ks * 32 + hf * 16);
                    s0 = __builtin_amdgcn_mfma_f32_32x32x16_bf16(ka, qf[ks], s0, 0, 0, 0);
                    s1 = __builtin_amdgcn_mfma_f32_32x32x16_bf16(kb, qf[ks], s1, 0, 0, 0);
                }
                const unsigned sm0 = cm0 >> (4 * hf), sm1 = cm1 >> (4 * hf);
                float tmax = -INFINITY;
#pragma unroll
                for (int i = 0; i < 16; ++i) { const unsigned bit = 1u << ((i & 3) + 8 * (i >> 2));
                    s0[i] = (sm0 & bit) ? s0[i] * sc2 : -INFINITY; s1[i] = (sm1 & bit) ? s1[i] * sc2 : -INFINITY; tmax = fmaxf(tmax, fmaxf(s0[i], s1[i])); }
                tmax = fmaxf(tmax, __shfl_xor(tmax, 32));
                const float mnew = fmaxf(mrun, tmax), alpha = __builtin_amdgcn_exp2f(mrun - mnew); mrun = mnew;
                float psum = 0.f;
#pragma unroll
                for (int i = 0; i < 16; ++i) { s0[i] = __builtin_amdgcn_exp2f(s0[i] - mnew); s1[i] = __builtin_amdgcn_exp2f(s1[i] - mnew); psum += s0[i] + s1[i]; }
                lrun = lrun * alpha + psum;
                if (!__all(alpha == 1.0f)) {
#pragma unroll
                    for (int db = 0; db < 4; ++db)
#pragma unroll
                        for (int i = 0; i < 16; ++i) o[db][i] *= alpha; }
#pragma unroll
                for (int kb = 0; kb < 2; ++kb)
#pragma unroll
                    for (int s = 0; s < 2; ++s) {
                        u32x4 pw;
                        if (kb == 0) { pw.x = pk2(s0[8 * s], s0[8 * s + 1]); pw.y = pk2(s0[8 * s + 2], s0[8 * s + 3]); pw.z = pk2(s0[8 * s + 4], s0[8 * s + 5]); pw.w = pk2(s0[8 * s + 6], s0[8 * s + 7]); }
                        else { pw.x = pk2(s1[8 * s], s1[8 * s + 1]); pw.y = pk2(s1[8 * s + 2], s1[8 * s + 3]); pw.z = pk2(s1[8 * s + 4], s1[8 * s + 5]); pw.w = pk2(s1[8 * s + 6], s1[8 * s + 7]); }
                        const bf16x8 pf = __builtin_bit_cast(bf16x8, pw);
#pragma unroll
                        for (int db = 0; db < 4; ++db) {
                            LAS unsigned char* vp = Bc + vbase + (kb * 32 + 16 * s) * VS_STRIDE + db * 64;
                            const s16x4 lo = __builtin_amdgcn_ds_read_tr16_b64_v4i16((LAS s16x4*)vp), hi = __builtin_amdgcn_ds_read_tr16_b64_v4i16((LAS s16x4*)(vp + 8 * VS_STRIDE));
                            const bf16x8 vf = __builtin_shufflevector(lo, hi, 0, 1, 2, 3, 4, 5, 6, 7);
                            o[db] = __builtin_amdgcn_mfma_f32_32x32x16_bf16(vf, pf, o[db], 0, 0, 0);
                        }
                    }
                if (more) {
                    *(LAS u32x4*)(Bn + sr0 * KS_STRIDE + sch * 16) = kr0; *(LAS u32x4*)(Bn + (sr0 + 32) * KS_STRIDE + sch * 16) = kr1;
                    *(LAS u32x4*)(Bn + ATT_V + sr0 * VS_STRIDE + sch * 16) = vr0; *(LAS u32x4*)(Bn + ATT_V + (sr0 + 32) * VS_STRIDE + sch * 16) = vr1; }
                __syncthreads();
            }
            const float ltot = lrun + __shfl_xor(lrun, 32), rl = 1.0f / ltot;
            const bf16* grow = proj + (size_t)qtok * NINP + C_G + head * 128; unsigned char* orow = mrg + (size_t)qtok * MIXW + head * 128;
#pragma unroll
            for (int db = 0; db < 4; ++db)
#pragma unroll
                for (int q4 = 0; q4 < 4; ++q4) { const int d0 = db * 32 + q4 * 8 + hf * 4; const u32x2 gv = *(const u32x2*)(grow + d0);
                    *(unsigned*)(orow + d0) = pk4_fp8(o[db][4 * q4] * rl * sigmoidf_(bflo(gv.x)), o[db][4 * q4 + 1] * rl * sigmoidf_(bfhi(gv.x)), o[db][4 * q4 + 2] * rl * sigmoidf_(bflo(gv.y)), o[db][4 * q4 + 3] * rl * sigmoidf_(bfhi(gv.y))); }
        }
    }
    __syncthreads();
}

template <int MODE, bool ROUTE, bool WRITE_BF, bool WRITE_F32, bool WRITE_F8 = false>
DI void p_layernorm(Frame& F, const Args& args, const float* src, const float* gam, const float* bet, float* outf, bf16* outb, unsigned char* outq = nullptr) {
    const int gw = F.bid * 8 + F.wave, NGW = F.G * 8, lane = F.lane;
    const unsigned* rt = (const unsigned*)(F.ws + WS_ROUTE); unsigned* rtw = (unsigned*)(F.ws + WS_ROUTE);
    LAS float* wr_l = (LAS float*)F.lds;
    LAS unsigned* cl = (LAS unsigned*)(F.lds + 65536);
    if (ROUTE) { for (int i = F.tid; i < DM * NEXP / 4; i += 512) *(LAS f32x4*)(wr_l + 4 * i) = *(const f32x4*)(INF(20) + 4 * i); if (F.tid < 8) cl[F.tid] = 0u; __syncthreads(); }
#define LN_COL(jj) (MODE == 1 ? (8 * lane + 512 * ((jj) >> 1) + 4 * ((jj) & 1)) : (4 * lane + 256 * (jj)))
    for (int row = gw; row < MTOK; row += NGW) {
        f32x4 v[8]; float s = 0.f;
        if (MODE == 0) {
#pragma unroll
            for (int j = 0; j < 8; ++j) v[j] = *(const f32x4*)(src + (size_t)row * DM + LN_COL(j));
        } else {
            const unsigned r0 = rt[RT_ROW + 2 * row], r1 = rt[RT_ROW + 2 * row + 1]; const float w0 = __uint_as_float(rt[RT_W + 2 * row]), w1 = __uint_as_float(rt[RT_W + 2 * row + 1]);
            const bf16* yb = (const bf16*)(F.ws + WS_YB);
            u32x4 pa[4][KSPLIT], pb[4][KSPLIT];
#pragma unroll
            for (int j = 0; j < 4; ++j)
#pragma unroll
                for (int ks = 0; ks < KSPLIT; ++ks) { pa[j][ks] = *(const u32x4*)(yb + ((size_t)ks * MOE_ROWS_MAX + r0) * DM + 8 * lane + 512 * j); pb[j][ks] = *(const u32x4*)(yb + ((size_t)ks * MOE_ROWS_MAX + r1) * DM + 8 * lane + 512 * j); }
#pragma unroll
            for (int j = 0; j < 4; ++j) { f32x4 a0 = {0.f, 0.f, 0.f, 0.f}, a1 = a0, b0 = a0, b1 = a0;
#pragma unroll
                for (int ks = 0; ks < KSPLIT; ++ks) { const u32x4 a = pa[j][ks], b = pb[j][ks];
                    a0 += (f32x4){bflo(a.x), bfhi(a.x), bflo(a.y), bfhi(a.y)}; a1 += (f32x4){bflo(a.z), bfhi(a.z), bflo(a.w), bfhi(a.w)};
                    b0 += (f32x4){bflo(b.x), bfhi(b.x), bflo(b.y), bfhi(b.y)}; b1 += (f32x4){bflo(b.z), bfhi(b.z), bflo(b.w), bfhi(b.w)}; }
                const u32x4 xr = *(const u32x4*)((const bf16*)src + (size_t)row * DM + 8 * lane + 512 * j);
                v[2 * j] = (f32x4){bflo(xr.x), bfhi(xr.x), bflo(xr.y), bfhi(xr.y)} * ALPHA + a0 * w0 + b0 * w1;
                v[2 * j + 1] = (f32x4){bflo(xr.z), bfhi(xr.z), bflo(xr.w), bfhi(xr.w)} * ALPHA + a1 * w0 + b1 * w1; }
        }
#pragma unroll
        for (int j = 0; j < 8; ++j) s += (v[j][0] + v[j][1]) + (v[j][2] + v[j][3]);
        const float mean = wave_sum(s) * (1.f / DM); float s2 = 0.f;
#pragma unroll
        for (int j = 0; j < 8; ++j) { v[j] = v[j] - mean; s2 += (v[j][0] * v[j][0] + v[j][1] * v[j][1]) + (v[j][2] * v[j][2] + v[j][3] * v[j][3]); }
        const float rstd = 1.0f / sqrtf(wave_sum(s2) * (1.f / DM) + LN_EPS);
        float lg[8];
#pragma unroll
        for (int e = 0; e < 8; ++e) lg[e] = 0.f;
#pragma unroll
        for (int j = 0; j < 8; ++j) { const int cc = LN_COL(j); const f32x4 gv = *(const f32x4*)(gam + cc), bv = *(const f32x4*)(bet + cc);
            const f32x4 y = v[j] * rstd * gv + bv; if (WRITE_F32) *(f32x4*)(outf + (size_t)row * DM + cc) = y;
            if (WRITE_BF) { u32x2 w; w.x = pk2(y[0], y[1]); w.y = pk2(y[2], y[3]); *(u32x2*)(outb + (size_t)row * DM + cc) = w; }
            if (WRITE_F8) *(unsigned*)(outq + (size_t)row * DM + cc) = pk4_fp8(y[0], y[1], y[2], y[3]);
            if (ROUTE) {
#pragma unroll
                for (int i = 0; i < 4; ++i) { const LAS float* wp = wr_l + (size_t)(cc + i) * 8; const f32x4 wa = *(const LAS f32x4*)wp, wb = *(const LAS f32x4*)(wp + 4); const float xv = y[i];
                    lg[0] += xv * wa[0]; lg[1] += xv * wa[1]; lg[2] += xv * wa[2]; lg[3] += xv * wa[3]; lg[4] += xv * wb[0]; lg[5] += xv * wb[1]; lg[6] += xv * wb[2]; lg[7] += xv * wb[3]; }
            }
            asm volatile("" ::: "memory"); }
        if (ROUTE) {
#pragma unroll
            for (int e = 0; e < 8; ++e) lg[e] = wave_sum(lg[e]);
            int e0 = 0; float l0 = lg[0];
#pragma unroll
            for (int e = 1; e < 8; ++e) if (lg[e] > l0) { l0 = lg[e]; e0 = e; }
            int e1 = 0; float l1 = -INFINITY;
#pragma unroll
            for (int e = 0; e < 8; ++e) if (e != e0 && lg[e] > l1) { l1 = lg[e]; e1 = e; }
            const float p1 = 1.0f / (1.0f + expf(l0 - l1)), p0 = 1.0f - p1;
            if (lane == 0) { const unsigned sl0 = __hip_atomic_fetch_add(cl + e0, 1u, __ATOMIC_RELAXED, __HIP_MEMORY_SCOPE_WORKGROUP), sl1 = __hip_atomic_fetch_add(cl + e1, 1u, __ATOMIC_RELAXED, __HIP_MEMORY_SCOPE_WORKGROUP);
                rtw[RT_E + 2 * row] = (unsigned)e0; rtw[RT_E + 2 * row + 1] = (unsigned)e1; rtw[RT_SLOT + 2 * row] = sl0; rtw[RT_SLOT + 2 * row + 1] = sl1;
                rtw[RT_W + 2 * row] = __float_as_uint(p0); rtw[RT_W + 2 * row + 1] = __float_as_uint(p1); }
        }
    }
#undef LN_COL
    if (ROUTE) { __syncthreads(); const int t2 = F.wave * 64 + lane_id_(); if (t2 < 8) rtw[RT_WGC + F.bid * 8 + t2] = cl[t2]; __syncthreads(); }
}

DI void p_moe_gather(Frame& F) {
    unsigned* rt = (unsigned*)(F.ws + WS_ROUTE);
    const bf16* x1b = (const bf16*)(F.ws + WS_X1B); bf16* am = (bf16*)(F.ws + WS_AMOE);
    LAS unsigned* pre = (LAS unsigned*)F.lds;
    LAS unsigned* tot = pre + 2048;
    const int lane = F.lane;
    __syncthreads();
    { const int e = F.wave; unsigned c[4]; unsigned s = 0u;
#pragma unroll
      for (int i = 0; i < 4; ++i) { const int b = 4 * lane + i; c[i] = b < F.G ? rt[RT_WGC + b * 8 + e] : 0u; s += c[i]; }
      unsigned inc = s;
#pragma unroll
      for (int o = 1; o < 64; o <<= 1) { const unsigned t = __shfl_up(inc, o); inc += (lane >= o) ? t : 0u; }
      unsigned ex = inc - s;
#pragma unroll
      for (int i = 0; i < 4; ++i) { pre[(4 * lane + i) * 8 + e] = ex; ex += c[i]; }
      if (lane == 63) tot[e] = inc; }
    __syncthreads();
    if (F.tid == 0) { unsigned t = 0u; for (int e = 0; e < 8; ++e) { tot[8 + e] = t; t += (tot[e] + 255u) >> 8; } }
    __syncthreads();
    if (F.bid == 0 && F.tid < 8) F.ctl[CW_CNT + F.tid] = tot[F.tid];
    const int gw = F.bid * 8 + F.wave, NGW = F.G * 8;
    for (int a = gw; a < MTOK * 2; a += NGW) {
        const int tok = a >> 1; const int e = (int)rt[RT_E + a], slot = (int)rt[RT_SLOT + a];
        const int bsrc = (tok % NGW) >> 3;
        const int row = (int)tot[8 + e] * 256 + (int)pre[bsrc * 8 + e] + slot;
        const u32x4* s = (const u32x4*)(x1b + (size_t)tok * DM) + 4 * lane; u32x4* d = (u32x4*)((unsigned char*)am + (size_t)row * DM) + 2 * lane;
        const u32x4 i0 = s[0], i1 = s[1], i2 = s[2], i3 = s[3];
        u32x4 o0, o1;
        o0.x = pk4_fp8(bflo(i0.x), bfhi(i0.x), bflo(i0.y), bfhi(i0.y)); o0.y = pk4_fp8(bflo(i0.z), bfhi(i0.z), bflo(i0.w), bfhi(i0.w)); o0.z = pk4_fp8(bflo(i1.x), bfhi(i1.x), bflo(i1.y), bfhi(i1.y)); o0.w = pk4_fp8(bflo(i1.z), bfhi(i1.z), bflo(i1.w), bfhi(i1.w));
        o1.x = pk4_fp8(bflo(i2.x), bfhi(i2.x), bflo(i2.y), bfhi(i2.y)); o1.y = pk4_fp8(bflo(i2.z), bfhi(i2.z), bflo(i2.w), bfhi(i2.w)); o1.z = pk4_fp8(bflo(i3.x), bfhi(i3.x), bflo(i3.y), bfhi(i3.y)); o1.w = pk4_fp8(bflo(i3.z), bfhi(i3.z), bflo(i3.w), bfhi(i3.w));
        d[0] = o0; d[1] = o1;
        if (lane == 0) rt[RT_ROW + a] = (unsigned)row;
    }
    for (int pr = gw; pr < 8 * 256; pr += NGW) { const int e = pr >> 8, i = pr & 255;
        const int row = (int)tot[8 + e] * 256 + (int)tot[e] + i, rend = ((int)tot[8 + e] + (((int)tot[e] + 255) >> 8)) * 256;
        if (row < rend) { u32x4* d = (u32x4*)((unsigned char*)am + (size_t)row * DM);
#pragma unroll
            for (int q = 0; q < 2; ++q) d[lane + 64 * q] = (u32x4){0u, 0u, 0u, 0u}; } }
    __syncthreads();
}

constexpr int NPH_LAYER = 12;
constexpr int NPHASES = 1 + 2 * NPH_LAYER;
#define IN(k) (lo <= (k) && (k) < hi)
#define RELAUNDER() do { int l_ = lane_id_(); asm volatile("" : "+v"(l_)); F.lane = l_; F.tid = F.wave * 64 + l_; } while (0)
#define STAMP(k) do { if (STAMP_PROBE && F.bid == 0 && xb_t0(F.wave)) ((volatile LAS unsigned*)(F.lds + LDSCTL_OFF + 512))[k] = (unsigned)__builtin_amdgcn_s_memrealtime(); } while (0)
#define SEAM(k) do { if (IN(k) && IN((k) + 1)) { xcd_barrier(bar); STAMP((k) + 1); } } while (0)
template <int LAYER>
DI void run_layer(Frame& F, const Args& args, const XcdBarrier& bar, const int lo, const int hi) {
    constexpr int P = 1 + NPH_LAYER * LAYER;
    bf16* proj = (bf16*)(F.ws + WS_PROJ); bf16* xb = (bf16*)(F.ws + WS_XB); unsigned char* mrg = F.ws + WS_MRG;
    float* x1 = (float*)(F.ws + WS_X1); bf16* x1b = (bf16*)(F.ws + WS_X1B); float* x2 = (float*)(F.ws + WS_X2); float* pre = (float*)(F.ws + WS_PRE);
    if (IN(P + 0)) {
        pg8::Gemm g{xb, (const bf16*)(F.ws + WS_WIN) + (size_t)LAYER * NINP * DM, DM, DM, DM};
        pg8::TileOrder S; S.init(MTOK / 256, NINP / 256, F.G, F.bid, (size_t)256 * DM * 2, (size_t)256 * DM * 2);
        pg8::EpiBf16 E{proj, NINP, 0, 1.0f};
        pg8::gemm_phase(F.lds, g, S, E, F.wave);
        RELAUNDER(); if (LAYER == 0) conv_range(F, args, CE_0, CE_3, 32); else conv_range(F, args, CE_5, CE_5 + MOE_EARLY, 32);
    }
    SEAM(P + 0);
    if (IN(P + 1)) { RELAUNDER(); p2_prep(F, args, LAYER); }
    SEAM(P + 1);
    if (IN(P + 2)) {
        { pg8::Gemm g{(const bf16*)(F.ws + WS_DIFF), (const bf16*)(F.ws + WS_WPOOL) + (size_t)LAYER * 2048 * 512, DM, 512, 512};
          pg8::TileOrder S; S.init(MTOK / 256, 8, F.G, F.bid, (size_t)256 * DM * 2, (size_t)256 * 512 * 2, 2, (size_t)512 * 2);
          pg8::EpiPool E{mrg, proj, INF(5) + (size_t)LAYER * DM};
          pg8::gemm_phase(F.lds, g, S, E, F.wave); }
        if (LAYER == 0) STAMP(25);
        { pg8::Gemm g{(const bf16*)(F.ws + WS_XC), (const bf16*)(F.ws + WS_WLRU) + (size_t)LAYER * 4096 * 256, DM, 256, 256};
          pg8::TileOrder S; S.init(MTOK / 256, 16, F.G, F.bid, (size_t)256 * DM * 2, (size_t)256 * 256 * 2, 2, (size_t)256 * 2);
          pg8::EpiLru E{(unsigned*)(F.ws + WS_A), (const bf16*)(F.ws + WS_XC), INF(9) + (size_t)LAYER * DM, INF(11) + (size_t)LAYER * DM, (const float*)(F.ws + WS_LRUC) + (size_t)LAYER * DM};
          pg8::gemm_phase(F.lds, g, S, E, F.wave); }
        if (LAYER == 0) STAMP(26);
        RELAUNDER(); p3_indexer(F);
        if (LAYER == 0) STAMP(29);
        __syncthreads(); RELAUNDER(); if (LAYER == 0) conv_range(F, args, CE_3, CE_3 + P2_ITEMS, 32); else conv_range(F, args, CE_5 + MOE_EARLY, CE_5 + MOE_EARLY + P2_ITEMS, 32);
    }
    SEAM(P + 2);
    if (IN(P + 3)) { RELAUNDER(); p4_select(F); if (LAYER == 0) STAMP(27); RELAUNDER(); p4_lru_pass1(F); }
    SEAM(P + 3);
    if (IN(P + 4)) { RELAUNDER(); p5_attention(F); if (LAYER == 0) STAMP(28); RELAUNDER(); p5_lru_pass2(F); }
    SEAM(P + 4);
    if (IN(P + 5)) {
        pg8::Gemm g{(const bf16*)mrg, (const bf16*)(F.ws + WS_WOUT + (size_t)LAYER * DM * MIXW), MIXW / 2, MIXW / 2, MIXW / 2};
        pg8::TileOrder S; S.init(MTOK / 256, DM / 256, F.G, F.bid, (size_t)256 * MIXW, (size_t)256 * MIXW);
        pg8::EpiRes<LAYER == 1> E{pre, LAYER == 0 ? (const void*)INF(0) : (const void*)xb, DM, 1.0f / F8_WSCALE};
        pg8::gemm_phase<pg8::EpiRes<LAYER == 1>, pg8::TileOrder, true>(F.lds, g, S, E, F.wave);
    }
    SEAM(P + 5);
    if (IN(P + 6)) { RELAUNDER(); } if (IN(P + 6)) p_layernorm<0, LAYER == 1, true, false>(F, args, pre, INF(13) + LAYER * DM, INF(14) + LAYER * DM, nullptr, x1b);
    SEAM(P + 6);
    if constexpr (LAYER == 0) {
        if (IN(P + 7)) {
            pg8::Gemm g{x1b, (const bf16*)(F.ws + WS_WGU), DM, DM, DM};
            pg8::TileOrder S; S.init(MTOK / 256, 2 * DFF / 256, F.G, F.bid, (size_t)256 * DM * 2, (size_t)256 * DM * 2);
            pg8::EpiSwiglu E{(bf16*)(F.ws + WS_H), DFF};
            pg8::gemm_phase(F.lds, g, S, E, F.wave);
            RELAUNDER(); conv_range(F, args, CE_3 + P2_ITEMS, CE_5, 96);
        }
        SEAM(P + 7);
        if (IN(P + 8)) {
            pg8::Gemm g{(const bf16*)(F.ws + WS_H), (const bf16*)(F.ws + WS_WDN), DFF, DFF, DFF};
            pg8::TileOrder S; S.init(MTOK / 256, DM / 256, F.G, F.bid, (size_t)256 * DFF * 2, (size_t)256 * DFF * 2);
            pg8::EpiRes<true> E{pre, x1b, DM, 1.0f};
            pg8::gemm_phase(F.lds, g, S, E, F.wave);
        }
        SEAM(P + 8);
        if (IN(P + 9)) { RELAUNDER(); } if (IN(P + 9)) p_layernorm<0, false, true, false>(F, args, pre, INF(15), INF(16), nullptr, xb);
        if (IN(P + 9) && IN(P + 12)) { xcd_barrier(bar); STAMP(P + 10); STAMP(P + 11); STAMP(P + 12); }
    } else {
        if (IN(P + 7)) { RELAUNDER(); conv_range(F, args, CE_5 + MOE_EARLY + P2_ITEMS, CE_7, 0); RELAUNDER(); p_moe_gather(F); }
        SEAM(P + 7);
        if (IN(P + 8)) {
            pg8::Gemm g{(const bf16*)(F.ws + WS_AMOE), (const bf16*)(F.ws + WS_MWGU), DM / 2, DM / 2, DM / 2};
            pg8::MoeOrder S; S.init(F.ctl + CW_CNT, 2 * DEXP / 256, 1, F.G, F.bid, (size_t)256 * DM, (size_t)2 * DEXP * DM, (size_t)256 * DM, 0);
            pg8::EpiSwigluF8 E{F.ws + WS_HMOE, DEXP, 1.0f / F8_WSCALE};
            pg8::gemm_phase<pg8::EpiSwigluF8, pg8::MoeOrder, true>(F.lds, g, S, E, F.wave);
        }
        SEAM(P + 8);
        if (IN(P + 9)) {
            pg8::Gemm g{(const bf16*)(F.ws + WS_HMOE), (const bf16*)(F.ws + WS_MWDN), DEXP / 2, DEXP / 2, DEXP / 2 / KSPLIT};
            pg8::MoeOrder S; S.init(F.ctl + CW_CNT, DM / 256, KSPLIT, F.G, F.bid, (size_t)256 * DEXP, (size_t)DM * DEXP, (size_t)256 * DEXP, (size_t)(DEXP / KSPLIT));
            pg8::EpiBf16 E{(bf16*)(F.ws + WS_YB), DM, (size_t)MOE_ROWS_MAX * DM, 1.0f / F8_WSCALE};
            pg8::gemm_phase<pg8::EpiBf16, pg8::MoeOrder, true>(F.lds, g, S, E, F.wave);
        }
        SEAM(P + 9);
        if (IN(P + 10)) { RELAUNDER(); } if (IN(P + 10)) p_layernorm<1, false, false, true>(F, args, (const float*)x1b, INF(15) + DM, INF(16) + DM, args.out, nullptr);
    }
}
__global__ void __launch_bounds__(512, 2) fwd_kernel(Args args) {
    extern __shared__ __attribute__((aligned(16))) unsigned char lds_raw[];
    Frame F;
    F.lds = (LAS unsigned char*)lds_raw; F.ws = args.ws; F.ctl = (unsigned*)(args.ws + WS_CTL);
    F.wave = __builtin_amdgcn_readfirstlane((int)threadIdx.x >> 6); F.lane = lane_id_(); F.tid = F.wave * 64 + F.lane; F.G = gridDim.x; F.bid = blockIdx.x;
    volatile LAS unsigned* MISC = (volatile LAS unsigned*)(F.lds + LDSCTL_OFF);
    for (int u = F.tid; u < (LDS_BYTES - LDSCTL_OFF) / 4; u += 512) ((LAS unsigned*)(F.lds + LDSCTL_OFF))[u] = 0u;
    __syncthreads();
    const int lo = args.ph_lo, hi = args.ph_hi;
    XcdBarrier bar; bar.bar = F.ctl + CW_BAR; bar.x = 0; bar.st = nullptr; bar.wave = F.wave;
    if ((hi - lo) > 1) bar = xcd_barrier_post(F.ctl + CW_BAR, MISC + 8, F.wave);
    STAMP(0);
    if (IN(0)) { RELAUNDER(); p0_prologue(F, args); __syncthreads(); }
    SEAM(0);
    run_layer<0>(F, args, bar, lo, hi);
    run_layer<1>(F, args, bar, lo, hi);
#if STAMP_PROBE
    RELAUNDER();
    if (F.bid == 0) {
        asm volatile("s_waitcnt vmcnt(0)" ::: "memory"); __syncthreads();
        if (xb_t0(F.wave)) ((volatile LAS unsigned*)(F.lds + LDSCTL_OFF + 512))[NPHASES - 1] = (unsigned)__builtin_amdgcn_s_memrealtime();
        __syncthreads();
        volatile LAS unsigned* st = (volatile LAS unsigned*)(F.lds + LDSCTL_OFF + 512);
        const float ta = (float)(st[STAMP_A_HI] - st[STAMP_A_LO]) * 0.01f, tb = (float)(st[STAMP_B_HI] - st[STAMP_B_LO]) * 0.01f;
        const float da = __builtin_amdgcn_sqrtf(ta * 0.005f);
        for (int i = F.tid; i < DM; i += 512) args.out[i] += da;
        if (F.tid == 0) args.out[DM] += tb * 0.1f;
    }
#endif
}
#undef IN
#undef SEAM

extern "C" void kernel_launch(void* const* d_in, const int* in_sizes, int n_in, void* d_out, int out_size, void* d_ws, size_t ws_size, hipStream_t stream) {
    static int grid = 0;
    if (grid == 0) {
        if (n_in != 24 || out_size != MTOK * DM || ws_size < WS_END) { fprintf(stderr, "kernel_launch: unexpected problem (n_in %d, out %d, ws %zu, need %zu)\n", n_in, out_size, ws_size, (size_t)WS_END); grid = -1; return; }
        int dev = 0, cus = 0, per_cu = 0;
        if (hipGetDevice(&dev) != hipSuccess || hipDeviceGetAttribute(&cus, hipDeviceAttributeMultiprocessorCount, dev) != hipSuccess) { grid = -1; return; }
        if (hipFuncSetAttribute((const void*)fwd_kernel, hipFuncAttributeMaxDynamicSharedMemorySize, LDS_BYTES) != hipSuccess) { fprintf(stderr, "kernel_launch: hipFuncSetAttribute failed\n"); grid = -1; return; }
        if (hipOccupancyMaxActiveBlocksPerMultiprocessor(&per_cu, (const void*)fwd_kernel, 512, LDS_BYTES) != hipSuccess || per_cu < 1) fprintf(stderr, "kernel_launch: occupancy query reports %d\n", per_cu);
        (void)hipGetLastError();
        grid = cus;
    }
    if (grid < 0) return;
    (void)hipMemsetAsync((char*)d_ws + WS_CTL, 0, CTL_ZERO_BYTES, stream);
    Args a{};
    for (int i = 0; i < 24; ++i) a.in[i] = d_in[i];
    a.out = (float*)d_out; a.ws = (unsigned char*)d_ws;
#if MK_N_LAUNCHES == 1
    a.ph_lo = 0; a.ph_hi = NPHASES;
    hipLaunchKernelGGL(fwd_kernel, dim3(grid), dim3(512), LDS_BYTES, stream, a);
#else
    const int plist[] = {0, 1, 2, 3, 4, 5, 6, 7, 8, 9, 10, 13, 14, 15, 16, 17, 18, 19, 20, 21, 22, 23};
    for (int i = 0; i < (int)(sizeof(plist) / sizeof(int)); ++i) { a.ph_lo = plist[i]; a.ph_hi = plist[i] + 1; hipLaunchKernelGGL(fwd_kernel, dim3(grid), dim3(512), LDS_BYTES, stream, a); }
#endif
}
```

```cpp
#include <hip/hip_runtime.h>
#include <cstdio>
#include <cstdint>

#ifndef MK_N_LAUNCHES
#define MK_N_LAUNCHES 1
#endif

#ifndef STAMP_PROBE
#define STAMP_PROBE 0
#endif
#ifndef STAMP_A_LO
#define STAMP_A_LO 0
#define STAMP_A_HI 1
#define STAMP_B_LO 1
#define STAMP_B_HI 2
#endif
#define DI __device__ __forceinline__
#define LAS __attribute__((address_space(3)))
#define GAS __attribute__((address_space(1)))
typedef unsigned short bf16;
typedef short bf16x8 __attribute__((ext_vector_type(8)));
typedef float f32x2 __attribute__((ext_vector_type(2)));
typedef float f32x4 __attribute__((ext_vector_type(4)));
typedef float f32x16 __attribute__((ext_vector_type(16)));
typedef unsigned u32x2 __attribute__((ext_vector_type(2)));
typedef unsigned u32x4 __attribute__((ext_vector_type(4)));
typedef __bf16 bf16x2_t __attribute__((ext_vector_type(2)));
typedef int i32x8 __attribute__((ext_vector_type(8)));
typedef int i32x4 __attribute__((ext_vector_type(4)));

#define LDS_WAIT() asm volatile("s_waitcnt lgkmcnt(0)" ::: "memory")
#define VM_WAIT() asm volatile("s_waitcnt vmcnt(0)" ::: "memory")

DI unsigned pk2(float lo, float hi) { f32x2 v = {lo, hi}; return __builtin_bit_cast(unsigned, __builtin_convertvector(v, bf16x2_t)); }
DI unsigned pk4_fp8(float a, float b, float c, float d) { int w = 0; w = __builtin_amdgcn_cvt_pk_fp8_f32(a, b, w, false); w = __builtin_amdgcn_cvt_pk_fp8_f32(c, d, w, true); return (unsigned)w; }
DI float bflo(unsigned w) { return __uint_as_float(w << 16); }
DI float bfhi(unsigned w) { return __uint_as_float(w & 0xffff0000u); }
DI float bf2f(bf16 b) { return __uint_as_float(((unsigned)b) << 16); }
DI float rcp_(float x) { return __builtin_amdgcn_rcpf(x); }
DI float sigmoidf_(float x) { return rcp_(1.0f + __expf(-x)); }
DI float siluf_(float x) { return x * rcp_(1.0f + __expf(-x)); }
DI float gelu_tanh_(float x) { const float u = 0.7978845608028654f * (x + 0.044715f * x * x * x); const float t = 1.0f - 2.0f * rcp_(1.0f + __expf(2.0f * u)); return 0.5f * x * (1.0f + t); }
DI float one_minus_exp_(float x) {
    const float p = -x * (1.0f + x * 0.5f * (1.0f + x * (1.0f / 3.0f) * (1.0f + x * 0.25f * (1.0f + x * 0.2f * (1.0f + x * (1.0f / 6.0f) * (1.0f + x * (1.0f / 7.0f)))))));
    const float e = 1.0f - __expf(x);
    return x > -0.5f ? p : e;
}
DI int lane_id_() { int l; asm volatile("v_mbcnt_lo_u32_b32 %0, -1, 0\n\tv_mbcnt_hi_u32_b32 %0, -1, %0" : "=v"(l)); return l; }

constexpr int DM = 2048, BATCH = 4, SEQ = 2048, MTOK = BATCH * SEQ;
constexpr int NIN = 16464, NINP = 16640;
constexpr int C_Q = 0, C_K = 2048, C_V = 2560, C_QI = 3072, C_KI = 4096, C_WI = 4160, C_PADLO = 4176, C_P = 4352, C_XR = 6400, C_GR = 8448, C_G = 10496;
constexpr int MIXW = 6144, DFF = 5504, NEXP = 8, DEXP = 7168;
constexpr int MOE_ROWS_MAX = (MTOK * 2 / 256 + NEXP) * 256;
constexpr float ALPHA = 1.4142135623730951f, LN_EPS = 1e-5f;
constexpr int DFFP = 5632;
constexpr int NT8 = 36, NT16 = 29;
constexpr int KSPLIT = 2;

constexpr size_t MiB = 1u << 20;
constexpr size_t WS_CTL = 0, CTL_ZERO_BYTES = 1 * MiB;
constexpr size_t WS_COSA = 1 * MiB, WS_SINA = 3 * MiB, WS_COSI = 5 * MiB, WS_SINI = 6 * MiB;
constexpr size_t WS_ROUTE = 9 * MiB;
constexpr size_t WS_MASK = 10 * MiB;
constexpr size_t WS_LRUC = 9 * MiB + 512 * 1024;
constexpr size_t WS_WIN = 12 * MiB;
constexpr size_t WIN_LAYER = 65 * MiB, WIN_F8 = 32 * MiB;
constexpr size_t WS_WOUT = 142 * MiB;
constexpr size_t WS_WPOOL = 190 * MiB;
constexpr size_t WS_WLRU = 194 * MiB;
constexpr size_t WS_WGU = 198 * MiB;
constexpr size_t WS_WDN = 241 * MiB;
constexpr size_t WS_XB = 263 * MiB;
constexpr size_t WS_X1 = 295 * MiB;
constexpr size_t WS_X1B = 359 * MiB;
constexpr size_t WS_X2 = 391 * MiB;
constexpr size_t WS_PRE = 455 * MiB;
constexpr size_t WS_MWGU = 519 * MiB;
constexpr size_t WS_MWDN = 967 * MiB;
constexpr size_t WS_OV = 1191 * MiB;
constexpr size_t WS_PROJ = WS_OV;
constexpr size_t WS_DIFF = WS_OV + 260 * MiB;
constexpr size_t WS_XC = WS_OV + 292 * MiB;
constexpr size_t WS_A = WS_OV + 324 * MiB;
constexpr size_t WS_CARRY = WS_OV + 388 * MiB;
constexpr size_t WS_SC = WS_OV + 452 * MiB;
constexpr size_t WS_MRG = WS_OV + 516 * MiB;
constexpr size_t WS_H = WS_OV;
constexpr size_t WS_AMOE = WS_OV;
constexpr size_t WS_HMOE = WS_OV + 72 * MiB;
constexpr size_t WS_YB = WS_OV + 324 * MiB;
constexpr size_t WS_END = WS_OV + 612 * MiB;
constexpr int CW_BAR = 4096, CW_CNT = 16384;
constexpr int RT_E = 0, RT_SLOT = 2 * MTOK, RT_W = 4 * MTOK, RT_ROW = 6 * MTOK, RT_WGC = 8 * MTOK;

constexpr int RING_BYTES = 131072, LDSCTL_OFF = RING_BYTES, LDS_BYTES = 147456;

#define XB_TMO      128
#define XB_XCNT(j)  (256  + 64 * (j))
#define XB_XSUB(j)  (1280 + 64 * (j))
#define XB_XGEN(j)  (2304 + 64 * (j))
#define XB_TOP      3328
#define XB_TOPGEN   3392
#define XCD_BAR_WORDS 3456
#define XB_SPIN_CAP (1u << 18)
DI unsigned xb_ld(unsigned* p)              { return __hip_atomic_load(p, __ATOMIC_RELAXED, __HIP_MEMORY_SCOPE_AGENT); }
DI unsigned xb_add(unsigned* p, unsigned v) { return __hip_atomic_fetch_add(p, v, __ATOMIC_RELAXED, __HIP_MEMORY_SCOPE_AGENT); }
DI unsigned xb_xcc_id() { return (unsigned)__builtin_amdgcn_s_getreg((3 << 11) | 20) & 0xFu; }
#define XB_SPIN(cond, bar) do { unsigned _sp = 0; while (cond) { __builtin_amdgcn_s_sleep(1); \
    if ((++_sp & 255u) == 0u) { if (xb_ld(&(bar)[XB_TMO])) break; if (_sp > XB_SPIN_CAP) { atomicAdd(&(bar)[XB_TMO], 1u); break; } } } } while (0)
struct XcdBarrier { unsigned* bar; unsigned x; volatile LAS unsigned* st; int wave; };
DI bool xb_t0(int wave) { return wave == 0 && lane_id_() == 0; }
DI XcdBarrier xcd_barrier_post(unsigned* bar, volatile LAS unsigned* st, int wave) {
    XcdBarrier b; b.bar = bar; b.x = xb_xcc_id(); b.st = st; b.wave = wave;
    if (xb_t0(wave)) (void)xb_add(&bar[XB_XCNT(b.x)], 1u);
    return b;
}
DI void xcd_barrier_complete(unsigned* bar, unsigned x, unsigned& nloc, unsigned& nx) {
    const unsigned G = gridDim.x * gridDim.y * gridDim.z;
    unsigned sum, cnt, mine, sp = 0u;
    for (;;) {
        sum = 0u; cnt = 0u; mine = 0u;
#pragma unroll
        for (unsigned j = 0; j < 16; ++j) { const unsigned c = xb_ld(&bar[XB_XCNT(j)]); sum += c; cnt += (c > 0u) ? 1u : 0u; mine = (j == x) ? c : mine; }
        if (sum == G) break;
        __builtin_amdgcn_s_sleep(1);
        if ((++sp & 255u) == 0u) { if (xb_ld(&bar[XB_TMO])) break; if (sp > XB_SPIN_CAP) { atomicAdd(&bar[XB_TMO], 1u); break; } }
    }
    nloc = mine > 0u ? mine : 1u; nx = cnt > 0u ? cnt : 1u;
}
DI void xcd_barrier(const XcdBarrier& b) {
    asm volatile("s_waitcnt vmcnt(0)" ::: "memory");
    __syncthreads();
    if (xb_t0(b.wave)) {
        unsigned* bar = b.bar;
        __builtin_amdgcn_s_waitcnt(0);
        unsigned nloc = b.st[0], nx = b.st[1];
        if (nloc == 0u) { xcd_barrier_complete(bar, b.x, nloc, nx); b.st[0] = nloc; b.st[1] = nx; }
        const unsigned old = xb_add(&bar[XB_XSUB(b.x)], 1u);
        const unsigned gen = old / nloc;
        if (old + 1u == (gen + 1u) * nloc) {
            __builtin_amdgcn_fence(__ATOMIC_RELEASE, "agent");
            asm volatile("s_waitcnt vmcnt(0)" ::: "memory");
            const unsigned og = xb_add(&bar[XB_TOP], 1u);
            const unsigned tg = og / nx;
            if (og + 1u == (tg + 1u) * nx) xb_add(&bar[XB_TOPGEN], 1u);
            else XB_SPIN(xb_ld(&bar[XB_TOPGEN]) == tg, bar);
            __builtin_amdgcn_fence(__ATOMIC_ACQUIRE, "agent");
            xb_add(&bar[XB_XGEN(b.x)], 1u);
            asm volatile("s_waitcnt vmcnt(0)" ::: "memory");
        } else {
            XB_SPIN(xb_ld(&bar[XB_XGEN(b.x)]) == gen, bar);
            __builtin_amdgcn_fence(__ATOMIC_ACQUIRE, "agent");
            asm volatile("s_waitcnt vmcnt(0)" ::: "memory");
        }
    }
    __syncthreads();
}

namespace pg8 {
constexpr int BM = 256, BK = 64, HALF = 128, HTB = HALF * BK * 2, STAGE_BYTES = 8 * HTB, NXCD = 8, WGM = 8;
DI int lds_byte(int r, int c) { const int st = (r >> 4) * 2 + (c >> 5), rr = r & 15, cc = c & 31, ob = rr * 64 + cc * 2; return st * 1024 + (ob ^ (((ob >> 9) & 1) << 5)); }
DI void stage_rc(int b, int& R, int& C) { const int st = b / 1024, sb = b % 1024, swz = sb ^ (((sb >> 9) & 1) << 5); R = (st >> 1) * 16 + swz / 64; C = (st & 1) * 32 + (swz % 64) / 2; }
DI int perm32(int rho) { const int n = rho >> 4, i = rho & 15; return 8 * (i >> 2) + 4 * n + (i & 3); }

struct Unit { int pm, pn, e, ks; };
struct Gemm { const bf16* A; const bf16* Bt; int lda, ldb, K; };

struct TileOrder {
    int nM, nN, nwg, G, c, a_div; size_t a_pm, a_pn, b_pn;
    DI void init(int nM_, int nN_, int G_, int c_, size_t a_pm_, size_t b_pn_, int a_div_ = 1, size_t a_pn_ = 0) { nM = nM_; nN = nN_; nwg = nM * nN; G = G_; c = c_; a_pm = a_pm_; b_pn = b_pn_; a_div = a_div_; a_pn = a_pn_; }
    DI bool next(int i, Unit& u) const {
        const long L = (long)i * G + c; if (L >= nwg) return false;
        int wgid = (int)L; { const int q = nwg / NXCD, r = nwg % NXCD, xcd = wgid % NXCD, off = wgid / NXCD; wgid = (xcd < r ? xcd * (q + 1) : r * (q + 1) + (xcd - r) * q) + off; }
        const int nig = WGM * nN, gid = wgid / nig, fm = gid * WGM, gsz = (nM - fm) < WGM ? (nM - fm) : WGM;
        u.pm = fm + ((wgid % nig) % gsz); u.pn = (wgid % nig) / gsz; u.e = 0; u.ks = 0; return true;
    }
    DI size_t aoff(const Unit& u) const { return (size_t)u.pm * a_pm + (size_t)(u.pn / a_div) * a_pn; }
    DI size_t boff(const Unit& u) const { return (size_t)u.pn * b_pn; }
};
struct MoeOrder {
    int nN, nNk, nwg, G, c; int t1, t2, t3, t4, t5, t6, t7, t8; size_t a_pm, b_e, b_pn, ks_step;
    DI void init(const unsigned* cnt, int nN_, int ksplit, int G_, int c_, size_t a_pm_, size_t b_e_, size_t b_pn_, size_t ks_step_) {
        nN = nN_; nNk = nN_ * ksplit; G = G_; c = c_; a_pm = a_pm_; b_e = b_e_; b_pn = b_pn_; ks_step = ks_step_;
        int s = 0; s += ((int)cnt[0] + 255) >> 8; t1 = s; s += ((int)cnt[1] + 255) >> 8; t2 = s; s += ((int)cnt[2] + 255) >> 8; t3 = s; s += ((int)cnt[3] + 255) >> 8; t4 = s;
        s += ((int)cnt[4] + 255) >> 8; t5 = s; s += ((int)cnt[5] + 255) >> 8; t6 = s; s += ((int)cnt[6] + 255) >> 8; t7 = s; s += ((int)cnt[7] + 255) >> 8; t8 = s;
        nwg = t8 * nNk;
    }
    DI bool next(int i, Unit& u) const {
        const long L = (long)i * G + c; if (L >= nwg) return false;
        int wgid = (int)L; { const int q = nwg / NXCD, r = nwg % NXCD, xcd = wgid % NXCD, off = wgid / NXCD; wgid = (xcd < r ? xcd * (q + 1) : r * (q + 1) + (xcd - r) * q) + off; }
        int e = 0, ts = 0, nt = t1;
        if (wgid >= t1 * nNk) { e = 1; ts = t1; nt = t2 - t1; }
        if (wgid >= t2 * nNk) { e = 2; ts = t2; nt = t3 - t2; }
        if (wgid >= t3 * nNk) { e = 3; ts = t3; nt = t4 - t3; }
        if (wgid >= t4 * nNk) { e = 4; ts = t4; nt = t5 - t4; }
        if (wgid >= t5 * nNk) { e = 5; ts = t5; nt = t6 - t5; }
        if (wgid >= t6 * nNk) { e = 6; ts = t6; nt = t7 - t6; }
        if (wgid >= t7 * nNk) { e = 7; ts = t7; nt = t8 - t7; }
        const int loc = wgid - ts * nNk; nt = nt > 0 ? nt : 1;
        const int pn2 = loc / nt;
        u.pm = ts + loc % nt; u.pn = pn2 % nN; u.ks = pn2 / nN; u.e = e; return true;
    }
    DI size_t aoff(const Unit& u) const { return (size_t)u.pm * a_pm + (size_t)u.ks * ks_step; }
    DI size_t boff(const Unit& u) const { return (size_t)u.e * b_e + (size_t)u.pn * b_pn + (size_t)u.ks * ks_step; }
};

struct EpiBf16 {
    static constexpr bool PERM = true;
    bf16* O; int ldc; size_t ks_stride; float scale; int split_pn, colA, colB;
    DI void operator()(const f32x4 (&acc)[2][2][4][2], const Unit& u, int wr, int wc, int fr, int fq) const {
        const int row0 = u.pm * BM + wr * 64 + fr, col0 = (u.pn < split_pn ? colA + u.pn * BM : colB + (u.pn - split_pn) * BM) + wc * 32 + 8 * fq;
#pragma unroll
        for (int ai = 0; ai < 2; ++ai)
#pragma unroll
            for (int m = 0; m < 4; ++m) { bf16* rowp = O + (size_t)u.ks * ks_stride + (size_t)(row0 + ai * HALF + m * 16) * ldc + col0;
#pragma unroll
                for (int bj = 0; bj < 2; ++bj) { const f32x4 v0 = acc[ai][bj][m][0] * scale, v1 = acc[ai][bj][m][1] * scale;
                    u32x4 w; w.x = pk2(v0[0], v0[1]); w.y = pk2(v0[2], v0[3]); w.z = pk2(v1[0], v1[1]); w.w = pk2(v1[2], v1[3]);
                    *(u32x4*)(rowp + bj * HALF) = w; } }
    }
};
struct EpiF32 {
    static constexpr bool PERM = false;
    float* C; int ldc;
    DI void operator()(const f32x4 (&acc)[2][2][4][2], const Unit& u, int wr, int wc, int fr, int fq) const {
        const int row0 = u.pm * BM + wr * 64 + fr, col0 = u.pn * BM + wc * 32 + 4 * fq;
#pragma unroll
        for (int ai = 0; ai < 2; ++ai)
#pragma unroll
            for (int m = 0; m < 4; ++m) { float* rowp = C + (size_t)(row0 + ai * HALF + m * 16) * ldc + col0;
#pragma unroll
                for (int bj = 0; bj < 2; ++bj)
#pragma unroll
                    for (int n = 0; n < 2; ++n) *(f32x4*)(rowp + bj * HALF + n * 16) = acc[ai][bj][m][n]; }
    }
};
template <bool RES_BF16>
struct EpiRes {
    static constexpr bool PERM = false;
    float* C; const void* res; int ldc; float scale;
    DI void operator()(const f32x4 (&acc)[2][2][4][2], const Unit& u, int wr, int wc, int fr, int fq) const {
        const int row0 = u.pm * BM + wr * 64 + fr, col0 = u.pn * BM + wc * 32 + 4 * fq;
#pragma unroll
        for (int ai = 0; ai < 2; ++ai)
#pragma unroll
            for (int m = 0; m < 4; ++m) { const size_t off = (size_t)(row0 + ai * HALF + m * 16) * ldc + col0;
#pragma unroll
                for (int bj = 0; bj < 2; ++bj)
#pragma unroll
                    for (int n = 0; n < 2; ++n) { f32x4 rv;
                        if (RES_BF16) { const u32x2 w = *(const u32x2*)((const bf16*)res + off + bj * HALF + n * 16); rv = (f32x4){bflo(w.x), bfhi(w.x), bflo(w.y), bfhi(w.y)}; }
                        else rv = *(const f32x4*)((const float*)res + off + bj * HALF + n * 16);
                        *(f32x4*)(C + off + bj * HALF + n * 16) = acc[ai][bj][m][n] * scale + rv * ALPHA; }
                asm volatile("" ::: "memory"); }
    }
};
struct EpiSwiglu {
    static constexpr bool PERM = true;
    bf16* H; int ldc;
    DI void operator()(const f32x4 (&acc)[2][2][4][2], const Unit& u, int wr, int wc, int fr, int fq) const {
        const int row0 = u.pm * BM + wr * 64 + fr, col0 = u.pn * HALF + wc * 32 + 8 * fq;
#pragma unroll
        for (int ai = 0; ai < 2; ++ai)
#pragma unroll
            for (int m = 0; m < 4; ++m) { bf16* rowp = H + (size_t)(row0 + ai * HALF + m * 16) * ldc + col0;
                const f32x4 g0 = acc[ai][0][m][0], g1 = acc[ai][0][m][1], u0 = acc[ai][1][m][0], u1 = acc[ai][1][m][1];
                u32x4 w; w.x = pk2(siluf_(g0[0]) * u0[0], siluf_(g0[1]) * u0[1]); w.y = pk2(siluf_(g0[2]) * u0[2], siluf_(g0[3]) * u0[3]);
                w.z = pk2(siluf_(g1[0]) * u1[0], siluf_(g1[1]) * u1[1]); w.w = pk2(siluf_(g1[2]) * u1[2], siluf_(g1[3]) * u1[3]);
                *(u32x4*)rowp = w; asm volatile("" ::: "memory"); }
    }
};
struct EpiSwigluF8 {
    static constexpr bool PERM = true;
    unsigned char* H; int ldc; float scale;
    DI void operator()(const f32x4 (&acc)[2][2][4][2], const Unit& u, int wr, int wc, int fr, int fq) const {
        const int row0 = u.pm * BM + wr * 64 + fr, col0 = u.pn * HALF + wc * 32 + 8 * fq;
#pragma unroll
        for (int ai = 0; ai < 2; ++ai)
#pragma unroll
            for (int m = 0; m < 4; ++m) { unsigned char* rowp = H + (size_t)(row0 + ai * HALF + m * 16) * ldc + col0;
                const f32x4 g0 = acc[ai][0][m][0] * scale, g1 = acc[ai][0][m][1] * scale, u0 = acc[ai][1][m][0] * scale, u1 = acc[ai][1][m][1] * scale;
                u32x2 w; w.x = pk4_fp8(siluf_(g0[0]) * u0[0], siluf_(g0[1]) * u0[1], siluf_(g0[2]) * u0[2], siluf_(g0[3]) * u0[3]);
                w.y = pk4_fp8(siluf_(g1[0]) * u1[0], siluf_(g1[1]) * u1[1], siluf_(g1[2]) * u1[2], siluf_(g1[3]) * u1[3]);
                *(u32x2*)rowp = w; asm volatile("" ::: "memory"); }
    }
};
struct EpiPool {
    static constexpr bool PERM = true;
    unsigned char* mrg; const bf16* proj; const float* scale;
    DI void operator()(const f32x4 (&acc)[2][2][4][2], const Unit& u, int wr, int wc, int fr, int fq) const {
        const int row0 = u.pm * BM + wr * 64 + fr, col0 = u.pn * BM + wc * 32 + 8 * fq;
#pragma unroll
        for (int bj = 0; bj < 2; ++bj) { const int c = col0 + bj * HALF; const f32x4 s0 = *(const f32x4*)(scale + c), s1 = *(const f32x4*)(scale + c + 4);
#pragma unroll
            for (int ai = 0; ai < 2; ++ai)
#pragma unroll
                for (int m = 0; m < 4; ++m) { const size_t row = (size_t)(row0 + ai * HALF + m * 16);
                    const u32x4 gv = *(const u32x4*)(proj + row * NINP + C_G + 2048 + c);
                    const f32x4 v0 = acc[ai][bj][m][0] * s0, v1 = acc[ai][bj][m][1] * s1;
                    u32x2 w; w.x = pk4_fp8(v0[0] * sigmoidf_(bflo(gv.x)), v0[1] * sigmoidf_(bfhi(gv.x)), v0[2] * sigmoidf_(bflo(gv.y)), v0[3] * sigmoidf_(bfhi(gv.y)));
                    w.y = pk4_fp8(v1[0] * sigmoidf_(bflo(gv.z)), v1[1] * sigmoidf_(bfhi(gv.z)), v1[2] * sigmoidf_(bflo(gv.w)), v1[3] * sigmoidf_(bfhi(gv.w)));
                    *(u32x2*)(mrg + row * MIXW + 2048 + c) = w; asm volatile("" ::: "memory"); } }
    }
};
struct EpiLru {
    static constexpr bool PERM = false;
    unsigned* AB; const bf16* xc; const float* ba; const float* bx; const float* c8sp;
    DI void operator()(const f32x4 (&acc)[2][2][4][2], const Unit& u, int wr, int wc, int fr, int fq) const {
        const int row0 = u.pm * BM + wr * 64 + fr, ch0 = u.pn * HALF + wc * 32 + 4 * fq;
#pragma unroll
        for (int n = 0; n < 2; ++n) { const int ch = ch0 + n * 16; const f32x4 vba = *(const f32x4*)(ba + ch), vbx = *(const f32x4*)(bx + ch), vsp = *(const f32x4*)(c8sp + ch);
#pragma unroll
            for (int ai = 0; ai < 2; ++ai)
#pragma unroll
                for (int m = 0; m < 4; ++m) { const size_t off = (size_t)(row0 + ai * HALF + m * 16) * DM + ch;
                    const u32x2 xv = *(const u32x2*)(xc + off); const float xf[4] = {bflo(xv.x), bfhi(xv.x), bflo(xv.y), bfhi(xv.y)};
                    u32x4 w;
#pragma unroll
                    for (int j = 0; j < 4; ++j) { const float r = sigmoidf_(acc[ai][0][m][n][j] + vba[j]), ig = sigmoidf_(acc[ai][1][m][n][j] + vbx[j]);
                        const float la = -vsp[j] * r; w[j] = pk2(la, __builtin_amdgcn_sqrtf(fmaxf(1.0f - __expf(2.0f * la), 0.f)) * ig * xf[j]); }
                    *(u32x4*)(AB + off) = w; asm volatile("" ::: "memory"); } }
    }
};

#ifndef PG8_ALIGN
#define PG8_ALIGN true
#endif
#ifndef PG8_SP2
#define PG8_SP2 true
#endif
template <class Epi, class Sched, bool F8 = false, bool ALIGN_EPI = PG8_ALIGN, bool SP2 = PG8_SP2>
DI void gemm_phase(LAS unsigned char* lds, const Gemm g, const Sched& S, const Epi& E, const int wave_id) {
    int lane_ = lane_id_(); asm volatile("" : "+v"(lane_));
    const int wid = wave_id, lane = lane_, tid = wid * 64 + lane, wr = wid >> 2, wc = wid & 3, fr = lane & 15, fq = lane >> 4;
    const int nt = g.K / BK;
    unsigned voffA[2], voffB[2];
#pragma unroll
    for (int i = 0; i < 2; ++i) { int R, C; stage_rc(tid * 16 + i * 8192, R, C); const int Rb = Epi::PERM ? ((R & ~31) + perm32(R & 31)) : R;
        voffA[i] = (unsigned)(R * g.lda + C) * 2u; voffB[i] = (unsigned)(Rb * g.ldb + C) * 2u; }
    const size_t kstep = (size_t)(BK * 2);
    const size_t hstepA = (size_t)HALF * g.lda * 2, hstepB = (size_t)HALF * g.ldb * 2;
    const unsigned ldsw = (unsigned)wid * 1024u;
    const int aoff = lds_byte(wr * 64 + fr, fq * 8), boff = lds_byte(wc * 32 + fr, fq * 8);
#define PG8_SA(b, h) (((b) * 2 + (h)) * HTB)
#define PG8_SB(b, h) ((4 + (b) * 2 + (h)) * HTB)
#define PG8_STAGE(bufoff, gbase, voff) do { _Pragma("unroll") for (int _i = 0; _i < 2; ++_i) \
        __builtin_amdgcn_global_load_lds((const unsigned*)((const char*)(gbase) + (voff)[_i]), (LAS unsigned*)(lds + (bufoff) + ldsw + _i * 8192), 16, 0, 0); } while (0)
#define PG8_LDA(dst, b, h) do { _Pragma("unroll") for (int m = 0; m < 4; ++m) _Pragma("unroll") for (int k = 0; k < 2; ++k) dst[m][k] = *(const LAS bf16x8*)(lds + PG8_SA(b, h) + aoff + m * 2048 + k * 1024); } while (0)
#define PG8_LDB(dst, b, h) do { _Pragma("unroll") for (int n = 0; n < 2; ++n) _Pragma("unroll") for (int k = 0; k < 2; ++k) dst[n][k] = *(const LAS bf16x8*)(lds + PG8_SB(b, h) + boff + n * 2048 + k * 1024); } while (0)
#define PG8_F8CAT(x) __builtin_shufflevector(__builtin_bit_cast(i32x4, (x)[0]), __builtin_bit_cast(i32x4, (x)[1]), 0, 1, 2, 3, 4, 5, 6, 7)
#define PG8_MMA(ai, bj, At, Bt) do { __builtin_amdgcn_s_setprio(1); _Pragma("unroll") for (int m = 0; m < 4; ++m) _Pragma("unroll") for (int n = 0; n < 2; ++n) { \
        if constexpr (F8) { const i32x8 fa_ = PG8_F8CAT(Bt[n]), fb_ = PG8_F8CAT(At[m]); asm volatile("v_mfma_scale_f32_16x16x128_f8f6f4 %0, %1, %2, %0, %3, %3 op_sel_hi:[0,0,0]" : "+v"(acc[ai][bj][m][n]) : "v"(fa_), "v"(fb_), "v"(f8one)); } \
        else { _Pragma("unroll") for (int k = 0; k < 2; ++k) acc[ai][bj][m][n] = __builtin_amdgcn_mfma_f32_16x16x32_bf16(Bt[n][k], At[m][k], acc[ai][bj][m][n], 0, 0, 0); } } \
        __builtin_amdgcn_s_setprio(0); } while (0)
#define PG8_WAIT_V(n) asm volatile("s_waitcnt vmcnt(" #n ")" ::: "memory")
#define PG8_WAIT_L(n) asm volatile("s_waitcnt lgkmcnt(" #n ")" ::: "memory")
#define PG8_BAR __builtin_amdgcn_s_barrier()
#define PG8_SCHED __builtin_amdgcn_sched_barrier(0)
    int f8one = 0x7f7f7f7f; asm volatile("" : "+v"(f8one));
    Unit cur, nxt; int ui = 0;
    if (!S.next(0, cur)) return;
    f32x4 acc[2][2][4][2];
#pragma unroll
    for (int a = 0; a < 2; ++a)
#pragma unroll
        for (int b = 0; b < 2; ++b)
#pragma unroll
            for (int m = 0; m < 4; ++m)
#pragma unroll
                for (int n = 0; n < 2; ++n) acc[a][b][m][n] = (f32x4){0.f, 0.f, 0.f, 0.f};
    bf16x8 At[4][2], B0[2][2], B1[2][2];
    const char* cA = (const char*)g.A + S.aoff(cur); const char* cB = (const char*)g.Bt + S.boff(cur);
    if constexpr (SP2) {
        PG8_STAGE(PG8_SB(0, 0), cB, voffB); PG8_STAGE(PG8_SB(0, 1), cB + hstepB, voffB); PG8_STAGE(PG8_SA(0, 0), cA, voffA); PG8_STAGE(PG8_SA(0, 1), cA + hstepA, voffA);
        if (wr == 1) PG8_BAR;
        PG8_WAIT_V(2); PG8_BAR;
        PG8_STAGE(PG8_SB(1, 0), cB + kstep, voffB); PG8_STAGE(PG8_SA(1, 0), cA + kstep, voffA); PG8_STAGE(PG8_SB(1, 1), cB + hstepB + kstep, voffB);
        PG8_WAIT_V(6); PG8_BAR;
    } else {
        PG8_STAGE(PG8_SB(0, 0), cB, voffB); PG8_STAGE(PG8_SA(0, 0), cA, voffA); PG8_STAGE(PG8_SB(0, 1), cB + hstepB, voffB); PG8_STAGE(PG8_SA(0, 1), cA + hstepA, voffA);
        if (wr == 1) PG8_BAR;
        PG8_WAIT_V(4); PG8_BAR;
        PG8_STAGE(PG8_SB(1, 0), cB + kstep, voffB); PG8_STAGE(PG8_SA(1, 0), cA + kstep, voffA); PG8_STAGE(PG8_SB(1, 1), cB + hstepB + kstep, voffB);
        PG8_WAIT_V(6); PG8_BAR;
    }
    for (;;) {
        const bool has_next = S.next(ui + 1, nxt);
        const char* nA = has_next ? (const char*)g.A + S.aoff(nxt) : cA; const char* nB = has_next ? (const char*)g.Bt + S.boff(nxt) : cB;
#pragma nounroll
        for (int t = 0; t < nt; t += 2) {
            const bool last = (t == nt - 2);
            const char* a1 = cA + (size_t)(t + 1) * kstep;
            const char* a2 = last ? nA : cA + (size_t)(t + 2) * kstep; const char* b2 = last ? nB : cB + (size_t)(t + 2) * kstep;
            const char* a3 = a2 + kstep; const char* b3 = b2 + kstep;
            if constexpr (SP2) {
            PG8_LDB(B0, 0, 0); PG8_LDB(B1, 0, 1); PG8_SCHED; PG8_LDA(At, 0, 0); PG8_STAGE(PG8_SA(1, 1), a1 + hstepA, voffA);
            PG8_WAIT_V(8); PG8_WAIT_L(0); PG8_BAR; PG8_MMA(0, 0, At, B0); PG8_MMA(0, 1, At, B1); PG8_BAR; PG8_SCHED;
            PG8_LDA(At, 0, 1); PG8_STAGE(PG8_SB(0, 0), b2, voffB); PG8_STAGE(PG8_SB(0, 1), b2 + hstepB, voffB); PG8_STAGE(PG8_SA(0, 0), a2, voffA);
            PG8_WAIT_V(8); PG8_WAIT_L(0); PG8_BAR; PG8_MMA(1, 0, At, B0); PG8_MMA(1, 1, At, B1); PG8_BAR; PG8_SCHED;
            PG8_LDB(B0, 1, 0); PG8_LDB(B1, 1, 1); PG8_SCHED; PG8_LDA(At, 1, 0); PG8_STAGE(PG8_SA(0, 1), a2 + hstepA, voffA);
            PG8_WAIT_V(8); PG8_WAIT_L(0); PG8_BAR; PG8_MMA(0, 0, At, B0); PG8_MMA(0, 1, At, B1); PG8_BAR; PG8_SCHED;
            PG8_LDA(At, 1, 1); PG8_STAGE(PG8_SB(1, 0), b3, voffB); PG8_STAGE(PG8_SB(1, 1), b3 + hstepB, voffB); PG8_STAGE(PG8_SA(1, 0), a3, voffA);
            PG8_WAIT_V(8); PG8_WAIT_L(0); PG8_BAR; PG8_MMA(1, 0, At, B0); PG8_MMA(1, 1, At, B1); PG8_BAR; PG8_SCHED;
            } else {
            PG8_LDB(B0, 0, 0); PG8_SCHED; PG8_LDA(At, 0, 0); PG8_STAGE(PG8_SA(1, 1), a1 + hstepA, voffA);
            PG8_WAIT_L(8); PG8_BAR; PG8_WAIT_L(0); PG8_MMA(0, 0, At, B0); PG8_BAR; PG8_SCHED;
            PG8_LDB(B1, 0, 1); PG8_STAGE(PG8_SB(0, 0), b2, voffB);
            PG8_BAR; PG8_WAIT_L(0); PG8_MMA(0, 1, At, B1); PG8_BAR;
            PG8_LDA(At, 0, 1); PG8_STAGE(PG8_SA(0, 0), a2, voffA);
            PG8_BAR; PG8_WAIT_L(0); PG8_MMA(1, 0, At, B0); PG8_BAR; PG8_SCHED;
            PG8_STAGE(PG8_SB(0, 1), b2 + hstepB, voffB);
            PG8_WAIT_V(6); PG8_BAR; PG8_MMA(1, 1, At, B1); PG8_BAR;
            PG8_LDB(B0, 1, 0); PG8_SCHED; PG8_LDA(At, 1, 0); PG8_STAGE(PG8_SA(0, 1), a2 + hstepA, voffA);
            PG8_WAIT_L(8); PG8_BAR; PG8_WAIT_L(0); PG8_MMA(0, 0, At, B0); PG8_BAR; PG8_SCHED;
            PG8_LDB(B1, 1, 1); PG8_STAGE(PG8_SB(1, 0), b3, voffB);
            PG8_BAR; PG8_WAIT_L(0); PG8_MMA(0, 1, At, B1); PG8_BAR;
            PG8_LDA(At, 1, 1); PG8_STAGE(PG8_SA(1, 0), a3, voffA);
            PG8_BAR; PG8_WAIT_L(0); PG8_MMA(1, 0, At, B0); PG8_BAR; PG8_SCHED;
            PG8_STAGE(PG8_SB(1, 1), b3 + hstepB, voffB);
            PG8_WAIT_V(6); PG8_BAR; PG8_MMA(1, 1, At, B1); PG8_BAR;
            }
        }
        if constexpr (ALIGN_EPI) { if (wr == 0) PG8_BAR; }
        if constexpr (F8) asm volatile("s_nop 15\n\ts_nop 15" ::: "memory");
        E(acc, cur, wr, wc, fr, fq);
        if (!has_next) break;
#pragma unroll
        for (int a = 0; a < 2; ++a)
#pragma unroll
            for (int b = 0; b < 2; ++b)
#pragma unroll
                for (int m = 0; m < 4; ++m)
#pragma unroll
                    for (int n = 0; n < 2; ++n) acc[a][b][m][n] = (f32x4){0.f, 0.f, 0.f, 0.f};
        cur = nxt; cA = nA; cB = nB; ++ui;
        if constexpr (ALIGN_EPI) { if (wr == 1) PG8_BAR; }
    }
    PG8_WAIT_V(0);
    if constexpr (!ALIGN_EPI) { if (wr == 0) PG8_BAR; }
    PG8_BAR;
#undef PG8_SA
#undef PG8_SB
#undef PG8_STAGE
#undef PG8_LDA
#undef PG8_LDB
#undef PG8_MMA
#undef PG8_F8CAT
#undef PG8_WAIT_V
#undef PG8_WAIT_L
#undef PG8_BAR
#undef PG8_SCHED
}
}

struct Args { const void* in[24]; float* out; unsigned char* ws; int ph_lo, ph_hi; };
struct Frame {
    LAS unsigned char* lds; unsigned* ctl; unsigned char* ws;
    int tid, lane, wave, G, bid;
};
#define INF(k) ((const float*)args.in[k])
DI float wave_sum(float v) {
#pragma unroll
    for (int o = 1; o < 64; o <<= 1) v += __shfl_xor(v, o);
    return v;
}

constexpr float F8_WSCALE = 64.0f;
DI void tr_item(const float* W, int ldS, int Nvalid, bf16* WT, int ldD, int koff, int mode, int roff, LAS float* scr, int k0, int n0, int lane, bool f8 = false) {
    const int nl = n0 + (lane & 31);
    float tv[32]; const float* wp = W + (size_t)(k0 + (lane >> 5)) * ldS + nl; const bool ok = nl < Nvalid;
#pragma unroll
    for (int i = 0; i < 32; ++i) tv[i] = ok ? __builtin_nontemporal_load(wp + (size_t)(2 * i) * ldS) : 0.f;
#pragma unroll
    for (int i = 0; i < 32; ++i) scr[(2 * i + (lane >> 5)) * 33 + (lane & 31)] = tv[i];
    LDS_WAIT(); asm volatile("" ::: "memory");
    const int c = lane & 7;
#pragma unroll
    for (int j = 0; j < 4; ++j) { const int nn = (lane >> 3) + 8 * j, n = n0 + nn; const LAS float* s = scr + (8 * c) * 33 + nn;
        u32x4 o; o.x = pk2(s[0 * 33], s[1 * 33]); o.y = pk2(s[2 * 33], s[3 * 33]); o.z = pk2(s[4 * 33], s[5 * 33]); o.w = pk2(s[6 * 33], s[7 * 33]);
        int row = mode == 0 ? roff + n : (mode == 1 ? (n < C_PADLO ? n : n + (C_P - C_PADLO)) : ((n >> 7) << 8) + roff + (n & 127));
        bool f8c = f8; bf16* WTc = WT;
        if (mode == 1) { if (row < 3072) { f8c = true; WTc = (bf16*)((unsigned char*)WT + WIN_F8); } else if (row >= C_G) { f8c = true; WTc = (bf16*)((unsigned char*)WT + WIN_F8); row = 3072 + (row - C_G); } else row -= 3072; }
        if (n < Nvalid) { if (f8c) { u32x2 o8; o8.x = pk4_fp8(s[0 * 33] * F8_WSCALE, s[1 * 33] * F8_WSCALE, s[2 * 33] * F8_WSCALE, s[3 * 33] * F8_WSCALE); o8.y = pk4_fp8(s[4 * 33] * F8_WSCALE, s[5 * 33] * F8_WSCALE, s[6 * 33] * F8_WSCALE, s[7 * 33] * F8_WSCALE);
                *(u32x2*)((unsigned char*)WTc + (size_t)row * ldD + koff + k0 + 8 * c) = o8; }
            else *(u32x4*)(WTc + (size_t)row * ldD + koff + k0 + 8 * c) = o; } }
    LDS_WAIT(); asm volatile("" ::: "memory");
}
constexpr int NB_IN = (NIN + 31) / 32;
constexpr int CI_IN = 32 * NB_IN, CI_OUT = 96 * 64, CI_POOL = 8 * 8 * 16, CI_LRU = 64 * 8, CI_GU = 2 * 32 * 172, CI_DN = 86 * 64, CI_MGU = 16 * 32 * 224, CI_MDN = 8 * 112 * 64;
constexpr int CE_0 = CI_IN + CI_POOL + CI_LRU;
constexpr int CE_1 = CE_0 + CI_OUT;
constexpr int CE_2 = CE_1 + CI_GU;
constexpr int CE_3 = CE_2 + CI_DN;
constexpr int CE_4 = CE_3 + CI_IN;
constexpr int CE_5 = CE_4 + CI_OUT;
constexpr int CE_6 = CE_5 + CI_MGU;
constexpr int CE_7 = CE_6 + CI_MDN;
constexpr int IP_A = 96 * 8 * 10;
constexpr int MOE_EARLY = CE_2 - CE_0;
constexpr int P2_ITEMS = 224 * 8 * 4;
DI void conv_item(unsigned char* ws, const Args& args, int idx, LAS float* scr, int lane) {
    const float* W; bf16* WT; int ldS, Nv, ldD, koff = 0, mode = 0, roff = 0, kb, nb; int r = idx; bool f8 = false;
    if (r < CI_IN) { kb = r / NB_IN; nb = r % NB_IN; W = INF(2); ldS = NIN; Nv = NIN; WT = (bf16*)(ws + WS_WIN); ldD = DM; mode = 1; }
    else if ((r -= CI_IN) < CI_POOL) { const int lg = r >> 7, q = r & 127; kb = q >> 4; nb = q & 15; W = INF(4) + (size_t)lg * 512 * 512; ldS = 512; Nv = 512; WT = (bf16*)(ws + WS_WPOOL) + (size_t)(lg >> 2) * 2048 * 512; ldD = 512; roff = (lg & 3) * 512; }
    else if ((r -= CI_POOL) < CI_LRU) { const int cmb = r >> 3, q = r & 7, l = cmb >> 5, which = (cmb >> 4) & 1, n = cmb & 15; kb = q >> 2; nb = q & 3;
        W = (which ? INF(10) : INF(8)) + ((size_t)l * 16 + n) * 128 * 128; ldS = 128; Nv = 128; WT = (bf16*)(ws + WS_WLRU) + (size_t)l * 4096 * 256; ldD = 256; koff = (n & 1) * 128; roff = n * 256 + which * 128; }
    else if ((r -= CI_LRU) < CI_OUT) { kb = r >> 6; nb = r & 63; W = INF(3); ldS = DM; Nv = DM; WT = (bf16*)(ws + WS_WOUT); ldD = MIXW; f8 = true; }
    else if ((r -= CI_OUT) < CI_GU) { const int which = r / (32 * 172), q = r % (32 * 172); kb = q / 172; nb = q % 172; W = which ? INF(18) : INF(17); ldS = DFF; Nv = DFF; WT = (bf16*)(ws + WS_WGU); ldD = DM; mode = 2; roff = which * 128; }
    else if ((r -= CI_GU) < CI_DN) { kb = r >> 6; nb = r & 63; W = INF(19); ldS = DM; Nv = DM; WT = (bf16*)(ws + WS_WDN); ldD = DFF; }
    else if ((r -= CI_DN) < CI_IN) { kb = r / NB_IN; nb = r % NB_IN; W = INF(2) + (size_t)DM * NIN; ldS = NIN; Nv = NIN; WT = (bf16*)(ws + WS_WIN + WIN_LAYER); ldD = DM; mode = 1; }
    else if ((r -= CI_IN) < CI_OUT) { kb = r >> 6; nb = r & 63; W = INF(3) + (size_t)MIXW * DM; ldS = DM; Nv = DM; WT = (bf16*)(ws + WS_WOUT + (size_t)DM * MIXW); ldD = MIXW; f8 = true; }
    else if ((r -= CI_OUT) < CI_MGU) { const int ew = r / (32 * 224), q = r % (32 * 224), e = ew >> 1, which = ew & 1; kb = q / 224; nb = q % 224;
        W = (which ? INF(22) : INF(21)) + (size_t)e * DM * DEXP; ldS = DEXP; Nv = DEXP; WT = (bf16*)(ws + WS_MWGU + (size_t)e * 2 * DEXP * DM); ldD = DM; mode = 2; roff = which * 128; f8 = true; }
    else { r -= CI_MGU; const int e = r / (112 * 64), q = r % (112 * 64); kb = q >> 6; nb = q & 63; W = INF(23) + (size_t)e * DEXP * DM; ldS = DM; Nv = DM; WT = (bf16*)(ws + WS_MWDN + (size_t)e * DM * DEXP); ldD = DEXP; f8 = true; }
    tr_item(W, ldS, Nv, WT, ldD, koff, mode, roff, scr, 64 * kb, 32 * nb, lane, f8);
}
DI void conv_range(Frame& F, const Args& args, int i0, int i1, int wg0) {
    if (F.bid < wg0) return;
    LAS float* scr = (LAS float*)(F.lds + F.wave * 16384);
    const int gw = (F.bid - wg0) * 8 + F.wave, NGW = (F.G - wg0) * 8;
    for (int it = i0 + gw; it < i1; it += NGW) conv_item(F.ws, args, it, scr, F.lane);
}
DI void p0_prologue(Frame& F, const Args& args) {
    conv_range(F, args, 0, CE_0, 0);
    bf16* Wlru = (bf16*)(F.ws + WS_WLRU);
    const int gt = F.bid * 512 + F.tid, NT = F.G * 512;
    for (int i = gt; i < 2 * 4096 * 16; i += NT) { const int row = i >> 4, ch = i & 15, n = (row & 4095) >> 8;
        *(u32x4*)(Wlru + (size_t)row * 256 + ((n + 1) & 1) * 128 + ch * 8) = (u32x4){0u, 0u, 0u, 0u}; }
    float* cosA = (float*)(F.ws + WS_COSA); float* sinA = (float*)(F.ws + WS_SINA); float* cosI = (float*)(F.ws + WS_COSI); float* sinI = (float*)(F.ws + WS_SINI);
    for (int i = gt; i < MTOK * 96; i += NT) {
        const int tok = i / 96, j = i % 96; const bool isA = j < 64; const int fi = isA ? j : j - 64; const double dim = isA ? 128.0 : 64.0;
        const float inv = (float)pow(10000.0, -(double)(2 * fi) / dim);
        const float ang = (float)((const int*)args.in[1])[tok] * inv; const double a = (double)ang; const double nrev = rint(a * 0.15915494309189535); const double rr = a - nrev * 6.283185307179586;
        const float cv = (float)cos(rr), sv = (float)sin(rr);
        if (isA) { cosA[tok * 64 + fi] = cv; sinA[tok * 64 + fi] = sv; } else { cosI[tok * 32 + fi] = cv; sinI[tok * 32 + fi] = sv; }
    }
    float* c8 = (float*)(F.ws + WS_LRUC);
    for (int i = gt; i < 2 * DM; i += NT) { const float lam = INF(12)[i]; c8[i] = 8.0f * log1pf(expf(-lam)); }
    bf16* xb = (bf16*)(F.ws + WS_XB);
    for (int i = gt; i < MTOK * DM / 8; i += NT) { const f32x4 a = *(const f32x4*)(INF(0) + (size_t)i * 8), b = *(const f32x4*)(INF(0) + (size_t)i * 8 + 4);
        u32x4 o; o.x = pk2(a[0], a[1]); o.y = pk2(a[2], a[3]); o.z = pk2(b[0], b[1]); o.w = pk2(b[2], b[3]); *(u32x4*)(xb + (size_t)i * 8) = o;
        u32x2 q; q.x = pk4_fp8(a[0], a[1], a[2], a[3]); q.y = pk4_fp8(b[0], b[1], b[2], b[3]); *(u32x2*)(F.ws + WS_X1 + (size_t)i * 8) = q; }
}

DI void ld8(const bf16* p, float (&v)[8]) { const u32x4 w = *(const u32x4*)p; v[0] = bflo(w.x); v[1] = bfhi(w.x); v[2] = bflo(w.y); v[3] = bfhi(w.y); v[4] = bflo(w.z); v[5] = bfhi(w.z); v[6] = bflo(w.w); v[7] = bfhi(w.w); }
DI void st8(bf16* p, const float (&v)[8]) { u32x4 o; o.x = pk2(v[0], v[1]); o.y = pk2(v[2], v[3]); o.z = pk2(v[4], v[5]); o.w = pk2(v[6], v[7]); *(u32x4*)p = o; }

DI void acc8(float (&s)[8], const u32x4& r, float m) { s[0] += m * bflo(r.x); s[1] += m * bfhi(r.x); s[2] += m * bflo(r.y); s[3] += m * bfhi(r.y); s[4] += m * bflo(r.z); s[5] += m * bfhi(r.z); s[6] += m * bflo(r.w); s[7] += m * bfhi(r.w); }
template <int G>
DI void pool_range(const bf16* proj, bf16* diff, int tok0, int c) {
    constexpr int W = 2 << G, NR = W - 1 + 16;
    const int tpos0 = tok0 & (SEQ - 1);
    const bf16* pp = proj + (size_t)tok0 * NINP + C_P + c;
    u32x4 r[NR];
#pragma unroll
    for (int i = 0; i < NR; ++i) { const int back = (W - 1) - i; r[i] = *(const u32x4*)(pp - (ptrdiff_t)((back > 0 && tpos0 - back < 0) ? 0 : back) * NINP); }
    float s[8];
#pragma unroll
    for (int k = 0; k < 8; ++k) s[k] = 0.f;
#pragma unroll
    for (int i = 0; i < W - 1; ++i) acc8(s, r[i], (tpos0 - ((W - 1) - i) >= 0) ? 1.f : 0.f);
#pragma unroll
    for (int t = 0; t < 16; ++t) {
        acc8(s, r[W - 1 + t], 1.f);
        const int tpos = tpos0 + t, cnt = (tpos + 1) < W ? (tpos + 1) : W; const float rc = 1.0f / (float)cnt; const u32x4 cur = r[W - 1 + t];
        float v[8] = {s[0] * rc - bflo(cur.x), s[1] * rc - bfhi(cur.x), s[2] * rc - bflo(cur.y), s[3] * rc - bfhi(cur.y), s[4] * rc - bflo(cur.z), s[5] * rc - bfhi(cur.z), s[6] * rc - bflo(cur.w), s[7] * rc - bfhi(cur.w)};
        st8(diff + (size_t)(tok0 + t) * DM + c, v);
        acc8(s, r[t], (tpos - (W - 1) >= 0) ? -1.f : 0.f);
    }
}
DI void p2_prep(Frame& F, const Args& args, int layer) {
    bf16* proj = (bf16*)(F.ws + WS_PROJ); bf16* diff = (bf16*)(F.ws + WS_DIFF); bf16* xc = (bf16*)(F.ws + WS_XC);
    const float* cosA = (const float*)(F.ws + WS_COSA); const float* sinA = (const float*)(F.ws + WS_SINA); const float* cosI = (const float*)(F.ws + WS_COSI); const float* sinI = (const float*)(F.ws + WS_SINI);
    const int gt = F.bid * 512 + F.tid, NT = F.G * 512;
    for (int it = gt; it < MTOK * 32; it += NT) {
        const int tok = it >> 5, dch = it & 7, hq = (it >> 3) & 3, d = dch * 8;
        const float* ct = cosA + tok * 64 + d; const float* st = sinA + tok * 64 + d;
        const f32x4 c0 = *(const f32x4*)ct, c1 = *(const f32x4*)(ct + 4), s0 = *(const f32x4*)st, s1 = *(const f32x4*)(st + 4);
        bf16* base = proj + (size_t)tok * NINP;
        u32x4 xa[5], xb_[5];
#pragma unroll
        for (int q = 0; q < 5; ++q) { bf16* p1 = base + (q < 4 ? C_Q + (hq * 4 + q) * 128 : C_K + hq * 128) + d; xa[q] = *(const u32x4*)p1; xb_[q] = *(const u32x4*)(p1 + 64); }
#pragma unroll
        for (int q = 0; q < 5; ++q) { bf16* p1 = base + (q < 4 ? C_Q + (hq * 4 + q) * 128 : C_K + hq * 128) + d;
            const float x1[8] = {bflo(xa[q].x), bfhi(xa[q].x), bflo(xa[q].y), bfhi(xa[q].y), bflo(xa[q].z), bfhi(xa[q].z), bflo(xa[q].w), bfhi(xa[q].w)};
            const float x2[8] = {bflo(xb_[q].x), bfhi(xb_[q].x), bflo(xb_[q].y), bfhi(xb_[q].y), bflo(xb_[q].z), bfhi(xb_[q].z), bflo(xb_[q].w), bfhi(xb_[q].w)};
            float y1[8], y2[8];
#pragma unroll
            for (int i = 0; i < 8; ++i) { const float c = i < 4 ? c0[i & 3] : c1[i & 3], s = i < 4 ? s0[i & 3] : s1[i & 3]; y1[i] = x1[i] * c - x2[i] * s; y2[i] = x2[i] * c + x1[i] * s; }
            st8(p1, y1); st8(p1 + 64, y2); }
    }
    for (int it = gt; it < MTOK * 16; it += NT) {
        const int tok = it >> 4, dch = it & 3, hq = (it >> 2) & 3, d = dch * 8;
        const float* ct = cosI + tok * 32 + d; const float* st = sinI + tok * 32 + d;
        const f32x4 c0 = *(const f32x4*)ct, c1 = *(const f32x4*)(ct + 4), s0 = *(const f32x4*)st, s1 = *(const f32x4*)(st + 4);
        bf16* base = proj + (size_t)tok * NINP;
        u32x4 xa[5], xb_[5];
#pragma unroll
        for (int q = 0; q < 5; ++q) { bf16* p1 = base + (q < 4 ? C_QI + (hq * 4 + q) * 64 : C_KI) + d; xa[q] = *(const u32x4*)p1; xb_[q] = *(const u32x4*)(p1 + 32); }
#pragma unroll
        for (int q = 0; q < 5; ++q) { if (q < 4 || hq == 0) { bf16* p1 = base + (q < 4 ? C_QI + (hq * 4 + q) * 64 : C_KI) + d;
            const float x1[8] = {bflo(xa[q].x), bfhi(xa[q].x), bflo(xa[q].y), bfhi(xa[q].y), bflo(xa[q].z), bfhi(xa[q].z), bflo(xa[q].w), bfhi(xa[q].w)};
            const float x2[8] = {bflo(xb_[q].x), bfhi(xb_[q].x), bflo(xb_[q].y), bfhi(xb_[q].y), bflo(xb_[q].z), bfhi(xb_[q].z), bflo(xb_[q].w), bfhi(xb_[q].w)};
            float y1[8], y2[8];
#pragma unroll
            for (int i = 0; i < 8; ++i) { const float c = i < 4 ? c0[i & 3] : c1[i & 3], s = i < 4 ? s0[i & 3] : s1[i & 3]; y1[i] = x1[i] * c - x2[i] * s; y2[i] = x2[i] * c + x1[i] * s; }
            st8(p1, y1); st8(p1 + 32, y2); } }
    }
    const float* cw = INF(6) + (size_t)layer * 4 * DM; const float* cb = INF(7) + (size_t)layer * DM;
    for (int it = gt; it < (MTOK / 16) * 256; it += NT) {
        const int cg = it & 255, c = cg * 8, tok0 = (it >> 8) * 16;
        const int g = cg >> 6;
        if (g == 0) pool_range<0>(proj, diff, tok0, c); else if (g == 1) pool_range<1>(proj, diff, tok0, c); else if (g == 2) pool_range<2>(proj, diff, tok0, c); else pool_range<3>(proj, diff, tok0, c);
    }
    for (int it = gt; it < (MTOK / 16) * 256; it += NT) {
        const int cg = it & 255, c = cg * 8, tok0 = (it >> 8) * 16, tpos0 = tok0 & (SEQ - 1);
        const bf16* px = proj + (size_t)tok0 * NINP + C_XR + c;
        u32x4 r[19];
#pragma unroll
        for (int i = 0; i < 19; ++i) { const int back = 3 - i; r[i] = *(const u32x4*)(px - (ptrdiff_t)((back > 0 && tpos0 - back < 0) ? 0 : back) * NINP); }
        f32x4 w0[4], w1[4]; const f32x4 b0 = *(const f32x4*)(cb + c), b1 = *(const f32x4*)(cb + c + 4);
#pragma unroll
        for (int jj = 0; jj < 4; ++jj) { w0[jj] = *(const f32x4*)(cw + jj * DM + c); w1[jj] = *(const f32x4*)(cw + jj * DM + c + 4); }
#pragma unroll
        for (int t = 0; t < 16; ++t) {
            float acc[8] = {b0[0], b0[1], b0[2], b0[3], b1[0], b1[1], b1[2], b1[3]};
#pragma unroll
            for (int jj = 0; jj < 4; ++jj) { const float m = (tpos0 + t - (3 - jj) >= 0) ? 1.f : 0.f; const u32x4 x = r[t + jj];
                acc[0] += m * bflo(x.x) * w0[jj][0]; acc[1] += m * bfhi(x.x) * w0[jj][1]; acc[2] += m * bflo(x.y) * w0[jj][2]; acc[3] += m * bfhi(x.y) * w0[jj][3];
                acc[4] += m * bflo(x.z) * w1[jj][0]; acc[5] += m * bfhi(x.z) * w1[jj][1]; acc[6] += m * bflo(x.w) * w1[jj][2]; acc[7] += m * bfhi(x.w) * w1[jj][3]; }
            st8(xc + (size_t)(tok0 + t) * DM + c, acc);
        }
    }
}

DI void p3_indexer(Frame& F) {
    const bf16* proj = (const bf16*)(F.ws + WS_PROJ); float* sc = (float*)(F.ws + WS_SC);
    const int gw = F.bid * 8 + F.wave, NGW = F.G * 8, l15 = F.lane & 15, l4 = F.lane >> 4;
    for (int u = gw; u < BATCH * 576; u += NGW) {
        const int b = u / 576, r = u % 576; int g8 = 0;
#pragma unroll
        for (int k = 1; k < 8; ++k) g8 = (r >= 8 * k * (k + 1)) ? k : g8;
        const int rr = r - 8 * g8 * (g8 + 1), sp = rr % (g8 + 1), qq = rr / (g8 + 1), qb16 = g8 * 16 + qq, c = qb16 >> 2;
        const int limit = (c + 1) * 64, kbeg = sp * 256, kend = (kbeg + 256) < limit ? (kbeg + 256) : limit;
        const int qtok = b * SEQ + qb16 * 16 + l15;
        const bf16* qrow = proj + (size_t)qtok * NINP;
        bf16x8 qf[16][2]; float w[16];
        { const u32x4 w0 = *(const u32x4*)(qrow + C_WI), w1 = *(const u32x4*)(qrow + C_WI + 8); const float s = 0.125f * 0.25f;
          w[0] = bflo(w0.x) * s; w[1] = bfhi(w0.x) * s; w[2] = bflo(w0.y) * s; w[3] = bfhi(w0.y) * s; w[4] = bflo(w0.z) * s; w[5] = bfhi(w0.z) * s; w[6] = bflo(w0.w) * s; w[7] = bfhi(w0.w) * s;
          w[8] = bflo(w1.x) * s; w[9] = bfhi(w1.x) * s; w[10] = bflo(w1.y) * s; w[11] = bfhi(w1.y) * s; w[12] = bflo(w1.z) * s; w[13] = bfhi(w1.z) * s; w[14] = bflo(w1.w) * s; w[15] = bfhi(w1.w) * s; }
#pragma unroll
        for (int h = 0; h < 16; ++h)
#pragma unroll
            for (int ks = 0; ks < 2; ++ks) qf[h][ks] = *(const bf16x8*)(qrow + C_QI + h * 64 + ks * 32 + l4 * 8);
        const bf16* kbase = proj + (size_t)(b * SEQ + l15) * NINP + C_KI + l4 * 8;
        bf16x8 nk0 = *(const bf16x8*)(kbase + (size_t)kbeg * NINP), nk1 = *(const bf16x8*)(kbase + (size_t)kbeg * NINP + 32);
        for (int k0 = kbeg; k0 < kend; k0 += 16) {
            const bf16x8 ka0 = nk0, ka1 = nk1;
            { const int kn = (k0 + 16 < kend) ? k0 + 16 : k0; nk0 = *(const bf16x8*)(kbase + (size_t)kn * NINP); nk1 = *(const bf16x8*)(kbase + (size_t)kn * NINP + 32); }
            f32x4 tot = {0.f, 0.f, 0.f, 0.f};
#pragma unroll
            for (int h = 0; h < 16; ++h) { f32x4 s = {0.f, 0.f, 0.f, 0.f};
                s = __builtin_amdgcn_mfma_f32_16x16x32_bf16(ka0, qf[h][0], s, 0, 0, 0); s = __builtin_amdgcn_mfma_f32_16x16x32_bf16(ka1, qf[h][1], s, 0, 0, 0);
#pragma unroll
                for (int j = 0; j < 4; ++j) tot[j] += w[h] * fmaxf(s[j], 0.f); }
            *(f32x4*)(sc + (size_t)qtok * SEQ + k0 + 4 * l4) = tot;
        }
    }
}

DI void p4_select(Frame& F) {
    const float* sc = (const float*)(F.ws + WS_SC); unsigned* mask = (unsigned*)(F.ws + WS_MASK);
    const int gw = F.bid * 8 + F.wave, NGW = F.G * 8, lane = F.lane;
    for (int tok = gw; tok < MTOK; tok += NGW) {
        const int tpos = tok & (SEQ - 1), limit = ((tpos >> 6) + 1) * 64, nw = limit >> 5;
        unsigned mw = 0u;
        if (limit <= 256) { mw = lane < nw ? 0xffffffffu : 0u; }
        else {
            unsigned key[32];
            if (lane < nw) { const float* p = sc + (size_t)tok * SEQ + lane * 32;
#pragma unroll
                for (int q = 0; q < 8; ++q) { const f32x4 v = *(const f32x4*)(p + 4 * q);
#pragma unroll
                    for (int j = 0; j < 4; ++j) { const unsigned uu = __float_as_uint(v[j]); key[4 * q + j] = (uu & 0x80000000u) ? ~uu : (uu | 0x80000000u); } } }
            else {
#pragma unroll
                for (int j = 0; j < 32; ++j) key[j] = 0u; }
            unsigned T = 0u; bool exact = false;
            for (int bit = 31; bit >= 0; --bit) {
                const unsigned cand = T | (1u << bit); int cnt = 0;
#pragma unroll
                for (int j = 0; j < 32; ++j) cnt += __popcll(__ballot(key[j] >= cand));
                if (cnt >= 256) { T = cand; if (cnt == 256) { exact = true; break; } }
            }
            unsigned gtw = 0u, eqw = 0u;
#pragma unroll
            for (int j = 0; j < 32; ++j) { gtw |= (key[j] > T) ? (1u << j) : 0u; eqw |= (key[j] == T) ? (1u << j) : 0u; }
            if (exact) { mw = gtw | eqw; }
            else {
                int ngt = 0;
#pragma unroll
                for (int j = 0; j < 32; ++j) ngt += __popcll(__ballot(key[j] > T));
                const int need = 256 - ngt; const int el = __popc(eqw);
                int pre = el;
#pragma unroll
                for (int o = 1; o < 64; o <<= 1) { const int t = __shfl_up(pre, o); pre += (lane >= o) ? t : 0; }
                int take = need - (pre - el); take = take < 0 ? 0 : (take > el ? el : take);
                unsigned sel = 0u, rem = eqw;
                for (int t = 0; t < 32; ++t) { if (t < take) { const unsigned low = rem & (0u - rem); sel |= low; rem ^= low; } }
                mw = gtw | sel;
            }
        }
        mask[(size_t)tok * 64 + lane] = mw;
    }
}

DI void p4_lru_pass1(Frame& F) {
    const unsigned* AB = (const unsigned*)(F.ws + WS_A); float* CP = (float*)(F.ws + WS_CARRY); float* CH = CP + BATCH * 64 * DM;
    for (int u = F.bid; u < BATCH * 64; u += F.G) {
        const int j = u & 63, b = u >> 6, c = 4 * F.tid;
        const size_t base = ((size_t)b * SEQ + j * 32) * DM + c;
        u32x4 w[32];
#pragma unroll
        for (int t = 0; t < 32; ++t) w[t] = *(const u32x4*)(AB + base + (size_t)t * DM);
        f32x4 P = {1.f, 1.f, 1.f, 1.f}, H = {0.f, 0.f, 0.f, 0.f};
#pragma unroll
        for (int t = 0; t < 32; ++t) { const f32x4 a = {__expf(bflo(w[t].x)), __expf(bflo(w[t].y)), __expf(bflo(w[t].z)), __expf(bflo(w[t].w))}, bb = {bfhi(w[t].x), bfhi(w[t].y), bfhi(w[t].z), bfhi(w[t].w)};
            H = a * H + bb; P = P * a; }
        *(f32x4*)(CP + ((size_t)b * 64 + j) * DM + c) = P; *(f32x4*)(CH + ((size_t)b * 64 + j) * DM + c) = H;
    }
}
DI void p5_lru_pass2(Frame& F) {
    const unsigned* AB = (const unsigned*)(F.ws + WS_A); const float* CP = (const float*)(F.ws + WS_CARRY); const float* CH = CP + BATCH * 64 * DM;
    const bf16* proj = (const bf16*)(F.ws + WS_PROJ); unsigned char* mrg = F.ws + WS_MRG;
    for (int u = F.bid; u < BATCH * 64; u += F.G) {
        const int j = u & 63, b = u >> 6, c = 4 * F.tid;
        f32x4 h = {0.f, 0.f, 0.f, 0.f};
#pragma unroll 8
        for (int jj = 0; jj < j; ++jj) { const f32x4 p = *(const f32x4*)(CP + ((size_t)b * 64 + jj) * DM + c), q = *(const f32x4*)(CH + ((size_t)b * 64 + jj) * DM + c); h = p * h + q; }
        const size_t tok0 = (size_t)b * SEQ + j * 32;
#pragma unroll 1
        for (int hs = 0; hs < 2; ++hs) {
            u32x4 w[16]; u32x2 gr[16], gg[16];
#pragma unroll
            for (int t = 0; t < 16; ++t) { const size_t tok = tok0 + hs * 16 + t; w[t] = *(const u32x4*)(AB + tok * DM + c); gr[t] = *(const u32x2*)(proj + tok * NINP + C_GR + c); gg[t] = *(const u32x2*)(proj + tok * NINP + C_G + 4096 + c); }
#pragma unroll
            for (int t = 0; t < 16; ++t) { const size_t tok = tok0 + hs * 16 + t;
                const f32x4 a = {__expf(bflo(w[t].x)), __expf(bflo(w[t].y)), __expf(bflo(w[t].z)), __expf(bflo(w[t].w))}, bb = {bfhi(w[t].x), bfhi(w[t].y), bfhi(w[t].z), bfhi(w[t].w)};
                h = a * h + bb;
                const unsigned o = pk4_fp8(h[0] * gelu_tanh_(bflo(gr[t].x)) * sigmoidf_(bflo(gg[t].x)), h[1] * gelu_tanh_(bfhi(gr[t].x)) * sigmoidf_(bfhi(gg[t].x)),
                                           h[2] * gelu_tanh_(bflo(gr[t].y)) * sigmoidf_(bflo(gg[t].y)), h[3] * gelu_tanh_(bfhi(gr[t].y)) * sigmoidf_(bfhi(gg[t].y)));
                *(unsigned*)(mrg + tok * MIXW + 4096 + c) = o; }
        }
    }
}

typedef short s16x4 __attribute__((ext_vector_type(4)));
constexpr int KS_STRIDE = 272, VS_STRIDE = 320, ATT_V = 64 * KS_STRIDE, ATT_BUF = 64 * KS_STRIDE + 64 * VS_STRIDE;
DI void p5_attention(Frame& F) {
    const bf16* proj = (const bf16*)(F.ws + WS_PROJ); const unsigned* mask = (const unsigned*)(F.ws + WS_MASK); unsigned char* mrg = F.ws + WS_MRG;
    const int lane = F.lane, l31 = lane & 31, hf = lane >> 5, wave = F.wave, hh = wave >> 1, qh = wave & 1, tid = F.tid;
    const float sc2 = 0.08838834764831845f * 1.4426950408889634f;
    const int gi = lane >> 4, i16 = lane & 15;
    const int vbase = ATT_V + (4 * (gi >> 1) + (i16 >> 2)) * VS_STRIDE + (16 * (gi & 1) + 4 * (i16 & 3)) * 2;
    const int sr0 = tid >> 4, sch = tid & 15;
    for (int u = F.bid; u < BATCH * 16 * 4; u += F.G) {
        const int g = u & 3, cp = (u >> 2) & 15, b = u >> 6;
        for (int half = 0; half < 2; ++half) {
            const int c = half ? (31 - cp) : cp, nkt = c + 1, head = g * 4 + hh;
            const int qtok = b * SEQ + c * 64 + qh * 32 + l31;
            const bf16* qrow = proj + (size_t)qtok * NINP + C_Q + head * 128 + hf * 8;
            bf16x8 qf[8];
#pragma unroll
            for (int ks = 0; ks < 8; ++ks) qf[ks] = *(const bf16x8*)(qrow + ks * 16);
            f32x16 o[4];
#pragma unroll
            for (int db = 0; db < 4; ++db)
#pragma unroll
                for (int i = 0; i < 16; ++i) o[db][i] = 0.f;
            float mrun = -1e30f, lrun = 0.f;
            const bf16* kg = proj + (size_t)(b * SEQ + sr0) * NINP + C_K + g * 128 + sch * 8;
            const bf16* vg = proj + (size_t)(b * SEQ + sr0) * NINP + C_V + g * 128 + sch * 8;
            u32x4 kr0 = *(const u32x4*)kg, kr1 = *(const u32x4*)(kg + (size_t)32 * NINP), vr0 = *(const u32x4*)vg, vr1 = *(const u32x4*)(vg + (size_t)32 * NINP);
            const unsigned* mrow = mask + (size_t)qtok * 64;
            unsigned mw0 = mrow[0], mw1 = mrow[1];
            { LAS unsigned char* B0 = F.lds;
              *(LAS u32x4*)(B0 + sr0 * KS_STRIDE + sch * 16) = kr0; *(LAS u32x4*)(B0 + (sr0 + 32) * KS_STRIDE + sch * 16) = kr1;
              *(LAS u32x4*)(B0 + ATT_V + sr0 * VS_STRIDE + sch * 16) = vr0; *(LAS u32x4*)(B0 + ATT_V + (sr0 + 32) * VS_STRIDE + sch * 16) = vr1; }
            __syncthreads();
            for (int kt = 0; kt < nkt; ++kt) {
                LAS unsigned char* Bc = F.lds + (kt & 1) * ATT_BUF; LAS unsigned char* Bn = F.lds + ((kt + 1) & 1) * ATT_BUF;
                const unsigned cm0 = mw0, cm1 = mw1; const bool more = kt + 1 < nkt;
                if (more) { const size_t adv = (size_t)(kt + 1) * 64 * NINP;
                    kr0 = *(const u32x4*)(kg + adv); kr1 = *(const u32x4*)(kg + adv + (size_t)32 * NINP); vr0 = *(const u32x4*)(vg + adv); vr1 = *(const u32x4*)(vg + adv + (size_t)32 * NINP);
                    mw0 = mrow[2 * kt + 2]; mw1 = mrow[2 * kt + 3]; }
                f32x16 s0, s1;
#pragma unroll
                for (int i = 0; i < 16; ++i) { s0[i] = 0.f; s1[i] = 0.f; }
#pragma unroll
                for (int ks = 0; ks < 8; ++ks) {
                    const bf16x8 ka = *(const LAS bf16x8*)(Bc + l31 * KS_STRIDE + ks * 32 + hf * 16);
                    const bf16x8 kb = *(const LAS bf16x8*)(Bc + (32 + l31) * KS_STRIDE + ks * 32 + hf * 16);
                    s0 = __builtin_amdgcn_mfma_f32_32x32x16_bf16(ka, qf[ks], s0, 0, 0, 0);
                    s1 = __builtin_amdgcn_mfma_f32_32x32x16_bf16(kb, qf[ks], s1, 0, 0, 0);
                }
                const unsigned sm0 = cm0 >> (4 * hf), sm1 = cm1 >> (4 * hf);
                float tmax = -INFINITY;
#pragma unroll
                for (int i = 0; i < 16; ++i) { const unsigned bit = 1u << ((i & 3) + 8 * (i >> 2));
                    s0[i] = (sm0 & bit) ? s0[i] * sc2 : -INFINITY; s1[i] = (sm1 & bit) ? s1[i] * sc2 : -INFINITY; tmax = fmaxf(tmax, fmaxf(s0[i], s1[i])); }
                tmax = fmaxf(tmax, __shfl_xor(tmax, 32));
                const float mnew = fmaxf(mrun, tmax), alpha = __builtin_amdgcn_exp2f(mrun - mnew); mrun = mnew;
                float psum = 0.f;
#pragma unroll
                for (int i = 0; i < 16; ++i) { s0[i] = __builtin_amdgcn_exp2f(s0[i] - mnew); s1[i] = __builtin_amdgcn_exp2f(s1[i] - mnew); psum += s0[i] + s1[i]; }
                lrun = lrun * alpha + psum;
                if (!__all(alpha == 1.0f)) {
#pragma unroll
                    for (int db = 0; db < 4; ++db)
#pragma unroll
                        for (int i = 0; i < 16; ++i) o[db][i] *= alpha; }
#pragma unroll
                for (int kb = 0; kb < 2; ++kb)
#pragma unroll
                    for (int s = 0; s < 2; ++s) {
                        u32x4 pw;
                        if (kb == 0) { pw.x = pk2(s0[8 * s], s0[8 * s + 1]); pw.y = pk2(s0[8 * s + 2], s0[8 * s + 3]); pw.z = pk2(s0[8 * s + 4], s0[8 * s + 5]); pw.w = pk2(s0[8 * s + 6], s0[8 * s + 7]); }
                        else { pw.x = pk2(s1[8 * s], s1[8 * s + 1]); pw.y = pk2(s1[8 * s + 2], s1[8 * s + 3]); pw.z = pk2(s1[8 * s + 4], s1[8 * s + 5]); pw.w = pk2(s1[8 * s + 6], s1[8 * s + 7]); }
                        const bf16x8 pf = __builtin_bit_cast(bf16x8, pw);
#pragma unroll
                        for (int db = 0; db < 4; ++db) {
                            LAS unsigned char* vp = Bc + vbase + (kb * 32 + 16 * s) * VS_STRIDE + db * 64;
                            const s16x4 lo = __builtin_amdgcn_ds_read_tr16_b64_v4i16((LAS s16x4*)vp), hi = __builtin_amdgcn_ds_read_tr16_b64_v4i16((LAS s16x4*)(vp + 8 * VS_STRIDE));
                            const bf16x8 vf = __builtin_shufflevector(lo, hi, 0, 1, 2, 3, 4, 5, 6, 7);
                            o[db] = __builtin_amdgcn_mfma_f32_32x32x16_bf16(vf, pf, o[db], 0, 0, 0);
                        }
                    }
                if (more) {
                    *(LAS u32x4*)(Bn + sr0 * KS_STRIDE + sch * 16) = kr0; *(LAS u32x4*)(Bn + (sr0 + 32) * KS_STRIDE + sch * 16) = kr1;
                    *(LAS u32x4*)(Bn + ATT_V + sr0 * VS_STRIDE + sch * 16) = vr0; *(LAS u32x4*)(Bn + ATT_V + (sr0 + 32) * VS_STRIDE + sch * 16) = vr1; }
                __syncthreads();
            }
            const float ltot = lrun + __shfl_xor(lrun, 32), rl = 1.0f / ltot;
            const bf16* grow = proj + (size_t)qtok * NINP + C_G + head * 128; unsigned char* orow = mrg + (size_t)qtok * MIXW + head * 128;
#pragma unroll
            for (int db = 0; db < 4; ++db)
#pragma unroll
                for (int q4 = 0; q4 < 4; ++q4) { const int d0 = db * 32 + q4 * 8 + hf * 4; const u32x2 gv = *(const u32x2*)(grow + d0);
                    *(unsigned*)(orow + d0) = pk4_fp8(o[db][4 * q4] * rl * sigmoidf_(bflo(gv.x)), o[db][4 * q4 + 1] * rl * sigmoidf_(bfhi(gv.x)), o[db][4 * q4 + 2] * rl * sigmoidf_(bflo(gv.y)), o[db][4 * q4 + 3] * rl * sigmoidf_(bfhi(gv.y))); }
        }
    }
    __syncthreads();
}

template <int MODE, bool ROUTE, bool WRITE_BF, bool WRITE_F32, bool WRITE_F8 = false>
DI void p_layernorm(Frame& F, const Args& args, const float* src, const float* gam, const float* bet, float* outf, bf16* outb, unsigned char* outq = nullptr) {
    const int gw = F.bid * 8 + F.wave, NGW = F.G * 8, lane = F.lane;
    const unsigned* rt = (const unsigned*)(F.ws + WS_ROUTE); unsigned* rtw = (unsigned*)(F.ws + WS_ROUTE);
    LAS float* wr_l = (LAS float*)F.lds;
    LAS unsigned* cl = (LAS unsigned*)(F.lds + 65536);
    if (ROUTE) { for (int i = F.tid; i < DM * NEXP / 4; i += 512) *(LAS f32x4*)(wr_l + 4 * i) = *(const f32x4*)(INF(20) + 4 * i); if (F.tid < 8) cl[F.tid] = 0u; __syncthreads(); }
#define LN_COL(jj) (MODE == 1 ? (8 * lane + 512 * ((jj) >> 1) + 4 * ((jj) & 1)) : (4 * lane + 256 * (jj)))
    for (int row = gw; row < MTOK; row += NGW) {
        f32x4 v[8]; float s = 0.f;
        if (MODE == 0) {
#pragma unroll
            for (int j = 0; j < 8; ++j) v[j] = *(const f32x4*)(src + (size_t)row * DM + LN_COL(j));
        } else {
            const unsigned r0 = rt[RT_ROW + 2 * row], r1 = rt[RT_ROW + 2 * row + 1]; const float w0 = __uint_as_float(rt[RT_W + 2 * row]), w1 = __uint_as_float(rt[RT_W + 2 * row + 1]);
            const bf16* yb = (const bf16*)(F.ws + WS_YB);
            u32x4 pa[4][KSPLIT], pb[4][KSPLIT];
#pragma unroll
            for (int j = 0; j < 4; ++j)
#pragma unroll
                for (int ks = 0; ks < KSPLIT; ++ks) { pa[j][ks] = *(const u32x4*)(yb + ((size_t)ks * MOE_ROWS_MAX + r0) * DM + 8 * lane + 512 * j); pb[j][ks] = *(const u32x4*)(yb + ((size_t)ks * MOE_ROWS_MAX + r1) * DM + 8 * lane + 512 * j); }
#pragma unroll
            for (int j = 0; j < 4; ++j) { f32x4 a0 = {0.f, 0.f, 0.f, 0.f}, a1 = a0, b0 = a0, b1 = a0;
#pragma unroll
                for (int ks = 0; ks < KSPLIT; ++ks) { const u32x4 a = pa[j][ks], b = pb[j][ks];
                    a0 += (f32x4){bflo(a.x), bfhi(a.x), bflo(a.y), bfhi(a.y)}; a1 += (f32x4){bflo(a.z), bfhi(a.z), bflo(a.w), bfhi(a.w)};
                    b0 += (f32x4){bflo(b.x), bfhi(b.x), bflo(b.y), bfhi(b.y)}; b1 += (f32x4){bflo(b.z), bfhi(b.z), bflo(b.w), bfhi(b.w)}; }
                const u32x4 xr = *(const u32x4*)((const bf16*)src + (size_t)row * DM + 8 * lane + 512 * j);
                v[2 * j] = (f32x4){bflo(xr.x), bfhi(xr.x), bflo(xr.y), bfhi(xr.y)} * ALPHA + a0 * w0 + b0 * w1;
                v[2 * j + 1] = (f32x4){bflo(xr.z), bfhi(xr.z), bflo(xr.w), bfhi(xr.w)} * ALPHA + a1 * w0 + b1 * w1; }
        }
#pragma unroll
        for (int j = 0; j < 8; ++j) s += (v[j][0] + v[j][1]) + (v[j][2] + v[j][3]);
        const float mean = wave_sum(s) * (1.f / DM); float s2 = 0.f;
#pragma unroll
        for (int j = 0; j < 8; ++j) { v[j] = v[j] - mean; s2 += (v[j][0] * v[j][0] + v[j][1] * v[j][1]) + (v[j][2] * v[j][2] + v[j][3] * v[j][3]); }
        const float rstd = 1.0f / sqrtf(wave_sum(s2) * (1.f / DM) + LN_EPS);
        float lg[8];
#pragma unroll
        for (int e = 0; e < 8; ++e) lg[e] = 0.f;
#pragma unroll
        for (int j = 0; j < 8; ++j) { const int cc = LN_COL(j); const f32x4 gv = *(const f32x4*)(gam + cc), bv = *(const f32x4*)(bet + cc);
            const f32x4 y = v[j] * rstd * gv + bv; if (WRITE_F32) *(f32x4*)(outf + (size_t)row * DM + cc) = y;
            if (WRITE_BF) { u32x2 w; w.x = pk2(y[0], y[1]); w.y = pk2(y[2], y[3]); *(u32x2*)(outb + (size_t)row * DM + cc) = w; }
            if (WRITE_F8) *(unsigned*)(outq + (size_t)row * DM + cc) = pk4_fp8(y[0], y[1], y[2], y[3]);
            if (ROUTE) {
#pragma unroll
                for (int i = 0; i < 4; ++i) { const LAS float* wp = wr_l + (size_t)(cc + i) * 8; const f32x4 wa = *(const LAS f32x4*)wp, wb = *(const LAS f32x4*)(wp + 4); const float xv = y[i];
                    lg[0] += xv * wa[0]; lg[1] += xv * wa[1]; lg[2] += xv * wa[2]; lg[3] += xv * wa[3]; lg[4] += xv * wb[0]; lg[5] += xv * wb[1]; lg[6] += xv * wb[2]; lg[7] += xv * wb[3]; }
            }
            asm volatile("" ::: "memory"); }
        if (ROUTE) {
#pragma unroll
            for (int e = 0; e < 8; ++e) lg[e] = wave_sum(lg[e]);
            int e0 = 0; float l0 = lg[0];
#pragma unroll
            for (int e = 1; e < 8; ++e) if (lg[e] > l0) { l0 = lg[e]; e0 = e; }
            int e1 = 0; float l1 = -INFINITY;
#pragma unroll
            for (int e = 0; e < 8; ++e) if (e != e0 && lg[e] > l1) { l1 = lg[e]; e1 = e; }
            const float p1 = 1.0f / (1.0f + expf(l0 - l1)), p0 = 1.0f - p1;
            if (lane == 0) { const unsigned sl0 = __hip_atomic_fetch_add(cl + e0, 1u, __ATOMIC_RELAXED, __HIP_MEMORY_SCOPE_WORKGROUP), sl1 = __hip_atomic_fetch_add(cl + e1, 1u, __ATOMIC_RELAXED, __HIP_MEMORY_SCOPE_WORKGROUP);
                rtw[RT_E + 2 * row] = (unsigned)e0; rtw[RT_E + 2 * row + 1] = (unsigned)e1; rtw[RT_SLOT + 2 * row] = sl0; rtw[RT_SLOT + 2 * row + 1] = sl1;
                rtw[RT_W + 2 * row] = __float_as_uint(p0); rtw[RT_W + 2 * row + 1] = __float_as_uint(p1); }
        }
    }
#undef LN_COL
    if (ROUTE) { __syncthreads(); const int t2 = F.wave * 64 + lane_id_(); if (t2 < 8) rtw[RT_WGC + F.bid * 8 + t2] = cl[t2]; __syncthreads(); }
}

DI void p_moe_gather(Frame& F) {
    unsigned* rt = (unsigned*)(F.ws + WS_ROUTE);
    const bf16* x1b = (const bf16*)(F.ws + WS_X1B); bf16* am = (bf16*)(F.ws + WS_AMOE);
    LAS unsigned* pre = (LAS unsigned*)F.lds;
    LAS unsigned* tot = pre + 2048;
    const int lane = F.lane;
    __syncthreads();
    { const int e = F.wave; unsigned c[4]; unsigned s = 0u;
#pragma unroll
      for (int i = 0; i < 4; ++i) { const int b = 4 * lane + i; c[i] = b < F.G ? rt[RT_WGC + b * 8 + e] : 0u; s += c[i]; }
      unsigned inc = s;
#pragma unroll
      for (int o = 1; o < 64; o <<= 1) { const unsigned t = __shfl_up(inc, o); inc += (lane >= o) ? t : 0u; }
      unsigned ex = inc - s;
#pragma unroll
      for (int i = 0; i < 4; ++i) { pre[(4 * lane + i) * 8 + e] = ex; ex += c[i]; }
      if (lane == 63) tot[e] = inc; }
    __syncthreads();
    if (F.tid == 0) { unsigned t = 0u; for (int e = 0; e < 8; ++e) { tot[8 + e] = t; t += (tot[e] + 255u) >> 8; } }
    __syncthreads();
    if (F.bid == 0 && F.tid < 8) F.ctl[CW_CNT + F.tid] = tot[F.tid];
    const int gw = F.bid * 8 + F.wave, NGW = F.G * 8;
    for (int a = gw; a < MTOK * 2; a += NGW) {
        const int tok = a >> 1; const int e = (int)rt[RT_E + a], slot = (int)rt[RT_SLOT + a];
        const int bsrc = (tok % NGW) >> 3;
        const int row = (int)tot[8 + e] * 256 + (int)pre[bsrc * 8 + e] + slot;
        const u32x4* s = (const u32x4*)(x1b + (size_t)tok * DM) + 4 * lane; u32x4* d = (u32x4*)((unsigned char*)am + (size_t)row * DM) + 2 * lane;
        const u32x4 i0 = s[0], i1 = s[1], i2 = s[2], i3 = s[3];
        u32x4 o0, o1;
        o0.x = pk4_fp8(bflo(i0.x), bfhi(i0.x), bflo(i0.y), bfhi(i0.y)); o0.y = pk4_fp8(bflo(i0.z), bfhi(i0.z), bflo(i0.w), bfhi(i0.w)); o0.z = pk4_fp8(bflo(i1.x), bfhi(i1.x), bflo(i1.y), bfhi(i1.y)); o0.w = pk4_fp8(bflo(i1.z), bfhi(i1.z), bflo(i1.w), bfhi(i1.w));
        o1.x = pk4_fp8(bflo(i2.x), bfhi(i2.x), bflo(i2.y), bfhi(i2.y)); o1.y = pk4_fp8(bflo(i2.z), bfhi(i2.z), bflo(i2.w), bfhi(i2.w)); o1.z = pk4_fp8(bflo(i3.x), bfhi(i3.x), bflo(i3.y), bfhi(i3.y)); o1.w = pk4_fp8(bflo(i3.z), bfhi(i3.z), bflo(i3.w), bfhi(i3.w));
        d[0] = o0; d[1] = o1;
        if (lane == 0) rt[RT_ROW + a] = (unsigned)row;
    }
    for (int pr = gw; pr < 8 * 256; pr += NGW) { const int e = pr >> 8, i = pr & 255;
        const int row = (int)tot[8 + e] * 256 + (int)tot[e] + i, rend = ((int)tot[8 + e] + (((int)tot[e] + 255) >> 8)) * 256;
        if (row < rend) { u32x4* d = (u32x4*)((unsigned char*)am + (size_t)row * DM);
#pragma unroll
            for (int q = 0; q < 2; ++q) d[lane + 64 * q] = (u32x4){0u, 0u, 0u, 0u}; } }
    __syncthreads();
}

constexpr int NPH_LAYER = 12;
constexpr int NPHASES = 1 + 2 * NPH_LAYER;
#define IN(k) (lo <= (k) && (k) < hi)
#define RELAUNDER() do { int l_ = lane_id_(); asm volatile("" : "+v"(l_)); F.lane = l_; F.tid = F.wave * 64 + l_; } while (0)
#define STAMP(k) do { if (STAMP_PROBE && F.bid == 0 && xb_t0(F.wave)) ((volatile LAS unsigned*)(F.lds + LDSCTL_OFF + 512))[k] = (unsigned)__builtin_amdgcn_s_memrealtime(); } while (0)
#define SEAM(k) do { if (IN(k) && IN((k) + 1)) { xcd_barrier(bar); STAMP((k) + 1); } } while (0)
template <int LAYER>
DI void run_layer(Frame& F, const Args& args, const XcdBarrier& bar, const int lo, const int hi) {
    constexpr int P = 1 + NPH_LAYER * LAYER;
    bf16* proj = (bf16*)(F.ws + WS_PROJ); bf16* xb = (bf16*)(F.ws + WS_XB); unsigned char* mrg = F.ws + WS_MRG;
    float* x1 = (float*)(F.ws + WS_X1); bf16* x1b = (bf16*)(F.ws + WS_X1B); float* x2 = (float*)(F.ws + WS_X2); float* pre = (float*)(F.ws + WS_PRE);
    if (IN(P + 0)) {
        { pg8::Gemm g{(const bf16*)(F.ws + WS_X1), (const bf16*)(F.ws + WS_WIN + (size_t)LAYER * WIN_LAYER + WIN_F8), DM / 2, DM / 2, DM / 2};
          pg8::TileOrder S; S.init(MTOK / 256, NT8, F.G, F.bid, (size_t)256 * DM, (size_t)256 * DM);
          pg8::EpiBf16 E{proj, NINP, 0, 1.0f / F8_WSCALE, 12, 0, C_G};
          pg8::gemm_phase<pg8::EpiBf16, pg8::TileOrder, true>(F.lds, g, S, E, F.wave); }
        { pg8::Gemm g{xb, (const bf16*)(F.ws + WS_WIN + (size_t)LAYER * WIN_LAYER), DM, DM, DM};
          pg8::TileOrder S; S.init(MTOK / 256, NT16, F.G, F.bid, (size_t)256 * DM * 2, (size_t)256 * DM * 2);
          pg8::EpiBf16 E{proj, NINP, 0, 1.0f, 1 << 30, 3072, 0};
          pg8::gemm_phase(F.lds, g, S, E, F.wave); }
        RELAUNDER();
        if (LAYER == 0) { conv_range(F, args, CE_0, CE_0 + IP_A, 160); conv_range(F, args, CE_0 + IP_A, CE_2, 128); }
        else { conv_range(F, args, CE_5, CE_5 + IP_A, 160); conv_range(F, args, CE_5 + IP_A, CE_5 + MOE_EARLY, 128); }
    }
    SEAM(P + 0);
    if (IN(P + 1)) { RELAUNDER(); p2_prep(F, args, LAYER); }
    SEAM(P + 1);
    if (IN(P + 2)) {
        { pg8::Gemm g{(const bf16*)(F.ws + WS_DIFF), (const bf16*)(F.ws + WS_WPOOL) + (size_t)LAYER * 2048 * 512, DM, 512, 512};
          pg8::TileOrder S; S.init(MTOK / 256, 8, F.G, F.bid, (size_t)256 * DM * 2, (size_t)256 * 512 * 2, 2, (size_t)512 * 2);
          pg8::EpiPool E{mrg, proj, INF(5) + (size_t)LAYER * DM};
          pg8::gemm_phase(F.lds, g, S, E, F.wave); }
        if (LAYER == 0) STAMP(25);
        { pg8::Gemm g{(const bf16*)(F.ws + WS_XC), (const bf16*)(F.ws + WS_WLRU) + (size_t)LAYER * 4096 * 256, DM, 256, 256};
          pg8::TileOrder S; S.init(MTOK / 256, 16, F.G, F.bid, (size_t)256 * DM * 2, (size_t)256 * 256 * 2, 2, (size_t)256 * 2);
          pg8::EpiLru E{(unsigned*)(F.ws + WS_A), (const bf16*)(F.ws + WS_XC), INF(9) + (size_t)LAYER * DM, INF(11) + (size_t)LAYER * DM, (const float*)(F.ws + WS_LRUC) + (size_t)LAYER * DM};
          pg8::gemm_phase(F.lds, g, S, E, F.wave); }
        if (LAYER == 0) STAMP(26);
        RELAUNDER(); p3_indexer(F);
        if (LAYER == 0) STAMP(29);
        __syncthreads(); RELAUNDER(); if (LAYER == 0) conv_range(F, args, CE_3, CE_3 + P2_ITEMS, 32); else conv_range(F, args, CE_5 + MOE_EARLY, CE_5 + MOE_EARLY + P2_ITEMS, 32);
    }
    SEAM(P + 2);
    if (IN(P + 3)) { RELAUNDER(); p4_select(F); if (LAYER == 0) STAMP(27); RELAUNDER(); p4_lru_pass1(F); }
    SEAM(P + 3);
    if (IN(P + 4)) { RELAUNDER(); p5_attention(F); if (LAYER == 0) STAMP(28); RELAUNDER(); p5_lru_pass2(F); }
    SEAM(P + 4);
    if (IN(P + 5)) {
        pg8::Gemm g{(const bf16*)mrg, (const bf16*)(F.ws + WS_WOUT + (size_t)LAYER * DM * MIXW), MIXW / 2, MIXW / 2, MIXW / 2};
        pg8::TileOrder S; S.init(MTOK / 256, DM / 256, F.G, F.bid, (size_t)256 * MIXW, (size_t)256 * MIXW);
        pg8::EpiRes<LAYER == 1> E{pre, LAYER == 0 ? (const void*)INF(0) : (const void*)xb, DM, 1.0f / F8_WSCALE};
        pg8::gemm_phase<pg8::EpiRes<LAYER == 1>, pg8::TileOrder, true>(F.lds, g, S, E, F.wave);
    }
    SEAM(P + 5);
    if (IN(P + 6)) { RELAUNDER(); } if (IN(P + 6)) p_layernorm<0, LAYER == 1, true, false>(F, args, pre, INF(13) + LAYER * DM, INF(14) + LAYER * DM, nullptr, x1b);
    SEAM(P + 6);
    if constexpr (LAYER == 0) {
        if (IN(P + 7)) {
            pg8::Gemm g{x1b, (const bf16*)(F.ws + WS_WGU), DM, DM, DM};
            pg8::TileOrder S; S.init(MTOK / 256, 2 * DFF / 256, F.G, F.bid, (size_t)256 * DM * 2, (size_t)256 * DM * 2);
            pg8::EpiSwiglu E{(bf16*)(F.ws + WS_H), DFF};
            pg8::gemm_phase(F.lds, g, S, E, F.wave);
            RELAUNDER(); conv_range(F, args, CE_2, CE_3, 96); conv_range(F, args, CE_3 + P2_ITEMS, CE_5, 96);
        }
        SEAM(P + 7);
        if (IN(P + 8)) {
            pg8::Gemm g{(const bf16*)(F.ws + WS_H), (const bf16*)(F.ws + WS_WDN), DFF, DFF, DFF};
            pg8::TileOrder S; S.init(MTOK / 256, DM / 256, F.G, F.bid, (size_t)256 * DFF * 2, (size_t)256 * DFF * 2);
            pg8::EpiRes<true> E{pre, x1b, DM, 1.0f};
            pg8::gemm_phase(F.lds, g, S, E, F.wave);
        }
        SEAM(P + 8);
        if (IN(P + 9)) { RELAUNDER(); } if (IN(P + 9)) p_layernorm<0, false, true, false, true>(F, args, pre, INF(15), INF(16), nullptr, xb, F.ws + WS_X1);
        if (IN(P + 9) && IN(P + 12)) { xcd_barrier(bar); STAMP(P + 10); STAMP(P + 11); STAMP(P + 12); }
    } else {
        if (IN(P + 7)) { RELAUNDER(); conv_range(F, args, CE_5 + MOE_EARLY + P2_ITEMS, CE_7, 0); RELAUNDER(); p_moe_gather(F); }
        SEAM(P + 7);
        if (IN(P + 8)) {
            pg8::Gemm g{(const bf16*)(F.ws + WS_AMOE), (const bf16*)(F.ws + WS_MWGU), DM / 2, DM / 2, DM / 2};
            pg8::MoeOrder S; S.init(F.ctl + CW_CNT, 2 * DEXP / 256, 1, F.G, F.bid, (size_t)256 * DM, (size_t)2 * DEXP * DM, (size_t)256 * DM, 0);
            pg8::EpiSwigluF8 E{F.ws + WS_HMOE, DEXP, 1.0f / F8_WSCALE};
            pg8::gemm_phase<pg8::EpiSwigluF8, pg8::MoeOrder, true>(F.lds, g, S, E, F.wave);
        }
        SEAM(P + 8);
        if (IN(P + 9)) {
            pg8::Gemm g{(const bf16*)(F.ws + WS_HMOE), (const bf16*)(F.ws + WS_MWDN), DEXP / 2, DEXP / 2, DEXP / 2 / KSPLIT};
            pg8::MoeOrder S; S.init(F.ctl + CW_CNT, DM / 256, KSPLIT, F.G, F.bid, (size_t)256 * DEXP, (size_t)DM * DEXP, (size_t)256 * DEXP, (size_t)(DEXP / KSPLIT));
            pg8::EpiBf16 E{(bf16*)(F.ws + WS_YB), DM, (size_t)MOE_ROWS_MAX * DM, 1.0f / F8_WSCALE, 1 << 30, 0, 0};
            pg8::gemm_phase<pg8::EpiBf16, pg8::MoeOrder, true>(F.lds, g, S, E, F.wave);
        }
        SEAM(P + 9);
        if (IN(P + 10)) { RELAUNDER(); } if (IN(P + 10)) p_layernorm<1, false, false, true>(F, args, (const float*)x1b, INF(15) + DM, INF(16) + DM, args.out, nullptr);
    }
}
__global__ void __launch_bounds__(512, 2) fwd_kernel(Args args) {
    extern __shared__ __attribute__((aligned(16))) unsigned char lds_raw[];
    Frame F;
    F.lds = (LAS unsigned char*)lds_raw; F.ws = args.ws; F.ctl = (unsigned*)(args.ws + WS_CTL);
    F.wave = __builtin_amdgcn_readfirstlane((int)threadIdx.x >> 6); F.lane = lane_id_(); F.tid = F.wave * 64 + F.lane; F.G = gridDim.x; F.bid = blockIdx.x;
    volatile LAS unsigned* MISC = (volatile LAS unsigned*)(F.lds + LDSCTL_OFF);
    for (int u = F.tid; u < (LDS_BYTES - LDSCTL_OFF) / 4; u += 512) ((LAS unsigned*)(F.lds + LDSCTL_OFF))[u] = 0u;
    __syncthreads();
    const int lo = args.ph_lo, hi = args.ph_hi;
    XcdBarrier bar; bar.bar = F.ctl + CW_BAR; bar.x = 0; bar.st = nullptr; bar.wave = F.wave;
    if ((hi - lo) > 1) bar = xcd_barrier_post(F.ctl + CW_BAR, MISC + 8, F.wave);
    STAMP(0);
    if (IN(0)) { RELAUNDER(); p0_prologue(F, args); __syncthreads(); }
    SEAM(0);
    run_layer<0>(F, args, bar, lo, hi);
    run_layer<1>(F, args, bar, lo, hi);
#if STAMP_PROBE
    RELAUNDER();
    if (F.bid == 0) {
        asm volatile("s_waitcnt vmcnt(0)" ::: "memory"); __syncthreads();
        if (xb_t0(F.wave)) ((volatile LAS unsigned*)(F.lds + LDSCTL_OFF + 512))[NPHASES - 1] = (unsigned)__builtin_amdgcn_s_memrealtime();
        __syncthreads();
        volatile LAS unsigned* st = (volatile LAS unsigned*)(F.lds + LDSCTL_OFF + 512);
        const float ta = (float)(st[STAMP_A_HI] - st[STAMP_A_LO]) * 0.01f, tb = (float)(st[STAMP_B_HI] - st[STAMP_B_LO]) * 0.01f;
        const float da = __builtin_amdgcn_sqrtf(ta * 0.005f);
        for (int i = F.tid; i < DM; i += 512) args.out[i] += da;
        if (F.tid == 0) args.out[DM] += tb * 0.1f;
    }
#endif
}
#undef IN
#undef SEAM

extern "C" void kernel_launch(void* const* d_in, const int* in_sizes, int n_in, void* d_out, int out_size, void* d_ws, size_t ws_size, hipStream_t stream) {
    static int grid = 0;
    if (grid == 0) {
        if (n_in != 24 || out_size != MTOK * DM || ws_size < WS_END) { fprintf(stderr, "kernel_launch: unexpected problem (n_in %d, out %d, ws %zu, need %zu)\n", n_in, out_size, ws_size, (size_t)WS_END); grid = -1; return; }
        int dev = 0, cus = 0, per_cu = 0;
        if (hipGetDevice(&dev) != hipSuccess || hipDeviceGetAttribute(&cus, hipDeviceAttributeMultiprocessorCount, dev) != hipSuccess) { grid = -1; return; }
        if (hipFuncSetAttribute((const void*)fwd_kernel, hipFuncAttributeMaxDynamicSharedMemorySize, LDS_BYTES) != hipSuccess) { fprintf(stderr, "kernel_launch: hipFuncSetAttribute failed\n"); grid = -1; return; }
        if (hipOccupancyMaxActiveBlocksPerMultiprocessor(&per_cu, (const void*)fwd_kernel, 512, LDS_BYTES) != hipSuccess || per_cu < 1) fprintf(stderr, "kernel_launch: occupancy query reports %d\n", per_cu);
        (void)hipGetLastError();
        grid = cus;
    }
    if (grid < 0) return;
    (void)hipMemsetAsync((char*)d_ws + WS_CTL, 0, CTL_ZERO_BYTES, stream);
    Args a{};
    for (int i = 0; i < 24; ++i) a.in[i] = d_in[i];
    a.out = (float*)d_out; a.ws = (unsigned char*)d_ws;
#if MK_N_LAUNCHES == 1
    a.ph_lo = 0; a.ph_hi = NPHASES;
    hipLaunchKernelGGL(fwd_kernel, dim3(grid), dim3(512), LDS_BYTES, stream, a);
#else
    const int plist[] = {0, 1, 2, 3, 4, 5, 6, 7, 8, 9, 10, 13, 14, 15, 16, 17, 18, 19, 20, 21, 22, 23};
    for (int i = 0; i < (int)(sizeof(plist) / sizeof(int)); ++i) { a.ph_lo = plist[i]; a.ph_hi = plist[i] + 1; hipLaunchKernelGGL(fwd_kernel, dim3(grid), dim3(512), LDS_BYTES, stream, a); }
#endif
}
```

```cpp
#include <hip/hip_runtime.h>
#include <cstdio>
#include <cstdint>

#ifndef MK_N_LAUNCHES
#define MK_N_LAUNCHES 1
#endif

#ifndef STAMP_PROBE
#define STAMP_PROBE 0
#endif
#ifndef STAMP_A_LO
#define STAMP_A_LO 0
#define STAMP_A_HI 1
#define STAMP_B_LO 1
#define STAMP_B_HI 2
#endif
#define DI __device__ __forceinline__
#define LAS __attribute__((address_space(3)))
#define GAS __attribute__((address_space(1)))
typedef unsigned short bf16;
typedef short bf16x8 __attribute__((ext_vector_type(8)));
typedef float f32x2 __attribute__((ext_vector_type(2)));
typedef float f32x4 __attribute__((ext_vector_type(4)));
typedef float f32x16 __attribute__((ext_vector_type(16)));
typedef unsigned u32x2 __attribute__((ext_vector_type(2)));
typedef unsigned u32x4 __attribute__((ext_vector_type(4)));
typedef __bf16 bf16x2_t __attribute__((ext_vector_type(2)));
typedef int i32x8 __attribute__((ext_vector_type(8)));
typedef int i32x4 __attribute__((ext_vector_type(4)));

#define LDS_WAIT() asm volatile("s_waitcnt lgkmcnt(0)" ::: "memory")
#define VM_WAIT() asm volatile("s_waitcnt vmcnt(0)" ::: "memory")

DI unsigned pk2(float lo, float hi) { f32x2 v = {lo, hi}; return __builtin_bit_cast(unsigned, __builtin_convertvector(v, bf16x2_t)); }
DI unsigned pk4_fp8(float a, float b, float c, float d) { int w = 0; w = __builtin_amdgcn_cvt_pk_fp8_f32(a, b, w, false); w = __builtin_amdgcn_cvt_pk_fp8_f32(c, d, w, true); return (unsigned)w; }
DI float bflo(unsigned w) { return __uint_as_float(w << 16); }
DI float bfhi(unsigned w) { return __uint_as_float(w & 0xffff0000u); }
DI float bf2f(bf16 b) { return __uint_as_float(((unsigned)b) << 16); }
DI float rcp_(float x) { return __builtin_amdgcn_rcpf(x); }
DI float sigmoidf_(float x) { return rcp_(1.0f + __expf(-x)); }
DI float siluf_(float x) { return x * rcp_(1.0f + __expf(-x)); }
DI float gelu_tanh_(float x) { const float u = 0.7978845608028654f * (x + 0.044715f * x * x * x); const float t = 1.0f - 2.0f * rcp_(1.0f + __expf(2.0f * u)); return 0.5f * x * (1.0f + t); }
DI float one_minus_exp_(float x) {
    const float p = -x * (1.0f + x * 0.5f * (1.0f + x * (1.0f / 3.0f) * (1.0f + x * 0.25f * (1.0f + x * 0.2f * (1.0f + x * (1.0f / 6.0f) * (1.0f + x * (1.0f / 7.0f)))))));
    const float e = 1.0f - __expf(x);
    return x > -0.5f ? p : e;
}
DI int lane_id_() { int l; asm volatile("v_mbcnt_lo_u32_b32 %0, -1, 0\n\tv_mbcnt_hi_u32_b32 %0, -1, %0" : "=v"(l)); return l; }

constexpr int DM = 2048, BATCH = 4, SEQ = 2048, MTOK = BATCH * SEQ;
constexpr int NIN = 16464, NINP = 16640;
constexpr int C_Q = 0, C_K = 2048, C_V = 2560, C_QI = 3072, C_KI = 4096, C_WI = 4160, C_PADLO = 4176, C_P = 4352, C_XR = 6400, C_GR = 8448, C_G = 10496;
constexpr int MIXW = 6144, DFF = 5504, NEXP = 8, DEXP = 7168;
constexpr int MOE_ROWS_MAX = (MTOK * 2 / 256 + NEXP) * 256;
constexpr float ALPHA = 1.4142135623730951f, LN_EPS = 1e-5f;
constexpr int DFFP = 5632;
constexpr int NT8 = 60, NT16 = 5;
constexpr int KSPLIT = 2;

constexpr size_t MiB = 1u << 20;
constexpr size_t WS_CTL = 0, CTL_ZERO_BYTES = 1 * MiB;
constexpr size_t WS_COSA = 1 * MiB, WS_SINA = 3 * MiB, WS_COSI = 5 * MiB, WS_SINI = 6 * MiB;
constexpr size_t WS_ROUTE = 9 * MiB;
constexpr size_t WS_MASK = 10 * MiB;
constexpr size_t WS_LRUC = 9 * MiB + 512 * 1024;
constexpr size_t WS_WIN = 12 * MiB;
constexpr size_t WIN_LAYER = 65 * MiB, WIN_F8 = 32 * MiB;
constexpr size_t WS_WOUT = 142 * MiB;
constexpr size_t WS_WPOOL = 190 * MiB;
constexpr size_t WS_WLRU = 194 * MiB;
constexpr size_t WS_WGU = 198 * MiB;
constexpr size_t WS_WDN = 241 * MiB;
constexpr size_t WS_XB = 263 * MiB;
constexpr size_t WS_X1 = 295 * MiB;
constexpr size_t WS_X1B = 359 * MiB;
constexpr size_t WS_X2 = 391 * MiB;
constexpr size_t WS_PRE = 455 * MiB;
constexpr size_t WS_MWGU = 519 * MiB;
constexpr size_t WS_MWDN = 967 * MiB;
constexpr size_t WS_OV = 1191 * MiB;
constexpr size_t WS_PROJ = WS_OV;
constexpr size_t WS_DIFF = WS_OV + 260 * MiB;
constexpr size_t WS_XC = WS_OV + 292 * MiB;
constexpr size_t WS_A = WS_OV + 324 * MiB;
constexpr size_t WS_CARRY = WS_OV + 388 * MiB;
constexpr size_t WS_SC = WS_OV + 452 * MiB;
constexpr size_t WS_MRG = WS_OV + 516 * MiB;
constexpr size_t WS_H = WS_OV;
constexpr size_t WS_AMOE = WS_OV;
constexpr size_t WS_HMOE = WS_OV + 72 * MiB;
constexpr size_t WS_YB = WS_OV + 324 * MiB;
constexpr size_t WS_END = WS_OV + 612 * MiB;
constexpr int CW_BAR = 4096, CW_CNT = 16384;
constexpr int RT_E = 0, RT_SLOT = 2 * MTOK, RT_W = 4 * MTOK, RT_ROW = 6 * MTOK, RT_WGC = 8 * MTOK;

constexpr int RING_BYTES = 131072, LDSCTL_OFF = RING_BYTES, LDS_BYTES = 147456;

#define XB_TMO      128
#define XB_XCNT(j)  (256  + 64 * (j))
#define XB_XSUB(j)  (1280 + 64 * (j))
#define XB_XGEN(j)  (2304 + 64 * (j))
#define XB_TOP      3328
#define XB_TOPGEN   3392
#define XCD_BAR_WORDS 3456
#define XB_SPIN_CAP (1u << 18)
DI unsigned xb_ld(unsigned* p)              { return __hip_atomic_load(p, __ATOMIC_RELAXED, __HIP_MEMORY_SCOPE_AGENT); }
DI unsigned xb_add(unsigned* p, unsigned v) { return __hip_atomic_fetch_add(p, v, __ATOMIC_RELAXED, __HIP_MEMORY_SCOPE_AGENT); }
DI unsigned xb_xcc_id() { return (unsigned)__builtin_amdgcn_s_getreg((3 << 11) | 20) & 0xFu; }
#define XB_SPIN(cond, bar) do { unsigned _sp = 0; while (cond) { __builtin_amdgcn_s_sleep(1); \
    if ((++_sp & 255u) == 0u) { if (xb_ld(&(bar)[XB_TMO])) break; if (_sp > XB_SPIN_CAP) { atomicAdd(&(bar)[XB_TMO], 1u); break; } } } } while (0)
struct XcdBarrier { unsigned* bar; unsigned x; volatile LAS unsigned* st; int wave; };
DI bool xb_t0(int wave) { return wave == 0 && lane_id_() == 0; }
DI XcdBarrier xcd_barrier_post(unsigned* bar, volatile LAS unsigned* st, int wave) {
    XcdBarrier b; b.bar = bar; b.x = xb_xcc_id(); b.st = st; b.wave = wave;
    if (xb_t0(wave)) (void)xb_add(&bar[XB_XCNT(b.x)], 1u);
    return b;
}
DI void xcd_barrier_complete(unsigned* bar, unsigned x, unsigned& nloc, unsigned& nx) {
    const unsigned G = gridDim.x * gridDim.y * gridDim.z;
    unsigned sum, cnt, mine, sp = 0u;
    for (;;) {
        sum = 0u; cnt = 0u; mine = 0u;
#pragma unroll
        for (unsigned j = 0; j < 16; ++j) { const unsigned c = xb_ld(&bar[XB_XCNT(j)]); sum += c; cnt += (c > 0u) ? 1u : 0u; mine = (j == x) ? c : mine; }
        if (sum == G) break;
        __builtin_amdgcn_s_sleep(1);
        if ((++sp & 255u) == 0u) { if (xb_ld(&bar[XB_TMO])) break; if (sp > XB_SPIN_CAP) { atomicAdd(&bar[XB_TMO], 1u); break; } }
    }
    nloc = mine > 0u ? mine : 1u; nx = cnt > 0u ? cnt : 1u;
}
DI void xcd_barrier(const XcdBarrier& b) {
    asm volatile("s_waitcnt vmcnt(0)" ::: "memory");
    __syncthreads();
    if (xb_t0(b.wave)) {
        unsigned* bar = b.bar;
        __builtin_amdgcn_s_waitcnt(0);
        unsigned nloc = b.st[0], nx = b.st[1];
        if (nloc == 0u) { xcd_barrier_complete(bar, b.x, nloc, nx); b.st[0] = nloc; b.st[1] = nx; }
        const unsigned old = xb_add(&bar[XB_XSUB(b.x)], 1u);
        const unsigned gen = old / nloc;
        if (old + 1u == (gen + 1u) * nloc) {
            __builtin_amdgcn_fence(__ATOMIC_RELEASE, "agent");
            asm volatile("s_waitcnt vmcnt(0)" ::: "memory");
            const unsigned og = xb_add(&bar[XB_TOP], 1u);
            const unsigned tg = og / nx;
            if (og + 1u == (tg + 1u) * nx) xb_add(&bar[XB_TOPGEN], 1u);
            else XB_SPIN(xb_ld(&bar[XB_TOPGEN]) == tg, bar);
            __builtin_amdgcn_fence(__ATOMIC_ACQUIRE, "agent");
            xb_add(&bar[XB_XGEN(b.x)], 1u);
            asm volatile("s_waitcnt vmcnt(0)" ::: "memory");
        } else {
            XB_SPIN(xb_ld(&bar[XB_XGEN(b.x)]) == gen, bar);
            __builtin_amdgcn_fence(__ATOMIC_ACQUIRE, "agent");
            asm volatile("s_waitcnt vmcnt(0)" ::: "memory");
        }
    }
    __syncthreads();
}

namespace pg8 {
constexpr int BM = 256, BK = 64, HALF = 128, HTB = HALF * BK * 2, STAGE_BYTES = 8 * HTB, NXCD = 8, WGM = 8;
DI int lds_byte(int r, int c) { const int st = (r >> 4) * 2 + (c >> 5), rr = r & 15, cc = c & 31, ob = rr * 64 + cc * 2; return st * 1024 + (ob ^ (((ob >> 9) & 1) << 5)); }
DI void stage_rc(int b, int& R, int& C) { const int st = b / 1024, sb = b % 1024, swz = sb ^ (((sb >> 9) & 1) << 5); R = (st >> 1) * 16 + swz / 64; C = (st & 1) * 32 + (swz % 64) / 2; }
DI int perm32(int rho) { const int n = rho >> 4, i = rho & 15; return 8 * (i >> 2) + 4 * n + (i & 3); }

struct Unit { int pm, pn, e, ks; };
struct Gemm { const bf16* A; const bf16* Bt; int lda, ldb, K; };

struct TileOrder {
    int nM, nN, nwg, G, c, a_div; size_t a_pm, a_pn, b_pn;
    DI void init(int nM_, int nN_, int G_, int c_, size_t a_pm_, size_t b_pn_, int a_div_ = 1, size_t a_pn_ = 0) { nM = nM_; nN = nN_; nwg = nM * nN; G = G_; c = c_; a_pm = a_pm_; b_pn = b_pn_; a_div = a_div_; a_pn = a_pn_; }
    DI bool next(int i, Unit& u) const {
        const long L = (long)i * G + c; if (L >= nwg) return false;
        int wgid = (int)L; { const int q = nwg / NXCD, r = nwg % NXCD, xcd = wgid % NXCD, off = wgid / NXCD; wgid = (xcd < r ? xcd * (q + 1) : r * (q + 1) + (xcd - r) * q) + off; }
        const int nig = WGM * nN, gid = wgid / nig, fm = gid * WGM, gsz = (nM - fm) < WGM ? (nM - fm) : WGM;
        u.pm = fm + ((wgid % nig) % gsz); u.pn = (wgid % nig) / gsz; u.e = 0; u.ks = 0; return true;
    }
    DI size_t aoff(const Unit& u) const { return (size_t)u.pm * a_pm + (size_t)(u.pn / a_div) * a_pn; }
    DI size_t boff(const Unit& u) const { return (size_t)u.pn * b_pn; }
};
struct MoeOrder {
    int nN, nNk, nwg, G, c; int t1, t2, t3, t4, t5, t6, t7, t8; size_t a_pm, b_e, b_pn, ks_step;
    DI void init(const unsigned* cnt, int nN_, int ksplit, int G_, int c_, size_t a_pm_, size_t b_e_, size_t b_pn_, size_t ks_step_) {
        nN = nN_; nNk = nN_ * ksplit; G = G_; c = c_; a_pm = a_pm_; b_e = b_e_; b_pn = b_pn_; ks_step = ks_step_;
        int s = 0; s += ((int)cnt[0] + 255) >> 8; t1 = s; s += ((int)cnt[1] + 255) >> 8; t2 = s; s += ((int)cnt[2] + 255) >> 8; t3 = s; s += ((int)cnt[3] + 255) >> 8; t4 = s;
        s += ((int)cnt[4] + 255) >> 8; t5 = s; s += ((int)cnt[5] + 255) >> 8; t6 = s; s += ((int)cnt[6] + 255) >> 8; t7 = s; s += ((int)cnt[7] + 255) >> 8; t8 = s;
        nwg = t8 * nNk;
    }
    DI bool next(int i, Unit& u) const {
        const long L = (long)i * G + c; if (L >= nwg) return false;
        int wgid = (int)L; { const int q = nwg / NXCD, r = nwg % NXCD, xcd = wgid % NXCD, off = wgid / NXCD; wgid = (xcd < r ? xcd * (q + 1) : r * (q + 1) + (xcd - r) * q) + off; }
        int e = 0, ts = 0, nt = t1;
        if (wgid >= t1 * nNk) { e = 1; ts = t1; nt = t2 - t1; }
        if (wgid >= t2 * nNk) { e = 2; ts = t2; nt = t3 - t2; }
        if (wgid >= t3 * nNk) { e = 3; ts = t3; nt = t4 - t3; }
        if (wgid >= t4 * nNk) { e = 4; ts = t4; nt = t5 - t4; }
        if (wgid >= t5 * nNk) { e = 5; ts = t5; nt = t6 - t5; }
        if (wgid >= t6 * nNk) { e = 6; ts = t6; nt = t7 - t6; }
        if (wgid >= t7 * nNk) { e = 7; ts = t7; nt = t8 - t7; }
        const int loc = wgid - ts * nNk; nt = nt > 0 ? nt : 1;
        const int pn2 = loc / nt;
        u.pm = ts + loc % nt; u.pn = pn2 % nN; u.ks = pn2 / nN; u.e = e; return true;
    }
    DI size_t aoff(const Unit& u) const { return (size_t)u.pm * a_pm + (size_t)u.ks * ks_step; }
    DI size_t boff(const Unit& u) const { return (size_t)u.e * b_e + (size_t)u.pn * b_pn + (size_t)u.ks * ks_step; }
};

struct EpiBf16 {
    static constexpr bool PERM = true;
    bf16* O; int ldc; size_t ks_stride; float scale; int split_pn, colA, colB;
    DI void operator()(const f32x4 (&acc)[2][2][4][2], const Unit& u, int wr, int wc, int fr, int fq) const {
        const int row0 = u.pm * BM + wr * 64 + fr, col0 = (u.pn < split_pn ? colA + u.pn * BM : colB + (u.pn - split_pn) * BM) + wc * 32 + 8 * fq;
#pragma unroll
        for (int ai = 0; ai < 2; ++ai)
#pragma unroll
            for (int m = 0; m < 4; ++m) { bf16* rowp = O + (size_t)u.ks * ks_stride + (size_t)(row0 + ai * HALF + m * 16) * ldc + col0;
#pragma unroll
                for (int bj = 0; bj < 2; ++bj) { const f32x4 v0 = acc[ai][bj][m][0] * scale, v1 = acc[ai][bj][m][1] * scale;
                    u32x4 w; w.x = pk2(v0[0], v0[1]); w.y = pk2(v0[2], v0[3]); w.z = pk2(v1[0], v1[1]); w.w = pk2(v1[2], v1[3]);
                    *(u32x4*)(rowp + bj * HALF) = w; } }
    }
};
struct EpiF32 {
    static constexpr bool PERM = false;
    float* C; int ldc;
    DI void operator()(const f32x4 (&acc)[2][2][4][2], const Unit& u, int wr, int wc, int fr, int fq) const {
        const int row0 = u.pm * BM + wr * 64 + fr, col0 = u.pn * BM + wc * 32 + 4 * fq;
#pragma unroll
        for (int ai = 0; ai < 2; ++ai)
#pragma unroll
            for (int m = 0; m < 4; ++m) { float* rowp = C + (size_t)(row0 + ai * HALF + m * 16) * ldc + col0;
#pragma unroll
                for (int bj = 0; bj < 2; ++bj)
#pragma unroll
                    for (int n = 0; n < 2; ++n) *(f32x4*)(rowp + bj * HALF + n * 16) = acc[ai][bj][m][n]; }
    }
};
template <bool RES_BF16>
struct EpiRes {
    static constexpr bool PERM = false;
    float* C; const void* res; int ldc; float scale;
    DI void operator()(const f32x4 (&acc)[2][2][4][2], const Unit& u, int wr, int wc, int fr, int fq) const {
        const int row0 = u.pm * BM + wr * 64 + fr, col0 = u.pn * BM + wc * 32 + 4 * fq;
#pragma unroll
        for (int ai = 0; ai < 2; ++ai)
#pragma unroll
            for (int m = 0; m < 4; ++m) { const size_t off = (size_t)(row0 + ai * HALF + m * 16) * ldc + col0;
#pragma unroll
                for (int bj = 0; bj < 2; ++bj)
#pragma unroll
                    for (int n = 0; n < 2; ++n) { f32x4 rv;
                        if (RES_BF16) { const u32x2 w = *(const u32x2*)((const bf16*)res + off + bj * HALF + n * 16); rv = (f32x4){bflo(w.x), bfhi(w.x), bflo(w.y), bfhi(w.y)}; }
                        else rv = *(const f32x4*)((const float*)res + off + bj * HALF + n * 16);
                        *(f32x4*)(C + off + bj * HALF + n * 16) = acc[ai][bj][m][n] * scale + rv * ALPHA; }
                asm volatile("" ::: "memory"); }
    }
};
struct EpiSwiglu {
    static constexpr bool PERM = true;
    bf16* H; int ldc;
    DI void operator()(const f32x4 (&acc)[2][2][4][2], const Unit& u, int wr, int wc, int fr, int fq) const {
        const int row0 = u.pm * BM + wr * 64 + fr, col0 = u.pn * HALF + wc * 32 + 8 * fq;
#pragma unroll
        for (int ai = 0; ai < 2; ++ai)
#pragma unroll
            for (int m = 0; m < 4; ++m) { bf16* rowp = H + (size_t)(row0 + ai * HALF + m * 16) * ldc + col0;
                const f32x4 g0 = acc[ai][0][m][0], g1 = acc[ai][0][m][1], u0 = acc[ai][1][m][0], u1 = acc[ai][1][m][1];
                u32x4 w; w.x = pk2(siluf_(g0[0]) * u0[0], siluf_(g0[1]) * u0[1]); w.y = pk2(siluf_(g0[2]) * u0[2], siluf_(g0[3]) * u0[3]);
                w.z = pk2(siluf_(g1[0]) * u1[0], siluf_(g1[1]) * u1[1]); w.w = pk2(siluf_(g1[2]) * u1[2], siluf_(g1[3]) * u1[3]);
                *(u32x4*)rowp = w; asm volatile("" ::: "memory"); }
    }
};
struct EpiSwigluF8 {
    static constexpr bool PERM = true;
    unsigned char* H; int ldc; float scale;
    DI void operator()(const f32x4 (&acc)[2][2][4][2], const Unit& u, int wr, int wc, int fr, int fq) const {
        const int row0 = u.pm * BM + wr * 64 + fr, col0 = u.pn * HALF + wc * 32 + 8 * fq;
#pragma unroll
        for (int ai = 0; ai < 2; ++ai)
#pragma unroll
            for (int m = 0; m < 4; ++m) { unsigned char* rowp = H + (size_t)(row0 + ai * HALF + m * 16) * ldc + col0;
                const f32x4 g0 = acc[ai][0][m][0] * scale, g1 = acc[ai][0][m][1] * scale, u0 = acc[ai][1][m][0] * scale, u1 = acc[ai][1][m][1] * scale;
                u32x2 w; w.x = pk4_fp8(siluf_(g0[0]) * u0[0], siluf_(g0[1]) * u0[1], siluf_(g0[2]) * u0[2], siluf_(g0[3]) * u0[3]);
                w.y = pk4_fp8(siluf_(g1[0]) * u1[0], siluf_(g1[1]) * u1[1], siluf_(g1[2]) * u1[2], siluf_(g1[3]) * u1[3]);
                *(u32x2*)rowp = w; asm volatile("" ::: "memory"); }
    }
};
struct EpiPool {
    static constexpr bool PERM = true;
    unsigned char* mrg; const bf16* proj; const float* scale;
    DI void operator()(const f32x4 (&acc)[2][2][4][2], const Unit& u, int wr, int wc, int fr, int fq) const {
        const int row0 = u.pm * BM + wr * 64 + fr, col0 = u.pn * BM + wc * 32 + 8 * fq;
#pragma unroll
        for (int bj = 0; bj < 2; ++bj) { const int c = col0 + bj * HALF; const f32x4 s0 = *(const f32x4*)(scale + c), s1 = *(const f32x4*)(scale + c + 4);
#pragma unroll
            for (int ai = 0; ai < 2; ++ai)
#pragma unroll
                for (int m = 0; m < 4; ++m) { const size_t row = (size_t)(row0 + ai * HALF + m * 16);
                    const u32x4 gv = *(const u32x4*)(proj + row * NINP + C_G + 2048 + c);
                    const f32x4 v0 = acc[ai][bj][m][0] * s0, v1 = acc[ai][bj][m][1] * s1;
                    u32x2 w; w.x = pk4_fp8(v0[0] * sigmoidf_(bflo(gv.x)), v0[1] * sigmoidf_(bfhi(gv.x)), v0[2] * sigmoidf_(bflo(gv.y)), v0[3] * sigmoidf_(bfhi(gv.y)));
                    w.y = pk4_fp8(v1[0] * sigmoidf_(bflo(gv.z)), v1[1] * sigmoidf_(bfhi(gv.z)), v1[2] * sigmoidf_(bflo(gv.w)), v1[3] * sigmoidf_(bfhi(gv.w)));
                    *(u32x2*)(mrg + row * MIXW + 2048 + c) = w; asm volatile("" ::: "memory"); } }
    }
};
struct EpiLru {
    static constexpr bool PERM = false;
    unsigned* AB; const bf16* xc; const float* ba; const float* bx; const float* c8sp;
    DI void operator()(const f32x4 (&acc)[2][2][4][2], const Unit& u, int wr, int wc, int fr, int fq) const {
        const int row0 = u.pm * BM + wr * 64 + fr, ch0 = u.pn * HALF + wc * 32 + 4 * fq;
#pragma unroll
        for (int n = 0; n < 2; ++n) { const int ch = ch0 + n * 16; const f32x4 vba = *(const f32x4*)(ba + ch), vbx = *(const f32x4*)(bx + ch), vsp = *(const f32x4*)(c8sp + ch);
#pragma unroll
            for (int ai = 0; ai < 2; ++ai)
#pragma unroll
                for (int m = 0; m < 4; ++m) { const size_t off = (size_t)(row0 + ai * HALF + m * 16) * DM + ch;
                    const u32x2 xv = *(const u32x2*)(xc + off); const float xf[4] = {bflo(xv.x), bfhi(xv.x), bflo(xv.y), bfhi(xv.y)};
                    u32x4 w;
#pragma unroll
                    for (int j = 0; j < 4; ++j) { const float r = sigmoidf_(acc[ai][0][m][n][j] + vba[j]), ig = sigmoidf_(acc[ai][1][m][n][j] + vbx[j]);
                        const float la = -vsp[j] * r; w[j] = pk2(la, __builtin_amdgcn_sqrtf(fmaxf(1.0f - __expf(2.0f * la), 0.f)) * ig * xf[j]); }
                    *(u32x4*)(AB + off) = w; asm volatile("" ::: "memory"); } }
    }
};

#ifndef PG8_ALIGN
#define PG8_ALIGN true
#endif
#ifndef PG8_SP2
#define PG8_SP2 true
#endif
template <class Epi, class Sched, bool F8 = false, bool ALIGN_EPI = PG8_ALIGN, bool SP2 = PG8_SP2>
DI void gemm_phase(LAS unsigned char* lds, const Gemm g, const Sched& S, const Epi& E, const int wave_id) {
    int lane_ = lane_id_(); asm volatile("" : "+v"(lane_));
    const int wid = wave_id, lane = lane_, tid = wid * 64 + lane, wr = wid >> 2, wc = wid & 3, fr = lane & 15, fq = lane >> 4;
    const int nt = g.K / BK;
    unsigned voffA[2], voffB[2];
#pragma unroll
    for (int i = 0; i < 2; ++i) { int R, C; stage_rc(tid * 16 + i * 8192, R, C); const int Rb = Epi::PERM ? ((R & ~31) + perm32(R & 31)) : R;
        voffA[i] = (unsigned)(R * g.lda + C) * 2u; voffB[i] = (unsigned)(Rb * g.ldb + C) * 2u; }
    const size_t kstep = (size_t)(BK * 2);
    const size_t hstepA = (size_t)HALF * g.lda * 2, hstepB = (size_t)HALF * g.ldb * 2;
    const unsigned ldsw = (unsigned)wid * 1024u;
    const int aoff = lds_byte(wr * 64 + fr, fq * 8), boff = lds_byte(wc * 32 + fr, fq * 8);
#define PG8_SA(b, h) (((b) * 2 + (h)) * HTB)
#define PG8_SB(b, h) ((4 + (b) * 2 + (h)) * HTB)
#define PG8_STAGE(bufoff, gbase, voff) do { _Pragma("unroll") for (int _i = 0; _i < 2; ++_i) \
        __builtin_amdgcn_global_load_lds((const unsigned*)((const char*)(gbase) + (voff)[_i]), (LAS unsigned*)(lds + (bufoff) + ldsw + _i * 8192), 16, 0, 0); } while (0)
#define PG8_LDA(dst, b, h) do { _Pragma("unroll") for (int m = 0; m < 4; ++m) _Pragma("unroll") for (int k = 0; k < 2; ++k) dst[m][k] = *(const LAS bf16x8*)(lds + PG8_SA(b, h) + aoff + m * 2048 + k * 1024); } while (0)
#define PG8_LDB(dst, b, h) do { _Pragma("unroll") for (int n = 0; n < 2; ++n) _Pragma("unroll") for (int k = 0; k < 2; ++k) dst[n][k] = *(const LAS bf16x8*)(lds + PG8_SB(b, h) + boff + n * 2048 + k * 1024); } while (0)
#define PG8_F8CAT(x) __builtin_shufflevector(__builtin_bit_cast(i32x4, (x)[0]), __builtin_bit_cast(i32x4, (x)[1]), 0, 1, 2, 3, 4, 5, 6, 7)
#define PG8_MMA(ai, bj, At, Bt) do { __builtin_amdgcn_s_setprio(1); _Pragma("unroll") for (int m = 0; m < 4; ++m) _Pragma("unroll") for (int n = 0; n < 2; ++n) { \
        if constexpr (F8) { const i32x8 fa_ = PG8_F8CAT(Bt[n]), fb_ = PG8_F8CAT(At[m]); asm volatile("v_mfma_scale_f32_16x16x128_f8f6f4 %0, %1, %2, %0, %3, %3 op_sel_hi:[0,0,0]" : "+v"(acc[ai][bj][m][n]) : "v"(fa_), "v"(fb_), "v"(f8one)); } \
        else { _Pragma("unroll") for (int k = 0; k < 2; ++k) acc[ai][bj][m][n] = __builtin_amdgcn_mfma_f32_16x16x32_bf16(Bt[n][k], At[m][k], acc[ai][bj][m][n], 0, 0, 0); } } \
        __builtin_amdgcn_s_setprio(0); } while (0)
#define PG8_WAIT_V(n) asm volatile("s_waitcnt vmcnt(" #n ")" ::: "memory")
#define PG8_WAIT_L(n) asm volatile("s_waitcnt lgkmcnt(" #n ")" ::: "memory")
#define PG8_BAR __builtin_amdgcn_s_barrier()
#define PG8_SCHED __builtin_amdgcn_sched_barrier(0)
    int f8one = 0x7f7f7f7f; asm volatile("" : "+v"(f8one));
    Unit cur, nxt; int ui = 0;
    if (!S.next(0, cur)) return;
    f32x4 acc[2][2][4][2];
#pragma unroll
    for (int a = 0; a < 2; ++a)
#pragma unroll
        for (int b = 0; b < 2; ++b)
#pragma unroll
            for (int m = 0; m < 4; ++m)
#pragma unroll
                for (int n = 0; n < 2; ++n) acc[a][b][m][n] = (f32x4){0.f, 0.f, 0.f, 0.f};
    bf16x8 At[4][2], B0[2][2], B1[2][2];
    const char* cA = (const char*)g.A + S.aoff(cur); const char* cB = (const char*)g.Bt + S.boff(cur);
    if constexpr (SP2) {
        PG8_STAGE(PG8_SB(0, 0), cB, voffB); PG8_STAGE(PG8_SB(0, 1), cB + hstepB, voffB); PG8_STAGE(PG8_SA(0, 0), cA, voffA); PG8_STAGE(PG8_SA(0, 1), cA + hstepA, voffA);
        if (wr == 1) PG8_BAR;
        PG8_WAIT_V(2); PG8_BAR;
        PG8_STAGE(PG8_SB(1, 0), cB + kstep, voffB); PG8_STAGE(PG8_SA(1, 0), cA + kstep, voffA); PG8_STAGE(PG8_SB(1, 1), cB + hstepB + kstep, voffB);
        PG8_WAIT_V(6); PG8_BAR;
    } else {
        PG8_STAGE(PG8_SB(0, 0), cB, voffB); PG8_STAGE(PG8_SA(0, 0), cA, voffA); PG8_STAGE(PG8_SB(0, 1), cB + hstepB, voffB); PG8_STAGE(PG8_SA(0, 1), cA + hstepA, voffA);
        if (wr == 1) PG8_BAR;
        PG8_WAIT_V(4); PG8_BAR;
        PG8_STAGE(PG8_SB(1, 0), cB + kstep, voffB); PG8_STAGE(PG8_SA(1, 0), cA + kstep, voffA); PG8_STAGE(PG8_SB(1, 1), cB + hstepB + kstep, voffB);
        PG8_WAIT_V(6); PG8_BAR;
    }
    for (;;) {
        const bool has_next = S.next(ui + 1, nxt);
        const char* nA = has_next ? (const char*)g.A + S.aoff(nxt) : cA; const char* nB = has_next ? (const char*)g.Bt + S.boff(nxt) : cB;
#pragma nounroll
        for (int t = 0; t < nt; t += 2) {
            const bool last = (t == nt - 2);
            const char* a1 = cA + (size_t)(t + 1) * kstep;
            const char* a2 = last ? nA : cA + (size_t)(t + 2) * kstep; const char* b2 = last ? nB : cB + (size_t)(t + 2) * kstep;
            const char* a3 = a2 + kstep; const char* b3 = b2 + kstep;
            if constexpr (SP2) {
            PG8_LDB(B0, 0, 0); PG8_LDB(B1, 0, 1); PG8_SCHED; PG8_LDA(At, 0, 0); PG8_STAGE(PG8_SA(1, 1), a1 + hstepA, voffA);
            PG8_WAIT_V(8); PG8_WAIT_L(0); PG8_BAR; PG8_MMA(0, 0, At, B0); PG8_MMA(0, 1, At, B1); PG8_BAR; PG8_SCHED;
            PG8_LDA(At, 0, 1); PG8_STAGE(PG8_SB(0, 0), b2, voffB); PG8_STAGE(PG8_SB(0, 1), b2 + hstepB, voffB); PG8_STAGE(PG8_SA(0, 0), a2, voffA);
            PG8_WAIT_V(8); PG8_WAIT_L(0); PG8_BAR; PG8_MMA(1, 0, At, B0); PG8_MMA(1, 1, At, B1); PG8_BAR; PG8_SCHED;
            PG8_LDB(B0, 1, 0); PG8_LDB(B1, 1, 1); PG8_SCHED; PG8_LDA(At, 1, 0); PG8_STAGE(PG8_SA(0, 1), a2 + hstepA, voffA);
            PG8_WAIT_V(8); PG8_WAIT_L(0); PG8_BAR; PG8_MMA(0, 0, At, B0); PG8_MMA(0, 1, At, B1); PG8_BAR; PG8_SCHED;
            PG8_LDA(At, 1, 1); PG8_STAGE(PG8_SB(1, 0), b3, voffB); PG8_STAGE(PG8_SB(1, 1), b3 + hstepB, voffB); PG8_STAGE(PG8_SA(1, 0), a3, voffA);
            PG8_WAIT_V(8); PG8_WAIT_L(0); PG8_BAR; PG8_MMA(1, 0, At, B0); PG8_MMA(1, 1, At, B1); PG8_BAR; PG8_SCHED;
            } else {
            PG8_LDB(B0, 0, 0); PG8_SCHED; PG8_LDA(At, 0, 0); PG8_STAGE(PG8_SA(1, 1), a1 + hstepA, voffA);
            PG8_WAIT_L(8); PG8_BAR; PG8_WAIT_L(0); PG8_MMA(0, 0, At, B0); PG8_BAR; PG8_SCHED;
            PG8_LDB(B1, 0, 1); PG8_STAGE(PG8_SB(0, 0), b2, voffB);
            PG8_BAR; PG8_WAIT_L(0); PG8_MMA(0, 1, At, B1); PG8_BAR;
            PG8_LDA(At, 0, 1); PG8_STAGE(PG8_SA(0, 0), a2, voffA);
            PG8_BAR; PG8_WAIT_L(0); PG8_MMA(1, 0, At, B0); PG8_BAR; PG8_SCHED;
            PG8_STAGE(PG8_SB(0, 1), b2 + hstepB, voffB);
            PG8_WAIT_V(6); PG8_BAR; PG8_MMA(1, 1, At, B1); PG8_BAR;
            PG8_LDB(B0, 1, 0); PG8_SCHED; PG8_LDA(At, 1, 0); PG8_STAGE(PG8_SA(0, 1), a2 + hstepA, voffA);
            PG8_WAIT_L(8); PG8_BAR; PG8_WAIT_L(0); PG8_MMA(0, 0, At, B0); PG8_BAR; PG8_SCHED;
            PG8_LDB(B1, 1, 1); PG8_STAGE(PG8_SB(1, 0), b3, voffB);
            PG8_BAR; PG8_WAIT_L(0); PG8_MMA(0, 1, At, B1); PG8_BAR;
            PG8_LDA(At, 1, 1); PG8_STAGE(PG8_SA(1, 0), a3, voffA);
            PG8_BAR; PG8_WAIT_L(0); PG8_MMA(1, 0, At, B0); PG8_BAR; PG8_SCHED;
            PG8_STAGE(PG8_SB(1, 1), b3 + hstepB, voffB);
            PG8_WAIT_V(6); PG8_BAR; PG8_MMA(1, 1, At, B1); PG8_BAR;
            }
        }
        if constexpr (ALIGN_EPI) { if (wr == 0) PG8_BAR; }
        if constexpr (F8) asm volatile("s_nop 15\n\ts_nop 15" ::: "memory");
        E(acc, cur, wr, wc, fr, fq);
        if (!has_next) break;
#pragma unroll
        for (int a = 0; a < 2; ++a)
#pragma unroll
            for (int b = 0; b < 2; ++b)
#pragma unroll
                for (int m = 0; m < 4; ++m)
#pragma unroll
                    for (int n = 0; n < 2; ++n) acc[a][b][m][n] = (f32x4){0.f, 0.f, 0.f, 0.f};
        cur = nxt; cA = nA; cB = nB; ++ui;
        if constexpr (ALIGN_EPI) { if (wr == 1) PG8_BAR; }
    }
    PG8_WAIT_V(0);
    if constexpr (!ALIGN_EPI) { if (wr == 0) PG8_BAR; }
    PG8_BAR;
#undef PG8_SA
#undef PG8_SB
#undef PG8_STAGE
#undef PG8_LDA
#undef PG8_LDB
#undef PG8_MMA
#undef PG8_F8CAT
#undef PG8_WAIT_V
#undef PG8_WAIT_L
#undef PG8_BAR
#undef PG8_SCHED
}
}

struct Args { const void* in[24]; float* out; unsigned char* ws; int ph_lo, ph_hi; };
struct Frame {
    LAS unsigned char* lds; unsigned* ctl; unsigned char* ws;
    int tid, lane, wave, G, bid;
};
#define INF(k) ((const float*)args.in[k])
DI float wave_sum(float v) {
#pragma unroll
    for (int o = 1; o < 64; o <<= 1) v += __shfl_xor(v, o);
    return v;
}

constexpr float F8_WSCALE = 64.0f;
DI void tr_item(const float* W, int ldS, int Nvalid, bf16* WT, int ldD, int koff, int mode, int roff, LAS float* scr, int k0, int n0, int lane, bool f8 = false) {
    const int nl = n0 + (lane & 31);
    float tv[32]; const float* wp = W + (size_t)(k0 + (lane >> 5)) * ldS + nl; const bool ok = nl < Nvalid;
#pragma unroll
    for (int i = 0; i < 32; ++i) tv[i] = ok ? __builtin_nontemporal_load(wp + (size_t)(2 * i) * ldS) : 0.f;
#pragma unroll
    for (int i = 0; i < 32; ++i) scr[(2 * i + (lane >> 5)) * 33 + (lane & 31)] = tv[i];
    LDS_WAIT(); asm volatile("" ::: "memory");
    const int c = lane & 7;
#pragma unroll
    for (int j = 0; j < 4; ++j) { const int nn = (lane >> 3) + 8 * j, n = n0 + nn; const LAS float* s = scr + (8 * c) * 33 + nn;
        u32x4 o; o.x = pk2(s[0 * 33], s[1 * 33]); o.y = pk2(s[2 * 33], s[3 * 33]); o.z = pk2(s[4 * 33], s[5 * 33]); o.w = pk2(s[6 * 33], s[7 * 33]);
        int row = mode == 0 ? roff + n : (mode == 1 ? (n < C_PADLO ? n : n + (C_P - C_PADLO)) : ((n >> 7) << 8) + roff + (n & 127));
        bool f8c = f8; bf16* WTc = WT;
        if (mode == 1) { if (row < 3072) { f8c = true; WTc = (bf16*)((unsigned char*)WT + WIN_F8); } else if (row >= C_P) { f8c = true; WTc = (bf16*)((unsigned char*)WT + WIN_F8); row = 3072 + (row - C_P); } else row -= 3072; }
        if (n < Nvalid) { if (f8c) { u32x2 o8; o8.x = pk4_fp8(s[0 * 33] * F8_WSCALE, s[1 * 33] * F8_WSCALE, s[2 * 33] * F8_WSCALE, s[3 * 33] * F8_WSCALE); o8.y = pk4_fp8(s[4 * 33] * F8_WSCALE, s[5 * 33] * F8_WSCALE, s[6 * 33] * F8_WSCALE, s[7 * 33] * F8_WSCALE);
                *(u32x2*)((unsigned char*)WTc + (size_t)row * ldD + koff + k0 + 8 * c) = o8; }
            else *(u32x4*)(WTc + (size_t)row * ldD + koff + k0 + 8 * c) = o; } }
    LDS_WAIT(); asm volatile("" ::: "memory");
}
constexpr int NB_IN = (NIN + 31) / 32;
constexpr int CI_IN = 32 * NB_IN, CI_OUT = 96 * 64, CI_POOL = 8 * 8 * 16, CI_LRU = 64 * 8, CI_GU = 2 * 32 * 172, CI_DN = 86 * 64, CI_MGU = 16 * 32 * 224, CI_MDN = 8 * 112 * 64;
constexpr int CE_0 = CI_IN + CI_POOL + CI_LRU;
constexpr int CE_1 = CE_0 + CI_OUT;
constexpr int CE_2 = CE_1 + CI_GU;
constexpr int CE_3 = CE_2 + CI_DN;
constexpr int CE_4 = CE_3 + CI_IN;
constexpr int CE_5 = CE_4 + CI_OUT;
constexpr int CE_6 = CE_5 + CI_MGU;
constexpr int CE_7 = CE_6 + CI_MDN;
constexpr int IP_A = 96 * 8 * 10;
constexpr int MOE_EARLY = CE_2 - CE_0;
constexpr int P2_ITEMS = 224 * 8 * 4;
DI void conv_item(unsigned char* ws, const Args& args, int idx, LAS float* scr, int lane) {
    const float* W; bf16* WT; int ldS, Nv, ldD, koff = 0, mode = 0, roff = 0, kb, nb; int r = idx; bool f8 = false;
    if (r < CI_IN) { kb = r / NB_IN; nb = r % NB_IN; W = INF(2); ldS = NIN; Nv = NIN; WT = (bf16*)(ws + WS_WIN); ldD = DM; mode = 1; }
    else if ((r -= CI_IN) < CI_POOL) { const int lg = r >> 7, q = r & 127; kb = q >> 4; nb = q & 15; W = INF(4) + (size_t)lg * 512 * 512; ldS = 512; Nv = 512; WT = (bf16*)(ws + WS_WPOOL) + (size_t)(lg >> 2) * 2048 * 512; ldD = 512; roff = (lg & 3) * 512; }
    else if ((r -= CI_POOL) < CI_LRU) { const int cmb = r >> 3, q = r & 7, l = cmb >> 5, which = (cmb >> 4) & 1, n = cmb & 15; kb = q >> 2; nb = q & 3;
        W = (which ? INF(10) : INF(8)) + ((size_t)l * 16 + n) * 128 * 128; ldS = 128; Nv = 128; WT = (bf16*)(ws + WS_WLRU) + (size_t)l * 4096 * 256; ldD = 256; koff = (n & 1) * 128; roff = n * 256 + which * 128; }
    else if ((r -= CI_LRU) < CI_OUT) { kb = r >> 6; nb = r & 63; W = INF(3); ldS = DM; Nv = DM; WT = (bf16*)(ws + WS_WOUT); ldD = MIXW; f8 = true; }
    else if ((r -= CI_OUT) < CI_GU) { const int which = r / (32 * 172), q = r % (32 * 172); kb = q / 172; nb = q % 172; W = which ? INF(18) : INF(17); ldS = DFF; Nv = DFF; WT = (bf16*)(ws + WS_WGU); ldD = DM; mode = 2; roff = which * 128; }
    else if ((r -= CI_GU) < CI_DN) { kb = r >> 6; nb = r & 63; W = INF(19); ldS = DM; Nv = DM; WT = (bf16*)(ws + WS_WDN); ldD = DFF; }
    else if ((r -= CI_DN) < CI_IN) { kb = r / NB_IN; nb = r % NB_IN; W = INF(2) + (size_t)DM * NIN; ldS = NIN; Nv = NIN; WT = (bf16*)(ws + WS_WIN + WIN_LAYER); ldD = DM; mode = 1; }
    else if ((r -= CI_IN) < CI_OUT) { kb = r >> 6; nb = r & 63; W = INF(3) + (size_t)MIXW * DM; ldS = DM; Nv = DM; WT = (bf16*)(ws + WS_WOUT + (size_t)DM * MIXW); ldD = MIXW; f8 = true; }
    else if ((r -= CI_OUT) < CI_MGU) { const int ew = r / (32 * 224), q = r % (32 * 224), e = ew >> 1, which = ew & 1; kb = q / 224; nb = q % 224;
        W = (which ? INF(22) : INF(21)) + (size_t)e * DM * DEXP; ldS = DEXP; Nv = DEXP; WT = (bf16*)(ws + WS_MWGU + (size_t)e * 2 * DEXP * DM); ldD = DM; mode = 2; roff = which * 128; f8 = true; }
    else { r -= CI_MGU; const int e = r / (112 * 64), q = r % (112 * 64); kb = q >> 6; nb = q & 63; W = INF(23) + (size_t)e * DEXP * DM; ldS = DM; Nv = DM; WT = (bf16*)(ws + WS_MWDN + (size_t)e * DM * DEXP); ldD = DEXP; f8 = true; }
    tr_item(W, ldS, Nv, WT, ldD, koff, mode, roff, scr, 64 * kb, 32 * nb, lane, f8);
}
DI void conv_range(Frame& F, const Args& args, int i0, int i1, int wg0) {
    if (F.bid < wg0) return;
    LAS float* scr = (LAS float*)(F.lds + F.wave * 16384);
    const int gw = (F.bid - wg0) * 8 + F.wave, NGW = (F.G - wg0) * 8;
    for (int it = i0 + gw; it < i1; it += NGW) conv_item(F.ws, args, it, scr, F.lane);
}
DI void p0_prologue(Frame& F, const Args& args) {
    conv_range(F, args, 0, CE_0, 0);
    bf16* Wlru = (bf16*)(F.ws + WS_WLRU);
    const int gt = F.bid * 512 + F.tid, NT = F.G * 512;
    for (int i = gt; i < 2 * 4096 * 16; i += NT) { const int row = i >> 4, ch = i & 15, n = (row & 4095) >> 8;
        *(u32x4*)(Wlru + (size_t)row * 256 + ((n + 1) & 1) * 128 + ch * 8) = (u32x4){0u, 0u, 0u, 0u}; }
    float* cosA = (float*)(F.ws + WS_COSA); float* sinA = (float*)(F.ws + WS_SINA); float* cosI = (float*)(F.ws + WS_COSI); float* sinI = (float*)(F.ws + WS_SINI);
    for (int i = gt; i < MTOK * 96; i += NT) {
        const int tok = i / 96, j = i % 96; const bool isA = j < 64; const int fi = isA ? j : j - 64; const double dim = isA ? 128.0 : 64.0;
        const float inv = (float)pow(10000.0, -(double)(2 * fi) / dim);
        const float ang = (float)((const int*)args.in[1])[tok] * inv; const double a = (double)ang; const double nrev = rint(a * 0.15915494309189535); const double rr = a - nrev * 6.283185307179586;
        const float cv = (float)cos(rr), sv = (float)sin(rr);
        if (isA) { cosA[tok * 64 + fi] = cv; sinA[tok * 64 + fi] = sv; } else { cosI[tok * 32 + fi] = cv; sinI[tok * 32 + fi] = sv; }
    }
    float* c8 = (float*)(F.ws + WS_LRUC);
    for (int i = gt; i < 2 * DM; i += NT) { const float lam = INF(12)[i]; c8[i] = 8.0f * log1pf(expf(-lam)); }
    bf16* xb = (bf16*)(F.ws + WS_XB);
    for (int i = gt; i < MTOK * DM / 8; i += NT) { const f32x4 a = *(const f32x4*)(INF(0) + (size_t)i * 8), b = *(const f32x4*)(INF(0) + (size_t)i * 8 + 4);
        u32x4 o; o.x = pk2(a[0], a[1]); o.y = pk2(a[2], a[3]); o.z = pk2(b[0], b[1]); o.w = pk2(b[2], b[3]); *(u32x4*)(xb + (size_t)i * 8) = o;
        u32x2 q; q.x = pk4_fp8(a[0], a[1], a[2], a[3]); q.y = pk4_fp8(b[0], b[1], b[2], b[3]); *(u32x2*)(F.ws + WS_X1 + (size_t)i * 8) = q; }
}

DI void ld8(const bf16* p, float (&v)[8]) { const u32x4 w = *(const u32x4*)p; v[0] = bflo(w.x); v[1] = bfhi(w.x); v[2] = bflo(w.y); v[3] = bfhi(w.y); v[4] = bflo(w.z); v[5] = bfhi(w.z); v[6] = bflo(w.w); v[7] = bfhi(w.w); }
DI void st8(bf16* p, const float (&v)[8]) { u32x4 o; o.x = pk2(v[0], v[1]); o.y = pk2(v[2], v[3]); o.z = pk2(v[4], v[5]); o.w = pk2(v[6], v[7]); *(u32x4*)p = o; }

DI void acc8(float (&s)[8], const u32x4& r, float m) { s[0] += m * bflo(r.x); s[1] += m * bfhi(r.x); s[2] += m * bflo(r.y); s[3] += m * bfhi(r.y); s[4] += m * bflo(r.z); s[5] += m * bfhi(r.z); s[6] += m * bflo(r.w); s[7] += m * bfhi(r.w); }
template <int G>
DI void pool_range(const bf16* proj, bf16* diff, int tok0, int c) {
    constexpr int W = 2 << G, NR = W - 1 + 16;
    const int tpos0 = tok0 & (SEQ - 1);
    const bf16* pp = proj + (size_t)tok0 * NINP + C_P + c;
    u32x4 r[NR];
#pragma unroll
    for (int i = 0; i < NR; ++i) { const int back = (W - 1) - i; r[i] = *(const u32x4*)(pp - (ptrdiff_t)((back > 0 && tpos0 - back < 0) ? 0 : back) * NINP); }
    float s[8];
#pragma unroll
    for (int k = 0; k < 8; ++k) s[k] = 0.f;
#pragma unroll
    for (int i = 0; i < W - 1; ++i) acc8(s, r[i], (tpos0 - ((W - 1) - i) >= 0) ? 1.f : 0.f);
#pragma unroll
    for (int t = 0; t < 16; ++t) {
        acc8(s, r[W - 1 + t], 1.f);
        const int tpos = tpos0 + t, cnt = (tpos + 1) < W ? (tpos + 1) : W; const float rc = 1.0f / (float)cnt; const u32x4 cur = r[W - 1 + t];
        float v[8] = {s[0] * rc - bflo(cur.x), s[1] * rc - bfhi(cur.x), s[2] * rc - bflo(cur.y), s[3] * rc - bfhi(cur.y), s[4] * rc - bflo(cur.z), s[5] * rc - bfhi(cur.z), s[6] * rc - bflo(cur.w), s[7] * rc - bfhi(cur.w)};
        st8(diff + (size_t)(tok0 + t) * DM + c, v);
        acc8(s, r[t], (tpos - (W - 1) >= 0) ? -1.f : 0.f);
    }
}
DI void p2_prep(Frame& F, const Args& args, int layer) {
    bf16* proj = (bf16*)(F.ws + WS_PROJ); bf16* diff = (bf16*)(F.ws + WS_DIFF); bf16* xc = (bf16*)(F.ws + WS_XC);
    const float* cosA = (const float*)(F.ws + WS_COSA); const float* sinA = (const float*)(F.ws + WS_SINA); const float* cosI = (const float*)(F.ws + WS_COSI); const float* sinI = (const float*)(F.ws + WS_SINI);
    const int gt = F.bid * 512 + F.tid, NT = F.G * 512;
    for (int it = gt; it < MTOK * 32; it += NT) {
        const int tok = it >> 5, dch = it & 7, hq = (it >> 3) & 3, d = dch * 8;
        const float* ct = cosA + tok * 64 + d; const float* st = sinA + tok * 64 + d;
        const f32x4 c0 = *(const f32x4*)ct, c1 = *(const f32x4*)(ct + 4), s0 = *(const f32x4*)st, s1 = *(const f32x4*)(st + 4);
        bf16* base = proj + (size_t)tok * NINP;
        u32x4 xa[5], xb_[5];
#pragma unroll
        for (int q = 0; q < 5; ++q) { bf16* p1 = base + (q < 4 ? C_Q + (hq * 4 + q) * 128 : C_K + hq * 128) + d; xa[q] = *(const u32x4*)p1; xb_[q] = *(const u32x4*)(p1 + 64); }
#pragma unroll
        for (int q = 0; q < 5; ++q) { bf16* p1 = base + (q < 4 ? C_Q + (hq * 4 + q) * 128 : C_K + hq * 128) + d;
            const float x1[8] = {bflo(xa[q].x), bfhi(xa[q].x), bflo(xa[q].y), bfhi(xa[q].y), bflo(xa[q].z), bfhi(xa[q].z), bflo(xa[q].w), bfhi(xa[q].w)};
            const float x2[8] = {bflo(xb_[q].x), bfhi(xb_[q].x), bflo(xb_[q].y), bfhi(xb_[q].y), bflo(xb_[q].z), bfhi(xb_[q].z), bflo(xb_[q].w), bfhi(xb_[q].w)};
            float y1[8], y2[8];
#pragma unroll
            for (int i = 0; i < 8; ++i) { const float c = i < 4 ? c0[i & 3] : c1[i & 3], s = i < 4 ? s0[i & 3] : s1[i & 3]; y1[i] = x1[i] * c - x2[i] * s; y2[i] = x2[i] * c + x1[i] * s; }
            st8(p1, y1); st8(p1 + 64, y2); }
    }
    for (int it = gt; it < MTOK * 16; it += NT) {
        const int tok = it >> 4, dch = it & 3, hq = (it >> 2) & 3, d = dch * 8;
        const float* ct = cosI + tok * 32 + d; const float* st = sinI + tok * 32 + d;
        const f32x4 c0 = *(const f32x4*)ct, c1 = *(const f32x4*)(ct + 4), s0 = *(const f32x4*)st, s1 = *(const f32x4*)(st + 4);
        bf16* base = proj + (size_t)tok * NINP;
        u32x4 xa[5], xb_[5];
#pragma unroll
        for (int q = 0; q < 5; ++q) { bf16* p1 = base + (q < 4 ? C_QI + (hq * 4 + q) * 64 : C_KI) + d; xa[q] = *(const u32x4*)p1; xb_[q] = *(const u32x4*)(p1 + 32); }
#pragma unroll
        for (int q = 0; q < 5; ++q) { if (q < 4 || hq == 0) { bf16* p1 = base + (q < 4 ? C_QI + (hq * 4 + q) * 64 : C_KI) + d;
            const float x1[8] = {bflo(xa[q].x), bfhi(xa[q].x), bflo(xa[q].y), bfhi(xa[q].y), bflo(xa[q].z), bfhi(xa[q].z), bflo(xa[q].w), bfhi(xa[q].w)};
            const float x2[8] = {bflo(xb_[q].x), bfhi(xb_[q].x), bflo(xb_[q].y), bfhi(xb_[q].y), bflo(xb_[q].z), bfhi(xb_[q].z), bflo(xb_[q].w), bfhi(xb_[q].w)};
            float y1[8], y2[8];
#pragma unroll
            for (int i = 0; i < 8; ++i) { const float c = i < 4 ? c0[i & 3] : c1[i & 3], s = i < 4 ? s0[i & 3] : s1[i & 3]; y1[i] = x1[i] * c - x2[i] * s; y2[i] = x2[i] * c + x1[i] * s; }
            st8(p1, y1); st8(p1 + 32, y2); } }
    }
    const float* cw = INF(6) + (size_t)layer * 4 * DM; const float* cb = INF(7) + (size_t)layer * DM;
    for (int it = gt; it < (MTOK / 16) * 256; it += NT) {
        const int cg = it & 255, c = cg * 8, tok0 = (it >> 8) * 16;
        const int g = cg >> 6;
        if (g == 0) pool_range<0>(proj, diff, tok0, c); else if (g == 1) pool_range<1>(proj, diff, tok0, c); else if (g == 2) pool_range<2>(proj, diff, tok0, c); else pool_range<3>(proj, diff, tok0, c);
    }
    for (int it = gt; it < (MTOK / 16) * 256; it += NT) {
        const int cg = it & 255, c = cg * 8, tok0 = (it >> 8) * 16, tpos0 = tok0 & (SEQ - 1);
        const bf16* px = proj + (size_t)tok0 * NINP + C_XR + c;
        u32x4 r[19];
#pragma unroll
        for (int i = 0; i < 19; ++i) { const int back = 3 - i; r[i] = *(const u32x4*)(px - (ptrdiff_t)((back > 0 && tpos0 - back < 0) ? 0 : back) * NINP); }
        f32x4 w0[4], w1[4]; const f32x4 b0 = *(const f32x4*)(cb + c), b1 = *(const f32x4*)(cb + c + 4);
#pragma unroll
        for (int jj = 0; jj < 4; ++jj) { w0[jj] = *(const f32x4*)(cw + jj * DM + c); w1[jj] = *(const f32x4*)(cw + jj * DM + c + 4); }
#pragma unroll
        for (int t = 0; t < 16; ++t) {
            float acc[8] = {b0[0], b0[1], b0[2], b0[3], b1[0], b1[1], b1[2], b1[3]};
#pragma unroll
            for (int jj = 0; jj < 4; ++jj) { const float m = (tpos0 + t - (3 - jj) >= 0) ? 1.f : 0.f; const u32x4 x = r[t + jj];
                acc[0] += m * bflo(x.x) * w0[jj][0]; acc[1] += m * bfhi(x.x) * w0[jj][1]; acc[2] += m * bflo(x.y) * w0[jj][2]; acc[3] += m * bfhi(x.y) * w0[jj][3];
                acc[4] += m * bflo(x.z) * w1[jj][0]; acc[5] += m * bfhi(x.z) * w1[jj][1]; acc[6] += m * bflo(x.w) * w1[jj][2]; acc[7] += m * bfhi(x.w) * w1[jj][3]; }
            st8(xc + (size_t)(tok0 + t) * DM + c, acc);
        }
    }
}

DI void p3_indexer(Frame& F) {
    const bf16* proj = (const bf16*)(F.ws + WS_PROJ); float* sc = (float*)(F.ws + WS_SC);
    const int gw = F.bid * 8 + F.wave, NGW = F.G * 8, l15 = F.lane & 15, l4 = F.lane >> 4;
    for (int u = gw; u < BATCH * 576; u += NGW) {
        const int b = u / 576, r = u % 576; int g8 = 0;
#pragma unroll
        for (int k = 1; k < 8; ++k) g8 = (r >= 8 * k * (k + 1)) ? k : g8;
        const int rr = r - 8 * g8 * (g8 + 1), sp = rr % (g8 + 1), qq = rr / (g8 + 1), qb16 = g8 * 16 + qq, c = qb16 >> 2;
        const int limit = (c + 1) * 64, kbeg = sp * 256, kend = (kbeg + 256) < limit ? (kbeg + 256) : limit;
        const int qtok = b * SEQ + qb16 * 16 + l15;
        const bf16* qrow = proj + (size_t)qtok * NINP;
        bf16x8 qf[16][2]; float w[16];
        { const u32x4 w0 = *(const u32x4*)(qrow + C_WI), w1 = *(const u32x4*)(qrow + C_WI + 8); const float s = 0.125f * 0.25f;
          w[0] = bflo(w0.x) * s; w[1] = bfhi(w0.x) * s; w[2] = bflo(w0.y) * s; w[3] = bfhi(w0.y) * s; w[4] = bflo(w0.z) * s; w[5] = bfhi(w0.z) * s; w[6] = bflo(w0.w) * s; w[7] = bfhi(w0.w) * s;
          w[8] = bflo(w1.x) * s; w[9] = bfhi(w1.x) * s; w[10] = bflo(w1.y) * s; w[11] = bfhi(w1.y) * s; w[12] = bflo(w1.z) * s; w[13] = bfhi(w1.z) * s; w[14] = bflo(w1.w) * s; w[15] = bfhi(w1.w) * s; }
#pragma unroll
        for (int h = 0; h < 16; ++h)
#pragma unroll
            for (int ks = 0; ks < 2; ++ks) qf[h][ks] = *(const bf16x8*)(qrow + C_QI + h * 64 + ks * 32 + l4 * 8);
        const bf16* kbase = proj + (size_t)(b * SEQ + l15) * NINP + C_KI + l4 * 8;
        bf16x8 nk0 = *(const bf16x8*)(kbase + (size_t)kbeg * NINP), nk1 = *(const bf16x8*)(kbase + (size_t)kbeg * NINP + 32);
        for (int k0 = kbeg; k0 < kend; k0 += 16) {
            const bf16x8 ka0 = nk0, ka1 = nk1;
            { const int kn = (k0 + 16 < kend) ? k0 + 16 : k0; nk0 = *(const bf16x8*)(kbase + (size_t)kn * NINP); nk1 = *(const bf16x8*)(kbase + (size_t)kn * NINP + 32); }
            f32x4 tot = {0.f, 0.f, 0.f, 0.f};
#pragma unroll
            for (int h = 0; h < 16; ++h) { f32x4 s = {0.f, 0.f, 0.f, 0.f};
                s = __builtin_amdgcn_mfma_f32_16x16x32_bf16(ka0, qf[h][0], s, 0, 0, 0); s = __builtin_amdgcn_mfma_f32_16x16x32_bf16(ka1, qf[h][1], s, 0, 0, 0);
#pragma unroll
                for (int j = 0; j < 4; ++j) tot[j] += w[h] * fmaxf(s[j], 0.f); }
            *(f32x4*)(sc + (size_t)qtok * SEQ + k0 + 4 * l4) = tot;
        }
    }
}

DI void p4_select(Frame& F) {
    const float* sc = (const float*)(F.ws + WS_SC); unsigned* mask = (unsigned*)(F.ws + WS_MASK);
    const int gw = F.bid * 8 + F.wave, NGW = F.G * 8, lane = F.lane;
    for (int tok = gw; tok < MTOK; tok += NGW) {
        const int tpos = tok & (SEQ - 1), limit = ((tpos >> 6) + 1) * 64, nw = limit >> 5;
        unsigned mw = 0u;
        if (limit <= 256) { mw = lane < nw ? 0xffffffffu : 0u; }
        else {
            unsigned key[32];
            if (lane < nw) { const float* p = sc + (size_t)tok * SEQ + lane * 32;
#pragma unroll
                for (int q = 0; q < 8; ++q) { const f32x4 v = *(const f32x4*)(p + 4 * q);
#pragma unroll
                    for (int j = 0; j < 4; ++j) { const unsigned uu = __float_as_uint(v[j]); key[4 * q + j] = (uu & 0x80000000u) ? ~uu : (uu | 0x80000000u); } } }
            else {
#pragma unroll
                for (int j = 0; j < 32; ++j) key[j] = 0u; }
            unsigned T = 0u; bool exact = false;
            for (int bit = 31; bit >= 0; --bit) {
                const unsigned cand = T | (1u << bit); int cnt = 0;
#pragma unroll
                for (int j = 0; j < 32; ++j) cnt += __popcll(__ballot(key[j] >= cand));
                if (cnt >= 256) { T = cand; if (cnt == 256) { exact = true; break; } }
            }
            unsigned gtw = 0u, eqw = 0u;
#pragma unroll
            for (int j = 0; j < 32; ++j) { gtw |= (key[j] > T) ? (1u << j) : 0u; eqw |= (key[j] == T) ? (1u << j) : 0u; }
            if (exact) { mw = gtw | eqw; }
            else {
                int ngt = 0;
#pragma unroll
                for (int j = 0; j < 32; ++j) ngt += __popcll(__ballot(key[j] > T));
                const int need = 256 - ngt; const int el = __popc(eqw);
                int pre = el;
#pragma unroll
                for (int o = 1; o < 64; o <<= 1) { const int t = __shfl_up(pre, o); pre += (lane >= o) ? t : 0; }
                int take = need - (pre - el); take = take < 0 ? 0 : (take > el ? el : take);
                unsigned sel = 0u, rem = eqw;
                for (int t = 0; t < 32; ++t) { if (t < take) { const unsigned low = rem & (0u - rem); sel |= low; rem ^= low; } }
                mw = gtw | sel;
            }
        }
        mask[(size_t)tok * 64 + lane] = mw;
    }
}

DI void p4_lru_pass1(Frame& F) {
    const unsigned* AB = (const unsigned*)(F.ws + WS_A); float* CP = (float*)(F.ws + WS_CARRY); float* CH = CP + BATCH * 64 * DM;
    for (int u = F.bid; u < BATCH * 64; u += F.G) {
        const int j = u & 63, b = u >> 6, c = 4 * F.tid;
        const size_t base = ((size_t)b * SEQ + j * 32) * DM + c;
        u32x4 w[32];
#pragma unroll
        for (int t = 0; t < 32; ++t) w[t] = *(const u32x4*)(AB + base + (size_t)t * DM);
        f32x4 P = {1.f, 1.f, 1.f, 1.f}, H = {0.f, 0.f, 0.f, 0.f};
#pragma unroll
        for (int t = 0; t < 32; ++t) { const f32x4 a = {__expf(bflo(w[t].x)), __expf(bflo(w[t].y)), __expf(bflo(w[t].z)), __expf(bflo(w[t].w))}, bb = {bfhi(w[t].x), bfhi(w[t].y), bfhi(w[t].z), bfhi(w[t].w)};
            H = a * H + bb; P = P * a; }
        *(f32x4*)(CP + ((size_t)b * 64 + j) * DM + c) = P; *(f32x4*)(CH + ((size_t)b * 64 + j) * DM + c) = H;
    }
}
DI void p5_lru_pass2(Frame& F) {
    const unsigned* AB = (const unsigned*)(F.ws + WS_A); const float* CP = (const float*)(F.ws + WS_CARRY); const float* CH = CP + BATCH * 64 * DM;
    const bf16* proj = (const bf16*)(F.ws + WS_PROJ); unsigned char* mrg = F.ws + WS_MRG;
    for (int u = F.bid; u < BATCH * 64; u += F.G) {
        const int j = u & 63, b = u >> 6, c = 4 * F.tid;
        f32x4 h = {0.f, 0.f, 0.f, 0.f};
#pragma unroll 8
        for (int jj = 0; jj < j; ++jj) { const f32x4 p = *(const f32x4*)(CP + ((size_t)b * 64 + jj) * DM + c), q = *(const f32x4*)(CH + ((size_t)b * 64 + jj) * DM + c); h = p * h + q; }
        const size_t tok0 = (size_t)b * SEQ + j * 32;
#pragma unroll 1
        for (int hs = 0; hs < 2; ++hs) {
            u32x4 w[16]; u32x2 gr[16], gg[16];
#pragma unroll
            for (int t = 0; t < 16; ++t) { const size_t tok = tok0 + hs * 16 + t; w[t] = *(const u32x4*)(AB + tok * DM + c); gr[t] = *(const u32x2*)(proj + tok * NINP + C_GR + c); gg[t] = *(const u32x2*)(proj + tok * NINP + C_G + 4096 + c); }
#pragma unroll
            for (int t = 0; t < 16; ++t) { const size_t tok = tok0 + hs * 16 + t;
                const f32x4 a = {__expf(bflo(w[t].x)), __expf(bflo(w[t].y)), __expf(bflo(w[t].z)), __expf(bflo(w[t].w))}, bb = {bfhi(w[t].x), bfhi(w[t].y), bfhi(w[t].z), bfhi(w[t].w)};
                h = a * h + bb;
                const unsigned o = pk4_fp8(h[0] * gelu_tanh_(bflo(gr[t].x)) * sigmoidf_(bflo(gg[t].x)), h[1] * gelu_tanh_(bfhi(gr[t].x)) * sigmoidf_(bfhi(gg[t].x)),
                                           h[2] * gelu_tanh_(bflo(gr[t].y)) * sigmoidf_(bflo(gg[t].y)), h[3] * gelu_tanh_(bfhi(gr[t].y)) * sigmoidf_(bfhi(gg[t].y)));
                *(unsigned*)(mrg + tok * MIXW + 4096 + c) = o; }
        }
    }
}

typedef short s16x4 __attribute__((ext_vector_type(4)));
constexpr int KS_STRIDE = 272, VS_STRIDE = 320, ATT_V = 64 * KS_STRIDE, ATT_BUF = 64 * KS_STRIDE + 64 * VS_STRIDE;
DI void p5_attention(Frame& F) {
    const bf16* proj = (const bf16*)(F.ws + WS_PROJ); const unsigned* mask = (const unsigned*)(F.ws + WS_MASK); unsigned char* mrg = F.ws + WS_MRG;
    const int lane = F.lane, l31 = lane & 31, hf = lane >> 5, wave = F.wave, hh = wave >> 1, qh = wave & 1, tid = F.tid;
    const float sc2 = 0.08838834764831845f * 1.4426950408889634f;
    const int gi = lane >> 4, i16 = lane & 15;
    const int vbase = ATT_V + (4 * (gi >> 1) + (i16 >> 2)) * VS_STRIDE + (16 * (gi & 1) + 4 * (i16 & 3)) * 2;
    const int sr0 = tid >> 4, sch = tid & 15;
    for (int u = F.bid; u < BATCH * 16 * 4; u += F.G) {
        const int g = u & 3, cp = (u >> 2) & 15, b = u >> 6;
        for (int half = 0; half < 2; ++half) {
            const int c = half ? (31 - cp) : cp, nkt = c + 1, head = g * 4 + hh;
            const int qtok = b * SEQ + c * 64 + qh * 32 + l31;
            const bf16* qrow = proj + (size_t)qtok * NINP + C_Q + head * 128 + hf * 8;
            bf16x8 qf[8];
#pragma unroll
            for (int ks = 0; ks < 8; ++ks) qf[ks] = *(const bf16x8*)(qrow + ks * 16);
            f32x16 o[4];
#pragma unroll
            for (int db = 0; db < 4; ++db)
#pragma unroll
                for (int i = 0; i < 16; ++i) o[db][i] = 0.f;
            float mrun = -1e30f, lrun = 0.f;
            const bf16* kg = proj + (size_t)(b * SEQ + sr0) * NINP + C_K + g * 128 + sch * 8;
            const bf16* vg = proj + (size_t)(b * SEQ + sr0) * NINP + C_V + g * 128 + sch * 8;
            u32x4 kr0 = *(const u32x4*)kg, kr1 = *(const u32x4*)(kg + (size_t)32 * NINP), vr0 = *(const u32x4*)vg, vr1 = *(const u32x4*)(vg + (size_t)32 * NINP);
            const unsigned* mrow = mask + (size_t)qtok * 64;
            unsigned mw0 = mrow[0], mw1 = mrow[1];
            { LAS unsigned char* B0 = F.lds;
              *(LAS u32x4*)(B0 + sr0 * KS_STRIDE + sch * 16) = kr0; *(LAS u32x4*)(B0 + (sr0 + 32) * KS_STRIDE + sch * 16) = kr1;
              *(LAS u32x4*)(B0 + ATT_V + sr0 * VS_STRIDE + sch * 16) = vr0; *(LAS u32x4*)(B0 + ATT_V + (sr0 + 32) * VS_STRIDE + sch * 16) = vr1; }
            __syncthreads();
            for (int kt = 0; kt < nkt; ++kt) {
                LAS unsigned char* Bc = F.lds + (kt & 1) * ATT_BUF; LAS unsigned char* Bn = F.lds + ((kt + 1) & 1) * ATT_BUF;
                const unsigned cm0 = mw0, cm1 = mw1; const bool more = kt + 1 < nkt;
                if (more) { const size_t adv = (size_t)(kt + 1) * 64 * NINP;
                    kr0 = *(const u32x4*)(kg + adv); kr1 = *(const u32x4*)(kg + adv + (size_t)32 * NINP); vr0 = *(const u32x4*)(vg + adv); vr1 = *(const u32x4*)(vg + adv + (size_t)32 * NINP);
                    mw0 = mrow[2 * kt + 2]; mw1 = mrow[2 * kt + 3]; }
                f32x16 s0, s1;
#pragma unroll
                for (int i = 0; i < 16; ++i) { s0[i] = 0.f; s1[i] = 0.f; }
#pragma unroll
                for (int ks = 0; ks < 8; ++ks) {
                    const bf16x8 ka = *(const LAS bf16x8*)(Bc + l31 * KS_STRIDE + ks * 32 + hf * 16);
                    const bf16x8 kb = *(const LAS bf16x8*)(Bc + (32 + l31) * KS_STRIDE + ks * 32 + hf * 16);
                    s0 = __builtin_amdgcn_mfma_f32_32x32x16_bf16(ka, qf[ks], s0, 0, 0, 0);
                    s1 = __builtin_amdgcn_mfma_f32_32x32x16_bf16(kb, qf[ks], s1, 0, 0, 0);
                }
                const unsigned sm0 = cm0 >> (4 * hf), sm1 = cm1 >> (4 * hf);
                float tmax = -INFINITY;
#pragma unroll
                for (int i = 0; i < 16; ++i) { const unsigned bit = 1u << ((i & 3) + 8 * (i >> 2));
                    s0[i] = (sm0 & bit) ? s0[i] * sc2 : -INFINITY; s1[i] = (sm1 & bit) ? s1[i] * sc2 : -INFINITY; tmax = fmaxf(tmax, fmaxf(s0[i], s1[i])); }
                tmax = fmaxf(tmax, __shfl_xor(tmax, 32));
                const float mnew = fmaxf(mrun, tmax), alpha = __builtin_amdgcn_exp2f(mrun - mnew); mrun = mnew;
                float psum = 0.f;
#pragma unroll
                for (int i = 0; i < 16; ++i) { s0[i] = __builtin_amdgcn_exp2f(s0[i] - mnew); s1[i] = __builtin_amdgcn_exp2f(s1[i] - mnew); psum += s0[i] + s1[i]; }
                lrun = lrun * alpha + psum;
                if (!__all(alpha == 1.0f)) {
#pragma unroll
                    for (int db = 0; db < 4; ++db)
#pragma unroll
                        for (int i = 0; i < 16; ++i) o[db][i] *= alpha; }
#pragma unroll
                for (int kb = 0; kb < 2; ++kb)
#pragma unroll
                    for (int s = 0; s < 2; ++s) {
                        u32x4 pw;
                        if (kb == 0) { pw.x = pk2(s0[8 * s], s0[8 * s + 1]); pw.y = pk2(s0[8 * s + 2], s0[8 * s + 3]); pw.z = pk2(s0[8 * s + 4], s0[8 * s + 5]); pw.w = pk2(s0[8 * s + 6], s0[8 * s + 7]); }
                        else { pw.x = pk2(s1[8 * s], s1[8 * s + 1]); pw.y = pk2(s1[8 * s + 2], s1[8 * s + 3]); pw.z = pk2(s1[8 * s + 4], s1[8 * s + 5]); pw.w = pk2(s1[8 * s + 6], s1[8 * s + 7]); }
                        const bf16x8 pf = __builtin_bit_cast(bf16x8, pw);
#pragma unroll
                        for (int db = 0; db < 4; ++db) {
                            LAS unsigned char* vp = Bc + vbase + (kb * 32 + 16 * s) * VS_STRIDE + db * 64;
                            const s16x4 lo = __builtin_amdgcn_ds_read_tr16_b64_v4i16((LAS s16x4*)vp), hi = __builtin_amdgcn_ds_read_tr16_b64_v4i16((LAS s16x4*)(vp + 8 * VS_STRIDE));
                            const bf16x8 vf = __builtin_shufflevector(lo, hi, 0, 1, 2, 3, 4, 5, 6, 7);
                            o[db] = __builtin_amdgcn_mfma_f32_32x32x16_bf16(vf, pf, o[db], 0, 0, 0);
                        }
                    }
                if (more) {
                    *(LAS u32x4*)(Bn + sr0 * KS_STRIDE + sch * 16) = kr0; *(LAS u32x4*)(Bn + (sr0 + 32) * KS_STRIDE + sch * 16) = kr1;
                    *(LAS u32x4*)(Bn + ATT_V + sr0 * VS_STRIDE + sch * 16) = vr0; *(LAS u32x4*)(Bn + ATT_V + (sr0 + 32) * VS_STRIDE + sch * 16) = vr1; }
                __syncthreads();
            }
            const float ltot = lrun + __shfl_xor(lrun, 32), rl = 1.0f / ltot;
            const bf16* grow = proj + (size_t)qtok * NINP + C_G + head * 128; unsigned char* orow = mrg + (size_t)qtok * MIXW + head * 128;
#pragma unroll
            for (int db = 0; db < 4; ++db)
#pragma unroll
                for (int q4 = 0; q4 < 4; ++q4) { const int d0 = db * 32 + q4 * 8 + hf * 4; const u32x2 gv = *(const u32x2*)(grow + d0);
                    *(unsigned*)(orow + d0) = pk4_fp8(o[db][4 * q4] * rl * sigmoidf_(bflo(gv.x)), o[db][4 * q4 + 1] * rl * sigmoidf_(bfhi(gv.x)), o[db][4 * q4 + 2] * rl * sigmoidf_(bflo(gv.y)), o[db][4 * q4 + 3] * rl * sigmoidf_(bfhi(gv.y))); }
        }
    }
    __syncthreads();
}

template <int MODE, bool ROUTE, bool WRITE_BF, bool WRITE_F32, bool WRITE_F8 = false>
DI void p_layernorm(Frame& F, const Args& args, const float* src, const float* gam, const float* bet, float* outf, bf16* outb, unsigned char* outq = nullptr) {
    const int gw = F.bid * 8 + F.wave, NGW = F.G * 8, lane = F.lane;
    const unsigned* rt = (const unsigned*)(F.ws + WS_ROUTE); unsigned* rtw = (unsigned*)(F.ws + WS_ROUTE);
    LAS float* wr_l = (LAS float*)F.lds;
    LAS unsigned* cl = (LAS unsigned*)(F.lds + 65536);
    if (ROUTE) { for (int i = F.tid; i < DM * NEXP / 4; i += 512) *(LAS f32x4*)(wr_l + 4 * i) = *(const f32x4*)(INF(20) + 4 * i); if (F.tid < 8) cl[F.tid] = 0u; __syncthreads(); }
#define LN_COL(jj) (MODE == 1 ? (8 * lane + 512 * ((jj) >> 1) + 4 * ((jj) & 1)) : (4 * lane + 256 * (jj)))
    for (int row = gw; row < MTOK; row += NGW) {
        f32x4 v[8]; float s = 0.f;
        if (MODE == 0) {
#pragma unroll
            for (int j = 0; j < 8; ++j) v[j] = *(const f32x4*)(src + (size_t)row * DM + LN_COL(j));
        } else {
            const unsigned r0 = rt[RT_ROW + 2 * row], r1 = rt[RT_ROW + 2 * row + 1]; const float w0 = __uint_as_float(rt[RT_W + 2 * row]), w1 = __uint_as_float(rt[RT_W + 2 * row + 1]);
            const bf16* yb = (const bf16*)(F.ws + WS_YB);
            u32x4 pa[4][KSPLIT], pb[4][KSPLIT];
#pragma unroll
            for (int j = 0; j < 4; ++j)
#pragma unroll
                for (int ks = 0; ks < KSPLIT; ++ks) { pa[j][ks] = *(const u32x4*)(yb + ((size_t)ks * MOE_ROWS_MAX + r0) * DM + 8 * lane + 512 * j); pb[j][ks] = *(const u32x4*)(yb + ((size_t)ks * MOE_ROWS_MAX + r1) * DM + 8 * lane + 512 * j); }
#pragma unroll
            for (int j = 0; j < 4; ++j) { f32x4 a0 = {0.f, 0.f, 0.f, 0.f}, a1 = a0, b0 = a0, b1 = a0;
#pragma unroll
                for (int ks = 0; ks < KSPLIT; ++ks) { const u32x4 a = pa[j][ks], b = pb[j][ks];
                    a0 += (f32x4){bflo(a.x), bfhi(a.x), bflo(a.y), bfhi(a.y)}; a1 += (f32x4){bflo(a.z), bfhi(a.z), bflo(a.w), bfhi(a.w)};
                    b0 += (f32x4){bflo(b.x), bfhi(b.x), bflo(b.y), bfhi(b.y)}; b1 += (f32x4){bflo(b.z), bfhi(b.z), bflo(b.w), bfhi(b.w)}; }
                const u32x4 xr = *(const u32x4*)((const bf16*)src + (size_t)row * DM + 8 * lane + 512 * j);
                v[2 * j] = (f32x4){bflo(xr.x), bfhi(xr.x), bflo(xr.y), bfhi(xr.y)} * ALPHA + a0 * w0 + b0 * w1;
                v[2 * j + 1] = (f32x4){bflo(xr.z), bfhi(xr.z), bflo(xr.w), bfhi(xr.w)} * ALPHA + a1 * w0 + b1 * w1; }
        }
#pragma unroll
        for (int j = 0; j < 8; ++j) s += (v[j][0] + v[j][1]) + (v[j][2] + v[j][3]);
        const float mean = wave_sum(s) * (1.f / DM); float s2 = 0.f;
#pragma unroll
        for (int j = 0; j < 8; ++j) { v[j] = v[j] - mean; s2 += (v[j][0] * v[j][0] + v[j][1] * v[j][1]) + (v[j][2] * v[j][2] + v[j][3] * v[j][3]); }
        const float rstd = 1.0f / sqrtf(wave_sum(s2) * (1.f / DM) + LN_EPS);
        float lg[8];
#pragma unroll
        for (int e = 0; e < 8; ++e) lg[e] = 0.f;
#pragma unroll
        for (int j = 0; j < 8; ++j) { const int cc = LN_COL(j); const f32x4 gv = *(const f32x4*)(gam + cc), bv = *(const f32x4*)(bet + cc);
            const f32x4 y = v[j] * rstd * gv + bv; if (WRITE_F32) *(f32x4*)(outf + (size_t)row * DM + cc) = y;
            if (WRITE_BF) { u32x2 w; w.x = pk2(y[0], y[1]); w.y = pk2(y[2], y[3]); *(u32x2*)(outb + (size_t)row * DM + cc) = w; }
            if (WRITE_F8) *(unsigned*)(outq + (size_t)row * DM + cc) = pk4_fp8(y[0], y[1], y[2], y[3]);
            if (ROUTE) {
#pragma unroll
                for (int i = 0; i < 4; ++i) { const LAS float* wp = wr_l + (size_t)(cc + i) * 8; const f32x4 wa = *(const LAS f32x4*)wp, wb = *(const LAS f32x4*)(wp + 4); const float xv = y[i];
                    lg[0] += xv * wa[0]; lg[1] += xv * wa[1]; lg[2] += xv * wa[2]; lg[3] += xv * wa[3]; lg[4] += xv * wb[0]; lg[5] += xv * wb[1]; lg[6] += xv * wb[2]; lg[7] += xv * wb[3]; }
            }
            asm volatile("" ::: "memory"); }
        if (ROUTE) {
#pragma unroll
            for (int e = 0; e < 8; ++e) lg[e] = wave_sum(lg[e]);
            int e0 = 0; float l0 = lg[0];
#pragma unroll
            for (int e = 1; e < 8; ++e) if (lg[e] > l0) { l0 = lg[e]; e0 = e; }
            int e1 = 0; float l1 = -INFINITY;
#pragma unroll
            for (int e = 0; e < 8; ++e) if (e != e0 && lg[e] > l1) { l1 = lg[e]; e1 = e; }
            const float p1 = 1.0f / (1.0f + expf(l0 - l1)), p0 = 1.0f - p1;
            if (lane == 0) { const unsigned sl0 = __hip_atomic_fetch_add(cl + e0, 1u, __ATOMIC_RELAXED, __HIP_MEMORY_SCOPE_WORKGROUP), sl1 = __hip_atomic_fetch_add(cl + e1, 1u, __ATOMIC_RELAXED, __HIP_MEMORY_SCOPE_WORKGROUP);
                rtw[RT_E + 2 * row] = (unsigned)e0; rtw[RT_E + 2 * row + 1] = (unsigned)e1; rtw[RT_SLOT + 2 * row] = sl0; rtw[RT_SLOT + 2 * row + 1] = sl1;
                rtw[RT_W + 2 * row] = __float_as_uint(p0); rtw[RT_W + 2 * row + 1] = __float_as_uint(p1); }
        }
    }
#undef LN_COL
    if (ROUTE) { __syncthreads(); const int t2 = F.wave * 64 + lane_id_(); if (t2 < 8) rtw[RT_WGC + F.bid * 8 + t2] = cl[t2]; __syncthreads(); }
}

DI void p_moe_gather(Frame& F) {
    unsigned* rt = (unsigned*)(F.ws + WS_ROUTE);
    const bf16* x1b = (const bf16*)(F.ws + WS_X1B); bf16* am = (bf16*)(F.ws + WS_AMOE);
    LAS unsigned* pre = (LAS unsigned*)F.lds;
    LAS unsigned* tot = pre + 2048;
    const int lane = F.lane;
    __syncthreads();
    { const int e = F.wave; unsigned c[4]; unsigned s = 0u;
#pragma unroll
      for (int i = 0; i < 4; ++i) { const int b = 4 * lane + i; c[i] = b < F.G ? rt[RT_WGC + b * 8 + e] : 0u; s += c[i]; }
      unsigned inc = s;
#pragma unroll
      for (int o = 1; o < 64; o <<= 1) { const unsigned t = __shfl_up(inc, o); inc += (lane >= o) ? t : 0u; }
      unsigned ex = inc - s;
#pragma unroll
      for (int i = 0; i < 4; ++i) { pre[(4 * lane + i) * 8 + e] = ex; ex += c[i]; }
      if (lane == 63) tot[e] = inc; }
    __syncthreads();
    if (F.tid == 0) { unsigned t = 0u; for (int e = 0; e < 8; ++e) { tot[8 + e] = t; t += (tot[e] + 255u) >> 8; } }
    __syncthreads();
    if (F.bid == 0 && F.tid < 8) F.ctl[CW_CNT + F.tid] = tot[F.tid];
    const int gw = F.bid * 8 + F.wave, NGW = F.G * 8;
    for (int a = gw; a < MTOK * 2; a += NGW) {
        const int tok = a >> 1; const int e = (int)rt[RT_E + a], slot = (int)rt[RT_SLOT + a];
        const int bsrc = (tok % NGW) >> 3;
        const int row = (int)tot[8 + e] * 256 + (int)pre[bsrc * 8 + e] + slot;
        const u32x4* s = (const u32x4*)(x1b + (size_t)tok * DM) + 4 * lane; u32x4* d = (u32x4*)((unsigned char*)am + (size_t)row * DM) + 2 * lane;
        const u32x4 i0 = s[0], i1 = s[1], i2 = s[2], i3 = s[3];
        u32x4 o0, o1;
        o0.x = pk4_fp8(bflo(i0.x), bfhi(i0.x), bflo(i0.y), bfhi(i0.y)); o0.y = pk4_fp8(bflo(i0.z), bfhi(i0.z), bflo(i0.w), bfhi(i0.w)); o0.z = pk4_fp8(bflo(i1.x), bfhi(i1.x), bflo(i1.y), bfhi(i1.y)); o0.w = pk4_fp8(bflo(i1.z), bfhi(i1.z), bflo(i1.w), bfhi(i1.w));
        o1.x = pk4_fp8(bflo(i2.x), bfhi(i2.x), bflo(i2.y), bfhi(i2.y)); o1.y = pk4_fp8(bflo(i2.z), bfhi(i2.z), bflo(i2.w), bfhi(i2.w)); o1.z = pk4_fp8(bflo(i3.x), bfhi(i3.x), bflo(i3.y), bfhi(i3.y)); o1.w = pk4_fp8(bflo(i3.z), bfhi(i3.z), bflo(i3.w), bfhi(i3.w));
        d[0] = o0; d[1] = o1;
        if (lane == 0) rt[RT_ROW + a] = (unsigned)row;
    }
    for (int pr = gw; pr < 8 * 256; pr += NGW) { const int e = pr >> 8, i = pr & 255;
        const int row = (int)tot[8 + e] * 256 + (int)tot[e] + i, rend = ((int)tot[8 + e] + (((int)tot[e] + 255) >> 8)) * 256;
        if (row < rend) { u32x4* d = (u32x4*)((unsigned char*)am + (size_t)row * DM);
#pragma unroll
            for (int q = 0; q < 2; ++q) d[lane + 64 * q] = (u32x4){0u, 0u, 0u, 0u}; } }
    __syncthreads();
}

constexpr int NPH_LAYER = 12;
constexpr int NPHASES = 1 + 2 * NPH_LAYER;
#define IN(k) (lo <= (k) && (k) < hi)
#define RELAUNDER() do { int l_ = lane_id_(); asm volatile("" : "+v"(l_)); F.lane = l_; F.tid = F.wave * 64 + l_; } while (0)
#define STAMP(k) do { if (STAMP_PROBE && F.bid == 0 && xb_t0(F.wave)) ((volatile LAS unsigned*)(F.lds + LDSCTL_OFF + 512))[k] = (unsigned)__builtin_amdgcn_s_memrealtime(); } while (0)
#define SEAM(k) do { if (IN(k) && IN((k) + 1)) { xcd_barrier(bar); STAMP((k) + 1); } } while (0)
template <int LAYER>
DI void run_layer(Frame& F, const Args& args, const XcdBarrier& bar, const int lo, const int hi) {
    constexpr int P = 1 + NPH_LAYER * LAYER;
    bf16* proj = (bf16*)(F.ws + WS_PROJ); bf16* xb = (bf16*)(F.ws + WS_XB); unsigned char* mrg = F.ws + WS_MRG;
    float* x1 = (float*)(F.ws + WS_X1); bf16* x1b = (bf16*)(F.ws + WS_X1B); float* x2 = (float*)(F.ws + WS_X2); float* pre = (float*)(F.ws + WS_PRE);
    if (IN(P + 0)) {
        { pg8::Gemm g{(const bf16*)(F.ws + WS_X1), (const bf16*)(F.ws + WS_WIN + (size_t)LAYER * WIN_LAYER + WIN_F8), DM / 2, DM / 2, DM / 2};
          pg8::TileOrder S; S.init(MTOK / 256, NT8, F.G, F.bid, (size_t)256 * DM, (size_t)256 * DM);
          pg8::EpiBf16 E{proj, NINP, 0, 1.0f / F8_WSCALE, 12, 0, C_P};
          pg8::gemm_phase<pg8::EpiBf16, pg8::TileOrder, true>(F.lds, g, S, E, F.wave); }
        { pg8::Gemm g{xb, (const bf16*)(F.ws + WS_WIN + (size_t)LAYER * WIN_LAYER), DM, DM, DM};
          pg8::TileOrder S; S.init(MTOK / 256, NT16, F.G, F.bid, (size_t)256 * DM * 2, (size_t)256 * DM * 2);
          pg8::EpiBf16 E{proj, NINP, 0, 1.0f, 1 << 30, 3072, 0};
          pg8::gemm_phase(F.lds, g, S, E, F.wave); }
        RELAUNDER();
        if (LAYER == 0) { conv_range(F, args, CE_0, CE_0 + IP_A, 160); conv_range(F, args, CE_0 + IP_A, CE_2, 128); }
        else { conv_range(F, args, CE_5, CE_5 + IP_A, 160); conv_range(F, args, CE_5 + IP_A, CE_5 + MOE_EARLY, 128); }
    }
    SEAM(P + 0);
    if (IN(P + 1)) { RELAUNDER(); p2_prep(F, args, LAYER); }
    SEAM(P + 1);
    if (IN(P + 2)) {
        { pg8::Gemm g{(const bf16*)(F.ws + WS_DIFF), (const bf16*)(F.ws + WS_WPOOL) + (size_t)LAYER * 2048 * 512, DM, 512, 512};
          pg8::TileOrder S; S.init(MTOK / 256, 8, F.G, F.bid, (size_t)256 * DM * 2, (size_t)256 * 512 * 2, 2, (size_t)512 * 2);
          pg8::EpiPool E{mrg, proj, INF(5) + (size_t)LAYER * DM};
          pg8::gemm_phase(F.lds, g, S, E, F.wave); }
        if (LAYER == 0) STAMP(25);
        { pg8::Gemm g{(const bf16*)(F.ws + WS_XC), (const bf16*)(F.ws + WS_WLRU) + (size_t)LAYER * 4096 * 256, DM, 256, 256};
          pg8::TileOrder S; S.init(MTOK / 256, 16, F.G, F.bid, (size_t)256 * DM * 2, (size_t)256 * 256 * 2, 2, (size_t)256 * 2);
          pg8::EpiLru E{(unsigned*)(F.ws + WS_A), (const bf16*)(F.ws + WS_XC), INF(9) + (size_t)LAYER * DM, INF(11) + (size_t)LAYER * DM, (const float*)(F.ws + WS_LRUC) + (size_t)LAYER * DM};
          pg8::gemm_phase(F.lds, g, S, E, F.wave); }
        if (LAYER == 0) STAMP(26);
        RELAUNDER(); p3_indexer(F);
        if (LAYER == 0) STAMP(29);
        __syncthreads(); RELAUNDER(); if (LAYER == 0) conv_range(F, args, CE_3, CE_3 + P2_ITEMS, 32); else conv_range(F, args, CE_5 + MOE_EARLY, CE_5 + MOE_EARLY + P2_ITEMS, 32);
    }
    SEAM(P + 2);
    if (IN(P + 3)) { RELAUNDER(); p4_select(F); if (LAYER == 0) STAMP(27); RELAUNDER(); p4_lru_pass1(F); }
    SEAM(P + 3);
    if (IN(P + 4)) { RELAUNDER(); p5_attention(F); if (LAYER == 0) STAMP(28); RELAUNDER(); p5_lru_pass2(F); }
    SEAM(P + 4);
    if (IN(P + 5)) {
        pg8::Gemm g{(const bf16*)mrg, (const bf16*)(F.ws + WS_WOUT + (size_t)LAYER * DM * MIXW), MIXW / 2, MIXW / 2, MIXW / 2};
        pg8::TileOrder S; S.init(MTOK / 256, DM / 256, F.G, F.bid, (size_t)256 * MIXW, (size_t)256 * MIXW);
        pg8::EpiRes<LAYER == 1> E{pre, LAYER == 0 ? (const void*)INF(0) : (const void*)xb, DM, 1.0f / F8_WSCALE};
        pg8::gemm_phase<pg8::EpiRes<LAYER == 1>, pg8::TileOrder, true>(F.lds, g, S, E, F.wave);
    }
    SEAM(P + 5);
    if (IN(P + 6)) { RELAUNDER(); } if (IN(P + 6)) p_layernorm<0, LAYER == 1, true, false>(F, args, pre, INF(13) + LAYER * DM, INF(14) + LAYER * DM, nullptr, x1b);
    SEAM(P + 6);
    if constexpr (LAYER == 0) {
        if (IN(P + 7)) {
            pg8::Gemm g{x1b, (const bf16*)(F.ws + WS_WGU), DM, DM, DM};
            pg8::TileOrder S; S.init(MTOK / 256, 2 * DFF / 256, F.G, F.bid, (size_t)256 * DM * 2, (size_t)256 * DM * 2);
            pg8::EpiSwiglu E{(bf16*)(F.ws + WS_H), DFF};
            pg8::gemm_phase(F.lds, g, S, E, F.wave);
            RELAUNDER(); conv_range(F, args, CE_2, CE_3, 96); conv_range(F, args, CE_3 + P2_ITEMS, CE_5, 96);
        }
        SEAM(P + 7);
        if (IN(P + 8)) {
            pg8::Gemm g{(const bf16*)(F.ws + WS_H), (const bf16*)(F.ws + WS_WDN), DFF, DFF, DFF};
            pg8::TileOrder S; S.init(MTOK / 256, DM / 256, F.G, F.bid, (size_t)256 * DFF * 2, (size_t)256 * DFF * 2);
            pg8::EpiRes<true> E{pre, x1b, DM, 1.0f};
            pg8::gemm_phase(F.lds, g, S, E, F.wave);
        }
        SEAM(P + 8);
        if (IN(P + 9)) { RELAUNDER(); } if (IN(P + 9)) p_layernorm<0, false, true, false, true>(F, args, pre, INF(15), INF(16), nullptr, xb, F.ws + WS_X1);
        if (IN(P + 9) && IN(P + 12)) { xcd_barrier(bar); STAMP(P + 10); STAMP(P + 11); STAMP(P + 12); }
    } else {
        if (IN(P + 7)) { RELAUNDER(); conv_range(F, args, CE_5 + MOE_EARLY + P2_ITEMS, CE_7, 0); RELAUNDER(); p_moe_gather(F); }
        SEAM(P + 7);
        if (IN(P + 8)) {
            pg8::Gemm g{(const bf16*)(F.ws + WS_AMOE), (const bf16*)(F.ws + WS_MWGU), DM / 2, DM / 2, DM / 2};
            pg8::MoeOrder S; S.init(F.ctl + CW_CNT, 2 * DEXP / 256, 1, F.G, F.bid, (size_t)256 * DM, (size_t)2 * DEXP * DM, (size_t)256 * DM, 0);
            pg8::EpiSwigluF8 E{F.ws + WS_HMOE, DEXP, 1.0f / F8_WSCALE};
            pg8::gemm_phase<pg8::EpiSwigluF8, pg8::MoeOrder, true>(F.lds, g, S, E, F.wave);
        }
        SEAM(P + 8);
        if (IN(P + 9)) {
            pg8::Gemm g{(const bf16*)(F.ws + WS_HMOE), (const bf16*)(F.ws + WS_MWDN), DEXP / 2, DEXP / 2, DEXP / 2 / KSPLIT};
            pg8::MoeOrder S; S.init(F.ctl + CW_CNT, DM / 256, KSPLIT, F.G, F.bid, (size_t)256 * DEXP, (size_t)DM * DEXP, (size_t)256 * DEXP, (size_t)(DEXP / KSPLIT));
            pg8::EpiBf16 E{(bf16*)(F.ws + WS_YB), DM, (size_t)MOE_ROWS_MAX * DM, 1.0f / F8_WSCALE, 1 << 30, 0, 0};
            pg8::gemm_phase<pg8::EpiBf16, pg8::MoeOrder, true>(F.lds, g, S, E, F.wave);
        }
        SEAM(P + 9);
        if (IN(P + 10)) { RELAUNDER(); } if (IN(P + 10)) p_layernorm<1, false, false, true>(F, args, (const float*)x1b, INF(15) + DM, INF(16) + DM, args.out, nullptr);
    }
}
__global__ void __launch_bounds__(512, 2) fwd_kernel(Args args) {
    extern __shared__ __attribute__((aligned(16))) unsigned char lds_raw[];
    Frame F;
    F.lds = (LAS unsigned char*)lds_raw; F.ws = args.ws; F.ctl = (unsigned*)(args.ws + WS_CTL);
    F.wave = __builtin_amdgcn_readfirstlane((int)threadIdx.x >> 6); F.lane = lane_id_(); F.tid = F.wave * 64 + F.lane; F.G = gridDim.x; F.bid = blockIdx.x;
    volatile LAS unsigned* MISC = (volatile LAS unsigned*)(F.lds + LDSCTL_OFF);
    for (int u = F.tid; u < (LDS_BYTES - LDSCTL_OFF) / 4; u += 512) ((LAS unsigned*)(F.lds + LDSCTL_OFF))[u] = 0u;
    __syncthreads();
    const int lo = args.ph_lo, hi = args.ph_hi;
    XcdBarrier bar; bar.bar = F.ctl + CW_BAR; bar.x = 0; bar.st = nullptr; bar.wave = F.wave;
    if ((hi - lo) > 1) bar = xcd_barrier_post(F.ctl + CW_BAR, MISC + 8, F.wave);
    STAMP(0);
    if (IN(0)) { RELAUNDER(); p0_prologue(F, args); __syncthreads(); }
    SEAM(0);
    run_layer<0>(F, args, bar, lo, hi);
    run_layer<1>(F, args, bar, lo, hi);
#if STAMP_PROBE
    RELAUNDER();
    if (F.bid == 0) {
        asm volatile("s_waitcnt vmcnt(0)" ::: "memory"); __syncthreads();
        if (xb_t0(F.wave)) ((volatile LAS unsigned*)(F.lds + LDSCTL_OFF + 512))[NPHASES - 1] = (unsigned)__builtin_amdgcn_s_memrealtime();
        __syncthreads();
        volatile LAS unsigned* st = (volatile LAS unsigned*)(F.lds + LDSCTL_OFF + 512);
        const float ta = (float)(st[STAMP_A_HI] - st[STAMP_A_LO]) * 0.01f, tb = (float)(st[STAMP_B_HI] - st[STAMP_B_LO]) * 0.01f;
        const float da = __builtin_amdgcn_sqrtf(ta * 0.005f);
        for (int i = F.tid; i < DM; i += 512) args.out[i] += da;
        if (F.tid == 0) args.out[DM] += tb * 0.1f;
    }
#endif
}
#undef IN
#undef SEAM

extern "C" void kernel_launch(void* const* d_in, const int* in_sizes, int n_in, void* d_out, int out_size, void* d_ws, size_t ws_size, hipStream_t stream) {
    static int grid = 0;
    if (grid == 0) {
        if (n_in != 24 || out_size != MTOK * DM || ws_size < WS_END) { fprintf(stderr, "kernel_launch: unexpected problem (n_in %d, out %d, ws %zu, need %zu)\n", n_in, out_size, ws_size, (size_t)WS_END); grid = -1; return; }
        int dev = 0, cus = 0, per_cu = 0;
        if (hipGetDevice(&dev) != hipSuccess || hipDeviceGetAttribute(&cus, hipDeviceAttributeMultiprocessorCount, dev) != hipSuccess) { grid = -1; return; }
        if (hipFuncSetAttribute((const void*)fwd_kernel, hipFuncAttributeMaxDynamicSharedMemorySize, LDS_BYTES) != hipSuccess) { fprintf(stderr, "kernel_launch: hipFuncSetAttribute failed\n"); grid = -1; return; }
        if (hipOccupancyMaxActiveBlocksPerMultiprocessor(&per_cu, (const void*)fwd_kernel, 512, LDS_BYTES) != hipSuccess || per_cu < 1) fprintf(stderr, "kernel_launch: occupancy query reports %d\n", per_cu);
        (void)hipGetLastError();
        grid = cus;
    }
    if (grid < 0) return;
    (void)hipMemsetAsync((char*)d_ws + WS_CTL, 0, CTL_ZERO_BYTES, stream);
    Args a{};
    for (int i = 0; i < 24; ++i) a.in[i] = d_in[i];
    a.out = (float*)d_out; a.ws = (unsigned char*)d_ws;
#if MK_N_LAUNCHES == 1
    a.ph_lo = 0; a.ph_hi = NPHASES;
    hipLaunchKernelGGL(fwd_kernel, dim3(grid), dim3(512), LDS_BYTES, stream, a);
#else
    const int plist[] = {0, 1, 2, 3, 4, 5, 6, 7, 8, 9, 10, 13, 14, 15, 16, 17, 18, 19, 20, 21, 22, 23};
    for (int i = 0; i < (int)(sizeof(plist) / sizeof(int)); ++i) { a.ph_lo = plist[i]; a.ph_hi = plist[i] + 1; hipLaunchKernelGGL(fwd_kernel, dim3(grid), dim3(512), LDS_BYTES, stream, a); }
#endif
}
```
